# Optimizing an MI355X kernel written in HIP

```python
import jax, jax.numpy as jnp
from jax import lax
import numpy as np

D_MODEL = 1024
BATCH = 32
SEQ = 2048
DEPTH = 1
DEC_BATCH = 16
DEC_SEQ = 16
PAST_LEN = 4096

CHUNK = 64
EPS = 1e-6
NEG_INF = -1e30
H_A = 8
NOPE_DIM = 64
ROPE_DIM = 32
V_DIM = 64
Q_RANK = 256
KV_RANK = 256
ROPE_THETA = 10000.0
MLA_SCALE = (NOPE_DIM + ROPE_DIM) ** -0.5
Q_BLOCK = 128
H_B = 8
HD_B = 64
N_PREV_CHUNKS = 8
BAND_PAST = N_PREV_CHUNKS * CHUNK
BAND = (N_PREV_CHUNKS + 1) * CHUNK
REL_CLIP = 256
N_REL = 2 * REL_CLIP + 1
BAND_SCALE = HD_B ** -0.5
MIX_A = H_A * V_DIM
MIX_B = H_B * HD_B
MIX_WIDTH = MIX_A + MIX_B
IN_COLS = Q_RANK + KV_RANK + ROPE_DIM + 3 * MIX_B
SPLITS = (Q_RANK, Q_RANK + KV_RANK, Q_RANK + KV_RANK + ROPE_DIM)
D_FF = -(-8 * D_MODEL // (3 * 256)) * 256

kernel_name = "hymba_mla_chunkband_stream_step"


def rmsnorm(x, g):
    xf = x.astype(jnp.float32)
    xf = xf * lax.rsqrt(jnp.mean(xf * xf, axis=-1, keepdims=True) + EPS)
    return xf.astype(x.dtype) * g


def rope(x, pos):
    inv = ROPE_THETA ** (-jnp.arange(0, ROPE_DIM, 2, dtype=jnp.float32) / ROPE_DIM)
    ang = pos.astype(jnp.float32)[:, None] * inv[None, :]
    cos = jnp.cos(ang)[None, :, None, :]
    sin = jnp.sin(ang)[None, :, None, :]
    x1, x2 = jnp.split(x.astype(jnp.float32), 2, axis=-1)
    return jnp.concatenate([x1 * cos - x2 * sin, x1 * sin + x2 * cos], axis=-1).astype(x.dtype)


def head_group_inputs(xn, pos, w_in, g_q, w_uq, g_kv):
    b, s, _ = xn.shape
    h = xn @ w_in
    c_q, c_kv, k_r, qkv = jnp.split(h, SPLITS, axis=-1)
    q = (rmsnorm(c_q, g_q) @ w_uq).reshape(b, s, H_A, NOPE_DIM + ROPE_DIM)
    q_nope = q[..., :NOPE_DIM]
    q_rope = rope(q[..., NOPE_DIM:], pos)
    c_kv = rmsnorm(c_kv, g_kv)
    k_rope = rope(k_r[:, :, None, :], pos)[:, :, 0, :]
    q_b, k_b, v_b = [t.reshape(b, s, H_B, HD_B) for t in jnp.split(qkv, 3, axis=-1)]
    return q_nope, q_rope, c_kv, k_rope, q_b, k_b, v_b


def mla_core(q_nope, q_rope, k_nope, k_rope, v, mask):
    s = (jnp.einsum('bqhd,bkhd->bhqk', q_nope, k_nope)
         + jnp.einsum('bqhr,bkr->bhqk', q_rope, k_rope)).astype(jnp.float32) * MLA_SCALE
    if mask is not None:
        s = jnp.where(mask, s, NEG_INF)
    p = jax.nn.softmax(s, axis=-1).astype(v.dtype)
    return jnp.einsum('bhqk,bkhd->bqhd', p, v)


def mla_prompt(q_nope, q_rope, c_kv, k_rope, w_uk, w_uv):
    b, s = q_nope.shape[:2]
    k_nope = jnp.einsum('bkc,chd->bkhd', c_kv, w_uk)
    v = jnp.einsum('bkc,chd->bkhd', c_kv, w_uv)
    nb = s // Q_BLOCK
    key_chunk = jnp.arange(s) // CHUNK

    def one_block(args):
        qn, qr, blk = args
        q_chunk = (blk * Q_BLOCK + jnp.arange(Q_BLOCK)) // CHUNK
        mask = key_chunk[None, :] <= q_chunk[:, None]
        return mla_core(qn, qr, k_nope, k_rope, v, mask)

    qn = q_nope.reshape(b, nb, Q_BLOCK, H_A, NOPE_DIM).swapaxes(0, 1)
    qr = q_rope.reshape(b, nb, Q_BLOCK, H_A, ROPE_DIM).swapaxes(0, 1)
    out = lax.map(one_block, (qn, qr, jnp.arange(nb)))
    return out.swapaxes(0, 1).reshape(b, s, MIX_A)


def mla_sample(q_nope, q_rope, c_kv, k_rope, cache_ckv, cache_kr, w_uk, w_uv):
    b, s = q_nope.shape[:2]
    ckv_all = jnp.concatenate([cache_ckv, c_kv], axis=1)
    kr_all = jnp.concatenate([cache_kr, k_rope], axis=1)
    k_nope = jnp.einsum('bkc,chd->bkhd', ckv_all, w_uk)
    v = jnp.einsum('bkc,chd->bkhd', ckv_all, w_uv)
    return mla_core(q_nope, q_rope, k_nope, kr_all, v, None).reshape(b, s, MIX_A)


def band_core(q, k, v, dist, valid, rel_bias):
    bias = rel_bias[:, jnp.clip(dist, -REL_CLIP, REL_CLIP) + REL_CLIP]
    s = jnp.einsum('...qhd,...khd->...hqk', q, k).astype(jnp.float32) * BAND_SCALE \
        + bias.astype(jnp.float32)
    if valid is not None:
        s = jnp.where(valid, s, NEG_INF)
    p = jax.nn.softmax(s, axis=-1).astype(v.dtype)
    return jnp.einsum('...hqk,...khd->...qhd', p, v)


def band_prompt(q, k, v, rel_bias):
    b, s = q.shape[:2]
    nc = s // CHUNK
    qc = q.reshape(b, nc, CHUNK, H_B, HD_B)
    pad = jnp.zeros((b, BAND_PAST, H_B, HD_B), k.dtype)
    kp = jnp.concatenate([pad, k], axis=1).reshape(b, nc + N_PREV_CHUNKS, CHUNK, H_B, HD_B)
    vp = jnp.concatenate([pad, v], axis=1).reshape(b, nc + N_PREV_CHUNKS, CHUNK, H_B, HD_B)
    idx = jnp.arange(nc)[:, None] + jnp.arange(N_PREV_CHUNKS + 1)[None, :]
    kb = kp[:, idx].reshape(b, nc, BAND, H_B, HD_B)
    vb = vp[:, idx].reshape(b, nc, BAND, H_B, HD_B)
    dist = jnp.arange(CHUNK)[:, None] - (jnp.arange(BAND) - BAND_PAST)[None, :]
    key_chunk = jnp.arange(nc)[:, None] - N_PREV_CHUNKS + (jnp.arange(BAND) // CHUNK)[None, :]
    valid = (key_chunk >= 0)[:, None, None, :]
    out = band_core(qc, kb, vb, dist, valid, rel_bias)
    return out.reshape(b, s, MIX_B)


def band_sample(q, k, v, cache_k, cache_v, rel_bias):
    b, t = q.shape[:2]
    n_c = cache_k.shape[1]
    k_all = jnp.concatenate([cache_k, k], axis=1)
    v_all = jnp.concatenate([cache_v, v], axis=1)
    kpos = jnp.concatenate([jnp.arange(n_c) - n_c, jnp.arange(t)])
    dist = jnp.arange(t)[:, None] - kpos[None, :]
    return band_core(q, k_all, v_all, dist, None, rel_bias).reshape(b, t, MIX_B)


def layer_forward(x, pos, cache, w_in, g_attn, g_q, w_uq, g_kv, w_uk, w_uv, rel_bias,
                  g_out_a, g_out_b, w_out, g_ffn, w_gate, w_up, w_down):
    xn = rmsnorm(x, g_attn)
    q_nope, q_rope, c_kv, k_rope, q_b, k_b, v_b = head_group_inputs(xn, pos, w_in, g_q, w_uq, g_kv)
    if cache is None:
        out_a = mla_prompt(q_nope, q_rope, c_kv, k_rope, w_uk, w_uv)
        out_b = band_prompt(q_b, k_b, v_b, rel_bias)
        n_keep = min(BAND_PAST, x.shape[1])
        new_state = (c_kv, k_rope, k_b[:, x.shape[1] - n_keep:], v_b[:, x.shape[1] - n_keep:])
    else:
        cache_ckv, cache_kr, cache_bk, cache_bv = cache
        out_a = mla_sample(q_nope, q_rope, c_kv, k_rope, cache_ckv, cache_kr, w_uk, w_uv)
        out_b = band_sample(q_b, k_b, v_b, cache_bk, cache_bv, rel_bias)
        new_state = (c_kv, k_rope, k_b, v_b)
    mix = jnp.concatenate([rmsnorm(out_a, g_out_a), rmsnorm(out_b, g_out_b)], axis=-1)
    x = x + mix @ w_out
    h = rmsnorm(x, g_ffn)
    x = x + (jax.nn.silu(h @ w_gate) * (h @ w_up)) @ w_down
    return x, new_state


def setup_inputs(seed: int = 0) -> dict:
    key = jax.random.key(seed)
    ks = jax.random.split(key, 24)
    f32 = jnp.float32

    def nrm(k, shape, scale=1.0):
        return jax.random.normal(k, shape, f32) * scale

    def gain(k, shape):
        return 1.0 + 0.02 * jax.random.normal(k, shape, f32)

    n_band = min(BAND_PAST, PAST_LEN)
    return {
        "x_prompt": nrm(ks[0], (BATCH, SEQ, D_MODEL)),
        "x_sample": nrm(ks[1], (DEC_BATCH, DEC_SEQ, D_MODEL)),
        "cache_mla_ckv": nrm(ks[2], (DEPTH, DEC_BATCH, PAST_LEN, KV_RANK)),
        "cache_mla_krope": nrm(ks[3], (DEPTH, DEC_BATCH, PAST_LEN, ROPE_DIM)),
        "cache_band_k": nrm(ks[4], (DEPTH, DEC_BATCH, n_band, H_B, HD_B)),
        "cache_band_v": nrm(ks[5], (DEPTH, DEC_BATCH, n_band, H_B, HD_B)),
        "w_in": nrm(ks[6], (DEPTH, D_MODEL, IN_COLS), D_MODEL ** -0.5),
        "g_attn": gain(ks[7], (DEPTH, D_MODEL)),
        "g_q": gain(ks[8], (DEPTH, Q_RANK)),
        "w_uq": nrm(ks[9], (DEPTH, Q_RANK, H_A * (NOPE_DIM + ROPE_DIM)), Q_RANK ** -0.5),
        "g_kv": gain(ks[10], (DEPTH, KV_RANK)),
        "w_uk": nrm(ks[11], (DEPTH, KV_RANK, H_A, NOPE_DIM), KV_RANK ** -0.5),
        "w_uv": nrm(ks[12], (DEPTH, KV_RANK, H_A, V_DIM), KV_RANK ** -0.5),
        "rel_bias": nrm(ks[13], (DEPTH, H_B, N_REL), 0.5),
        "g_out_a": gain(ks[14], (DEPTH, MIX_A)),
        "g_out_b": gain(ks[15], (DEPTH, MIX_B)),
        "w_out": nrm(ks[16], (DEPTH, MIX_WIDTH, D_MODEL), MIX_WIDTH ** -0.5),
        "g_ffn": gain(ks[17], (DEPTH, D_MODEL)),
        "w_gate": nrm(ks[18], (DEPTH, D_MODEL, D_FF), D_MODEL ** -0.5),
        "w_up": nrm(ks[19], (DEPTH, D_MODEL, D_FF), D_MODEL ** -0.5),
        "w_down": nrm(ks[20], (DEPTH, D_FF, D_MODEL), D_FF ** -0.5),
        "g_final": gain(ks[21], (D_MODEL,)),
    }


def reference(x_prompt, x_sample, cache_mla_ckv, cache_mla_krope, cache_band_k, cache_band_v,
              w_in, g_attn, g_q, w_uq, g_kv, w_uk, w_uv, rel_bias, g_out_a, g_out_b, w_out,
              g_ffn, w_gate, w_up, w_down, g_final):
    past_len = cache_mla_ckv.shape[2]
    pos_p = jnp.arange(x_prompt.shape[1], dtype=jnp.int32)
    pos_s = past_len + jnp.arange(x_sample.shape[1], dtype=jnp.int32)
    yp, ys = x_prompt, x_sample
    st_p, st_s = [], []
    for l in range(DEPTH):
        w = (w_in[l], g_attn[l], g_q[l], w_uq[l], g_kv[l], w_uk[l], w_uv[l], rel_bias[l],
             g_out_a[l], g_out_b[l], w_out[l], g_ffn[l], w_gate[l], w_up[l], w_down[l])
        yp, sp = layer_forward(yp, pos_p, None, *w)
        ys, ss = layer_forward(ys, pos_s, (cache_mla_ckv[l], cache_mla_krope[l],
                                           cache_band_k[l], cache_band_v[l]), *w)
        st_p.append(sp)
        st_s.append(ss)
    y_prompt = rmsnorm(yp, g_final)
    y_sample = rmsnorm(ys, g_final)
    new_ckv_prompt = jnp.stack([s[0] for s in st_p])
    new_kr_prompt = jnp.stack([s[1] for s in st_p])
    new_bk_prompt = jnp.stack([s[2] for s in st_p])
    new_bv_prompt = jnp.stack([s[3] for s in st_p])
    new_ckv_sample = jnp.stack([s[0] for s in st_s])
    new_kr_sample = jnp.stack([s[1] for s in st_s])
    new_bk_sample = jnp.stack([s[2] for s in st_s])
    new_bv_sample = jnp.stack([s[3] for s in st_s])
    return (y_prompt, y_sample, new_ckv_prompt, new_kr_prompt, new_bk_prompt, new_bv_prompt,
            new_ckv_sample, new_kr_sample, new_bk_sample, new_bv_sample)
```

```cpp
#include <hip/hip_runtime.h>
#include <hip/hip_cooperative_groups.h>
#include <cstdio>
#include <cstdint>


namespace cg = cooperative_groups;

#define LAS __attribute__((address_space(3)))
typedef unsigned short bf16_t;
typedef short bf16x8 __attribute__((ext_vector_type(8)));
typedef short s16x4 __attribute__((ext_vector_type(4)));
typedef float f32x4 __attribute__((ext_vector_type(4)));
typedef float f32x16 __attribute__((ext_vector_type(16)));
typedef unsigned u32x4 __attribute__((ext_vector_type(4)));
typedef unsigned u32x2 __attribute__((ext_vector_type(2)));
typedef float f32x2_t __attribute__((ext_vector_type(2)));
typedef __bf16 bf16x2_t __attribute__((ext_vector_type(2)));

constexpr int D = 1024, NBATCH = 32, SEQ = 2048, MP = NBATCH * SEQ, DB = 16, DSQ = 16, MS = DB * DSQ, MT = MP + MS, PAST = 4096;
constexpr int NIN = 2304, FF = 2816, NGU = 2 * FF;
constexpr int LROW = 4352, BROW = 768;
constexpr int MLAT = MP + DB * LROW, MBND = MP + DB * BROW;
constexpr float EPS = 1e-6f, LOG2E = 1.4426950408889634f;
constexpr float QSCALE_A = 0.10206207261596575f * LOG2E;
constexpr float QSCALE_B = 0.125f * LOG2E;
constexpr int NTHREADS = 512;
constexpr size_t OFF_Y = 0, OFF_CKVP = (size_t)MT * D, OFF_KRP = OFF_CKVP + (size_t)MP * 256, OFF_BKP = OFF_KRP + (size_t)MP * 32,
                 OFF_BVP = OFF_BKP + (size_t)NBATCH * 512 * 512, OFF_CKVS = OFF_BVP + (size_t)NBATCH * 512 * 512, OFF_KRS = OFF_CKVS + (size_t)MS * 256,
                 OFF_BKS = OFF_KRS + (size_t)MS * 32, OFF_BVS = OFF_BKS + (size_t)MS * 512, OUT_TOTAL = OFF_BVS + (size_t)MS * 512;
constexpr size_t al256(size_t x) { return (x + 255) & ~(size_t)255; }
constexpr size_t WS_SSQ = 0;
constexpr size_t WS_WIN = al256(WS_SSQ + 4 * (size_t)MT * 4);
constexpr size_t WS_WUQ = al256(WS_WIN + (size_t)NIN * 1024 * 2);
constexpr size_t WS_WKV = al256(WS_WUQ + (size_t)768 * 256 * 2);
constexpr size_t WS_WO = al256(WS_WKV + (size_t)1024 * 256 * 2);
constexpr size_t WS_WGU = al256(WS_WO + (size_t)1024 * 1024 * 2);
constexpr size_t WS_WD = al256(WS_WGU + (size_t)NGU * 1024 * 2);
constexpr size_t WS_X1B = al256(WS_WD + (size_t)1024 * FF * 2);
constexpr size_t WS_XN = al256(WS_X1B + (size_t)MT * 1024 * 2);
constexpr size_t WS_CQN = al256(WS_XN + (size_t)MT * 1024 * 2);
constexpr size_t WS_CKV = al256(WS_CQN + (size_t)MT * 256 * 2);
constexpr size_t WS_KR = al256(WS_CKV + (size_t)MLAT * 256 * 2);
constexpr size_t WS_QB = al256(WS_KR + (size_t)MLAT * 32 * 2);
constexpr size_t WS_KB = al256(WS_QB + (size_t)MT * 512 * 2);
constexpr size_t WS_VB = al256(WS_KB + (size_t)MBND * 512 * 2);
constexpr size_t WS_Q = al256(WS_VB + (size_t)MBND * 512 * 2);
constexpr size_t WS_KN = al256(WS_Q + (size_t)MT * 768 * 2);
constexpr size_t WS_V = al256(WS_KN + (size_t)MLAT * 512 * 2);
constexpr size_t WS_END = al256(WS_V + (size_t)MLAT * 512 * 2);
constexpr size_t WS_BAR = WS_END;
constexpr size_t WS_TOTAL = WS_END + 16384;
constexpr size_t WS_H = WS_XN;
static_assert(WS_H + (size_t)MT * FF * 2 <= WS_VB, "H overlay must end before anything live in P5/P6 (nothing is, but keep it inside dead buffers)");
static_assert(WS_TOTAL <= (size_t)1073741824, "workspace");

constexpr int LDS_GEMM = 131072, LDS_RED = LDS_GEMM, LDS_BYTES = 143360;
constexpr int KP_A = 208, KP_B = 144;
constexpr int AT_TILE = 0, AT_PRIV = 21504  , AT_QT = 51200  , AT_BIAS = 104448, AT_WSF = 107008, AT_OSTG = 109056, AT_CMB = 141824;
static_assert(AT_CMB + 1024 <= LDS_BYTES, "attention LDS map");

struct Params {
  const float *xp, *xs, *c_ckv, *c_kr, *c_bk, *c_bv, *w_in, *g_attn, *g_q, *w_uq, *g_kv, *w_uk, *w_uv, *rel_bias, *g_out_a, *g_out_b, *w_out, *g_ffn,
      *w_gate, *w_up, *w_down, *g_final;
  float* out; unsigned char* ws;
};

typedef const __attribute__((address_space(4))) Params* ParamsC;
__device__ __forceinline__ unsigned f2bf(float f) { unsigned u = __builtin_bit_cast(unsigned, f); return (u + 0x7fffu + ((u >> 16) & 1u)) >> 16; }
__device__ __forceinline__ unsigned pk2(float lo, float hi) { f32x2_t v = {lo, hi}; bf16x2_t b = __builtin_convertvector(v, bf16x2_t); return __builtin_bit_cast(unsigned, b); }
__device__ __forceinline__ float bf2f(unsigned short b) { return __builtin_bit_cast(float, (unsigned)b << 16); }
__device__ __forceinline__ int maprow_lat(int row) { return row < MP ? row : MP + ((row - MP) >> 4) * LROW + PAST + ((row - MP) & 15); }
__device__ __forceinline__ int maprow_bnd(int row) { return row < MP ? row : MP + ((row - MP) >> 4) * BROW + 512 + ((row - MP) & 15); }
__device__ __forceinline__ int row_pos(int row) { return row < MP ? (row & (SEQ - 1)) : PAST + ((row - MP) & 15); }
__device__ __forceinline__ void rope_cs(int pos, int i, float& c, float& s) {
  const float inv = __builtin_amdgcn_exp2f(-(float)i * (13.287712379549449f / 16.0f));
  float rev = (float)pos * inv * 0.15915494309189535f; rev = rev - __builtin_floorf(rev);
  s = __builtin_amdgcn_sinf(rev); c = __builtin_amdgcn_cosf(rev);
}

namespace pg8 {
constexpr int BM = 256, BK = 64, HALF = 128, HTB = HALF * BK * 2, STAGE_BYTES = 8 * HTB, NXCD = 8, WGM = 8;
__host__ __device__ __forceinline__ int lds_byte(int r, int c) { const int st = (r >> 4) * 2 + (c >> 5), rr = r & 15, cc = c & 31, ob = rr * 64 + cc * 2; return st * 1024 + (ob ^ (((ob >> 9) & 1) << 5)); }
__host__ __device__ __forceinline__ void stage_rc(int b, int& R, int& C) { const int st = b / 1024, sb = b % 1024, swz = sb ^ (((sb >> 9) & 1) << 5); R = (st >> 1) * 16 + swz / 64; C = (st & 1) * 32 + (swz % 64) / 2; }
struct Unit { int pm, pn, koff; };
struct Gemm { const bf16_t* A; const bf16_t* Bt; int lda, ldb, K; };
struct StaticOrder {
  int nM, nN, nwg, G, c;
  __device__ void init(int M, int N, int G_, int c_) { nM = M / BM; nN = N / BM; nwg = nM * nN; G = G_; c = c_; }
  __device__ bool next(int i, Unit& u) const {
    const long L = (long)i * G + c; if (L >= nwg) return false;
    int wgid = (int)L; { const int q = nwg / NXCD, r = nwg % NXCD, xcd = wgid % NXCD, off = wgid / NXCD; wgid = (xcd < r ? xcd * (q + 1) : r * (q + 1) + (xcd - r) * q) + off; }
    const int nig = WGM * nN, gid = wgid / nig, fm = gid * WGM, gsz = (nM - fm) < WGM ? (nM - fm) : WGM;
    u.pm = fm + ((wgid % nig) % gsz); u.pn = (wgid % nig) / gsz; u.koff = 0; return true;
  }
};
struct SplitOrder {
  int pm, nN, nsub, kchunk, G, c;
  __device__ bool next(int i, Unit& u) const { const int s = i * G + c; if (s >= nsub) return false; u.pm = pm; u.pn = s % nN; u.koff = (s / nN) * kchunk; return true; }
};
template <class Epi, class Order>
__device__ __forceinline__ void gemm_phase(LAS unsigned char* lds, const Gemm g, const Order& S, Epi& E) {
  int tid_ = threadIdx.x; asm volatile("" : "+v"(tid_));
  const int tid = tid_, wid = __builtin_amdgcn_readfirstlane(tid >> 6), lane = tid & 63, wr = wid >> 2, wc = wid & 3, fr = lane & 15, fq = lane >> 4;
  int K_ = g.K; asm volatile("" : "+s"(K_));
  const int K = K_, nt = K / BK;
  int lda_ = g.lda, ldb_ = g.ldb; asm volatile("" : "+s"(lda_), "+s"(ldb_));
  unsigned voffA[2];
#pragma unroll
  for (int i = 0; i < 2; ++i) { int R, C; stage_rc(tid * 16 + i * 8192, R, C); voffA[i] = (unsigned)(R * lda_ + C) * 2u; }
  const size_t kstep = (size_t)(BK * 2), hstepA = (size_t)HALF * lda_ * 2, tstepA = 2 * hstepA, hstepB = (size_t)HALF * ldb_ * 2, tstepB = 2 * hstepB;
  const unsigned ldsw = (unsigned)wid * 1024u;
  const int aoff = lds_byte(wr * 64 + fr, fq * 8), boff = lds_byte(wc * 32 + fr, fq * 8);
#define PG8_SA(b, h) (((b) * 2 + (h)) * HTB)
#define PG8_SB(b, h) ((4 + (b) * 2 + (h)) * HTB)
#define PG8_STAGE_(bufoff, gbase, voff) do { _Pragma("unroll") for (int _i = 0; _i < 2; ++_i) \
    __builtin_amdgcn_global_load_lds((const unsigned*)((const char*)(gbase) + (voff)[_i]), (LAS unsigned*)(lds + (bufoff) + ldsw + _i * 8192), 16, 0, 0); } while (0)
#define PG8_STA(bufoff, gbase) PG8_STAGE_(bufoff, gbase, voffA)
#define PG8_STB(bufoff, gbase) PG8_STAGE_(bufoff, gbase, voffA)
#define PG8_LDA(dst, b, h) do { _Pragma("unroll") for (int m = 0; m < 4; ++m) _Pragma("unroll") for (int k = 0; k < 2; ++k) dst[m][k] = *(const LAS bf16x8*)(lds + PG8_SA(b, h) + aoff + m * 2048 + k * 1024); } while (0)
#define PG8_LDB(dst, b, h) do { _Pragma("unroll") for (int n = 0; n < 2; ++n) _Pragma("unroll") for (int k = 0; k < 2; ++k) dst[n][k] = *(const LAS bf16x8*)(lds + PG8_SB(b, h) + boff + n * 2048 + k * 1024); } while (0)
#define PG8_MMA(ai, bj, At, Bt) do { __builtin_amdgcn_s_setprio(1); _Pragma("unroll") for (int m = 0; m < 4; ++m) _Pragma("unroll") for (int n = 0; n < 2; ++n) _Pragma("unroll") for (int k = 0; k < 2; ++k) \
    acc[ai][bj][m][n] = __builtin_amdgcn_mfma_f32_16x16x32_bf16(Bt[n][k], At[m][k], acc[ai][bj][m][n], 0, 0, 0); __builtin_amdgcn_s_setprio(0); } while (0)
#define PG8_WAIT_V(n) asm volatile("s_waitcnt vmcnt(" #n ")" ::: "memory")
#define PG8_WAIT_L(n) asm volatile("s_waitcnt lgkmcnt(" #n ")" ::: "memory")
#define PG8_BAR __builtin_amdgcn_s_barrier()
#define PG8_SCHED __builtin_amdgcn_sched_barrier(0)
  Unit cur, nxt; int ui = 0;
  if (!S.next(0, cur)) return;
  f32x4 acc[2][2][4][2];
#pragma unroll
  for (int a = 0; a < 2; ++a)
#pragma unroll
    for (int b = 0; b < 2; ++b)
#pragma unroll
      for (int m = 0; m < 4; ++m)
#pragma unroll
        for (int n = 0; n < 2; ++n) acc[a][b][m][n] = (f32x4){0.f, 0.f, 0.f, 0.f};
  bf16x8 At[4][2], B0[2][2], B1[2][2];
  const char* cA = (const char*)g.A + (size_t)cur.pm * tstepA + (size_t)cur.koff * 2; const char* cB = (const char*)g.Bt + (size_t)cur.pn * tstepB + (size_t)cur.koff * 2;
  PG8_STB(PG8_SB(0, 0), cB); PG8_STB(PG8_SB(0, 1), cB + hstepB); PG8_STA(PG8_SA(0, 0), cA); PG8_STA(PG8_SA(0, 1), cA + hstepA);
  if (wr == 1) PG8_BAR;
  PG8_WAIT_V(2); PG8_BAR;
  PG8_STB(PG8_SB(1, 0), cB + kstep); PG8_STA(PG8_SA(1, 0), cA + kstep); PG8_STB(PG8_SB(1, 1), cB + hstepB + kstep);
  PG8_WAIT_V(6); PG8_BAR;
  for (;;) {
    const bool has_next = S.next(ui + 1, nxt);
    const char* nA = has_next ? (const char*)g.A + (size_t)nxt.pm * tstepA + (size_t)nxt.koff * 2 : cA; const char* nB = has_next ? (const char*)g.Bt + (size_t)nxt.pn * tstepB + (size_t)nxt.koff * 2 : cB;
    for (int t = 0; t < nt; t += 2) {
      const bool last = (t == nt - 2);
      const char* a1 = cA + (size_t)(t + 1) * kstep;
      const char* a2 = last ? nA : cA + (size_t)(t + 2) * kstep; const char* b2 = last ? nB : cB + (size_t)(t + 2) * kstep;
      const char* a3 = a2 + kstep; const char* b3 = b2 + kstep;
      if constexpr (Epi::HAS_MID) { if (t == E.tsplit) { E.mid(acc, cur, wr, wc, fr, fq); } }
      PG8_LDB(B0, 0, 0); PG8_LDB(B1, 0, 1); PG8_SCHED; PG8_LDA(At, 0, 0); PG8_STA(PG8_SA(1, 1), a1 + hstepA);
      PG8_WAIT_V(8); PG8_WAIT_L(0); PG8_BAR; PG8_MMA(0, 0, At, B0); PG8_MMA(0, 1, At, B1); PG8_BAR; PG8_SCHED;
      PG8_LDA(At, 0, 1); PG8_STB(PG8_SB(0, 0), b2); PG8_STB(PG8_SB(0, 1), b2 + hstepB); PG8_STA(PG8_SA(0, 0), a2);
      PG8_WAIT_V(8); PG8_WAIT_L(0); PG8_BAR; PG8_MMA(1, 0, At, B0); PG8_MMA(1, 1, At, B1); PG8_BAR; PG8_SCHED;
      PG8_LDB(B0, 1, 0); PG8_LDB(B1, 1, 1); PG8_SCHED; PG8_LDA(At, 1, 0); PG8_STA(PG8_SA(0, 1), a2 + hstepA);
      PG8_WAIT_V(8); PG8_WAIT_L(0); PG8_BAR; PG8_MMA(0, 0, At, B0); PG8_MMA(0, 1, At, B1); PG8_BAR; PG8_SCHED;
      PG8_LDA(At, 1, 1); PG8_STB(PG8_SB(1, 0), b3); PG8_STB(PG8_SB(1, 1), b3 + hstepB); PG8_STA(PG8_SA(1, 0), a3);
      PG8_WAIT_V(8); PG8_WAIT_L(0); PG8_BAR; PG8_MMA(1, 0, At, B0); PG8_MMA(1, 1, At, B1); PG8_BAR; PG8_SCHED;
    }
    if (wr == 0) PG8_BAR;
    E(acc, cur, wr, wc, fr, fq);
    if (!has_next) break;
#pragma unroll
    for (int a = 0; a < 2; ++a)
#pragma unroll
      for (int b = 0; b < 2; ++b)
#pragma unroll
        for (int m = 0; m < 4; ++m)
#pragma unroll
          for (int n = 0; n < 2; ++n) acc[a][b][m][n] = (f32x4){0.f, 0.f, 0.f, 0.f};
    cur = nxt; cA = nA; cB = nB; ++ui;
    if (wr == 1) PG8_BAR;
  }
  PG8_WAIT_V(0);
  PG8_BAR;
#undef PG8_SA
#undef PG8_SB
#undef PG8_STAGE_
#undef PG8_STA
#undef PG8_STB
#undef PG8_LDA
#undef PG8_LDB
#undef PG8_MMA
#undef PG8_WAIT_V
#undef PG8_WAIT_L
#undef PG8_BAR
#undef PG8_SCHED
}
}
using pg8::Unit;
typedef f32x4 Acc[2][2][4][2];
#define FOR_AM _Pragma("unroll") for (int ai = 0; ai < 2; ++ai) _Pragma("unroll") for (int m = 0; m < 4; ++m)
#define FOR_BN _Pragma("unroll") for (int bj = 0; bj < 2; ++bj) _Pragma("unroll") for (int n = 0; n < 2; ++n)
__device__ __forceinline__ void st_bf4(bf16_t* p, f32x4 v) { u32x2 w; w.x = pk2(v[0], v[1]); w.y = pk2(v[2], v[3]); *(u32x2*)p = w; }
__device__ __forceinline__ void st_bf8(bf16_t* p, f32x4 a, f32x4 b) { u32x4 w; w.x = pk2(a[0], a[1]); w.y = pk2(a[2], a[3]); w.z = pk2(b[0], b[1]); w.w = pk2(b[2], b[3]); *(u32x4*)p = w; }
__device__ __forceinline__ void atomic_addf(float* p, float v) { __hip_atomic_fetch_add(p, v, __ATOMIC_RELAXED, __HIP_MEMORY_SCOPE_AGENT); }

struct EpiIn {
  static constexpr bool HAS_MID = false;
  float* out; bf16_t *CQN, *CKV, *KR, *QB, *KB, *VB; const float* g_kv; LAS float* red;
  __device__ __forceinline__ void operator()(const Acc& acc, const Unit& u, int wr, int wc, int fr, int fq) const {
    const int pn = u.pn, rbase = u.pm * 256 + wr * 64 + fr, cw = wc * 32 + 4 * fq;
    if (pn <= 1) {
      FOR_AM { float s = 0.f; FOR_BN { const f32x4 x = acc[ai][bj][m][n]; s += (x[0] * x[0] + x[1] * x[1]) + (x[2] * x[2] + x[3] * x[3]); }
        s += __shfl_xor(s, 16); s += __shfl_xor(s, 32);
        if (fq == 0) red[(ai * 128 + wr * 64 + m * 16 + fr) * 4 + wc] = s; }
      asm volatile("s_waitcnt lgkmcnt(0)" ::: "memory"); __builtin_amdgcn_s_barrier(); asm volatile("" ::: "memory");
      FOR_AM { const f32x4 t = *(const LAS f32x4*)(red + (ai * 128 + wr * 64 + m * 16 + fr) * 4);
        const float rstd = __builtin_amdgcn_rsqf(((t[0] + t[1]) + (t[2] + t[3])) * (1.0f / 256.0f) + EPS);
        const int row = rbase + ai * 128 + m * 16;
        if (pn == 0) { FOR_BN { const int col = bj * 128 + n * 16 + cw; st_bf4(CQN + (size_t)row * 256 + col, acc[ai][bj][m][n] * rstd); } }
        else { const int mr = maprow_lat(row); float* o = row < MP ? out + OFF_CKVP + (size_t)row * 256 : out + OFF_CKVS + (size_t)(row - MP) * 256;
          FOR_BN { const int col = bj * 128 + n * 16 + cw; const f32x4 v = acc[ai][bj][m][n] * rstd * *(const f32x4*)(g_kv + col);
            *(f32x4*)(o + col) = v; st_bf4(CKV + (size_t)mr * 256 + col, v); } } }
      asm volatile("s_waitcnt lgkmcnt(0)" ::: "memory"); __builtin_amdgcn_s_barrier(); asm volatile("" ::: "memory");
    } else if (pn <= 3) {
      FOR_AM { const int row = rbase + ai * 128 + m * 16; FOR_BN { const int col = (pn - 2) * 256 + bj * 128 + n * 16 + cw; st_bf4(QB + (size_t)row * 512 + col, acc[ai][bj][m][n] * QSCALE_B); } }
    } else if (pn <= 7) {
      const bool isv = pn >= 6; bf16_t* dst = isv ? VB : KB; const int c0 = (pn & 1) * 256;
      FOR_AM { const int row = rbase + ai * 128 + m * 16; const int mr = maprow_bnd(row);
        float* o = nullptr;
        if (row >= MP) o = out + (isv ? OFF_BVS : OFF_BKS) + (size_t)(row - MP) * 512;
        else if ((row & (SEQ - 1)) >= SEQ - 512) o = out + (isv ? OFF_BVP : OFF_BKP) + ((size_t)(row >> 11) * 512 + ((row & (SEQ - 1)) - (SEQ - 512))) * 512;
        FOR_BN { const int col = c0 + bj * 128 + n * 16 + cw; const f32x4 v = acc[ai][bj][m][n]; st_bf4(dst + (size_t)mr * 512 + col, v); if (o) *(f32x4*)(o + col) = v; } }
    } else {
      if (wc == 0) {
        FOR_AM { const int row = rbase + ai * 128 + m * 16; const int pos = row_pos(row), mr = maprow_lat(row);
          float* o = row < MP ? out + OFF_KRP + (size_t)row * 32 : out + OFF_KRS + (size_t)(row - MP) * 32;
          const f32x4 x1 = acc[ai][0][m][0], x2 = acc[ai][0][m][1]; f32x4 y1, y2;
#pragma unroll
          for (int j = 0; j < 4; ++j) { float c, s; rope_cs(pos, 4 * fq + j, c, s); y1[j] = x1[j] * c - x2[j] * s; y2[j] = x1[j] * s + x2[j] * c; }
          *(f32x4*)(o + 4 * fq) = y1; *(f32x4*)(o + 16 + 4 * fq) = y2;
          st_bf4(KR + (size_t)mr * 32 + 4 * fq, y1); st_bf4(KR + (size_t)mr * 32 + 16 + 4 * fq, y2); }
      }
    }
  }
};
struct EpiQ {
  static constexpr bool HAS_MID = false;
  bf16_t* Q;
  __device__ __forceinline__ void operator()(const Acc& acc, const Unit& u, int wr, int wc, int fr, int fq) const {
    const int pn = u.pn, rbase = u.pm * 256 + wr * 64 + fr;
    if (pn <= 1) {
      FOR_AM { const int row = rbase + ai * 128 + m * 16; FOR_BN { const int col = pn * 256 + bj * 128 + wc * 32 + n * 16 + 4 * fq; st_bf4(Q + (size_t)row * 768 + (col >> 6) * 96 + (col & 63), acc[ai][bj][m][n] * QSCALE_A); } }
    } else {
      FOR_AM { const int row = rbase + ai * 128 + m * 16; const int pos = row_pos(row);
        float cs[4], sn[4];
#pragma unroll
        for (int j = 0; j < 4; ++j) rope_cs(pos, 4 * fq + j, cs[j], sn[j]);
#pragma unroll
        for (int bj = 0; bj < 2; ++bj) { const int head = 4 * bj + wc; const f32x4 x1 = acc[ai][bj][m][0], x2 = acc[ai][bj][m][1]; f32x4 y1, y2;
#pragma unroll
          for (int j = 0; j < 4; ++j) { y1[j] = (x1[j] * cs[j] - x2[j] * sn[j]) * QSCALE_A; y2[j] = (x1[j] * sn[j] + x2[j] * cs[j]) * QSCALE_A; }
          bf16_t* q = Q + (size_t)row * 768 + head * 96 + 64 + 4 * fq; st_bf4(q, y1); st_bf4(q + 16, y2); } __builtin_amdgcn_sched_barrier(0); }
    }
  }
};
struct EpiKV {
  static constexpr bool HAS_MID = false;
  bf16_t *KN, *V;
  __device__ __forceinline__ void operator()(const Acc& acc, const Unit& u, int wr, int wc, int fr, int fq) const {
    const int pn = u.pn, rbase = u.pm * 256 + wr * 64 + fr; bf16_t* dst = pn >= 2 ? V : KN; const int c0 = (pn & 1) * 256 + wc * 32 + 4 * fq;
    FOR_AM { const int row = rbase + ai * 128 + m * 16; FOR_BN { st_bf4(dst + (size_t)row * 512 + c0 + bj * 128 + n * 16, acc[ai][bj][m][n]); } }
  }
};
struct EpiO {
  static constexpr bool HAS_MID = true;
  int tsplit; const float *ssq_a, *ssq_b, *xp, *xs; bf16_t* X1B; float* ssq_x1;
  __device__ __forceinline__ void mid(Acc& acc, const Unit& u, int wr, int wc, int fr, int fq) const {
    const int rbase = u.pm * 256 + wr * 64 + fr;
    FOR_AM { const int row = rbase + ai * 128 + m * 16; const float sa = ssq_a[row], sb = ssq_b[row];
      const float ratio = __builtin_amdgcn_rsqf(sa * (1.0f / 512.0f) + EPS) * __builtin_sqrtf(sb * (1.0f / 512.0f) + EPS);
      FOR_BN { acc[ai][bj][m][n] = acc[ai][bj][m][n] * ratio; }
      __builtin_amdgcn_sched_barrier(0); }
    asm volatile("s_waitcnt vmcnt(0)" ::: "memory");
  }
  __device__ __forceinline__ void operator()(const Acc& acc, const Unit& u, int wr, int wc, int fr, int fq) const {
    const int rbase = u.pm * 256 + wr * 64 + fr, c0 = u.pn * 256 + wc * 32 + 4 * fq;
    FOR_AM { const int row = rbase + ai * 128 + m * 16; const float rb = __builtin_amdgcn_rsqf(ssq_b[row] * (1.0f / 512.0f) + EPS);
      const float* xr = row < MP ? xp + (size_t)row * D : xs + (size_t)(row - MP) * D; float s = 0.f;
      FOR_BN { const int col = c0 + bj * 128 + n * 16; const f32x4 v = *(const f32x4*)(xr + col) + acc[ai][bj][m][n] * rb;
        st_bf4(X1B + (size_t)row * D + col, v); s += (v[0] * v[0] + v[1] * v[1]) + (v[2] * v[2] + v[3] * v[3]); }
      s += __shfl_xor(s, 16); s += __shfl_xor(s, 32); if (fq == 0) atomic_addf(ssq_x1 + row, s); __builtin_amdgcn_sched_barrier(0); }
  }
};
struct EpiGU {
  static constexpr bool HAS_MID = false;
  const float* ssq_x1; bf16_t* H;
  __device__ __forceinline__ void operator()(const Acc& acc, const Unit& u, int wr, int wc, int fr, int fq) const {
    const int rbase = u.pm * 256 + wr * 64 + fr, c0 = u.pn * 128 + wc * 16 + 4 * fq;
    FOR_AM { const int row = rbase + ai * 128 + m * 16; const float rstd = __builtin_amdgcn_rsqf(ssq_x1[row] * (1.0f / 1024.0f) + EPS);
#pragma unroll
      for (int bj = 0; bj < 2; ++bj) { const f32x4 g = acc[ai][bj][m][0] * rstd, up = acc[ai][bj][m][1] * rstd; f32x4 hv;
#pragma unroll
        for (int j = 0; j < 4; ++j) hv[j] = g[j] * __builtin_amdgcn_rcpf(1.0f + __builtin_amdgcn_exp2f(-g[j] * LOG2E)) * up[j];
        st_bf4(H + (size_t)row * FF + c0 + bj * 64, hv); } }
  }
};
__device__ __forceinline__ f32x4 ld_bf4(const bf16_t* p) { const u32x2 w = *(const u32x2*)p; return (f32x4){__builtin_bit_cast(float, w.x << 16), __builtin_bit_cast(float, w.x & 0xffff0000u), __builtin_bit_cast(float, w.y << 16), __builtin_bit_cast(float, w.y & 0xffff0000u)}; }
struct EpiD {
  static constexpr bool HAS_MID = false;
  bf16_t* X; float* ssq_x2;
  __device__ __forceinline__ void operator()(const Acc& acc, const Unit& u, int wr, int wc, int fr, int fq) const {
    const int rbase = u.pm * 256 + wr * 64 + fr, c0 = u.pn * 256 + wc * 32 + 4 * fq;
    FOR_AM { const int row = rbase + ai * 128 + m * 16; float s = 0.f;
      FOR_BN { bf16_t* x = X + (size_t)row * D + c0 + bj * 128 + n * 16; const f32x4 v = ld_bf4(x) + acc[ai][bj][m][n]; st_bf4(x, v);
        s += (v[0] * v[0] + v[1] * v[1]) + (v[2] * v[2] + v[3] * v[3]); }
      s += __shfl_xor(s, 16); s += __shfl_xor(s, 32); if (fq == 0) atomic_addf(ssq_x2 + row, s); }
  }
};
struct EpiPart {
  static constexpr bool HAS_MID = false;
  float* PART;
  __device__ __forceinline__ void operator()(const Acc& acc, const Unit& u, int wr, int wc, int fr, int fq) const {
    float* base = PART + (size_t)(u.koff >> 8) * 256 * D; const int r0 = wr * 64 + fr, c0 = u.pn * 256 + wc * 32 + 4 * fq;
    FOR_AM { FOR_BN { *(f32x4*)(base + (size_t)(r0 + ai * 128 + m * 16) * D + c0 + bj * 128 + n * 16) = acc[ai][bj][m][n]; } }
  }
};

__device__ __forceinline__ float wave_sum(float v) {
#pragma unroll
  for (int o = 1; o < 64; o <<= 1) v += __shfl_xor(v, o);
  return v;
}
template <class Map>
__device__ __forceinline__ void transpose_item(const float* W, int K, int N, bf16_t* WT, const float* g, LAS float* scr, int item, int lane, Map map) {
  const int nblk = N / 32, kb = item / nblk, nb = item % nblk, k0 = 64 * kb, n0 = 32 * nb;
#pragma unroll 8
  for (int i = 0; i < 32; ++i) { const int kk = 2 * i + (lane >> 5); scr[kk * 33 + (lane & 31)] = W[(size_t)(k0 + kk) * N + n0 + (lane & 31)] * (g ? g[k0 + kk] : 1.0f); }
  asm volatile("s_waitcnt lgkmcnt(0)" ::: "memory");
  const int c = lane & 7;
#pragma unroll
  for (int j = 0; j < 4; ++j) { const int n = (lane >> 3) + 8 * j; const LAS float* s = scr + (8 * c) * 33 + n;
    u32x4 o; o.x = pk2(s[0 * 33], s[1 * 33]); o.y = pk2(s[2 * 33], s[3 * 33]); o.z = pk2(s[4 * 33], s[5 * 33]); o.w = pk2(s[6 * 33], s[7 * 33]);
    *(u32x4*)(WT + (size_t)map(n0 + n) * K + k0 + 8 * c) = o; }
  asm volatile("s_waitcnt lgkmcnt(0)" ::: "memory");
}
template <class Map>
__device__ __forceinline__ void convert_rows(const float* src, bf16_t* dst, int R, int cshift, int gt, int ngt, Map map) {
  const long n8 = ((long)R << cshift) >> 3;
  for (long i0 = gt; i0 < n8; i0 += 4L * ngt) {
    f32x4 v[4][2];
#pragma unroll
    for (int k = 0; k < 4; ++k) { const long i = i0 + (long)k * ngt; if (i < n8) { v[k][0] = *(const f32x4*)(src + i * 8); v[k][1] = *(const f32x4*)(src + i * 8 + 4); } }
#pragma unroll
    for (int k = 0; k < 4; ++k) { const long i = i0 + (long)k * ngt; if (i < n8) { const long e = i * 8; const int r = (int)(e >> cshift), c = (int)(e & ((1 << cshift) - 1));
      st_bf8(dst + ((size_t)map(r) << cshift) + c, v[k][0], v[k][1]); } }
  }
}
__device__ __forceinline__ void zero_rows(bf16_t* dst, int cshift, int r0, int nr, int nb, int bstride, int gt, int ngt) {
  const long per = ((long)nr << cshift) >> 3, n8 = per * nb;
  for (long i = gt; i < n8; i += ngt) { const int b = (int)(i / per); const long e = (i % per) * 8; *(u32x4*)(dst + (((size_t)b * bstride + r0) << cshift) + e) = (u32x4){0u, 0u, 0u, 0u}; }
}
__device__ __forceinline__ void prologue(ParamsC p, LAS unsigned char* lds, int G) {
  const int tid = threadIdx.x, lane = tid & 63, wave = tid >> 6; unsigned char* ws = p->ws;
  const int gw = blockIdx.x * 8 + wave, NGW = G * 8, gt = blockIdx.x * NTHREADS + tid, ngt = G * NTHREADS;
  LAS float* scr = (LAS float*)(lds + wave * 16384);
  bf16_t* WinT = (bf16_t*)(ws + WS_WIN); bf16_t* WuqT = (bf16_t*)(ws + WS_WUQ); bf16_t* WkvT = (bf16_t*)(ws + WS_WKV); bf16_t* WoT = (bf16_t*)(ws + WS_WO);
  bf16_t* WguT = (bf16_t*)(ws + WS_WGU); bf16_t* WdT = (bf16_t*)(ws + WS_WD);
  constexpr int I_IN = 16 * 65, I_UQ = 4 * 24, I_UK = 4 * 16, I_O = 16 * 32, I_G = 16 * 88, I_D = 44 * 32;
  constexpr int NITEMS = I_IN + I_UQ + 2 * I_UK + I_O + 2 * I_G + I_D;
  for (int it = gw; it < NITEMS; it += NGW) {
    int r = it;
    if (r < I_IN) { transpose_item(p->w_in, 1024, 2080, WinT, p->g_attn, scr, r, lane, [](int n) { return n < 512 ? n : (n < 544 ? 2048 + (n - 512) : 512 + (n - 544)); }); continue; } r -= I_IN;
    if (r < I_UQ) { transpose_item(p->w_uq, 256, 768, WuqT, p->g_q, scr, r, lane, [](int n) { const int h = n / 96, d = n % 96; return d < 64 ? h * 64 + d : 512 + h * 32 + (d - 64); }); continue; } r -= I_UQ;
    if (r < I_UK) { transpose_item(p->w_uk, 256, 512, WkvT, nullptr, scr, r, lane, [](int n) { return n; }); continue; } r -= I_UK;
    if (r < I_UK) { transpose_item(p->w_uv, 256, 512, WkvT, nullptr, scr, r, lane, [](int n) { return 512 + n; }); continue; } r -= I_UK;
    if (r < I_O) { const int kb = r / 32; transpose_item(p->w_out, 1024, 1024, WoT, kb < 8 ? p->g_out_a : p->g_out_b - 512, scr, r, lane, [](int n) { return n; }); continue; } r -= I_O;
    if (r < I_G) { transpose_item(p->w_gate, 1024, FF, WguT, p->g_ffn, scr, r, lane, [](int n) { return 32 * (n >> 4) + (n & 15); }); continue; } r -= I_G;
    if (r < I_G) { transpose_item(p->w_up, 1024, FF, WguT, p->g_ffn, scr, r, lane, [](int n) { return 32 * (n >> 4) + 16 + (n & 15); }); continue; } r -= I_G;
    transpose_item(p->w_down, FF, 1024, WdT, nullptr, scr, r, lane, [](int n) { return n; });
  }
  zero_rows(WinT, 10, 2080, NIN - 2080, 1, 0, gt, ngt);
  bf16_t* XN = (bf16_t*)(ws + WS_XN);
  for (int row0 = gw; row0 < MT; row0 += 4 * NGW) {
    f32x4 v[4][4]; float s[4] = {0.f, 0.f, 0.f, 0.f};
#pragma unroll
    for (int k = 0; k < 4; ++k) { const int row = row0 + k * NGW; if (row < MT) { const float* xr = row < MP ? p->xp + (size_t)row * D : p->xs + (size_t)(row - MP) * D;
#pragma unroll
      for (int j = 0; j < 2; ++j) { v[k][2 * j] = *(const f32x4*)(xr + 8 * lane + 512 * j); v[k][2 * j + 1] = *(const f32x4*)(xr + 8 * lane + 512 * j + 4); } } }
#pragma unroll
    for (int k = 0; k < 4; ++k) { const int row = row0 + k * NGW; if (row < MT) {
#pragma unroll
      for (int j = 0; j < 4; ++j) s[k] += (v[k][j][0] * v[k][j][0] + v[k][j][1] * v[k][j][1]) + (v[k][j][2] * v[k][j][2] + v[k][j][3] * v[k][j][3]);
      const float rstd = __builtin_amdgcn_rsqf(wave_sum(s[k]) * (1.0f / D) + EPS);
#pragma unroll
      for (int j = 0; j < 2; ++j) st_bf8(XN + (size_t)row * D + 8 * lane + 512 * j, v[k][2 * j] * rstd, v[k][2 * j + 1] * rstd); } }
  }
  bf16_t* CKV = (bf16_t*)(ws + WS_CKV); bf16_t* KR = (bf16_t*)(ws + WS_KR); bf16_t* KB = (bf16_t*)(ws + WS_KB); bf16_t* VB = (bf16_t*)(ws + WS_VB);
  convert_rows(p->c_ckv, CKV, DB * PAST, 8, gt, ngt, [](int r) { return MP + (r >> 12) * LROW + (r & 4095); });
  convert_rows(p->c_kr, KR, DB * PAST, 5, gt, ngt, [](int r) { return MP + (r >> 12) * LROW + (r & 4095); });
  convert_rows(p->c_bk, KB, DB * 512, 9, gt, ngt, [](int r) { return MP + (r >> 9) * BROW + (r & 511); });
  convert_rows(p->c_bv, VB, DB * 512, 9, gt, ngt, [](int r) { return MP + (r >> 9) * BROW + (r & 511); });
  zero_rows(CKV + (size_t)MP * 256, 8, PAST + DSQ, LROW - PAST - DSQ, DB, LROW, gt, ngt);
  zero_rows(KR + (size_t)MP * 32, 5, PAST + DSQ, LROW - PAST - DSQ, DB, LROW, gt, ngt);
  zero_rows(KB + (size_t)MP * 512, 9, 512 + DSQ, BROW - 512 - DSQ, DB, BROW, gt, ngt);
  zero_rows(VB + (size_t)MP * 512, 9, 512 + DSQ, BROW - 512 - DSQ, DB, BROW, gt, ngt);
  float* ssq = (float*)(ws + WS_SSQ);
  for (int i = gt; i < 4 * MT; i += ngt) ssq[i] = 0.f;
}

__device__ __forceinline__ f32x16 mfma32(bf16x8 a, bf16x8 b, f32x16 c) { return __builtin_amdgcn_mfma_f32_32x32x16_bf16(a, b, c, 0, 0, 0); }
__device__ __forceinline__ s16x4 vtr(const LAS unsigned char* p) { return __builtin_bit_cast(s16x4, __builtin_amdgcn_ds_read_tr16_b64_v4i16((LAS s16x4*)p)); }
template <int NS, bool BIAS, bool QL>
__device__ __forceinline__ void attn_qk(const LAS unsigned char* Kt, const bf16x8 (&qf)[NS], const LAS unsigned char* Qt, f32x16 (&st)[2], int nvalid, const LAS float* btab, int rb, bool lookup, int lane) {
  constexpr int KP = NS == 6 ? KP_A : KP_B;
  const int r = lane & 31, h = lane >> 5;
  bf16x8 qv[NS];
#pragma unroll
  for (int s = 0; s < NS; ++s) qv[s] = QL ? *(const LAS bf16x8*)(Qt + r * KP + (2 * s + h) * 16) : qf[s];
#pragma unroll
  for (int kh = 0; kh < 2; ++kh) {
    bf16x8 kf[NS];
#pragma unroll
    for (int s = 0; s < NS; ++s) kf[s] = *(const LAS bf16x8*)(Kt + (32 * kh + r) * KP + (2 * s + h) * 16);
    __builtin_amdgcn_sched_barrier(0);
    __builtin_amdgcn_s_setprio(1);
    { const f32x16 z = {0.f, 0.f, 0.f, 0.f, 0.f, 0.f, 0.f, 0.f, 0.f, 0.f, 0.f, 0.f, 0.f, 0.f, 0.f, 0.f}; st[kh] = mfma32(kf[0], qv[0], z); }
#pragma unroll
    for (int s = 1; s < NS; ++s) st[kh] = mfma32(kf[s], qv[s], st[kh]);
    __builtin_amdgcn_s_setprio(0);
    __builtin_amdgcn_sched_barrier(0);
  }
  if (BIAS) {
    if (lookup) { const LAS float* bp = btab + rb + 4 * h;
#pragma unroll
      for (int kh = 0; kh < 2; ++kh)
#pragma unroll
        for (int i = 0; i < 16; ++i) st[kh][i] += bp[32 * kh + (i & 3) + 8 * (i >> 2)];
    } else { const float bc = btab[0];
#pragma unroll
      for (int kh = 0; kh < 2; ++kh)
#pragma unroll
        for (int i = 0; i < 16; ++i) st[kh][i] += bc; }
  }
  if (nvalid < 64) {
#pragma unroll
    for (int kh = 0; kh < 2; ++kh)
#pragma unroll
      for (int i = 0; i < 16; ++i) { const int key = 32 * kh + (i & 3) + 8 * (i >> 2) + 4 * h; if (key >= nvalid) st[kh][i] = -1e30f; }
  }
}
__device__ __forceinline__ void attn_smpv(const LAS unsigned char* Vt, f32x16 (&st)[2], f32x16 (&o)[2], float& m_run, float& l_run, LAS float* wsf, int lane) {
  const int r = lane & 31, h = lane >> 5;
  float mx = st[0][0];
#pragma unroll
  for (int kh = 0; kh < 2; ++kh)
#pragma unroll
    for (int i = 0; i < 16; ++i) mx = __builtin_fmaxf(mx, st[kh][i]);
  mx = __builtin_fmaxf(mx, __shfl_xor(mx, 32));
  const float m_new = __builtin_fmaxf(m_run, mx), alpha = __builtin_amdgcn_exp2f(m_run - m_new);
  float rs = 0.f;
#pragma unroll
  for (int kh = 0; kh < 2; ++kh)
#pragma unroll
    for (int i = 0; i < 16; ++i) { const float pv = __builtin_amdgcn_exp2f(st[kh][i] - m_new); st[kh][i] = pv; rs += pv; }
  rs += __shfl_xor(rs, 32);
  l_run = l_run * alpha + rs; m_run = m_new;
  {
    if (h == 0) wsf[r] = alpha;
    typedef float f32x8 __attribute__((ext_vector_type(8)));
    const f32x4 a0 = *(const LAS f32x4*)(wsf + 4 * h), a1 = *(const LAS f32x4*)(wsf + 8 + 4 * h), a2 = *(const LAS f32x4*)(wsf + 16 + 4 * h), a3 = *(const LAS f32x4*)(wsf + 24 + 4 * h);
    const f32x8 lo = __builtin_shufflevector(a0, a1, 0, 1, 2, 3, 4, 5, 6, 7), hi = __builtin_shufflevector(a2, a3, 0, 1, 2, 3, 4, 5, 6, 7);
    const f32x16 av = __builtin_shufflevector(lo, hi, 0, 1, 2, 3, 4, 5, 6, 7, 8, 9, 10, 11, 12, 13, 14, 15);
    o[0] = o[0] * av; o[1] = o[1] * av;
  }
  const int blk = (lane >> 4) & 1, q = (lane & 15) >> 2, p = lane & 3;
  const int vb = (4 * h + q) * 128 + 8 * (p & 1), co0 = ((2 * blk + (p >> 1)) ^ (((q >> 1) & 1) << 2)) << 4;
#pragma unroll
  for (int kh = 0; kh < 2; ++kh)
#pragma unroll
    for (int s2 = 0; s2 < 2; ++s2) {
      u32x4 pw;
#pragma unroll
      for (int k = 0; k < 4; ++k) pw[k] = pk2(st[kh][8 * s2 + 2 * k], st[kh][8 * s2 + 2 * k + 1]);
      const bf16x8 pa = __builtin_bit_cast(bf16x8, pw);
#pragma unroll
      for (int c = 0; c < 2; ++c) {
        const LAS unsigned char* vp = Vt + (32 * kh + 16 * s2) * 128 + vb + (c ? (co0 ^ 64) : co0);
        const s16x4 lo = vtr(vp), hi = vtr(vp + 8 * 128);
        const bf16x8 vf = __builtin_shufflevector(lo, hi, 0, 1, 2, 3, 4, 5, 6, 7);
        __builtin_amdgcn_s_setprio(1); o[c] = mfma32(pa, vf, o[c]); __builtin_amdgcn_s_setprio(0);
      }
    }
}
__device__ __forceinline__ void scale_o(f32x16 (&o)[2], float f, LAS float* wsf, int lane) {
  const int r = lane & 31, h = lane >> 5;
  if (h == 0) wsf[r] = f;
#pragma unroll
  for (int g = 0; g < 4; ++g) { const f32x4 a4 = *(const LAS f32x4*)(wsf + 8 * g + 4 * h);
#pragma unroll
    for (int j = 0; j < 4; ++j) { o[0][4 * g + j] *= a4[j]; o[1][4 * g + j] *= a4[j]; } }
}
__device__ __forceinline__ void store_o(const f32x16 (&o)[2], LAS bf16_t* stg, bf16_t* att  , float* ssq  , int nq, int lane) {
  const int r = lane & 31, h = lane >> 5;
#pragma unroll
  for (int c = 0; c < 2; ++c)
#pragma unroll
    for (int i = 0; i < 16; ++i) stg[((i & 3) + 8 * (i >> 2) + 4 * h) * 64 + 32 * c + r] = (bf16_t)f2bf(o[c][i]);
  const int qr = lane >> 1, half = lane & 1; float s = 0.f; u32x4 v[4];
#pragma unroll
  for (int k = 0; k < 4; ++k) { v[k] = *(const LAS u32x4*)(stg + qr * 64 + half * 32 + 8 * k);
#pragma unroll
    for (int e = 0; e < 4; ++e) { const float a = __builtin_bit_cast(float, v[k][e] << 16), b = __builtin_bit_cast(float, v[k][e] & 0xffff0000u); s += a * a + b * b; } }
  s += __shfl_xor(s, 1);
  if (qr < nq) {
#pragma unroll
    for (int k = 0; k < 4; ++k) *(u32x4*)(att + (size_t)qr * D + half * 32 + 8 * k) = v[k];
    if (half == 0 && ssq) atomic_addf(ssq + qr, s);
  }
}
struct KVSrc { const bf16_t* K; const bf16_t* KRp; const bf16_t* V; };
template <int NS>
__device__ __forceinline__ u32x4 ld_kchunk(const KVSrc& s, long krow, int id) {
  if (NS == 6) { const int row = id / 12, ch = id - row * 12;
    return ch < 8 ? *(const u32x4*)(s.K + (krow + row) * 512 + ch * 8) : *(const u32x4*)(s.KRp + (krow + row) * 32 + (ch - 8) * 8); }
  else { const int row = id >> 3, ch = id & 7; return *(const u32x4*)(s.K + (krow + row) * 512 + ch * 8); }
}
template <int NS>
__device__ __forceinline__ void st_kchunk(LAS unsigned char* Kt, int id, u32x4 v) {
  constexpr int KP = NS == 6 ? KP_A : KP_B, CPR = NS == 6 ? 12 : 8;
  const int row = id / CPR, ch = id - row * CPR; *(LAS u32x4*)(Kt + row * KP + ch * 16) = v;
}
__device__ __forceinline__ void st_vchunk(LAS unsigned char* Vt, int id, u32x4 v) { const int row = id >> 3, ch = id & 7; *(LAS u32x4*)(Vt + row * 128 + ((ch ^ (((row >> 1) & 1) << 2)) << 4)) = v; }

__device__ __forceinline__ void glds16(const void* gsrc, unsigned lds_dst) {
  unsigned keep;
  asm volatile("s_mov_b32 %0, m0\n\ts_mov_b32 m0, %2\n\ts_nop 0\n\tglobal_load_lds_dwordx4 %1, off\n\ts_mov_b32 m0, %0" : "=&s"(keep) : "v"(gsrc), "s"(lds_dst) : "memory");
}
template <int NS>
__device__ __forceinline__ void dma_tile(LAS unsigned char* Kt, LAS unsigned char* Vt, const KVSrc& src, long krow, int wave, int lane) {
  constexpr int CPR = NS == 6 ? 13 : 9, ND = CPR;
#pragma unroll
  for (int k = 0; k < 2; ++k) { const int d = wave + 8 * k;
    if (d < ND) { const int c = d * 64 + lane, row = c / CPR, ch = c - row * CPR;
      const bf16_t* g = (NS == 6 && ch >= 8 && ch < 12) ? src.KRp + (krow + row) * 32 + (ch - 8) * 8 : src.K + (krow + row) * 512 + (ch < 8 ? ch : 0) * 8;
      glds16(g, (unsigned)__builtin_amdgcn_readfirstlane((int)(unsigned)(uintptr_t)(Kt + d * 1024))); } }
  { const int c = wave * 64 + lane, row = c >> 3, ch = (c & 7) ^ (((row >> 1) & 1) << 2);
    glds16(src.V + (krow + row) * 512 + ch * 8, (unsigned)__builtin_amdgcn_readfirstlane((int)(unsigned)(uintptr_t)(Vt + wave * 1024))); }
}
#define AT_VMWAIT(n) asm volatile("s_waitcnt vmcnt(" #n ")" ::: "memory")
template <int NS, bool BIAS>
__device__ __forceinline__ void attn_unit_shared(LAS unsigned char* lds, const bf16_t* Qw  , int qpitch, const KVSrc src, long krow0,
                                                 int t_lo, int t_hi, int w_lo, int w_hi, int qpos0  , bf16_t* att, float* ssq) {
  constexpr int SLOT = 21504, ND = NS == 6 ? 13 : 9;
  int tid_ = threadIdx.x; asm volatile("" : "+v"(tid_));
  const int tid = tid_, lane = tid & 63, wave = __builtin_amdgcn_readfirstlane(tid >> 6), r = lane & 31, h = lane >> 5;
  LAS float* wsf = (LAS float*)(lds + AT_WSF) + wave * 64; const LAS float* btab = (const LAS float*)(lds + AT_BIAS);
#pragma unroll
  for (int k = 0; k < 2; ++k) if (t_lo + k <= t_hi) dma_tile<NS>(lds + AT_TILE + k * SLOT, lds + AT_TILE + k * SLOT + 13312, src, krow0 + 64L * (t_lo + k), wave, lane);
  bf16x8 qf[NS];
#pragma unroll
  for (int s = 0; s < NS; ++s) qf[s] = *(const bf16x8*)(Qw + (size_t)r * qpitch + 16 * s + 8 * h);
#pragma unroll
  for (int s = 0; s < NS; ++s) asm volatile("" : "+v"(qf[s]));
  f32x16 o[2];
#pragma unroll
  for (int i = 0; i < 16; ++i) { o[0][i] = 0.f; o[1][i] = 0.f; }
  float m_run = -1e30f, l_run = 0.f;
  AT_VMWAIT(0);
  asm volatile("s_waitcnt lgkmcnt(0)" ::: "memory"); __builtin_amdgcn_s_barrier(); asm volatile("" ::: "memory");
  for (int t0 = t_lo; t0 <= t_hi; t0 += 2) {
#pragma unroll
    for (int k = 2; k < 4; ++k) if (t0 + k <= t_hi) { const int s3 = (t0 + k - t_lo) & 3; dma_tile<NS>(lds + AT_TILE + s3 * SLOT, lds + AT_TILE + s3 * SLOT + 13312, src, krow0 + 64L * (t0 + k), wave, lane); }
#pragma unroll
    for (int k = 0; k < 2; ++k) { const int t = t0 + k; const int sl = (t - t_lo) & 3;
      if (t <= t_hi && t >= w_lo && t <= w_hi) {
        const bool lookup = BIAS && (qpos0 - (64 * t + 63) < 256);
        f32x16 st[2]; attn_qk<NS, BIAS, false>(lds + AT_TILE + sl * SLOT, qf, nullptr, st, 64, btab, 639 - (qpos0 + r - 64 * t + 256), lookup, lane);
        attn_smpv(lds + AT_TILE + sl * SLOT + 13312, st, o, m_run, l_run, wsf, lane);
      } }
    AT_VMWAIT(0);
    asm volatile("s_waitcnt lgkmcnt(0)" ::: "memory"); __builtin_amdgcn_s_barrier(); asm volatile("" ::: "memory");
  }
  scale_o(o, 1.0f / l_run, wsf, lane);
  store_o(o, (LAS bf16_t*)(lds + AT_OSTG) + wave * 2048, att, ssq, 32, lane);
}
template <int NS, bool BIAS>
__device__ __forceinline__ void attn_unit_sample(LAS unsigned char* lds, const bf16_t* Qw, int qpitch, const KVSrc src, long krow0, int ntiles, int nvalid_last, int qpos0, bf16_t* att, float* ssq) {
  constexpr int NKC = NS == 6 ? 768 : 512;
  int tid_ = threadIdx.x; asm volatile("" : "+v"(tid_));
  const int tid = tid_, lane = tid & 63, wave = tid >> 6, r = lane & 31, h = lane >> 5;
  LAS float* wsf = (LAS float*)(lds + AT_WSF) + wave * 64; const LAS float* btab = (const LAS float*)(lds + AT_BIAS);
  LAS float* cm = (LAS float*)(lds + AT_CMB);
  f32x16 o[2];
#pragma unroll
  for (int i = 0; i < 16; ++i) { o[0][i] = 0.f; o[1][i] = 0.f; }
  float m_run = -1e30f, l_run = 0.f;
  LAS unsigned char* Kt = lds + AT_TILE + (wave & 3) * AT_PRIV; LAS unsigned char* Vt = Kt + 13312;
  bf16x8 qf[NS];
#pragma unroll
  for (int s = 0; s < NS; ++s) qf[s] = *(const bf16x8*)(Qw + (size_t)(r & 15) * qpitch + 16 * s + 8 * h);
  constexpr int NK4 = 4 * NKC / 512;
  u32x4 kc[NK4], vc[4];
#define SMP_LOAD(T0) do { _Pragma("unroll") for (int i = 0; i < NK4; ++i) { const int id = tid + 512 * i, tt = id / NKC, cid = id - tt * NKC; if ((T0) + tt < ntiles) kc[i] = ld_kchunk<NS>(src, krow0 + 64L * ((T0) + tt), cid); } \
    _Pragma("unroll") for (int i = 0; i < 4; ++i) { const int id = tid + 512 * i, tt = id >> 9, cid = id & 511; if ((T0) + tt < ntiles) vc[i] = *(const u32x4*)(src.V + (krow0 + 64L * ((T0) + tt) + (cid >> 3)) * 512 + (cid & 7) * 8); } } while (0)
#define SMP_STORE(T0) do { _Pragma("unroll") for (int i = 0; i < NK4; ++i) { const int id = tid + 512 * i, tt = id / NKC, cid = id - tt * NKC; if ((T0) + tt < ntiles) st_kchunk<NS>(lds + AT_TILE + tt * AT_PRIV, cid, kc[i]); } \
    _Pragma("unroll") for (int i = 0; i < 4; ++i) { const int id = tid + 512 * i, tt = id >> 9, cid = id & 511; if ((T0) + tt < ntiles) st_vchunk(lds + AT_TILE + tt * AT_PRIV + 13312, cid, vc[i]); } } while (0)
  SMP_LOAD(0); SMP_STORE(0);
  __syncthreads();
  for (int t0 = 0; t0 < ntiles; t0 += 4) {
    if (t0 + 4 < ntiles) SMP_LOAD(t0 + 4);
    const int t = t0 + wave;
    if (wave < 4 && t < ntiles) {
      const bool lookup = BIAS && (qpos0 - (64 * t + 63) < 256);
      f32x16 st[2]; attn_qk<NS, BIAS, false>(Kt, qf, nullptr, st, (t == ntiles - 1) ? nvalid_last : 64, btab, 639 - (qpos0 + (r & 15) - 64 * t + 256), lookup, lane);
      attn_smpv(Vt, st, o, m_run, l_run, wsf, lane);
    }
    __syncthreads();
    if (t0 + 4 < ntiles) { SMP_STORE(t0 + 4); }
    __syncthreads();
  }
#undef SMP_LOAD
#undef SMP_STORE
  if (wave < 4 && h == 0) cm[wave * 32 + r] = m_run;
  __syncthreads();
  if (wave < 4) {
    const float M = __builtin_fmaxf(__builtin_fmaxf(cm[r], cm[32 + r]), __builtin_fmaxf(cm[64 + r], cm[96 + r]));
    const float f = __builtin_amdgcn_exp2f(m_run - M);
    scale_o(o, f, wsf, lane);
    if (h == 0) cm[128 + wave * 32 + r] = l_run * f;
    LAS float* po = (LAS float*)(lds + AT_TILE + wave * AT_PRIV);
#pragma unroll
    for (int c = 0; c < 2; ++c)
#pragma unroll
      for (int i = 0; i < 16; ++i) po[(c * 16 + i) * 64 + lane] = o[c][i];
  }
  __syncthreads();
  if (wave == 0) {
    const float l = (cm[128 + r] + cm[160 + r]) + (cm[192 + r] + cm[224 + r]);
#pragma unroll
    for (int w = 1; w < 4; ++w) { const LAS float* po = (const LAS float*)(lds + AT_TILE + w * AT_PRIV);
#pragma unroll
      for (int c = 0; c < 2; ++c)
#pragma unroll
        for (int i = 0; i < 16; ++i) o[c][i] += po[(c * 16 + i) * 64 + lane]; }
    scale_o(o, 1.0f / l, wsf, lane);
    store_o(o, (LAS bf16_t*)(lds + AT_OSTG), att, ssq, 16, lane);
  }
  __syncthreads();
}
__device__ __forceinline__ void load_bias(LAS unsigned char* lds, const float* rel_bias, int head) {
  LAS float* btab = (LAS float*)(lds + AT_BIAS);
  for (int i = threadIdx.x; i < 640; i += NTHREADS) { const int j = 639 - i; btab[i] = rel_bias[head * 513 + (j > 512 ? 512 : j)] * LOG2E; }
  __syncthreads();
}
__device__ __forceinline__ void attention_phase(ParamsC p, LAS unsigned char* lds, int G, bool dry, int apm = 15) {
  unsigned char* ws = p->ws; const int wave = threadIdx.x >> 6;
  const bf16_t* Q = (const bf16_t*)(ws + WS_Q); const bf16_t* KN = (const bf16_t*)(ws + WS_KN); const bf16_t* V = (const bf16_t*)(ws + WS_V); const bf16_t* KR = (const bf16_t*)(ws + WS_KR);
  const bf16_t* QB = (const bf16_t*)(ws + WS_QB); const bf16_t* KB = (const bf16_t*)(ws + WS_KB); const bf16_t* VB = (const bf16_t*)(ws + WS_VB);
  bf16_t* ATT = (bf16_t*)(ws + WS_XN); float* ssq_a = (float*)(ws + WS_SSQ); float* ssq_b = ssq_a + MT;
  for (int u = blockIdx.x; u < 256; u += G) {
    const int b = (u & 127) >> 3, head = u & 7; const int row0 = MP + b * DSQ;
#ifndef AP
#define AP 15
#endif
    if (u < 128) { if (apm & 1) {
      const KVSrc src{KN + head * 64, KR, V + head * 64};
      attn_unit_sample<6, false>(lds, Q + (size_t)row0 * 768 + head * 96, 768, src, (long)MP + (long)b * LROW, 65, 16, 0, ATT + (size_t)row0 * D + head * 64, dry ? nullptr : ssq_a + row0); }
    } else if (apm & 2) {
      load_bias(lds, p->rel_bias, head);
      const KVSrc src{KB + head * 64, nullptr, VB + head * 64};
      attn_unit_sample<4, true>(lds, QB + (size_t)row0 * 512 + head * 64, 512, src, (long)MP + (long)b * BROW, 9, 16, 512, ATT + (size_t)row0 * D + 512 + head * 64, dry ? nullptr : ssq_b + row0);
    }
  }
  if (G == 256) {
    const int vcu = (blockIdx.x & 7) * 32 + (blockIdx.x >> 3), grp = vcu >> 3, mem = vcu & 7; const int b = grp; const long brow = (long)b * SEQ;
    if (apm & 4) for (int i = 0; i < 8; ++i) { const int head = i, qb = (mem + i) & 7; const KVSrc src{KN + head * 64, KR, V + head * 64}; const long qrow = brow + 256 * qb + 32 * wave;
      attn_unit_shared<6, false>(lds, Q + (size_t)qrow * 768 + head * 96, 768, src, brow, 0, 4 * qb + 3, 0, 4 * qb + (wave >> 1), 0, ATT + (size_t)qrow * D + head * 64, dry ? nullptr : ssq_a + qrow); }
    if (apm & 8) for (int i = 0; i < 8; ++i) { const int head = i, cb = (mem + i) & 7; load_bias(lds, p->rel_bias, head);
      const KVSrc src{KB + head * 64, nullptr, VB + head * 64}; const long qrow = brow + 256 * cb + 32 * wave; const int cq = 4 * cb + (wave >> 1); const int tl = 4 * cb - 8 < 0 ? 0 : 4 * cb - 8;
      attn_unit_shared<4, true>(lds, QB + (size_t)qrow * 512 + head * 64, 512, src, brow, tl, 4 * cb + 3, cq - 8, cq, 256 * cb + 32 * wave, ATT + (size_t)qrow * D + 512 + head * 64, dry ? nullptr : ssq_b + qrow); }
  } else {
  for (int bh = blockIdx.x; bh < NBATCH * 8; bh += G) {
    const int b = bh >> 3, head = bh & 7; const long brow = (long)b * SEQ;
    if (apm & 4) { const KVSrc src{KN + head * 64, KR, V + head * 64};
      for (int qb = 0; qb < 8; ++qb) { const long qrow = brow + 256 * qb + 32 * wave;
        attn_unit_shared<6, false>(lds, Q + (size_t)qrow * 768 + head * 96, 768, src, brow, 0, 4 * qb + 3, 0, 4 * qb + (wave >> 1), 0, ATT + (size_t)qrow * D + head * 64, dry ? nullptr : ssq_a + qrow); } }
    load_bias(lds, p->rel_bias, head);
    if (apm & 8) { const KVSrc src{KB + head * 64, nullptr, VB + head * 64};
      for (int cb = 0; cb < 8; ++cb) { const long qrow = brow + 256 * cb + 32 * wave; const int cq = 4 * cb + (wave >> 1); const int tl = 4 * cb - 8 < 0 ? 0 : 4 * cb - 8;
        attn_unit_shared<4, true>(lds, QB + (size_t)qrow * 512 + head * 64, 512, src, brow, tl, 4 * cb + 3, cq - 8, cq, 256 * cb + 32 * wave, ATT + (size_t)qrow * D + 512 + head * 64, dry ? nullptr : ssq_b + qrow); } }
  }
  }
}


#define XB_TMO      128
#define XB_XCNT(j)  (256  + 64 * (j))
#define XB_XSUB(j)  (1280 + 64 * (j))
#define XB_XGEN(j)  (2304 + 64 * (j))
#define XB_TOP      3328
#define XB_TOPGEN   3392
#define XCD_BAR_WORDS 3456
#define XB_SPIN_CAP (1u << 18)
__device__ __forceinline__ unsigned xb_ld(unsigned* p)              { return __hip_atomic_load(p, __ATOMIC_RELAXED, __HIP_MEMORY_SCOPE_AGENT); }
__device__ __forceinline__ unsigned xb_add(unsigned* p, unsigned v) { return __hip_atomic_fetch_add(p, v, __ATOMIC_RELAXED, __HIP_MEMORY_SCOPE_AGENT); }
__device__ __forceinline__ unsigned xb_xcc_id() { return (unsigned)__builtin_amdgcn_s_getreg((3 << 11) | 20) & 0xFu; }
#define XB_SPIN(cond, bar) do { unsigned _sp = 0; while (cond) { __builtin_amdgcn_s_sleep(1); \
    if ((++_sp & 255u) == 0u) { if (xb_ld(&(bar)[XB_TMO])) break; if (_sp > XB_SPIN_CAP) { atomicAdd(&(bar)[XB_TMO], 1u); break; } } } } while (0)
__device__ __forceinline__ void xcd_barrier_complete(unsigned* bar, unsigned x, unsigned& nloc, unsigned& nx) {
  const unsigned G = gridDim.x * gridDim.y * gridDim.z;
  unsigned sum, cnt, mine, sp = 0u;
  for (;;) {
    sum = 0u; cnt = 0u; mine = 0u;
#pragma unroll
    for (unsigned j = 0; j < 16; ++j) { const unsigned c = xb_ld(&bar[XB_XCNT(j)]); sum += c; cnt += (c > 0u) ? 1u : 0u; mine = (j == x) ? c : mine; }
    if (sum == G) break;
    __builtin_amdgcn_s_sleep(1);
    if ((++sp & 255u) == 0u) { if (xb_ld(&bar[XB_TMO])) break; if (sp > XB_SPIN_CAP) { atomicAdd(&bar[XB_TMO], 1u); break; } }
  }
  nloc = mine > 0u ? mine : 1u; nx = cnt > 0u ? cnt : 1u;
}
__device__ __forceinline__ void xcd_barrier(unsigned* bar, volatile LAS unsigned* st) {
  asm volatile("s_waitcnt vmcnt(0)" ::: "memory");
  __syncthreads();
  if (threadIdx.x == 0) {
    const unsigned x = xb_xcc_id();
    __builtin_amdgcn_s_waitcnt(0);
    unsigned nloc = st[0], nx = st[1];
    if (nloc == 0u) { xcd_barrier_complete(bar, x, nloc, nx); st[0] = nloc; st[1] = nx; }
    const unsigned old = xb_add(&bar[XB_XSUB(x)], 1u);
    const unsigned gen = old / nloc;
    if (old + 1u == (gen + 1u) * nloc) {
      __builtin_amdgcn_fence(__ATOMIC_RELEASE, "agent");
      asm volatile("s_waitcnt vmcnt(0)" ::: "memory");
      const unsigned og = xb_add(&bar[XB_TOP], 1u);
      const unsigned tg = og / nx;
      if (og + 1u == (tg + 1u) * nx) xb_add(&bar[XB_TOPGEN], 1u);
      else XB_SPIN(xb_ld(&bar[XB_TOPGEN]) == tg, bar);
      __builtin_amdgcn_fence(__ATOMIC_ACQUIRE, "agent");
      xb_add(&bar[XB_XGEN(x)], 1u);
      asm volatile("s_waitcnt vmcnt(0)" ::: "memory");
    } else {
      XB_SPIN(xb_ld(&bar[XB_XGEN(x)]) == gen, bar);
      __builtin_amdgcn_fence(__ATOMIC_ACQUIRE, "agent");
      asm volatile("s_waitcnt vmcnt(0)" ::: "memory");
    }
  }
  __syncthreads();
}

__device__ __forceinline__ ParamsC get_params() {
  ParamsC pp = (ParamsC)__builtin_amdgcn_kernarg_segment_ptr(); asm volatile("" : "+s"(pp)); return pp;
}
__global__ void __launch_bounds__(NTHREADS) mk_fwd(Params p_unused) {
  extern __shared__ __attribute__((aligned(16))) unsigned char lds_raw[];
  LAS unsigned char* lds = (LAS unsigned char*)lds_raw;
  cg::grid_group grid = cg::this_grid();
  const int G = gridDim.x;
  volatile LAS unsigned* xst = (volatile LAS unsigned*)(lds + LDS_BYTES - 16);
  if (threadIdx.x < 2) xst[threadIdx.x] = 0u;
  if (threadIdx.x == 0) (void)xb_add(&((unsigned*)(get_params()->ws + WS_BAR))[XB_XCNT(xb_xcc_id())], 1u);
  __syncthreads();
#define FAST_SYNC() xcd_barrier((unsigned*)(get_params()->ws + WS_BAR), xst)
#define WSP(T, off) ((T*)(get_params()->ws + (off)))
#define ssq WSP(float, WS_SSQ)
#define X1B WSP(bf16_t, WS_X1B)
#define XN WSP(bf16_t, WS_XN)
#define CQN WSP(bf16_t, WS_CQN)
#define CKV WSP(bf16_t, WS_CKV)
#define KR WSP(bf16_t, WS_KR)
#define QB WSP(bf16_t, WS_QB)
#define KB WSP(bf16_t, WS_KB)
#define VB WSP(bf16_t, WS_VB)
#define Q WSP(bf16_t, WS_Q)
#define KN WSP(bf16_t, WS_KN)
#define V WSP(bf16_t, WS_V)
#define H WSP(bf16_t, WS_H)
  pg8::StaticOrder S;
#ifndef PH
#define PH 255
#endif
  if (PH & 1) prologue(get_params(), lds, G);
#ifdef DUP_P0
  grid.sync(); prologue(get_params(), lds, G);
#endif
  grid.sync();
  if (PH & 2) { pg8::Gemm g{XN, (const bf16_t*)(get_params()->ws + WS_WIN), 1024, 1024, 1024}; S.init(MT, NIN, G, blockIdx.x);
    ParamsC pp = get_params(); EpiIn E{pp->out, CQN, CKV, KR, QB, KB, VB, pp->g_kv, (LAS float*)(lds + LDS_RED)};
    pg8::gemm_phase(lds, g, S, E); }
  FAST_SYNC();
  if ((PH & 4) && !(PH & 256)) { pg8::Gemm g{CQN, (const bf16_t*)(get_params()->ws + WS_WUQ), 256, 256, 256}; S.init(MT, 768, G, blockIdx.x); EpiQ E{Q}; pg8::gemm_phase(lds, g, S, E); }
  if ((PH & 4) && !(PH & 512)) { pg8::Gemm g{CKV, (const bf16_t*)(get_params()->ws + WS_WKV), 256, 256, 256}; S.init(MLAT, 1024, G, blockIdx.x); EpiKV E{KN, V}; pg8::gemm_phase(lds, g, S, E); }
  FAST_SYNC();
  if (PH & 8) attention_phase(get_params(), lds, G, false);
#ifdef DUP_ATTN
  grid.sync(); attention_phase(get_params(), lds, G, true, DUP_ATTN);
#endif
  FAST_SYNC();
  if (PH & 16) { pg8::Gemm g{XN  , (const bf16_t*)(get_params()->ws + WS_WO), 1024, 1024, 1024}; S.init(MT, 1024, G, blockIdx.x);
    ParamsC pp = get_params(); EpiO E{8, ssq, ssq + MT, pp->xp, pp->xs, X1B, ssq + 2 * MT}; pg8::gemm_phase(lds, g, S, E); }
  FAST_SYNC();
  if (PH & 32) { pg8::Gemm g{X1B, (const bf16_t*)(get_params()->ws + WS_WGU), 1024, 1024, 1024}; S.init(MT, NGU, G, blockIdx.x); EpiGU E{ssq + 2 * MT, H}; pg8::gemm_phase(lds, g, S, E);
#ifdef DUP_P5
    grid.sync(); pg8::gemm_phase(lds, g, S, E);
#endif
  }
  FAST_SYNC();
#define PART WSP(float, WS_Q)
  if (PH & 64) { pg8::Gemm g{H, (const bf16_t*)(get_params()->ws + WS_WD), FF, FF, FF}; S.init(MP, 1024, G, blockIdx.x); EpiD E{X1B, ssq + 3 * MT}; pg8::gemm_phase(lds, g, S, E);
    pg8::Gemm g2{H, (const bf16_t*)(get_params()->ws + WS_WD), FF, FF, 256}; pg8::SplitOrder S2{MP / 256, 4, 44, 256, G, (int)blockIdx.x}; EpiPart E2{PART}; pg8::gemm_phase(lds, g2, S2, E2); }
  FAST_SYNC();
  if (PH & 128) { ParamsC p = get_params(); int t7 = threadIdx.x; asm volatile("" : "+v"(t7)); const int lane = t7 & 63, gw = blockIdx.x * 8 + (t7 >> 6), NGW = G * 8; const float* s2 = ssq + 3 * MT;
    f32x4 gf[4];
#pragma unroll
    for (int j = 0; j < 2; ++j) { gf[2 * j] = *(const f32x4*)(p->g_final + 8 * lane + 512 * j); gf[2 * j + 1] = *(const f32x4*)(p->g_final + 8 * lane + 512 * j + 4); }
    for (int rr0 = gw; rr0 < MT; rr0 += 4 * NGW) {
      u32x4 raw[4][2]; int rows[4];
#pragma unroll
      for (int k = 0; k < 4; ++k) { const int rr = rr0 + k * NGW; rows[k] = rr < MS ? MP + rr : rr - MS;
        if (rr < MT) { const bf16_t* x = X1B + (size_t)rows[k] * D;
#pragma unroll
          for (int j = 0; j < 2; ++j) raw[k][j] = *(const u32x4*)(x + 8 * lane + 512 * j); } }
#pragma unroll
      for (int k = 0; k < 4; ++k) { const int rr = rr0 + k * NGW, row = rows[k]; if (rr < MT) {
        f32x4 v[4];
#pragma unroll
        for (int j = 0; j < 2; ++j) { const u32x4 w = raw[k][j];
          v[2 * j] = (f32x4){__builtin_bit_cast(float, w.x << 16), __builtin_bit_cast(float, w.x & 0xffff0000u), __builtin_bit_cast(float, w.y << 16), __builtin_bit_cast(float, w.y & 0xffff0000u)};
          v[2 * j + 1] = (f32x4){__builtin_bit_cast(float, w.z << 16), __builtin_bit_cast(float, w.z & 0xffff0000u), __builtin_bit_cast(float, w.w << 16), __builtin_bit_cast(float, w.w & 0xffff0000u)}; }
        float* y = p->out + OFF_Y + (size_t)row * D; float rstd;
        if (row >= MP) { float s = 0.f;
          for (int kc = 0; kc < 11; ++kc) { const float* pr = PART + ((size_t)kc * 256 + (row - MP)) * D;
#pragma unroll
            for (int j = 0; j < 2; ++j) { v[2 * j] = v[2 * j] + *(const f32x4*)(pr + 8 * lane + 512 * j); v[2 * j + 1] = v[2 * j + 1] + *(const f32x4*)(pr + 8 * lane + 512 * j + 4); } }
#pragma unroll
          for (int j = 0; j < 4; ++j) s += (v[j][0] * v[j][0] + v[j][1] * v[j][1]) + (v[j][2] * v[j][2] + v[j][3] * v[j][3]);
          rstd = __builtin_amdgcn_rsqf(wave_sum(s) * (1.0f / D) + EPS);
        } else rstd = __builtin_amdgcn_rsqf(s2[row] * (1.0f / D) + EPS);
#pragma unroll
        for (int j = 0; j < 2; ++j) { *(f32x4*)(y + 8 * lane + 512 * j) = v[2 * j] * rstd * gf[2 * j]; *(f32x4*)(y + 8 * lane + 512 * j + 4) = v[2 * j + 1] * rstd * gf[2 * j + 1]; } } } } }
}

#undef FAST_SYNC
#undef ssq
#undef X1B
#undef XN
#undef CQN
#undef CKV
#undef KR
#undef QB
#undef KB
#undef VB
#undef Q
#undef KN
#undef V
#undef H
#undef PART
extern "C" void kernel_launch(void* const* d_in, const int* in_sizes, int n_in, void* d_out, int out_size, void* d_ws, size_t ws_size, hipStream_t stream) {
  static int grid = 0;
  if (grid == 0) {
    if (n_in != 22 || (size_t)out_size != OUT_TOTAL || ws_size < WS_TOTAL) { fprintf(stderr, "kernel_launch: unexpected shapes (n_in %d out %d ws %zu, need ws %zu)\n", n_in, out_size, ws_size, (size_t)WS_END); grid = -1; return; }
    int dev = 0, cus = 0, per_cu = 0;
    hipGetDevice(&dev); hipDeviceGetAttribute(&cus, hipDeviceAttributeMultiprocessorCount, dev);
    hipFuncSetAttribute((const void*)mk_fwd, hipFuncAttributeMaxDynamicSharedMemorySize, LDS_BYTES);
    hipOccupancyMaxActiveBlocksPerMultiprocessor(&per_cu, (const void*)mk_fwd, NTHREADS, LDS_BYTES);
    if (per_cu < 1 || cus < 1) { fprintf(stderr, "kernel_launch: occupancy query gave %d blocks/CU on %d CUs\n", per_cu, cus); grid = -1; return; }
    grid = cus * (per_cu > 1 ? 1 : per_cu);
  }
  if (grid < 0) return;
  Params p{};
  const float** pp = (const float**)&p;
  for (int i = 0; i < 22; ++i) pp[i] = (const float*)d_in[i];
  p.out = (float*)d_out; p.ws = (unsigned char*)d_ws;
  if (hipMemsetAsync((char*)d_ws + WS_BAR, 0, 16384, stream) != hipSuccess) { fprintf(stderr, "kernel_launch: memset of barrier words failed\n"); return; }
  void* args[] = {&p};
  hipError_t e = hipLaunchCooperativeKernel((void*)mk_fwd, dim3(grid), dim3(NTHREADS), args, LDS_BYTES, stream);
  if (e != hipSuccess) fprintf(stderr, "cooperative launch failed: %s (grid %d)\n", hipGetErrorString(e), grid);
}
```

```cpp
#include <hip/hip_runtime.h>
#include <hip/hip_cooperative_groups.h>
#include <cstdio>
#include <cstdint>


namespace cg = cooperative_groups;

#define LAS __attribute__((address_space(3)))
typedef unsigned short bf16_t;
typedef short bf16x8 __attribute__((ext_vector_type(8)));
typedef short s16x4 __attribute__((ext_vector_type(4)));
typedef float f32x4 __attribute__((ext_vector_type(4)));
typedef float f32x16 __attribute__((ext_vector_type(16)));
typedef unsigned u32x4 __attribute__((ext_vector_type(4)));
typedef unsigned u32x2 __attribute__((ext_vector_type(2)));
typedef float f32x2_t __attribute__((ext_vector_type(2)));
typedef __bf16 bf16x2_t __attribute__((ext_vector_type(2)));

constexpr int D = 1024, NBATCH = 32, SEQ = 2048, MP = NBATCH * SEQ, DB = 16, DSQ = 16, MS = DB * DSQ, MT = MP + MS, PAST = 4096;
constexpr int NIN = 2304, FF = 2816, NGU = 2 * FF;
constexpr int LROW = 4352, BROW = 768;
constexpr int MLAT = MP + DB * LROW, MBND = MP + DB * BROW;
constexpr float EPS = 1e-6f, LOG2E = 1.4426950408889634f;
constexpr float QSCALE_A = 0.10206207261596575f * LOG2E;
constexpr float QSCALE_B = 0.125f * LOG2E;
constexpr int NTHREADS = 512;
constexpr size_t OFF_Y = 0, OFF_CKVP = (size_t)MT * D, OFF_KRP = OFF_CKVP + (size_t)MP * 256, OFF_BKP = OFF_KRP + (size_t)MP * 32,
                 OFF_BVP = OFF_BKP + (size_t)NBATCH * 512 * 512, OFF_CKVS = OFF_BVP + (size_t)NBATCH * 512 * 512, OFF_KRS = OFF_CKVS + (size_t)MS * 256,
                 OFF_BKS = OFF_KRS + (size_t)MS * 32, OFF_BVS = OFF_BKS + (size_t)MS * 512, OUT_TOTAL = OFF_BVS + (size_t)MS * 512;
constexpr size_t al256(size_t x) { return (x + 255) & ~(size_t)255; }
constexpr size_t WS_SSQ = 0;
constexpr size_t WS_WIN = al256(WS_SSQ + 4 * (size_t)MT * 4);
constexpr size_t WS_WUQ = al256(WS_WIN + (size_t)NIN * 1024 * 2);
constexpr size_t WS_WKV = al256(WS_WUQ + (size_t)768 * 256 * 2);
constexpr size_t WS_WO = al256(WS_WKV + (size_t)1024 * 256 * 2);
constexpr size_t WS_WGU = al256(WS_WO + (size_t)1024 * 1024 * 2);
constexpr size_t WS_WD = al256(WS_WGU + (size_t)NGU * 1024 * 2);
constexpr size_t WS_X1B = al256(WS_WD + (size_t)1024 * FF * 2);
constexpr size_t WS_XN = al256(WS_X1B + (size_t)MT * 1024 * 2);
constexpr size_t WS_CQN = al256(WS_XN + (size_t)MT * 1024 * 2);
constexpr size_t WS_CKV = al256(WS_CQN + (size_t)MT * 256 * 2);
constexpr size_t WS_KR = al256(WS_CKV + (size_t)MLAT * 256 * 2);
constexpr size_t WS_QB = al256(WS_KR + (size_t)MLAT * 32 * 2);
constexpr size_t WS_KB = al256(WS_QB + (size_t)MT * 512 * 2);
constexpr size_t WS_VB = al256(WS_KB + (size_t)MBND * 512 * 2);
constexpr size_t WS_Q = al256(WS_VB + (size_t)MBND * 512 * 2);
constexpr size_t WS_KN = al256(WS_Q + (size_t)MT * 768 * 2);
constexpr size_t WS_V = al256(WS_KN + (size_t)MLAT * 512 * 2);
constexpr size_t WS_END = al256(WS_V + (size_t)MLAT * 512 * 2);
constexpr size_t WS_BAR = WS_END;
constexpr size_t WS_TOTAL = WS_END + 16384;
constexpr size_t WS_H = WS_XN;
static_assert(WS_H + (size_t)MT * FF * 2 <= WS_VB, "H overlay must end before anything live in P5/P6 (nothing is, but keep it inside dead buffers)");
static_assert(WS_TOTAL <= (size_t)1073741824, "workspace");

constexpr int LDS_GEMM = 131072, LDS_RED = LDS_GEMM, LDS_BYTES = 143360;
constexpr int KP_A = 208, KP_B = 144;
constexpr int AT_TILE = 0, AT_PRIV = 21504  , AT_QT = 51200  , AT_BIAS = 86016  , AT_WSF = 107008, AT_OSTG = 109056, AT_CMB = 141824;
static_assert(AT_CMB + 1024 <= LDS_BYTES, "attention LDS map");

struct Params {
  const float *xp, *xs, *c_ckv, *c_kr, *c_bk, *c_bv, *w_in, *g_attn, *g_q, *w_uq, *g_kv, *w_uk, *w_uv, *rel_bias, *g_out_a, *g_out_b, *w_out, *g_ffn,
      *w_gate, *w_up, *w_down, *g_final;
  float* out; unsigned char* ws;
};

typedef const __attribute__((address_space(4))) Params* ParamsC;
__device__ __forceinline__ unsigned f2bf(float f) { unsigned u = __builtin_bit_cast(unsigned, f); return (u + 0x7fffu + ((u >> 16) & 1u)) >> 16; }
__device__ __forceinline__ unsigned pk2(float lo, float hi) { f32x2_t v = {lo, hi}; bf16x2_t b = __builtin_convertvector(v, bf16x2_t); return __builtin_bit_cast(unsigned, b); }
__device__ __forceinline__ float bf2f(unsigned short b) { return __builtin_bit_cast(float, (unsigned)b << 16); }
__device__ __forceinline__ int maprow_lat(int row) { return row < MP ? row : MP + ((row - MP) >> 4) * LROW + PAST + ((row - MP) & 15); }
__device__ __forceinline__ int maprow_bnd(int row) { return row < MP ? row : MP + ((row - MP) >> 4) * BROW + 512 + ((row - MP) & 15); }
__device__ __forceinline__ int row_pos(int row) { return row < MP ? (row & (SEQ - 1)) : PAST + ((row - MP) & 15); }
__device__ __forceinline__ void rope_cs(int pos, int i, float& c, float& s) {
  const float inv = __builtin_amdgcn_exp2f(-(float)i * (13.287712379549449f / 16.0f));
  float rev = (float)pos * inv * 0.15915494309189535f; rev = rev - __builtin_floorf(rev);
  s = __builtin_amdgcn_sinf(rev); c = __builtin_amdgcn_cosf(rev);
}

namespace pg8 {
constexpr int BM = 256, BK = 64, HALF = 128, HTB = HALF * BK * 2, STAGE_BYTES = 8 * HTB, NXCD = 8, WGM = 8;
__host__ __device__ __forceinline__ int lds_byte(int r, int c) { const int st = (r >> 4) * 2 + (c >> 5), rr = r & 15, cc = c & 31, ob = rr * 64 + cc * 2; return st * 1024 + (ob ^ (((ob >> 9) & 1) << 5)); }
__host__ __device__ __forceinline__ void stage_rc(int b, int& R, int& C) { const int st = b / 1024, sb = b % 1024, swz = sb ^ (((sb >> 9) & 1) << 5); R = (st >> 1) * 16 + swz / 64; C = (st & 1) * 32 + (swz % 64) / 2; }
struct Unit { int pm, pn, koff; };
struct Gemm { const bf16_t* A; const bf16_t* Bt; int lda, ldb, K; };
struct StaticOrder {
  int nM, nN, nwg, G, c;
  __device__ void init(int M, int N, int G_, int c_) { nM = M / BM; nN = N / BM; nwg = nM * nN; G = G_; c = c_; }
  __device__ bool next(int i, Unit& u) const {
    const long L = (long)i * G + c; if (L >= nwg) return false;
    int wgid = (int)L; { const int q = nwg / NXCD, r = nwg % NXCD, xcd = wgid % NXCD, off = wgid / NXCD; wgid = (xcd < r ? xcd * (q + 1) : r * (q + 1) + (xcd - r) * q) + off; }
    const int nig = WGM * nN, gid = wgid / nig, fm = gid * WGM, gsz = (nM - fm) < WGM ? (nM - fm) : WGM;
    u.pm = fm + ((wgid % nig) % gsz); u.pn = (wgid % nig) / gsz; u.koff = 0; return true;
  }
};
struct SplitOrder {
  int pm, nN, nsub, kchunk, G, c;
  __device__ bool next(int i, Unit& u) const { const int s = i * G + c; if (s >= nsub) return false; u.pm = pm; u.pn = s % nN; u.koff = (s / nN) * kchunk; return true; }
};
template <class Epi, class Order>
__device__ __forceinline__ void gemm_phase(LAS unsigned char* lds, const Gemm g, const Order& S, Epi& E) {
  int tid_ = threadIdx.x; asm volatile("" : "+v"(tid_));
  const int tid = tid_, wid = __builtin_amdgcn_readfirstlane(tid >> 6), lane = tid & 63, wr = wid >> 2, wc = wid & 3, fr = lane & 15, fq = lane >> 4;
  int K_ = g.K; asm volatile("" : "+s"(K_));
  const int K = K_, nt = K / BK;
  int lda_ = g.lda, ldb_ = g.ldb; asm volatile("" : "+s"(lda_), "+s"(ldb_));
  unsigned voffA[2];
#pragma unroll
  for (int i = 0; i < 2; ++i) { int R, C; stage_rc(tid * 16 + i * 8192, R, C); voffA[i] = (unsigned)(R * lda_ + C) * 2u; }
  const size_t kstep = (size_t)(BK * 2), hstepA = (size_t)HALF * lda_ * 2, tstepA = 2 * hstepA, hstepB = (size_t)HALF * ldb_ * 2, tstepB = 2 * hstepB;
  const unsigned ldsw = (unsigned)wid * 1024u;
  const int aoff = lds_byte(wr * 64 + fr, fq * 8), boff = lds_byte(wc * 32 + fr, fq * 8);
#define PG8_SA(b, h) (((b) * 2 + (h)) * HTB)
#define PG8_SB(b, h) ((4 + (b) * 2 + (h)) * HTB)
#define PG8_STAGE_(bufoff, gbase, voff) do { _Pragma("unroll") for (int _i = 0; _i < 2; ++_i) \
    __builtin_amdgcn_global_load_lds((const unsigned*)((const char*)(gbase) + (voff)[_i]), (LAS unsigned*)(lds + (bufoff) + ldsw + _i * 8192), 16, 0, 0); } while (0)
#define PG8_STA(bufoff, gbase) PG8_STAGE_(bufoff, gbase, voffA)
#define PG8_STB(bufoff, gbase) PG8_STAGE_(bufoff, gbase, voffA)
#define PG8_LDA(dst, b, h) do { _Pragma("unroll") for (int m = 0; m < 4; ++m) _Pragma("unroll") for (int k = 0; k < 2; ++k) dst[m][k] = *(const LAS bf16x8*)(lds + PG8_SA(b, h) + aoff + m * 2048 + k * 1024); } while (0)
#define PG8_LDB(dst, b, h) do { _Pragma("unroll") for (int n = 0; n < 2; ++n) _Pragma("unroll") for (int k = 0; k < 2; ++k) dst[n][k] = *(const LAS bf16x8*)(lds + PG8_SB(b, h) + boff + n * 2048 + k * 1024); } while (0)
#define PG8_MMA(ai, bj, At, Bt) do { __builtin_amdgcn_s_setprio(1); _Pragma("unroll") for (int m = 0; m < 4; ++m) _Pragma("unroll") for (int n = 0; n < 2; ++n) _Pragma("unroll") for (int k = 0; k < 2; ++k) \
    acc[ai][bj][m][n] = __builtin_amdgcn_mfma_f32_16x16x32_bf16(Bt[n][k], At[m][k], acc[ai][bj][m][n], 0, 0, 0); __builtin_amdgcn_s_setprio(0); } while (0)
#define PG8_WAIT_V(n) asm volatile("s_waitcnt vmcnt(" #n ")" ::: "memory")
#define PG8_WAIT_L(n) asm volatile("s_waitcnt lgkmcnt(" #n ")" ::: "memory")
#define PG8_BAR __builtin_amdgcn_s_barrier()
#define PG8_SCHED __builtin_amdgcn_sched_barrier(0)
  Unit cur, nxt; int ui = 0;
  if (!S.next(0, cur)) return;
  f32x4 acc[2][2][4][2];
#pragma unroll
  for (int a = 0; a < 2; ++a)
#pragma unroll
    for (int b = 0; b < 2; ++b)
#pragma unroll
      for (int m = 0; m < 4; ++m)
#pragma unroll
        for (int n = 0; n < 2; ++n) acc[a][b][m][n] = (f32x4){0.f, 0.f, 0.f, 0.f};
  bf16x8 At[4][2], B0[2][2], B1[2][2];
  const char* cA = (const char*)g.A + (size_t)cur.pm * tstepA + (size_t)cur.koff * 2; const char* cB = (const char*)g.Bt + (size_t)cur.pn * tstepB + (size_t)cur.koff * 2;
  PG8_STB(PG8_SB(0, 0), cB); PG8_STB(PG8_SB(0, 1), cB + hstepB); PG8_STA(PG8_SA(0, 0), cA); PG8_STA(PG8_SA(0, 1), cA + hstepA);
  if (wr == 1) PG8_BAR;
  PG8_WAIT_V(2); PG8_BAR;
  PG8_STB(PG8_SB(1, 0), cB + kstep); PG8_STA(PG8_SA(1, 0), cA + kstep); PG8_STB(PG8_SB(1, 1), cB + hstepB + kstep);
  PG8_WAIT_V(6); PG8_BAR;
  for (;;) {
    const bool has_next = S.next(ui + 1, nxt);
    const char* nA = has_next ? (const char*)g.A + (size_t)nxt.pm * tstepA + (size_t)nxt.koff * 2 : cA; const char* nB = has_next ? (const char*)g.Bt + (size_t)nxt.pn * tstepB + (size_t)nxt.koff * 2 : cB;
    for (int t = 0; t < nt; t += 2) {
      const bool last = (t == nt - 2);
      const char* a1 = cA + (size_t)(t + 1) * kstep;
      const char* a2 = last ? nA : cA + (size_t)(t + 2) * kstep; const char* b2 = last ? nB : cB + (size_t)(t + 2) * kstep;
      const char* a3 = a2 + kstep; const char* b3 = b2 + kstep;
      if constexpr (Epi::HAS_MID) { if (t == E.tsplit) { E.mid(acc, cur, wr, wc, fr, fq); } }
      PG8_LDB(B0, 0, 0); PG8_LDB(B1, 0, 1); PG8_SCHED; PG8_LDA(At, 0, 0); PG8_STA(PG8_SA(1, 1), a1 + hstepA);
      PG8_WAIT_V(8); PG8_WAIT_L(0); PG8_BAR; PG8_MMA(0, 0, At, B0); PG8_MMA(0, 1, At, B1); PG8_BAR; PG8_SCHED;
      PG8_LDA(At, 0, 1); PG8_STB(PG8_SB(0, 0), b2); PG8_STB(PG8_SB(0, 1), b2 + hstepB); PG8_STA(PG8_SA(0, 0), a2);
      PG8_WAIT_V(8); PG8_WAIT_L(0); PG8_BAR; PG8_MMA(1, 0, At, B0); PG8_MMA(1, 1, At, B1); PG8_BAR; PG8_SCHED;
      PG8_LDB(B0, 1, 0); PG8_LDB(B1, 1, 1); PG8_SCHED; PG8_LDA(At, 1, 0); PG8_STA(PG8_SA(0, 1), a2 + hstepA);
      PG8_WAIT_V(8); PG8_WAIT_L(0); PG8_BAR; PG8_MMA(0, 0, At, B0); PG8_MMA(0, 1, At, B1); PG8_BAR; PG8_SCHED;
      PG8_LDA(At, 1, 1); PG8_STB(PG8_SB(1, 0), b3); PG8_STB(PG8_SB(1, 1), b3 + hstepB); PG8_STA(PG8_SA(1, 0), a3);
      PG8_WAIT_V(8); PG8_WAIT_L(0); PG8_BAR; PG8_MMA(1, 0, At, B0); PG8_MMA(1, 1, At, B1); PG8_BAR; PG8_SCHED;
    }
    if (wr == 0) PG8_BAR;
    E(acc, cur, wr, wc, fr, fq);
    if (!has_next) break;
#pragma unroll
    for (int a = 0; a < 2; ++a)
#pragma unroll
      for (int b = 0; b < 2; ++b)
#pragma unroll
        for (int m = 0; m < 4; ++m)
#pragma unroll
          for (int n = 0; n < 2; ++n) acc[a][b][m][n] = (f32x4){0.f, 0.f, 0.f, 0.f};
    cur = nxt; cA = nA; cB = nB; ++ui;
    if (wr == 1) PG8_BAR;
  }
  PG8_WAIT_V(0);
  PG8_BAR;
#undef PG8_SA
#undef PG8_SB
#undef PG8_STAGE_
#undef PG8_STA
#undef PG8_STB
#undef PG8_LDA
#undef PG8_LDB
#undef PG8_MMA
#undef PG8_WAIT_V
#undef PG8_WAIT_L
#undef PG8_BAR
#undef PG8_SCHED
}
}
using pg8::Unit;
typedef f32x4 Acc[2][2][4][2];
#define FOR_AM _Pragma("unroll") for (int ai = 0; ai < 2; ++ai) _Pragma("unroll") for (int m = 0; m < 4; ++m)
#define FOR_BN _Pragma("unroll") for (int bj = 0; bj < 2; ++bj) _Pragma("unroll") for (int n = 0; n < 2; ++n)
__device__ __forceinline__ void st_bf4(bf16_t* p, f32x4 v) { u32x2 w; w.x = pk2(v[0], v[1]); w.y = pk2(v[2], v[3]); *(u32x2*)p = w; }
__device__ __forceinline__ void st_bf8(bf16_t* p, f32x4 a, f32x4 b) { u32x4 w; w.x = pk2(a[0], a[1]); w.y = pk2(a[2], a[3]); w.z = pk2(b[0], b[1]); w.w = pk2(b[2], b[3]); *(u32x4*)p = w; }
__device__ __forceinline__ void atomic_addf(float* p, float v) { __hip_atomic_fetch_add(p, v, __ATOMIC_RELAXED, __HIP_MEMORY_SCOPE_AGENT); }

struct EpiIn {
  static constexpr bool HAS_MID = false;
  float* out; bf16_t *CQN, *CKV, *KR, *QB, *KB, *VB; const float* g_kv; LAS float* red;
  __device__ __forceinline__ void operator()(const Acc& acc, const Unit& u, int wr, int wc, int fr, int fq) const {
    const int pn = u.pn, rbase = u.pm * 256 + wr * 64 + fr, cw = wc * 32 + 4 * fq;
    if (pn <= 1) {
      FOR_AM { float s = 0.f; FOR_BN { const f32x4 x = acc[ai][bj][m][n]; s += (x[0] * x[0] + x[1] * x[1]) + (x[2] * x[2] + x[3] * x[3]); }
        s += __shfl_xor(s, 16); s += __shfl_xor(s, 32);
        if (fq == 0) red[(ai * 128 + wr * 64 + m * 16 + fr) * 4 + wc] = s; }
      asm volatile("s_waitcnt lgkmcnt(0)" ::: "memory"); __builtin_amdgcn_s_barrier(); asm volatile("" ::: "memory");
      FOR_AM { const f32x4 t = *(const LAS f32x4*)(red + (ai * 128 + wr * 64 + m * 16 + fr) * 4);
        const float rstd = __builtin_amdgcn_rsqf(((t[0] + t[1]) + (t[2] + t[3])) * (1.0f / 256.0f) + EPS);
        const int row = rbase + ai * 128 + m * 16;
        if (pn == 0) { FOR_BN { const int col = bj * 128 + n * 16 + cw; st_bf4(CQN + (size_t)row * 256 + col, acc[ai][bj][m][n] * rstd); } }
        else { const int mr = maprow_lat(row); float* o = row < MP ? out + OFF_CKVP + (size_t)row * 256 : out + OFF_CKVS + (size_t)(row - MP) * 256;
          FOR_BN { const int col = bj * 128 + n * 16 + cw; const f32x4 v = acc[ai][bj][m][n] * rstd * *(const f32x4*)(g_kv + col);
            *(f32x4*)(o + col) = v; st_bf4(CKV + (size_t)mr * 256 + col, v); } } }
      asm volatile("s_waitcnt lgkmcnt(0)" ::: "memory"); __builtin_amdgcn_s_barrier(); asm volatile("" ::: "memory");
    } else if (pn <= 3) {
      FOR_AM { const int row = rbase + ai * 128 + m * 16; FOR_BN { const int col = (pn - 2) * 256 + bj * 128 + n * 16 + cw; st_bf4(QB + (size_t)row * 512 + col, acc[ai][bj][m][n] * QSCALE_B); } }
    } else if (pn <= 7) {
      const bool isv = pn >= 6; bf16_t* dst = isv ? VB : KB; const int c0 = (pn & 1) * 256;
      FOR_AM { const int row = rbase + ai * 128 + m * 16; const int mr = maprow_bnd(row);
        float* o = nullptr;
        if (row >= MP) o = out + (isv ? OFF_BVS : OFF_BKS) + (size_t)(row - MP) * 512;
        else if ((row & (SEQ - 1)) >= SEQ - 512) o = out + (isv ? OFF_BVP : OFF_BKP) + ((size_t)(row >> 11) * 512 + ((row & (SEQ - 1)) - (SEQ - 512))) * 512;
        FOR_BN { const int col = c0 + bj * 128 + n * 16 + cw; const f32x4 v = acc[ai][bj][m][n]; st_bf4(dst + (size_t)mr * 512 + col, v); if (o) *(f32x4*)(o + col) = v; } }
    } else {
      if (wc == 0) {
        FOR_AM { const int row = rbase + ai * 128 + m * 16; const int pos = row_pos(row), mr = maprow_lat(row);
          float* o = row < MP ? out + OFF_KRP + (size_t)row * 32 : out + OFF_KRS + (size_t)(row - MP) * 32;
          const f32x4 x1 = acc[ai][0][m][0], x2 = acc[ai][0][m][1]; f32x4 y1, y2;
#pragma unroll
          for (int j = 0; j < 4; ++j) { float c, s; rope_cs(pos, 4 * fq + j, c, s); y1[j] = x1[j] * c - x2[j] * s; y2[j] = x1[j] * s + x2[j] * c; }
          *(f32x4*)(o + 4 * fq) = y1; *(f32x4*)(o + 16 + 4 * fq) = y2;
          st_bf4(KR + (size_t)mr * 32 + 4 * fq, y1); st_bf4(KR + (size_t)mr * 32 + 16 + 4 * fq, y2); }
      }
    }
  }
};
struct EpiQ {
  static constexpr bool HAS_MID = false;
  bf16_t* Q;
  __device__ __forceinline__ void operator()(const Acc& acc, const Unit& u, int wr, int wc, int fr, int fq) const {
    const int pn = u.pn, rbase = u.pm * 256 + wr * 64 + fr;
    if (pn <= 1) {
      FOR_AM { const int row = rbase + ai * 128 + m * 16; FOR_BN { const int col = pn * 256 + bj * 128 + wc * 32 + n * 16 + 4 * fq; st_bf4(Q + (size_t)row * 768 + (col >> 6) * 96 + (col & 63), acc[ai][bj][m][n] * QSCALE_A); } }
    } else {
      FOR_AM { const int row = rbase + ai * 128 + m * 16; const int pos = row_pos(row);
        float cs[4], sn[4];
#pragma unroll
        for (int j = 0; j < 4; ++j) rope_cs(pos, 4 * fq + j, cs[j], sn[j]);
#pragma unroll
        for (int bj = 0; bj < 2; ++bj) { const int head = 4 * bj + wc; const f32x4 x1 = acc[ai][bj][m][0], x2 = acc[ai][bj][m][1]; f32x4 y1, y2;
#pragma unroll
          for (int j = 0; j < 4; ++j) { y1[j] = (x1[j] * cs[j] - x2[j] * sn[j]) * QSCALE_A; y2[j] = (x1[j] * sn[j] + x2[j] * cs[j]) * QSCALE_A; }
          bf16_t* q = Q + (size_t)row * 768 + head * 96 + 64 + 4 * fq; st_bf4(q, y1); st_bf4(q + 16, y2); } __builtin_amdgcn_sched_barrier(0); }
    }
  }
};
struct EpiKV {
  static constexpr bool HAS_MID = false;
  bf16_t *KN, *V;
  __device__ __forceinline__ void operator()(const Acc& acc, const Unit& u, int wr, int wc, int fr, int fq) const {
    const int pn = u.pn, rbase = u.pm * 256 + wr * 64 + fr; bf16_t* dst = pn >= 2 ? V : KN; const int c0 = (pn & 1) * 256 + wc * 32 + 4 * fq;
    FOR_AM { const int row = rbase + ai * 128 + m * 16; FOR_BN { st_bf4(dst + (size_t)row * 512 + c0 + bj * 128 + n * 16, acc[ai][bj][m][n]); } }
  }
};
struct EpiO {
  static constexpr bool HAS_MID = true;
  int tsplit; const float *ssq_a, *ssq_b, *xp, *xs; bf16_t* X1B; float* ssq_x1;
  __device__ __forceinline__ void mid(Acc& acc, const Unit& u, int wr, int wc, int fr, int fq) const {
    const int rbase = u.pm * 256 + wr * 64 + fr;
    FOR_AM { const int row = rbase + ai * 128 + m * 16; const float sa = ssq_a[row], sb = ssq_b[row];
      const float ratio = __builtin_amdgcn_rsqf(sa * (1.0f / 512.0f) + EPS) * __builtin_sqrtf(sb * (1.0f / 512.0f) + EPS);
      FOR_BN { acc[ai][bj][m][n] = acc[ai][bj][m][n] * ratio; }
      __builtin_amdgcn_sched_barrier(0); }
    asm volatile("s_waitcnt vmcnt(0)" ::: "memory");
  }
  __device__ __forceinline__ void operator()(const Acc& acc, const Unit& u, int wr, int wc, int fr, int fq) const {
    const int rbase = u.pm * 256 + wr * 64 + fr, c0 = u.pn * 256 + wc * 32 + 4 * fq;
    FOR_AM { const int row = rbase + ai * 128 + m * 16; const float rb = __builtin_amdgcn_rsqf(ssq_b[row] * (1.0f / 512.0f) + EPS);
      const float* xr = row < MP ? xp + (size_t)row * D : xs + (size_t)(row - MP) * D; float s = 0.f;
      FOR_BN { const int col = c0 + bj * 128 + n * 16; const f32x4 v = *(const f32x4*)(xr + col) + acc[ai][bj][m][n] * rb;
        st_bf4(X1B + (size_t)row * D + col, v); s += (v[0] * v[0] + v[1] * v[1]) + (v[2] * v[2] + v[3] * v[3]); }
      s += __shfl_xor(s, 16); s += __shfl_xor(s, 32); if (fq == 0) atomic_addf(ssq_x1 + row, s); __builtin_amdgcn_sched_barrier(0); }
  }
};
struct EpiGU {
  static constexpr bool HAS_MID = false;
  const float* ssq_x1; bf16_t* H;
  __device__ __forceinline__ void operator()(const Acc& acc, const Unit& u, int wr, int wc, int fr, int fq) const {
    const int rbase = u.pm * 256 + wr * 64 + fr, c0 = u.pn * 128 + wc * 16 + 4 * fq;
    FOR_AM { const int row = rbase + ai * 128 + m * 16; const float rstd = __builtin_amdgcn_rsqf(ssq_x1[row] * (1.0f / 1024.0f) + EPS);
#pragma unroll
      for (int bj = 0; bj < 2; ++bj) { const f32x4 g = acc[ai][bj][m][0] * rstd, up = acc[ai][bj][m][1] * rstd; f32x4 hv;
#pragma unroll
        for (int j = 0; j < 4; ++j) hv[j] = g[j] * __builtin_amdgcn_rcpf(1.0f + __builtin_amdgcn_exp2f(-g[j] * LOG2E)) * up[j];
        st_bf4(H + (size_t)row * FF + c0 + bj * 64, hv); } }
  }
};
__device__ __forceinline__ f32x4 ld_bf4(const bf16_t* p) { const u32x2 w = *(const u32x2*)p; return (f32x4){__builtin_bit_cast(float, w.x << 16), __builtin_bit_cast(float, w.x & 0xffff0000u), __builtin_bit_cast(float, w.y << 16), __builtin_bit_cast(float, w.y & 0xffff0000u)}; }
struct EpiD {
  static constexpr bool HAS_MID = false;
  bf16_t* X; float* ssq_x2;
  __device__ __forceinline__ void operator()(const Acc& acc, const Unit& u, int wr, int wc, int fr, int fq) const {
    const int rbase = u.pm * 256 + wr * 64 + fr, c0 = u.pn * 256 + wc * 32 + 4 * fq;
    FOR_AM { const int row = rbase + ai * 128 + m * 16; float s = 0.f;
      FOR_BN { bf16_t* x = X + (size_t)row * D + c0 + bj * 128 + n * 16; const f32x4 v = ld_bf4(x) + acc[ai][bj][m][n]; st_bf4(x, v);
        s += (v[0] * v[0] + v[1] * v[1]) + (v[2] * v[2] + v[3] * v[3]); }
      s += __shfl_xor(s, 16); s += __shfl_xor(s, 32); if (fq == 0) atomic_addf(ssq_x2 + row, s); }
  }
};
struct EpiPart {
  static constexpr bool HAS_MID = false;
  float* PART;
  __device__ __forceinline__ void operator()(const Acc& acc, const Unit& u, int wr, int wc, int fr, int fq) const {
    float* base = PART + (size_t)(u.koff >> 8) * 256 * D; const int r0 = wr * 64 + fr, c0 = u.pn * 256 + wc * 32 + 4 * fq;
    FOR_AM { FOR_BN { *(f32x4*)(base + (size_t)(r0 + ai * 128 + m * 16) * D + c0 + bj * 128 + n * 16) = acc[ai][bj][m][n]; } }
  }
};

__device__ __forceinline__ float wave_sum(float v) {
#pragma unroll
  for (int o = 1; o < 64; o <<= 1) v += __shfl_xor(v, o);
  return v;
}
template <class Map>
__device__ __forceinline__ void transpose_item(const float* W, int K, int N, bf16_t* WT, const float* g, LAS float* scr, int item, int lane, Map map) {
  const int nblk = N / 32, kb = item / nblk, nb = item % nblk, k0 = 64 * kb, n0 = 32 * nb;
#pragma unroll 8
  for (int i = 0; i < 32; ++i) { const int kk = 2 * i + (lane >> 5); scr[kk * 33 + (lane & 31)] = W[(size_t)(k0 + kk) * N + n0 + (lane & 31)] * (g ? g[k0 + kk] : 1.0f); }
  asm volatile("s_waitcnt lgkmcnt(0)" ::: "memory");
  const int c = lane & 7;
#pragma unroll
  for (int j = 0; j < 4; ++j) { const int n = (lane >> 3) + 8 * j; const LAS float* s = scr + (8 * c) * 33 + n;
    u32x4 o; o.x = pk2(s[0 * 33], s[1 * 33]); o.y = pk2(s[2 * 33], s[3 * 33]); o.z = pk2(s[4 * 33], s[5 * 33]); o.w = pk2(s[6 * 33], s[7 * 33]);
    *(u32x4*)(WT + (size_t)map(n0 + n) * K + k0 + 8 * c) = o; }
  asm volatile("s_waitcnt lgkmcnt(0)" ::: "memory");
}
template <class Map>
__device__ __forceinline__ void convert_rows(const float* src, bf16_t* dst, int R, int cshift, int gt, int ngt, Map map) {
  const long n8 = ((long)R << cshift) >> 3;
  for (long i0 = gt; i0 < n8; i0 += 4L * ngt) {
    f32x4 v[4][2];
#pragma unroll
    for (int k = 0; k < 4; ++k) { const long i = i0 + (long)k * ngt; if (i < n8) { v[k][0] = *(const f32x4*)(src + i * 8); v[k][1] = *(const f32x4*)(src + i * 8 + 4); } }
#pragma unroll
    for (int k = 0; k < 4; ++k) { const long i = i0 + (long)k * ngt; if (i < n8) { const long e = i * 8; const int r = (int)(e >> cshift), c = (int)(e & ((1 << cshift) - 1));
      st_bf8(dst + ((size_t)map(r) << cshift) + c, v[k][0], v[k][1]); } }
  }
}
__device__ __forceinline__ void zero_rows(bf16_t* dst, int cshift, int r0, int nr, int nb, int bstride, int gt, int ngt) {
  const long per = ((long)nr << cshift) >> 3, n8 = per * nb;
  for (long i = gt; i < n8; i += ngt) { const int b = (int)(i / per); const long e = (i % per) * 8; *(u32x4*)(dst + (((size_t)b * bstride + r0) << cshift) + e) = (u32x4){0u, 0u, 0u, 0u}; }
}
__device__ __forceinline__ void prologue(ParamsC p, LAS unsigned char* lds, int G) {
  const int tid = threadIdx.x, lane = tid & 63, wave = tid >> 6; unsigned char* ws = p->ws;
  const int gw = blockIdx.x * 8 + wave, NGW = G * 8, gt = blockIdx.x * NTHREADS + tid, ngt = G * NTHREADS;
  LAS float* scr = (LAS float*)(lds + wave * 16384);
  bf16_t* WinT = (bf16_t*)(ws + WS_WIN); bf16_t* WuqT = (bf16_t*)(ws + WS_WUQ); bf16_t* WkvT = (bf16_t*)(ws + WS_WKV); bf16_t* WoT = (bf16_t*)(ws + WS_WO);
  bf16_t* WguT = (bf16_t*)(ws + WS_WGU); bf16_t* WdT = (bf16_t*)(ws + WS_WD);
  constexpr int I_IN = 16 * 65, I_UQ = 4 * 24, I_UK = 4 * 16, I_O = 16 * 32, I_G = 16 * 88, I_D = 44 * 32;
  constexpr int NITEMS = I_IN + I_UQ + 2 * I_UK + I_O + 2 * I_G + I_D;
  for (int it = gw; it < NITEMS; it += NGW) {
    int r = it;
    if (r < I_IN) { transpose_item(p->w_in, 1024, 2080, WinT, p->g_attn, scr, r, lane, [](int n) { return n < 512 ? n : (n < 544 ? 2048 + (n - 512) : 512 + (n - 544)); }); continue; } r -= I_IN;
    if (r < I_UQ) { transpose_item(p->w_uq, 256, 768, WuqT, p->g_q, scr, r, lane, [](int n) { const int h = n / 96, d = n % 96; return d < 64 ? h * 64 + d : 512 + h * 32 + (d - 64); }); continue; } r -= I_UQ;
    if (r < I_UK) { transpose_item(p->w_uk, 256, 512, WkvT, nullptr, scr, r, lane, [](int n) { return n; }); continue; } r -= I_UK;
    if (r < I_UK) { transpose_item(p->w_uv, 256, 512, WkvT, nullptr, scr, r, lane, [](int n) { return 512 + n; }); continue; } r -= I_UK;
    if (r < I_O) { const int kb = r / 32; transpose_item(p->w_out, 1024, 1024, WoT, kb < 8 ? p->g_out_a : p->g_out_b - 512, scr, r, lane, [](int n) { return n; }); continue; } r -= I_O;
    if (r < I_G) { transpose_item(p->w_gate, 1024, FF, WguT, p->g_ffn, scr, r, lane, [](int n) { return 32 * (n >> 4) + (n & 15); }); continue; } r -= I_G;
    if (r < I_G) { transpose_item(p->w_up, 1024, FF, WguT, p->g_ffn, scr, r, lane, [](int n) { return 32 * (n >> 4) + 16 + (n & 15); }); continue; } r -= I_G;
    transpose_item(p->w_down, FF, 1024, WdT, nullptr, scr, r, lane, [](int n) { return n; });
  }
  zero_rows(WinT, 10, 2080, NIN - 2080, 1, 0, gt, ngt);
  bf16_t* XN = (bf16_t*)(ws + WS_XN);
  for (int row0 = gw; row0 < MT; row0 += 4 * NGW) {
    f32x4 v[4][4]; float s[4] = {0.f, 0.f, 0.f, 0.f};
#pragma unroll
    for (int k = 0; k < 4; ++k) { const int row = row0 + k * NGW; if (row < MT) { const float* xr = row < MP ? p->xp + (size_t)row * D : p->xs + (size_t)(row - MP) * D;
#pragma unroll
      for (int j = 0; j < 2; ++j) { v[k][2 * j] = *(const f32x4*)(xr + 8 * lane + 512 * j); v[k][2 * j + 1] = *(const f32x4*)(xr + 8 * lane + 512 * j + 4); } } }
#pragma unroll
    for (int k = 0; k < 4; ++k) { const int row = row0 + k * NGW; if (row < MT) {
#pragma unroll
      for (int j = 0; j < 4; ++j) s[k] += (v[k][j][0] * v[k][j][0] + v[k][j][1] * v[k][j][1]) + (v[k][j][2] * v[k][j][2] + v[k][j][3] * v[k][j][3]);
      const float rstd = __builtin_amdgcn_rsqf(wave_sum(s[k]) * (1.0f / D) + EPS);
#pragma unroll
      for (int j = 0; j < 2; ++j) st_bf8(XN + (size_t)row * D + 8 * lane + 512 * j, v[k][2 * j] * rstd, v[k][2 * j + 1] * rstd); } }
  }
  bf16_t* CKV = (bf16_t*)(ws + WS_CKV); bf16_t* KR = (bf16_t*)(ws + WS_KR); bf16_t* KB = (bf16_t*)(ws + WS_KB); bf16_t* VB = (bf16_t*)(ws + WS_VB);
  convert_rows(p->c_ckv, CKV, DB * PAST, 8, gt, ngt, [](int r) { return MP + (r >> 12) * LROW + (r & 4095); });
  convert_rows(p->c_kr, KR, DB * PAST, 5, gt, ngt, [](int r) { return MP + (r >> 12) * LROW + (r & 4095); });
  convert_rows(p->c_bk, KB, DB * 512, 9, gt, ngt, [](int r) { return MP + (r >> 9) * BROW + (r & 511); });
  convert_rows(p->c_bv, VB, DB * 512, 9, gt, ngt, [](int r) { return MP + (r >> 9) * BROW + (r & 511); });
  zero_rows(CKV + (size_t)MP * 256, 8, PAST + DSQ, LROW - PAST - DSQ, DB, LROW, gt, ngt);
  zero_rows(KR + (size_t)MP * 32, 5, PAST + DSQ, LROW - PAST - DSQ, DB, LROW, gt, ngt);
  zero_rows(KB + (size_t)MP * 512, 9, 512 + DSQ, BROW - 512 - DSQ, DB, BROW, gt, ngt);
  zero_rows(VB + (size_t)MP * 512, 9, 512 + DSQ, BROW - 512 - DSQ, DB, BROW, gt, ngt);
  float* ssq = (float*)(ws + WS_SSQ);
  for (int i = gt; i < 4 * MT; i += ngt) ssq[i] = 0.f;
}

__device__ __forceinline__ f32x16 mfma32(bf16x8 a, bf16x8 b, f32x16 c) { return __builtin_amdgcn_mfma_f32_32x32x16_bf16(a, b, c, 0, 0, 0); }
__device__ __forceinline__ s16x4 vtr(const LAS unsigned char* p) { return __builtin_bit_cast(s16x4, __builtin_amdgcn_ds_read_tr16_b64_v4i16((LAS s16x4*)p)); }
template <int NS, bool BIAS, bool QL>
__device__ __forceinline__ void attn_qk(const LAS unsigned char* Kt, const bf16x8 (&qf)[NS], const LAS unsigned char* Qt, f32x16 (&st)[2], int nvalid, const LAS float* btab, int rb, bool lookup, int lane) {
  constexpr int KP = NS == 6 ? KP_A : KP_B;
  const int r = lane & 31, h = lane >> 5;
  bf16x8 qv[NS];
#pragma unroll
  for (int s = 0; s < NS; ++s) qv[s] = QL ? *(const LAS bf16x8*)(Qt + r * KP + (2 * s + h) * 16) : qf[s];
#pragma unroll
  for (int kh = 0; kh < 2; ++kh) {
    bf16x8 kf[NS];
#pragma unroll
    for (int s = 0; s < NS; ++s) kf[s] = *(const LAS bf16x8*)(Kt + (32 * kh + r) * KP + (2 * s + h) * 16);
    __builtin_amdgcn_sched_barrier(0);
    __builtin_amdgcn_s_setprio(1);
    { const f32x16 z = {0.f, 0.f, 0.f, 0.f, 0.f, 0.f, 0.f, 0.f, 0.f, 0.f, 0.f, 0.f, 0.f, 0.f, 0.f, 0.f}; st[kh] = mfma32(kf[0], qv[0], z); }
#pragma unroll
    for (int s = 1; s < NS; ++s) st[kh] = mfma32(kf[s], qv[s], st[kh]);
    __builtin_amdgcn_s_setprio(0);
    __builtin_amdgcn_sched_barrier(0);
  }
  if (BIAS) {
    if (lookup) { const LAS float* bp = btab + rb + 4 * h;
#pragma unroll
      for (int kh = 0; kh < 2; ++kh)
#pragma unroll
        for (int i = 0; i < 16; ++i) st[kh][i] += bp[32 * kh + (i & 3) + 8 * (i >> 2)];
    } else { const float bc = btab[0];
#pragma unroll
      for (int kh = 0; kh < 2; ++kh)
#pragma unroll
        for (int i = 0; i < 16; ++i) st[kh][i] += bc; }
  }
  if (nvalid < 64) {
#pragma unroll
    for (int kh = 0; kh < 2; ++kh)
#pragma unroll
      for (int i = 0; i < 16; ++i) { const int key = 32 * kh + (i & 3) + 8 * (i >> 2) + 4 * h; if (key >= nvalid) st[kh][i] = -1e30f; }
  }
}
__device__ __forceinline__ void attn_smpv(const LAS unsigned char* Vt, f32x16 (&st)[2], f32x16 (&o)[2], float& m_run, float& l_run, LAS float* wsf, int lane) {
  const int r = lane & 31, h = lane >> 5;
  float mx = st[0][0];
#pragma unroll
  for (int kh = 0; kh < 2; ++kh)
#pragma unroll
    for (int i = 0; i < 16; ++i) mx = __builtin_fmaxf(mx, st[kh][i]);
  mx = __builtin_fmaxf(mx, __shfl_xor(mx, 32));
  const float m_new = __builtin_fmaxf(m_run, mx), alpha = __builtin_amdgcn_exp2f(m_run - m_new);
  float rs = 0.f;
#pragma unroll
  for (int kh = 0; kh < 2; ++kh)
#pragma unroll
    for (int i = 0; i < 16; ++i) { const float pv = __builtin_amdgcn_exp2f(st[kh][i] - m_new); st[kh][i] = pv; rs += pv; }
  rs += __shfl_xor(rs, 32);
  l_run = l_run * alpha + rs; m_run = m_new;
  {
    if (h == 0) wsf[r] = alpha;
    typedef float f32x8 __attribute__((ext_vector_type(8)));
    const f32x4 a0 = *(const LAS f32x4*)(wsf + 4 * h), a1 = *(const LAS f32x4*)(wsf + 8 + 4 * h), a2 = *(const LAS f32x4*)(wsf + 16 + 4 * h), a3 = *(const LAS f32x4*)(wsf + 24 + 4 * h);
    const f32x8 lo = __builtin_shufflevector(a0, a1, 0, 1, 2, 3, 4, 5, 6, 7), hi = __builtin_shufflevector(a2, a3, 0, 1, 2, 3, 4, 5, 6, 7);
    const f32x16 av = __builtin_shufflevector(lo, hi, 0, 1, 2, 3, 4, 5, 6, 7, 8, 9, 10, 11, 12, 13, 14, 15);
    o[0] = o[0] * av; o[1] = o[1] * av;
  }
  const int blk = (lane >> 4) & 1, q = (lane & 15) >> 2, p = lane & 3;
  const int vb = (4 * h + q) * 128 + 8 * (p & 1), co0 = ((2 * blk + (p >> 1)) ^ (((q >> 1) & 1) << 2)) << 4;
#pragma unroll
  for (int kh = 0; kh < 2; ++kh)
#pragma unroll
    for (int s2 = 0; s2 < 2; ++s2) {
      u32x4 pw;
#pragma unroll
      for (int k = 0; k < 4; ++k) pw[k] = pk2(st[kh][8 * s2 + 2 * k], st[kh][8 * s2 + 2 * k + 1]);
      const bf16x8 pa = __builtin_bit_cast(bf16x8, pw);
#pragma unroll
      for (int c = 0; c < 2; ++c) {
        const LAS unsigned char* vp = Vt + (32 * kh + 16 * s2) * 128 + vb + (c ? (co0 ^ 64) : co0);
        const s16x4 lo = vtr(vp), hi = vtr(vp + 8 * 128);
        const bf16x8 vf = __builtin_shufflevector(lo, hi, 0, 1, 2, 3, 4, 5, 6, 7);
        __builtin_amdgcn_s_setprio(1); o[c] = mfma32(pa, vf, o[c]); __builtin_amdgcn_s_setprio(0);
      }
    }
}
__device__ __forceinline__ void scale_o(f32x16 (&o)[2], float f, LAS float* wsf, int lane) {
  const int r = lane & 31, h = lane >> 5;
  if (h == 0) wsf[r] = f;
#pragma unroll
  for (int g = 0; g < 4; ++g) { const f32x4 a4 = *(const LAS f32x4*)(wsf + 8 * g + 4 * h);
#pragma unroll
    for (int j = 0; j < 4; ++j) { o[0][4 * g + j] *= a4[j]; o[1][4 * g + j] *= a4[j]; } }
}
__device__ __forceinline__ void store_o(const f32x16 (&o)[2], LAS bf16_t* stg, bf16_t* att  , float* ssq  , int nq, int lane) {
  const int r = lane & 31, h = lane >> 5;
#pragma unroll
  for (int c = 0; c < 2; ++c)
#pragma unroll
    for (int i = 0; i < 16; ++i) stg[((i & 3) + 8 * (i >> 2) + 4 * h) * 64 + 32 * c + r] = (bf16_t)f2bf(o[c][i]);
  const int qr = lane >> 1, half = lane & 1; float s = 0.f; u32x4 v[4];
#pragma unroll
  for (int k = 0; k < 4; ++k) { v[k] = *(const LAS u32x4*)(stg + qr * 64 + half * 32 + 8 * k);
#pragma unroll
    for (int e = 0; e < 4; ++e) { const float a = __builtin_bit_cast(float, v[k][e] << 16), b = __builtin_bit_cast(float, v[k][e] & 0xffff0000u); s += a * a + b * b; } }
  s += __shfl_xor(s, 1);
  if (qr < nq) {
#pragma unroll
    for (int k = 0; k < 4; ++k) *(u32x4*)(att + (size_t)qr * D + half * 32 + 8 * k) = v[k];
    if (half == 0 && ssq) atomic_addf(ssq + qr, s);
  }
}
struct KVSrc { const bf16_t* K; const bf16_t* KRp; const bf16_t* V; };
template <int NS>
__device__ __forceinline__ u32x4 ld_kchunk(const KVSrc& s, long krow, int id) {
  if (NS == 6) { const int row = id / 12, ch = id - row * 12;
    return ch < 8 ? *(const u32x4*)(s.K + (krow + row) * 512 + ch * 8) : *(const u32x4*)(s.KRp + (krow + row) * 32 + (ch - 8) * 8); }
  else { const int row = id >> 3, ch = id & 7; return *(const u32x4*)(s.K + (krow + row) * 512 + ch * 8); }
}
template <int NS>
__device__ __forceinline__ void st_kchunk(LAS unsigned char* Kt, int id, u32x4 v) {
  constexpr int KP = NS == 6 ? KP_A : KP_B, CPR = NS == 6 ? 12 : 8;
  const int row = id / CPR, ch = id - row * CPR; *(LAS u32x4*)(Kt + row * KP + ch * 16) = v;
}
__device__ __forceinline__ void st_vchunk(LAS unsigned char* Vt, int id, u32x4 v) { const int row = id >> 3, ch = id & 7; *(LAS u32x4*)(Vt + row * 128 + ((ch ^ (((row >> 1) & 1) << 2)) << 4)) = v; }

__device__ __forceinline__ void glds16(const void* gsrc, unsigned lds_dst) {
  unsigned keep;
  asm volatile("s_mov_b32 %0, m0\n\ts_mov_b32 m0, %2\n\ts_nop 0\n\tglobal_load_lds_dwordx4 %1, off\n\ts_mov_b32 m0, %0" : "=&s"(keep) : "v"(gsrc), "s"(lds_dst) : "memory");
}
template <int NS>
__device__ __forceinline__ void dma_tile(LAS unsigned char* Kt, LAS unsigned char* Vt, const KVSrc& src, long krow, int wave, int lane) {
  constexpr int CPR = NS == 6 ? 13 : 9, ND = CPR;
#pragma unroll
  for (int k = 0; k < 2; ++k) { const int d = wave + 8 * k;
    if (d < ND) { const int c = d * 64 + lane, row = c / CPR, ch = c - row * CPR;
      const bf16_t* g = (NS == 6 && ch >= 8 && ch < 12) ? src.KRp + (krow + row) * 32 + (ch - 8) * 8 : src.K + (krow + row) * 512 + (ch < 8 ? ch : 0) * 8;
      glds16(g, (unsigned)__builtin_amdgcn_readfirstlane((int)(unsigned)(uintptr_t)(Kt + d * 1024))); } }
  { const int c = wave * 64 + lane, row = c >> 3, ch = (c & 7) ^ (((row >> 1) & 1) << 2);
    glds16(src.V + (krow + row) * 512 + ch * 8, (unsigned)__builtin_amdgcn_readfirstlane((int)(unsigned)(uintptr_t)(Vt + wave * 1024))); }
}
#define AT_VMWAIT(n) asm volatile("s_waitcnt vmcnt(" #n ")" ::: "memory")
template <int NS, bool BIAS>
__device__ __forceinline__ void attn_unit_shared(LAS unsigned char* lds, const bf16_t* Qw  , int qpitch, const KVSrc src, long krow0,
                                                 int t_lo, int t_hi, int w_lo, int w_hi, int qpos0  , bf16_t* att, float* ssq, int bhead = 0) {
  constexpr int SLOT = 21504, ND = NS == 6 ? 13 : 9;
  int tid_ = threadIdx.x; asm volatile("" : "+v"(tid_));
  const int tid = tid_, lane = tid & 63, wave = __builtin_amdgcn_readfirstlane(tid >> 6), r = lane & 31, h = lane >> 5;
  LAS float* wsf = (LAS float*)(lds + AT_WSF) + wave * 64; const LAS float* btab = (const LAS float*)(lds + AT_BIAS) + bhead * 640;
#pragma unroll
  for (int k = 0; k < 2; ++k) if (t_lo + k <= t_hi) dma_tile<NS>(lds + AT_TILE + k * SLOT, lds + AT_TILE + k * SLOT + 13312, src, krow0 + 64L * (t_lo + k), wave, lane);
  bf16x8 qf[NS];
#pragma unroll
  for (int s = 0; s < NS; ++s) qf[s] = *(const bf16x8*)(Qw + (size_t)r * qpitch + 16 * s + 8 * h);
#pragma unroll
  for (int s = 0; s < NS; ++s) asm volatile("" : "+v"(qf[s]));
  f32x16 o[2];
#pragma unroll
  for (int i = 0; i < 16; ++i) { o[0][i] = 0.f; o[1][i] = 0.f; }
  float m_run = -1e30f, l_run = 0.f;
  AT_VMWAIT(0);
  asm volatile("s_waitcnt lgkmcnt(0)" ::: "memory"); __builtin_amdgcn_s_barrier(); asm volatile("" ::: "memory");
  for (int t0 = t_lo; t0 <= t_hi; t0 += 2) {
#pragma unroll
    for (int k = 2; k < 4; ++k) if (t0 + k <= t_hi) { const int s3 = (t0 + k - t_lo) & 3; dma_tile<NS>(lds + AT_TILE + s3 * SLOT, lds + AT_TILE + s3 * SLOT + 13312, src, krow0 + 64L * (t0 + k), wave, lane); }
#pragma unroll
    for (int k = 0; k < 2; ++k) { const int t = t0 + k; const int sl = (t - t_lo) & 3;
      if (t <= t_hi && t >= w_lo && t <= w_hi) {
        const bool lookup = BIAS && (qpos0 - (64 * t + 63) < 256);
        f32x16 st[2]; attn_qk<NS, BIAS, false>(lds + AT_TILE + sl * SLOT, qf, nullptr, st, 64, btab, 639 - (qpos0 + r - 64 * t + 256), lookup, lane);
        attn_smpv(lds + AT_TILE + sl * SLOT + 13312, st, o, m_run, l_run, wsf, lane);
      } }
    AT_VMWAIT(0);
    asm volatile("s_waitcnt lgkmcnt(0)" ::: "memory"); __builtin_amdgcn_s_barrier(); asm volatile("" ::: "memory");
  }
  scale_o(o, 1.0f / l_run, wsf, lane);
  store_o(o, (LAS bf16_t*)(lds + AT_OSTG) + wave * 2048, att, ssq, 32, lane);
}
template <int NS, bool BIAS>
__device__ __forceinline__ void attn_unit_sample(LAS unsigned char* lds, const bf16_t* Qw, int qpitch, const KVSrc src, long krow0, int ntiles, int nvalid_last, int qpos0, bf16_t* att, float* ssq, int bhead = 0) {
  constexpr int NKC = NS == 6 ? 768 : 512;
  int tid_ = threadIdx.x; asm volatile("" : "+v"(tid_));
  const int tid = tid_, lane = tid & 63, wave = tid >> 6, r = lane & 31, h = lane >> 5;
  LAS float* wsf = (LAS float*)(lds + AT_WSF) + wave * 64; const LAS float* btab = (const LAS float*)(lds + AT_BIAS) + bhead * 640;
  LAS float* cm = (LAS float*)(lds + AT_CMB);
  f32x16 o[2];
#pragma unroll
  for (int i = 0; i < 16; ++i) { o[0][i] = 0.f; o[1][i] = 0.f; }
  float m_run = -1e30f, l_run = 0.f;
  LAS unsigned char* Kt = lds + AT_TILE + (wave & 3) * AT_PRIV; LAS unsigned char* Vt = Kt + 13312;
  bf16x8 qf[NS];
#pragma unroll
  for (int s = 0; s < NS; ++s) qf[s] = *(const bf16x8*)(Qw + (size_t)(r & 15) * qpitch + 16 * s + 8 * h);
  constexpr int NK4 = 4 * NKC / 512;
  u32x4 kc[NK4], vc[4];
#define SMP_LOAD(T0) do { _Pragma("unroll") for (int i = 0; i < NK4; ++i) { const int id = tid + 512 * i, tt = id / NKC, cid = id - tt * NKC; if ((T0) + tt < ntiles) kc[i] = ld_kchunk<NS>(src, krow0 + 64L * ((T0) + tt), cid); } \
    _Pragma("unroll") for (int i = 0; i < 4; ++i) { const int id = tid + 512 * i, tt = id >> 9, cid = id & 511; if ((T0) + tt < ntiles) vc[i] = *(const u32x4*)(src.V + (krow0 + 64L * ((T0) + tt) + (cid >> 3)) * 512 + (cid & 7) * 8); } } while (0)
#define SMP_STORE(T0) do { _Pragma("unroll") for (int i = 0; i < NK4; ++i) { const int id = tid + 512 * i, tt = id / NKC, cid = id - tt * NKC; if ((T0) + tt < ntiles) st_kchunk<NS>(lds + AT_TILE + tt * AT_PRIV, cid, kc[i]); } \
    _Pragma("unroll") for (int i = 0; i < 4; ++i) { const int id = tid + 512 * i, tt = id >> 9, cid = id & 511; if ((T0) + tt < ntiles) st_vchunk(lds + AT_TILE + tt * AT_PRIV + 13312, cid, vc[i]); } } while (0)
  SMP_LOAD(0); SMP_STORE(0);
  __syncthreads();
  for (int t0 = 0; t0 < ntiles; t0 += 4) {
    if (t0 + 4 < ntiles) SMP_LOAD(t0 + 4);
    const int t = t0 + wave;
    if (wave < 4 && t < ntiles) {
      const bool lookup = BIAS && (qpos0 - (64 * t + 63) < 256);
      f32x16 st[2]; attn_qk<NS, BIAS, false>(Kt, qf, nullptr, st, (t == ntiles - 1) ? nvalid_last : 64, btab, 639 - (qpos0 + (r & 15) - 64 * t + 256), lookup, lane);
      attn_smpv(Vt, st, o, m_run, l_run, wsf, lane);
    }
    __syncthreads();
    if (t0 + 4 < ntiles) { SMP_STORE(t0 + 4); }
    __syncthreads();
  }
#undef SMP_LOAD
#undef SMP_STORE
  if (wave < 4 && h == 0) cm[wave * 32 + r] = m_run;
  __syncthreads();
  if (wave < 4) {
    const float M = __builtin_fmaxf(__builtin_fmaxf(cm[r], cm[32 + r]), __builtin_fmaxf(cm[64 + r], cm[96 + r]));
    const float f = __builtin_amdgcn_exp2f(m_run - M);
    scale_o(o, f, wsf, lane);
    if (h == 0) cm[128 + wave * 32 + r] = l_run * f;
    LAS float* po = (LAS float*)(lds + AT_TILE + wave * AT_PRIV);
#pragma unroll
    for (int c = 0; c < 2; ++c)
#pragma unroll
      for (int i = 0; i < 16; ++i) po[(c * 16 + i) * 64 + lane] = o[c][i];
  }
  __syncthreads();
  if (wave == 0) {
    const float l = (cm[128 + r] + cm[160 + r]) + (cm[192 + r] + cm[224 + r]);
#pragma unroll
    for (int w = 1; w < 4; ++w) { const LAS float* po = (const LAS float*)(lds + AT_TILE + w * AT_PRIV);
#pragma unroll
      for (int c = 0; c < 2; ++c)
#pragma unroll
        for (int i = 0; i < 16; ++i) o[c][i] += po[(c * 16 + i) * 64 + lane]; }
    scale_o(o, 1.0f / l, wsf, lane);
    store_o(o, (LAS bf16_t*)(lds + AT_OSTG), att, ssq, 16, lane);
  }
  __syncthreads();
}
__device__ __forceinline__ void load_bias_all(LAS unsigned char* lds, const float* rel_bias) {
  LAS float* btab = (LAS float*)(lds + AT_BIAS);
  for (int i = threadIdx.x; i < 8 * 640; i += NTHREADS) { const int hd = i / 640, j = 639 - (i - hd * 640); btab[i] = rel_bias[hd * 513 + (j > 512 ? 512 : j)] * LOG2E; }
  __syncthreads();
}
__device__ __forceinline__ void attention_phase(ParamsC p, LAS unsigned char* lds, int G, bool dry, int apm = 15) {
  unsigned char* ws = p->ws; const int wave = threadIdx.x >> 6;
  const bf16_t* Q = (const bf16_t*)(ws + WS_Q); const bf16_t* KN = (const bf16_t*)(ws + WS_KN); const bf16_t* V = (const bf16_t*)(ws + WS_V); const bf16_t* KR = (const bf16_t*)(ws + WS_KR);
  const bf16_t* QB = (const bf16_t*)(ws + WS_QB); const bf16_t* KB = (const bf16_t*)(ws + WS_KB); const bf16_t* VB = (const bf16_t*)(ws + WS_VB);
  bf16_t* ATT = (bf16_t*)(ws + WS_XN); float* ssq_a = (float*)(ws + WS_SSQ); float* ssq_b = ssq_a + MT;
  load_bias_all(lds, p->rel_bias);
  for (int u = blockIdx.x; u < 256; u += G) {
    const int b = (u & 127) >> 3, head = u & 7; const int row0 = MP + b * DSQ;
#ifndef AP
#define AP 15
#endif
    if (u < 128) { if (apm & 1) {
      const KVSrc src{KN + head * 64, KR, V + head * 64};
      attn_unit_sample<6, false>(lds, Q + (size_t)row0 * 768 + head * 96, 768, src, (long)MP + (long)b * LROW, 65, 16, 0, ATT + (size_t)row0 * D + head * 64, dry ? nullptr : ssq_a + row0); }
    } else if (apm & 2) {
      const KVSrc src{KB + head * 64, nullptr, VB + head * 64};
      attn_unit_sample<4, true>(lds, QB + (size_t)row0 * 512 + head * 64, 512, src, (long)MP + (long)b * BROW, 9, 16, 512, ATT + (size_t)row0 * D + 512 + head * 64, dry ? nullptr : ssq_b + row0, head);
    }
  }
  if (G == 256) {
    const int vcu = (blockIdx.x & 7) * 32 + (blockIdx.x >> 3), grp = vcu >> 3, mem = vcu & 7; const int b = grp; const long brow = (long)b * SEQ;
    if (apm & 4) for (int i = 0; i < 8; ++i) { const int head = i, qb = (mem + i) & 7; const KVSrc src{KN + head * 64, KR, V + head * 64}; const long qrow = brow + 256 * qb + 32 * wave;
      attn_unit_shared<6, false>(lds, Q + (size_t)qrow * 768 + head * 96, 768, src, brow, 0, 4 * qb + 3, 0, 4 * qb + (wave >> 1), 0, ATT + (size_t)qrow * D + head * 64, dry ? nullptr : ssq_a + qrow); }
    if (apm & 8) for (int i = 0; i < 8; ++i) { const int head = i, cb = (mem + i) & 7;
      const KVSrc src{KB + head * 64, nullptr, VB + head * 64}; const long qrow = brow + 256 * cb + 32 * wave; const int cq = 4 * cb + (wave >> 1); const int tl = 4 * cb - 8 < 0 ? 0 : 4 * cb - 8;
      attn_unit_shared<4, true>(lds, QB + (size_t)qrow * 512 + head * 64, 512, src, brow, tl, 4 * cb + 3, cq - 8, cq, 256 * cb + 32 * wave, ATT + (size_t)qrow * D + 512 + head * 64, dry ? nullptr : ssq_b + qrow, head); }
  } else {
  for (int bh = blockIdx.x; bh < NBATCH * 8; bh += G) {
    const int b = bh >> 3, head = bh & 7; const long brow = (long)b * SEQ;
    if (apm & 4) { const KVSrc src{KN + head * 64, KR, V + head * 64};
      for (int qb = 0; qb < 8; ++qb) { const long qrow = brow + 256 * qb + 32 * wave;
        attn_unit_shared<6, false>(lds, Q + (size_t)qrow * 768 + head * 96, 768, src, brow, 0, 4 * qb + 3, 0, 4 * qb + (wave >> 1), 0, ATT + (size_t)qrow * D + head * 64, dry ? nullptr : ssq_a + qrow); } }
    if (apm & 8) { const KVSrc src{KB + head * 64, nullptr, VB + head * 64};
      for (int cb = 0; cb < 8; ++cb) { const long qrow = brow + 256 * cb + 32 * wave; const int cq = 4 * cb + (wave >> 1); const int tl = 4 * cb - 8 < 0 ? 0 : 4 * cb - 8;
        attn_unit_shared<4, true>(lds, QB + (size_t)qrow * 512 + head * 64, 512, src, brow, tl, 4 * cb + 3, cq - 8, cq, 256 * cb + 32 * wave, ATT + (size_t)qrow * D + 512 + head * 64, dry ? nullptr : ssq_b + qrow, head); } }
  }
  }
}


#define XB_TMO      128
#define XB_XCNT(j)  (256  + 64 * (j))
#define XB_XSUB(j)  (1280 + 64 * (j))
#define XB_XGEN(j)  (2304 + 64 * (j))
#define XB_TOP      3328
#define XB_TOPGEN   3392
#define XCD_BAR_WORDS 3456
#define XB_SPIN_CAP (1u << 18)
__device__ __forceinline__ unsigned xb_ld(unsigned* p)              { return __hip_atomic_load(p, __ATOMIC_RELAXED, __HIP_MEMORY_SCOPE_AGENT); }
__device__ __forceinline__ unsigned xb_add(unsigned* p, unsigned v) { return __hip_atomic_fetch_add(p, v, __ATOMIC_RELAXED, __HIP_MEMORY_SCOPE_AGENT); }
__device__ __forceinline__ unsigned xb_xcc_id() { return (unsigned)__builtin_amdgcn_s_getreg((3 << 11) | 20) & 0xFu; }
#define XB_SPIN(cond, bar) do { unsigned _sp = 0; while (cond) { __builtin_amdgcn_s_sleep(1); \
    if ((++_sp & 255u) == 0u) { if (xb_ld(&(bar)[XB_TMO])) break; if (_sp > XB_SPIN_CAP) { atomicAdd(&(bar)[XB_TMO], 1u); break; } } } } while (0)
__device__ __forceinline__ void xcd_barrier_complete(unsigned* bar, unsigned x, unsigned& nloc, unsigned& nx) {
  const unsigned G = gridDim.x * gridDim.y * gridDim.z;
  unsigned sum, cnt, mine, sp = 0u;
  for (;;) {
    sum = 0u; cnt = 0u; mine = 0u;
#pragma unroll
    for (unsigned j = 0; j < 16; ++j) { const unsigned c = xb_ld(&bar[XB_XCNT(j)]); sum += c; cnt += (c > 0u) ? 1u : 0u; mine = (j == x) ? c : mine; }
    if (sum == G) break;
    __builtin_amdgcn_s_sleep(1);
    if ((++sp & 255u) == 0u) { if (xb_ld(&bar[XB_TMO])) break; if (sp > XB_SPIN_CAP) { atomicAdd(&bar[XB_TMO], 1u); break; } }
  }
  nloc = mine > 0u ? mine : 1u; nx = cnt > 0u ? cnt : 1u;
}
__device__ __forceinline__ void xcd_barrier(unsigned* bar, volatile LAS unsigned* st) {
  asm volatile("s_waitcnt vmcnt(0)" ::: "memory");
  __syncthreads();
  if (threadIdx.x == 0) {
    const unsigned x = xb_xcc_id();
    __builtin_amdgcn_s_waitcnt(0);
    unsigned nloc = st[0], nx = st[1];
    if (nloc == 0u) { xcd_barrier_complete(bar, x, nloc, nx); st[0] = nloc; st[1] = nx; }
    const unsigned old = xb_add(&bar[XB_XSUB(x)], 1u);
    const unsigned gen = old / nloc;
    if (old + 1u == (gen + 1u) * nloc) {
      __builtin_amdgcn_fence(__ATOMIC_RELEASE, "agent");
      asm volatile("s_waitcnt vmcnt(0)" ::: "memory");
      const unsigned og = xb_add(&bar[XB_TOP], 1u);
      const unsigned tg = og / nx;
      if (og + 1u == (tg + 1u) * nx) xb_add(&bar[XB_TOPGEN], 1u);
      else XB_SPIN(xb_ld(&bar[XB_TOPGEN]) == tg, bar);
      __builtin_amdgcn_fence(__ATOMIC_ACQUIRE, "agent");
      xb_add(&bar[XB_XGEN(x)], 1u);
      asm volatile("s_waitcnt vmcnt(0)" ::: "memory");
    } else {
      XB_SPIN(xb_ld(&bar[XB_XGEN(x)]) == gen, bar);
      __builtin_amdgcn_fence(__ATOMIC_ACQUIRE, "agent");
      asm volatile("s_waitcnt vmcnt(0)" ::: "memory");
    }
  }
  __syncthreads();
}

__device__ __forceinline__ ParamsC get_params() {
  ParamsC pp = (ParamsC)__builtin_amdgcn_kernarg_segment_ptr(); asm volatile("" : "+s"(pp)); return pp;
}
__global__ void __launch_bounds__(NTHREADS) mk_fwd(Params p_unused) {
  extern __shared__ __attribute__((aligned(16))) unsigned char lds_raw[];
  LAS unsigned char* lds = (LAS unsigned char*)lds_raw;
  cg::grid_group grid = cg::this_grid();
  const int G = gridDim.x;
  volatile LAS unsigned* xst = (volatile LAS unsigned*)(lds + LDS_BYTES - 16);
  if (threadIdx.x < 2) xst[threadIdx.x] = 0u;
  if (threadIdx.x == 0) (void)xb_add(&((unsigned*)(get_params()->ws + WS_BAR))[XB_XCNT(xb_xcc_id())], 1u);
  __syncthreads();
#define FAST_SYNC() xcd_barrier((unsigned*)(get_params()->ws + WS_BAR), xst)
#define WSP(T, off) ((T*)(get_params()->ws + (off)))
#define ssq WSP(float, WS_SSQ)
#define X1B WSP(bf16_t, WS_X1B)
#define XN WSP(bf16_t, WS_XN)
#define CQN WSP(bf16_t, WS_CQN)
#define CKV WSP(bf16_t, WS_CKV)
#define KR WSP(bf16_t, WS_KR)
#define QB WSP(bf16_t, WS_QB)
#define KB WSP(bf16_t, WS_KB)
#define VB WSP(bf16_t, WS_VB)
#define Q WSP(bf16_t, WS_Q)
#define KN WSP(bf16_t, WS_KN)
#define V WSP(bf16_t, WS_V)
#define H WSP(bf16_t, WS_H)
  pg8::StaticOrder S;
#ifndef PH
#define PH 255
#endif
  if (PH & 1) prologue(get_params(), lds, G);
#ifdef DUP_P0
  grid.sync(); prologue(get_params(), lds, G);
#endif
  grid.sync();
  if (PH & 2) { pg8::Gemm g{XN, (const bf16_t*)(get_params()->ws + WS_WIN), 1024, 1024, 1024}; S.init(MT, NIN, G, blockIdx.x);
    ParamsC pp = get_params(); EpiIn E{pp->out, CQN, CKV, KR, QB, KB, VB, pp->g_kv, (LAS float*)(lds + LDS_RED)};
    pg8::gemm_phase(lds, g, S, E); }
  FAST_SYNC();
  if ((PH & 4) && !(PH & 256)) { pg8::Gemm g{CQN, (const bf16_t*)(get_params()->ws + WS_WUQ), 256, 256, 256}; S.init(MT, 768, G, blockIdx.x); EpiQ E{Q}; pg8::gemm_phase(lds, g, S, E); }
  if ((PH & 4) && !(PH & 512)) { pg8::Gemm g{CKV, (const bf16_t*)(get_params()->ws + WS_WKV), 256, 256, 256}; S.init(MLAT, 1024, G, blockIdx.x); EpiKV E{KN, V}; pg8::gemm_phase(lds, g, S, E); }
  FAST_SYNC();
  if (PH & 8) attention_phase(get_params(), lds, G, false);
#ifdef DUP_ATTN
  grid.sync(); attention_phase(get_params(), lds, G, true, DUP_ATTN);
#endif
  FAST_SYNC();
  if (PH & 16) { pg8::Gemm g{XN  , (const bf16_t*)(get_params()->ws + WS_WO), 1024, 1024, 1024}; S.init(MT, 1024, G, blockIdx.x);
    ParamsC pp = get_params(); EpiO E{8, ssq, ssq + MT, pp->xp, pp->xs, X1B, ssq + 2 * MT}; pg8::gemm_phase(lds, g, S, E); }
  FAST_SYNC();
  if (PH & 32) { pg8::Gemm g{X1B, (const bf16_t*)(get_params()->ws + WS_WGU), 1024, 1024, 1024}; S.init(MT, NGU, G, blockIdx.x); EpiGU E{ssq + 2 * MT, H}; pg8::gemm_phase(lds, g, S, E);
#ifdef DUP_P5
    grid.sync(); pg8::gemm_phase(lds, g, S, E);
#endif
  }
  FAST_SYNC();
#define PART WSP(float, WS_Q)
  if (PH & 64) { pg8::Gemm g{H, (const bf16_t*)(get_params()->ws + WS_WD), FF, FF, FF}; S.init(MP, 1024, G, blockIdx.x); EpiD E{X1B, ssq + 3 * MT}; pg8::gemm_phase(lds, g, S, E);
    pg8::Gemm g2{H, (const bf16_t*)(get_params()->ws + WS_WD), FF, FF, 256}; pg8::SplitOrder S2{MP / 256, 4, 44, 256, G, (int)blockIdx.x}; EpiPart E2{PART}; pg8::gemm_phase(lds, g2, S2, E2); }
  FAST_SYNC();
  if (PH & 128) { ParamsC p = get_params(); int t7 = threadIdx.x; asm volatile("" : "+v"(t7)); const int lane = t7 & 63, gw = blockIdx.x * 8 + (t7 >> 6), NGW = G * 8; const float* s2 = ssq + 3 * MT;
    f32x4 gf[4];
#pragma unroll
    for (int j = 0; j < 2; ++j) { gf[2 * j] = *(const f32x4*)(p->g_final + 8 * lane + 512 * j); gf[2 * j + 1] = *(const f32x4*)(p->g_final + 8 * lane + 512 * j + 4); }
    for (int rr0 = gw; rr0 < MT; rr0 += 4 * NGW) {
      u32x4 raw[4][2]; int rows[4];
#pragma unroll
      for (int k = 0; k < 4; ++k) { const int rr = rr0 + k * NGW; rows[k] = rr < MS ? MP + rr : rr - MS;
        if (rr < MT) { const bf16_t* x = X1B + (size_t)rows[k] * D;
#pragma unroll
          for (int j = 0; j < 2; ++j) raw[k][j] = *(const u32x4*)(x + 8 * lane + 512 * j); } }
#pragma unroll
      for (int k = 0; k < 4; ++k) { const int rr = rr0 + k * NGW, row = rows[k]; if (rr < MT) {
        f32x4 v[4];
#pragma unroll
        for (int j = 0; j < 2; ++j) { const u32x4 w = raw[k][j];
          v[2 * j] = (f32x4){__builtin_bit_cast(float, w.x << 16), __builtin_bit_cast(float, w.x & 0xffff0000u), __builtin_bit_cast(float, w.y << 16), __builtin_bit_cast(float, w.y & 0xffff0000u)};
          v[2 * j + 1] = (f32x4){__builtin_bit_cast(float, w.z << 16), __builtin_bit_cast(float, w.z & 0xffff0000u), __builtin_bit_cast(float, w.w << 16), __builtin_bit_cast(float, w.w & 0xffff0000u)}; }
        float* y = p->out + OFF_Y + (size_t)row * D; float rstd;
        if (row >= MP) { float s = 0.f;
          for (int kc = 0; kc < 11; ++kc) { const float* pr = PART + ((size_t)kc * 256 + (row - MP)) * D;
#pragma unroll
            for (int j = 0; j < 2; ++j) { v[2 * j] = v[2 * j] + *(const f32x4*)(pr + 8 * lane + 512 * j); v[2 * j + 1] = v[2 * j + 1] + *(const f32x4*)(pr + 8 * lane + 512 * j + 4); } }
#pragma unroll
          for (int j = 0; j < 4; ++j) s += (v[j][0] * v[j][0] + v[j][1] * v[j][1]) + (v[j][2] * v[j][2] + v[j][3] * v[j][3]);
          rstd = __builtin_amdgcn_rsqf(wave_sum(s) * (1.0f / D) + EPS);
        } else rstd = __builtin_amdgcn_rsqf(s2[row] * (1.0f / D) + EPS);
#pragma unroll
        for (int j = 0; j < 2; ++j) { *(f32x4*)(y + 8 * lane + 512 * j) = v[2 * j] * rstd * gf[2 * j]; *(f32x4*)(y + 8 * lane + 512 * j + 4) = v[2 * j + 1] * rstd * gf[2 * j + 1]; } } } } }
}

#undef FAST_SYNC
#undef ssq
#undef X1B
#undef XN
#undef CQN
#undef CKV
#undef KR
#undef QB
#undef KB
#undef VB
#undef Q
#undef KN
#undef V
#undef H
#undef PART
extern "C" void kernel_launch(void* const* d_in, const int* in_sizes, int n_in, void* d_out, int out_size, void* d_ws, size_t ws_size, hipStream_t stream) {
  static int grid = 0;
  if (grid == 0) {
    if (n_in != 22 || (size_t)out_size != OUT_TOTAL || ws_size < WS_TOTAL) { fprintf(stderr, "kernel_launch: unexpected shapes (n_in %d out %d ws %zu, need ws %zu)\n", n_in, out_size, ws_size, (size_t)WS_END); grid = -1; return; }
    int dev = 0, cus = 0, per_cu = 0;
    hipGetDevice(&dev); hipDeviceGetAttribute(&cus, hipDeviceAttributeMultiprocessorCount, dev);
    hipFuncSetAttribute((const void*)mk_fwd, hipFuncAttributeMaxDynamicSharedMemorySize, LDS_BYTES);
    hipOccupancyMaxActiveBlocksPerMultiprocessor(&per_cu, (const void*)mk_fwd, NTHREADS, LDS_BYTES);
    if (per_cu < 1 || cus < 1) { fprintf(stderr, "kernel_launch: occupancy query gave %d blocks/CU on %d CUs\n", per_cu, cus); grid = -1; return; }
    grid = cus * (per_cu > 1 ? 1 : per_cu);
  }
  if (grid < 0) return;
  Params p{};
  const float** pp = (const float**)&p;
  for (int i = 0; i < 22; ++i) pp[i] = (const float*)d_in[i];
  p.out = (float*)d_out; p.ws = (unsigned char*)d_ws;
  if (hipMemsetAsync((char*)d_ws + WS_BAR, 0, 16384, stream) != hipSuccess) { fprintf(stderr, "kernel_launch: memset of barrier words failed\n"); return; }
  void* args[] = {&p};
  hipError_t e = hipLaunchCooperativeKernel((void*)mk_fwd, dim3(grid), dim3(NTHREADS), args, LDS_BYTES, stream);
  if (e != hipSuccess) fprintf(stderr, "cooperative launch failed: %s (grid %d)\n", hipGetErrorString(e), grid);
}
```

```cpp
#include <hip/hip_runtime.h>
#include <hip/hip_cooperative_groups.h>
#include <cstdio>
#include <cstdint>


namespace cg = cooperative_groups;

#define LAS __attribute__((address_space(3)))
typedef unsigned short bf16_t;
typedef short bf16x8 __attribute__((ext_vector_type(8)));
typedef short s16x4 __attribute__((ext_vector_type(4)));
typedef float f32x4 __attribute__((ext_vector_type(4)));
typedef float f32x16 __attribute__((ext_vector_type(16)));
typedef unsigned u32x4 __attribute__((ext_vector_type(4)));
typedef unsigned u32x2 __attribute__((ext_vector_type(2)));
typedef float f32x2_t __attribute__((ext_vector_type(2)));
typedef __bf16 bf16x2_t __attribute__((ext_vector_type(2)));

constexpr int D = 1024, NBATCH = 32, SEQ = 2048, MP = NBATCH * SEQ, DB = 16, DSQ = 16, MS = DB * DSQ, MT = MP + MS, PAST = 4096;
constexpr int NIN = 2304, FF = 2816, NGU = 2 * FF;
constexpr int LROW = 4352, BROW = 768;
constexpr int MLAT = MP + DB * LROW, MBND = MP + DB * BROW;
constexpr float EPS = 1e-6f, LOG2E = 1.4426950408889634f;
constexpr float QSCALE_A = 0.10206207261596575f * LOG2E;
constexpr float QSCALE_B = 0.125f * LOG2E;
constexpr int NTHREADS = 512;
constexpr size_t OFF_Y = 0, OFF_CKVP = (size_t)MT * D, OFF_KRP = OFF_CKVP + (size_t)MP * 256, OFF_BKP = OFF_KRP + (size_t)MP * 32,
                 OFF_BVP = OFF_BKP + (size_t)NBATCH * 512 * 512, OFF_CKVS = OFF_BVP + (size_t)NBATCH * 512 * 512, OFF_KRS = OFF_CKVS + (size_t)MS * 256,
                 OFF_BKS = OFF_KRS + (size_t)MS * 32, OFF_BVS = OFF_BKS + (size_t)MS * 512, OUT_TOTAL = OFF_BVS + (size_t)MS * 512;
constexpr size_t al256(size_t x) { return (x + 255) & ~(size_t)255; }
constexpr size_t WS_SSQ = 0;
constexpr size_t WS_WIN = al256(WS_SSQ + 4 * (size_t)MT * 4);
constexpr size_t WS_WUQ = al256(WS_WIN + (size_t)NIN * 1024 * 2);
constexpr size_t WS_WKV = al256(WS_WUQ + (size_t)768 * 256 * 2);
constexpr size_t WS_WO = al256(WS_WKV + (size_t)1024 * 256 * 2);
constexpr size_t WS_WGU = al256(WS_WO + (size_t)1024 * 1024 * 2);
constexpr size_t WS_WD = al256(WS_WGU + (size_t)NGU * 1024 * 2);
constexpr size_t WS_X1B = al256(WS_WD + (size_t)1024 * FF * 2);
constexpr size_t WS_XN = al256(WS_X1B + (size_t)MT * 1024 * 2);
constexpr size_t WS_CQN = al256(WS_XN + (size_t)MT * 1024 * 2);
constexpr size_t WS_CKV = al256(WS_CQN + (size_t)MT * 256 * 2);
constexpr size_t WS_KR = al256(WS_CKV + (size_t)MLAT * 256 * 2);
constexpr size_t WS_QB = al256(WS_KR + (size_t)MLAT * 32 * 2);
constexpr size_t WS_KB = al256(WS_QB + (size_t)MT * 512 * 2);
constexpr size_t WS_VB = al256(WS_KB + (size_t)MBND * 512 * 2);
constexpr size_t WS_Q = al256(WS_VB + (size_t)MBND * 512 * 2);
constexpr size_t WS_KN = al256(WS_Q + (size_t)MT * 768 * 2);
constexpr size_t WS_V = al256(WS_KN + (size_t)MLAT * 512 * 2);
constexpr size_t WS_END = al256(WS_V + (size_t)MLAT * 512 * 2);
constexpr size_t WS_BAR = WS_END;
constexpr size_t WS_TOTAL = WS_END + 16384;
constexpr size_t WS_H = WS_XN;
static_assert(WS_H + (size_t)MT * FF * 2 <= WS_VB, "H overlay must end before anything live in P5/P6 (nothing is, but keep it inside dead buffers)");
static_assert(WS_TOTAL <= (size_t)1073741824, "workspace");

constexpr int LDS_GEMM = 131072, LDS_RED = LDS_GEMM, LDS_BYTES = 143360;
constexpr int KP_A = 208, KP_B = 144;
constexpr int AT_TILE = 0, AT_PRIV = 21504  , AT_QT = 51200  , AT_BIAS = 86016  , AT_WSF = 107008, AT_OSTG = 109056, AT_CMB = 141824;
static_assert(AT_CMB + 1024 <= LDS_BYTES, "attention LDS map");

struct Params {
  const float *xp, *xs, *c_ckv, *c_kr, *c_bk, *c_bv, *w_in, *g_attn, *g_q, *w_uq, *g_kv, *w_uk, *w_uv, *rel_bias, *g_out_a, *g_out_b, *w_out, *g_ffn,
      *w_gate, *w_up, *w_down, *g_final;
  float* out; unsigned char* ws;
};

typedef const __attribute__((address_space(4))) Params* ParamsC;
__device__ __forceinline__ unsigned f2bf(float f) { unsigned u = __builtin_bit_cast(unsigned, f); return (u + 0x7fffu + ((u >> 16) & 1u)) >> 16; }
__device__ __forceinline__ unsigned pk2(float lo, float hi) { f32x2_t v = {lo, hi}; bf16x2_t b = __builtin_convertvector(v, bf16x2_t); return __builtin_bit_cast(unsigned, b); }
__device__ __forceinline__ float bf2f(unsigned short b) { return __builtin_bit_cast(float, (unsigned)b << 16); }
__device__ __forceinline__ int maprow_lat(int row) { return row < MP ? row : MP + ((row - MP) >> 4) * LROW + PAST + ((row - MP) & 15); }
__device__ __forceinline__ int maprow_bnd(int row) { return row < MP ? row : MP + ((row - MP) >> 4) * BROW + 512 + ((row - MP) & 15); }
__device__ __forceinline__ int row_pos(int row) { return row < MP ? (row & (SEQ - 1)) : PAST + ((row - MP) & 15); }
__device__ __forceinline__ void rope_cs(int pos, int i, float& c, float& s) {
  const float inv = __builtin_amdgcn_exp2f(-(float)i * (13.287712379549449f / 16.0f));
  float rev = (float)pos * inv * 0.15915494309189535f; rev = rev - __builtin_floorf(rev);
  s = __builtin_amdgcn_sinf(rev); c = __builtin_amdgcn_cosf(rev);
}

namespace pg8 {
constexpr int BM = 256, BK = 64, HALF = 128, HTB = HALF * BK * 2, STAGE_BYTES = 8 * HTB, NXCD = 8, WGM = 8;
__host__ __device__ __forceinline__ int lds_byte(int r, int c) { const int st = (r >> 4) * 2 + (c >> 5), rr = r & 15, cc = c & 31, ob = rr * 64 + cc * 2; return st * 1024 + (ob ^ (((ob >> 9) & 1) << 5)); }
__host__ __device__ __forceinline__ void stage_rc(int b, int& R, int& C) { const int st = b / 1024, sb = b % 1024, swz = sb ^ (((sb >> 9) & 1) << 5); R = (st >> 1) * 16 + swz / 64; C = (st & 1) * 32 + (swz % 64) / 2; }
struct Unit { int pm, pn, koff; };
struct Gemm { const bf16_t* A; const bf16_t* Bt; int lda, ldb, K; };
struct StaticOrder {
  int nM, nN, nwg, G, c;
  __device__ void init(int M, int N, int G_, int c_) { nM = M / BM; nN = N / BM; nwg = nM * nN; G = G_; c = c_; }
  __device__ bool next(int i, Unit& u) const {
    const long L = (long)i * G + c; if (L >= nwg) return false;
    int wgid = (int)L; { const int q = nwg / NXCD, r = nwg % NXCD, xcd = wgid % NXCD, off = wgid / NXCD; wgid = (xcd < r ? xcd * (q + 1) : r * (q + 1) + (xcd - r) * q) + off; }
    const int nig = WGM * nN, gid = wgid / nig, fm = gid * WGM, gsz = (nM - fm) < WGM ? (nM - fm) : WGM;
    u.pm = fm + ((wgid % nig) % gsz); u.pn = (wgid % nig) / gsz; u.koff = 0; return true;
  }
};
struct SplitOrder {
  int pm, nN, nsub, kchunk, G, c;
  __device__ bool next(int i, Unit& u) const { const int s = i * G + c; if (s >= nsub) return false; u.pm = pm; u.pn = s % nN; u.koff = (s / nN) * kchunk; return true; }
};
template <class Epi, class Order>
__device__ __forceinline__ void gemm_phase(LAS unsigned char* lds, const Gemm g, const Order& S, Epi& E) {
  int tid_ = threadIdx.x; asm volatile("" : "+v"(tid_));
  const int tid = tid_, wid = __builtin_amdgcn_readfirstlane(tid >> 6), lane = tid & 63, wr = wid >> 2, wc = wid & 3, fr = lane & 15, fq = lane >> 4;
  int K_ = g.K; asm volatile("" : "+s"(K_));
  const int K = K_, nt = K / BK;
  int lda_ = g.lda, ldb_ = g.ldb; asm volatile("" : "+s"(lda_), "+s"(ldb_));
  unsigned voffA[2];
#pragma unroll
  for (int i = 0; i < 2; ++i) { int R, C; stage_rc(tid * 16 + i * 8192, R, C); voffA[i] = (unsigned)(R * lda_ + C) * 2u; }
  const size_t kstep = (size_t)(BK * 2), hstepA = (size_t)HALF * lda_ * 2, tstepA = 2 * hstepA, hstepB = (size_t)HALF * ldb_ * 2, tstepB = 2 * hstepB;
  const unsigned ldsw = (unsigned)wid * 1024u;
  const int aoff = lds_byte(wr * 64 + fr, fq * 8), boff = lds_byte(wc * 32 + fr, fq * 8);
#define PG8_SA(b, h) (((b) * 2 + (h)) * HTB)
#define PG8_SB(b, h) ((4 + (b) * 2 + (h)) * HTB)
#define PG8_STAGE_(bufoff, gbase, voff) do { _Pragma("unroll") for (int _i = 0; _i < 2; ++_i) \
    __builtin_amdgcn_global_load_lds((const unsigned*)((const char*)(gbase) + (voff)[_i]), (LAS unsigned*)(lds + (bufoff) + ldsw + _i * 8192), 16, 0, 0); } while (0)
#define PG8_STA(bufoff, gbase) PG8_STAGE_(bufoff, gbase, voffA)
#define PG8_STB(bufoff, gbase) PG8_STAGE_(bufoff, gbase, voffA)
#define PG8_LDA(dst, b, h) do { _Pragma("unroll") for (int m = 0; m < 4; ++m) _Pragma("unroll") for (int k = 0; k < 2; ++k) dst[m][k] = *(const LAS bf16x8*)(lds + PG8_SA(b, h) + aoff + m * 2048 + k * 1024); } while (0)
#define PG8_LDB(dst, b, h) do { _Pragma("unroll") for (int n = 0; n < 2; ++n) _Pragma("unroll") for (int k = 0; k < 2; ++k) dst[n][k] = *(const LAS bf16x8*)(lds + PG8_SB(b, h) + boff + n * 2048 + k * 1024); } while (0)
#define PG8_MMA(ai, bj, At, Bt) do { __builtin_amdgcn_s_setprio(1); _Pragma("unroll") for (int m = 0; m < 4; ++m) _Pragma("unroll") for (int n = 0; n < 2; ++n) _Pragma("unroll") for (int k = 0; k < 2; ++k) \
    acc[ai][bj][m][n] = __builtin_amdgcn_mfma_f32_16x16x32_bf16(Bt[n][k], At[m][k], acc[ai][bj][m][n], 0, 0, 0); __builtin_amdgcn_s_setprio(0); } while (0)
#define PG8_WAIT_V(n) asm volatile("s_waitcnt vmcnt(" #n ")" ::: "memory")
#define PG8_WAIT_L(n) asm volatile("s_waitcnt lgkmcnt(" #n ")" ::: "memory")
#define PG8_BAR __builtin_amdgcn_s_barrier()
#define PG8_SCHED __builtin_amdgcn_sched_barrier(0)
  Unit cur, nxt; int ui = 0;
  if (!S.next(0, cur)) return;
  f32x4 acc[2][2][4][2];
#pragma unroll
  for (int a = 0; a < 2; ++a)
#pragma unroll
    for (int b = 0; b < 2; ++b)
#pragma unroll
      for (int m = 0; m < 4; ++m)
#pragma unroll
        for (int n = 0; n < 2; ++n) acc[a][b][m][n] = (f32x4){0.f, 0.f, 0.f, 0.f};
  bf16x8 At[4][2], B0[2][2], B1[2][2];
  const char* cA = (const char*)g.A + (size_t)cur.pm * tstepA + (size_t)cur.koff * 2; const char* cB = (const char*)g.Bt + (size_t)cur.pn * tstepB + (size_t)cur.koff * 2;
  PG8_STB(PG8_SB(0, 0), cB); PG8_STB(PG8_SB(0, 1), cB + hstepB); PG8_STA(PG8_SA(0, 0), cA); PG8_STA(PG8_SA(0, 1), cA + hstepA);
  if (wr == 1) PG8_BAR;
  PG8_WAIT_V(2); PG8_BAR;
  PG8_STB(PG8_SB(1, 0), cB + kstep); PG8_STA(PG8_SA(1, 0), cA + kstep); PG8_STB(PG8_SB(1, 1), cB + hstepB + kstep);
  PG8_WAIT_V(6); PG8_BAR;
  for (;;) {
    const bool has_next = S.next(ui + 1, nxt);
    const char* nA = has_next ? (const char*)g.A + (size_t)nxt.pm * tstepA + (size_t)nxt.koff * 2 : cA; const char* nB = has_next ? (const char*)g.Bt + (size_t)nxt.pn * tstepB + (size_t)nxt.koff * 2 : cB;
    for (int t = 0; t < nt; t += 2) {
      const bool last = (t == nt - 2);
      const char* a1 = cA + (size_t)(t + 1) * kstep;
      const char* a2 = last ? nA : cA + (size_t)(t + 2) * kstep; const char* b2 = last ? nB : cB + (size_t)(t + 2) * kstep;
      const char* a3 = a2 + kstep; const char* b3 = b2 + kstep;
      if constexpr (Epi::HAS_MID) { if (t == E.tsplit) { E.mid(acc, cur, wr, wc, fr, fq); } }
      PG8_LDB(B0, 0, 0); PG8_LDB(B1, 0, 1); PG8_SCHED; PG8_LDA(At, 0, 0); PG8_STA(PG8_SA(1, 1), a1 + hstepA);
      PG8_WAIT_V(8); PG8_WAIT_L(0); PG8_BAR; PG8_MMA(0, 0, At, B0); PG8_MMA(0, 1, At, B1); PG8_BAR; PG8_SCHED;
      PG8_LDA(At, 0, 1); PG8_STB(PG8_SB(0, 0), b2); PG8_STB(PG8_SB(0, 1), b2 + hstepB); PG8_STA(PG8_SA(0, 0), a2);
      PG8_WAIT_V(8); PG8_WAIT_L(0); PG8_BAR; PG8_MMA(1, 0, At, B0); PG8_MMA(1, 1, At, B1); PG8_BAR; PG8_SCHED;
      PG8_LDB(B0, 1, 0); PG8_LDB(B1, 1, 1); PG8_SCHED; PG8_LDA(At, 1, 0); PG8_STA(PG8_SA(0, 1), a2 + hstepA);
      PG8_WAIT_V(8); PG8_WAIT_L(0); PG8_BAR; PG8_MMA(0, 0, At, B0); PG8_MMA(0, 1, At, B1); PG8_BAR; PG8_SCHED;
      PG8_LDA(At, 1, 1); PG8_STB(PG8_SB(1, 0), b3); PG8_STB(PG8_SB(1, 1), b3 + hstepB); PG8_STA(PG8_SA(1, 0), a3);
      PG8_WAIT_V(8); PG8_WAIT_L(0); PG8_BAR; PG8_MMA(1, 0, At, B0); PG8_MMA(1, 1, At, B1); PG8_BAR; PG8_SCHED;
    }
    if (wr == 0) PG8_BAR;
    E(acc, cur, wr, wc, fr, fq);
    if (!has_next) break;
#pragma unroll
    for (int a = 0; a < 2; ++a)
#pragma unroll
      for (int b = 0; b < 2; ++b)
#pragma unroll
        for (int m = 0; m < 4; ++m)
#pragma unroll
          for (int n = 0; n < 2; ++n) acc[a][b][m][n] = (f32x4){0.f, 0.f, 0.f, 0.f};
    cur = nxt; cA = nA; cB = nB; ++ui;
    if (wr == 1) PG8_BAR;
  }
  PG8_WAIT_V(0);
  PG8_BAR;
#undef PG8_SA
#undef PG8_SB
#undef PG8_STAGE_
#undef PG8_STA
#undef PG8_STB
#undef PG8_LDA
#undef PG8_LDB
#undef PG8_MMA
#undef PG8_WAIT_V
#undef PG8_WAIT_L
#undef PG8_BAR
#undef PG8_SCHED
}
}
using pg8::Unit;
typedef f32x4 Acc[2][2][4][2];
#define FOR_AM _Pragma("unroll") for (int ai = 0; ai < 2; ++ai) _Pragma("unroll") for (int m = 0; m < 4; ++m)
#define FOR_BN _Pragma("unroll") for (int bj = 0; bj < 2; ++bj) _Pragma("unroll") for (int n = 0; n < 2; ++n)
__device__ __forceinline__ void st_bf4(bf16_t* p, f32x4 v) { u32x2 w; w.x = pk2(v[0], v[1]); w.y = pk2(v[2], v[3]); *(u32x2*)p = w; }
__device__ __forceinline__ void st_bf8(bf16_t* p, f32x4 a, f32x4 b) { u32x4 w; w.x = pk2(a[0], a[1]); w.y = pk2(a[2], a[3]); w.z = pk2(b[0], b[1]); w.w = pk2(b[2], b[3]); *(u32x4*)p = w; }
__device__ __forceinline__ void st_bf4x2(bf16_t* pa, f32x4 a, bf16_t* pb, f32x4 b, int fq) {
  const unsigned A0 = pk2(a[0], a[1]), A1 = pk2(a[2], a[3]), B0 = pk2(b[0], b[1]), B1 = pk2(b[2], b[3]);
  const auto r0 = __builtin_amdgcn_permlane16_swap(A0, B0, false, false);
  const auto r1 = __builtin_amdgcn_permlane16_swap(A1, B1, false, false);
  u32x4 w; w.x = r0[0]; w.y = r1[0]; w.z = r0[1]; w.w = r1[1];
  *(u32x4*)((fq & 1) ? pb - 4 : pa) = w;
}
__device__ __forceinline__ void atomic_addf(float* p, float v) { __hip_atomic_fetch_add(p, v, __ATOMIC_RELAXED, __HIP_MEMORY_SCOPE_AGENT); }

struct EpiIn {
  static constexpr bool HAS_MID = false;
  float* out; bf16_t *CQN, *CKV, *KR, *QB, *KB, *VB; const float* g_kv; LAS float* red;
  __device__ __forceinline__ void operator()(const Acc& acc, const Unit& u, int wr, int wc, int fr, int fq) const {
    const int pn = u.pn, rbase = u.pm * 256 + wr * 64 + fr, cw = wc * 32 + 4 * fq;
    if (pn <= 1) {
      FOR_AM { float s = 0.f; FOR_BN { const f32x4 x = acc[ai][bj][m][n]; s += (x[0] * x[0] + x[1] * x[1]) + (x[2] * x[2] + x[3] * x[3]); }
        s += __shfl_xor(s, 16); s += __shfl_xor(s, 32);
        if (fq == 0) red[(ai * 128 + wr * 64 + m * 16 + fr) * 4 + wc] = s; }
      asm volatile("s_waitcnt lgkmcnt(0)" ::: "memory"); __builtin_amdgcn_s_barrier(); asm volatile("" ::: "memory");
      FOR_AM { const f32x4 t = *(const LAS f32x4*)(red + (ai * 128 + wr * 64 + m * 16 + fr) * 4);
        const float rstd = __builtin_amdgcn_rsqf(((t[0] + t[1]) + (t[2] + t[3])) * (1.0f / 256.0f) + EPS);
        const int row = rbase + ai * 128 + m * 16;
        if (pn == 0) {
#pragma unroll
          for (int bj = 0; bj < 2; ++bj) { bf16_t* q = CQN + (size_t)row * 256 + bj * 128 + cw; st_bf4x2(q, acc[ai][bj][m][0] * rstd, q + 16, acc[ai][bj][m][1] * rstd, fq); } }
        else { const int mr = maprow_lat(row); float* o = row < MP ? out + OFF_CKVP + (size_t)row * 256 : out + OFF_CKVS + (size_t)(row - MP) * 256;
          FOR_BN { const int col = bj * 128 + n * 16 + cw; const f32x4 v = acc[ai][bj][m][n] * rstd * *(const f32x4*)(g_kv + col);
            *(f32x4*)(o + col) = v; st_bf4(CKV + (size_t)mr * 256 + col, v); } } }
      asm volatile("s_waitcnt lgkmcnt(0)" ::: "memory"); __builtin_amdgcn_s_barrier(); asm volatile("" ::: "memory");
    } else if (pn <= 3) {
      FOR_AM { const int row = rbase + ai * 128 + m * 16;
#pragma unroll
        for (int bj = 0; bj < 2; ++bj) { bf16_t* q = QB + (size_t)row * 512 + (pn - 2) * 256 + bj * 128 + cw; st_bf4x2(q, acc[ai][bj][m][0] * QSCALE_B, q + 16, acc[ai][bj][m][1] * QSCALE_B, fq); } }
    } else if (pn <= 7) {
      const bool isv = pn >= 6; bf16_t* dst = isv ? VB : KB; const int c0 = (pn & 1) * 256;
      FOR_AM { const int row = rbase + ai * 128 + m * 16; const int mr = maprow_bnd(row);
        float* o = nullptr;
        if (row >= MP) o = out + (isv ? OFF_BVS : OFF_BKS) + (size_t)(row - MP) * 512;
        else if ((row & (SEQ - 1)) >= SEQ - 512) o = out + (isv ? OFF_BVP : OFF_BKP) + ((size_t)(row >> 11) * 512 + ((row & (SEQ - 1)) - (SEQ - 512))) * 512;
#pragma unroll
        for (int bj = 0; bj < 2; ++bj) { const int col = c0 + bj * 128 + cw; st_bf4x2(dst + (size_t)mr * 512 + col, acc[ai][bj][m][0], dst + (size_t)mr * 512 + col + 16, acc[ai][bj][m][1], fq);
          if (o) { *(f32x4*)(o + col) = acc[ai][bj][m][0]; *(f32x4*)(o + col + 16) = acc[ai][bj][m][1]; } } }
    } else {
      if (wc == 0) {
        FOR_AM { const int row = rbase + ai * 128 + m * 16; const int pos = row_pos(row), mr = maprow_lat(row);
          float* o = row < MP ? out + OFF_KRP + (size_t)row * 32 : out + OFF_KRS + (size_t)(row - MP) * 32;
          const f32x4 x1 = acc[ai][0][m][0], x2 = acc[ai][0][m][1]; f32x4 y1, y2;
#pragma unroll
          for (int j = 0; j < 4; ++j) { float c, s; rope_cs(pos, 4 * fq + j, c, s); y1[j] = x1[j] * c - x2[j] * s; y2[j] = x1[j] * s + x2[j] * c; }
          *(f32x4*)(o + 4 * fq) = y1; *(f32x4*)(o + 16 + 4 * fq) = y2;
          st_bf4(KR + (size_t)mr * 32 + 4 * fq, y1); st_bf4(KR + (size_t)mr * 32 + 16 + 4 * fq, y2); }
      }
    }
  }
};
struct EpiQ {
  static constexpr bool HAS_MID = false;
  bf16_t* Q;
  __device__ __forceinline__ void operator()(const Acc& acc, const Unit& u, int wr, int wc, int fr, int fq) const {
    const int pn = u.pn, rbase = u.pm * 256 + wr * 64 + fr;
    if (pn <= 1) {
      FOR_AM { const int row = rbase + ai * 128 + m * 16; FOR_BN { const int col = pn * 256 + bj * 128 + wc * 32 + n * 16 + 4 * fq; st_bf4(Q + (size_t)row * 768 + (col >> 6) * 96 + (col & 63), acc[ai][bj][m][n] * QSCALE_A); } }
    } else {
      FOR_AM { const int row = rbase + ai * 128 + m * 16; const int pos = row_pos(row);
        float cs[4], sn[4];
#pragma unroll
        for (int j = 0; j < 4; ++j) rope_cs(pos, 4 * fq + j, cs[j], sn[j]);
#pragma unroll
        for (int bj = 0; bj < 2; ++bj) { const int head = 4 * bj + wc; const f32x4 x1 = acc[ai][bj][m][0], x2 = acc[ai][bj][m][1]; f32x4 y1, y2;
#pragma unroll
          for (int j = 0; j < 4; ++j) { y1[j] = (x1[j] * cs[j] - x2[j] * sn[j]) * QSCALE_A; y2[j] = (x1[j] * sn[j] + x2[j] * cs[j]) * QSCALE_A; }
          bf16_t* q = Q + (size_t)row * 768 + head * 96 + 64 + 4 * fq; st_bf4(q, y1); st_bf4(q + 16, y2); } __builtin_amdgcn_sched_barrier(0); }
    }
  }
};
struct EpiKV {
  static constexpr bool HAS_MID = false;
  bf16_t *KN, *V;
  __device__ __forceinline__ void operator()(const Acc& acc, const Unit& u, int wr, int wc, int fr, int fq) const {
    const int pn = u.pn, rbase = u.pm * 256 + wr * 64 + fr; bf16_t* dst = pn >= 2 ? V : KN; const int c0 = (pn & 1) * 256 + wc * 32 + 4 * fq;
    FOR_AM { const int row = rbase + ai * 128 + m * 16;
#pragma unroll
      for (int bj = 0; bj < 2; ++bj) { bf16_t* q = dst + (size_t)row * 512 + c0 + bj * 128; st_bf4x2(q, acc[ai][bj][m][0], q + 16, acc[ai][bj][m][1], fq); } }
  }
};
struct EpiO {
  static constexpr bool HAS_MID = true;
  int tsplit; const float *ssq_a, *ssq_b, *xp, *xs; bf16_t* X1B; float* ssq_x1;
  __device__ __forceinline__ void mid(Acc& acc, const Unit& u, int wr, int wc, int fr, int fq) const {
    const int rbase = u.pm * 256 + wr * 64 + fr;
    FOR_AM { const int row = rbase + ai * 128 + m * 16; const float sa = ssq_a[row], sb = ssq_b[row];
      const float ratio = __builtin_amdgcn_rsqf(sa * (1.0f / 512.0f) + EPS) * __builtin_sqrtf(sb * (1.0f / 512.0f) + EPS);
      FOR_BN { acc[ai][bj][m][n] = acc[ai][bj][m][n] * ratio; }
      __builtin_amdgcn_sched_barrier(0); }
    asm volatile("s_waitcnt vmcnt(0)" ::: "memory");
  }
  __device__ __forceinline__ void operator()(const Acc& acc, const Unit& u, int wr, int wc, int fr, int fq) const {
    const int rbase = u.pm * 256 + wr * 64 + fr, c0 = u.pn * 256 + wc * 32 + 4 * fq;
    FOR_AM { const int row = rbase + ai * 128 + m * 16; const float rb = __builtin_amdgcn_rsqf(ssq_b[row] * (1.0f / 512.0f) + EPS);
      const float* xr = row < MP ? xp + (size_t)row * D : xs + (size_t)(row - MP) * D; float s = 0.f;
#pragma unroll
      for (int bj = 0; bj < 2; ++bj) { const int col = c0 + bj * 128; const f32x4 v0 = *(const f32x4*)(xr + col) + acc[ai][bj][m][0] * rb, v1 = *(const f32x4*)(xr + col + 16) + acc[ai][bj][m][1] * rb;
        st_bf4x2(X1B + (size_t)row * D + col, v0, X1B + (size_t)row * D + col + 16, v1, fq);
        s += ((v0[0] * v0[0] + v0[1] * v0[1]) + (v0[2] * v0[2] + v0[3] * v0[3])) + ((v1[0] * v1[0] + v1[1] * v1[1]) + (v1[2] * v1[2] + v1[3] * v1[3])); }
      s += __shfl_xor(s, 16); s += __shfl_xor(s, 32); if (fq == 0) atomic_addf(ssq_x1 + row, s); __builtin_amdgcn_sched_barrier(0); }
  }
};
struct EpiGU {
  static constexpr bool HAS_MID = false;
  const float* ssq_x1; bf16_t* H;
  __device__ __forceinline__ void operator()(const Acc& acc, const Unit& u, int wr, int wc, int fr, int fq) const {
    const int rbase = u.pm * 256 + wr * 64 + fr, c0 = u.pn * 128 + wc * 16 + 4 * fq;
    FOR_AM { const int row = rbase + ai * 128 + m * 16; const float rstd = __builtin_amdgcn_rsqf(ssq_x1[row] * (1.0f / 1024.0f) + EPS);
      f32x4 hv[2];
#pragma unroll
      for (int bj = 0; bj < 2; ++bj) { const f32x4 g = acc[ai][bj][m][0] * rstd, up = acc[ai][bj][m][1] * rstd;
#pragma unroll
        for (int j = 0; j < 4; ++j) hv[bj][j] = g[j] * __builtin_amdgcn_rcpf(1.0f + __builtin_amdgcn_exp2f(-g[j] * LOG2E)) * up[j]; }
      st_bf4x2(H + (size_t)row * FF + c0, hv[0], H + (size_t)row * FF + c0 + 64, hv[1], fq); }
  }
};
__device__ __forceinline__ f32x4 ld_bf4(const bf16_t* p) { const u32x2 w = *(const u32x2*)p; return (f32x4){__builtin_bit_cast(float, w.x << 16), __builtin_bit_cast(float, w.x & 0xffff0000u), __builtin_bit_cast(float, w.y << 16), __builtin_bit_cast(float, w.y & 0xffff0000u)}; }
struct EpiD {
  static constexpr bool HAS_MID = false;
  bf16_t* X; float* ssq_x2;
  __device__ __forceinline__ void operator()(const Acc& acc, const Unit& u, int wr, int wc, int fr, int fq) const {
    const int rbase = u.pm * 256 + wr * 64 + fr, c0 = u.pn * 256 + wc * 32 + 4 * fq;
    FOR_AM { const int row = rbase + ai * 128 + m * 16; float s = 0.f;
#pragma unroll
      for (int bj = 0; bj < 2; ++bj) { bf16_t* x = X + (size_t)row * D + c0 + bj * 128; const f32x4 v0 = ld_bf4(x) + acc[ai][bj][m][0], v1 = ld_bf4(x + 16) + acc[ai][bj][m][1];
        st_bf4x2(x, v0, x + 16, v1, fq);
        s += ((v0[0] * v0[0] + v0[1] * v0[1]) + (v0[2] * v0[2] + v0[3] * v0[3])) + ((v1[0] * v1[0] + v1[1] * v1[1]) + (v1[2] * v1[2] + v1[3] * v1[3])); }
      s += __shfl_xor(s, 16); s += __shfl_xor(s, 32); if (fq == 0) atomic_addf(ssq_x2 + row, s); }
  }
};
struct EpiPart {
  static constexpr bool HAS_MID = false;
  float* PART;
  __device__ __forceinline__ void operator()(const Acc& acc, const Unit& u, int wr, int wc, int fr, int fq) const {
    float* base = PART + (size_t)(u.koff >> 8) * 256 * D; const int r0 = wr * 64 + fr, c0 = u.pn * 256 + wc * 32 + 4 * fq;
    FOR_AM { FOR_BN { *(f32x4*)(base + (size_t)(r0 + ai * 128 + m * 16) * D + c0 + bj * 128 + n * 16) = acc[ai][bj][m][n]; } }
  }
};

__device__ __forceinline__ float wave_sum(float v) {
#pragma unroll
  for (int o = 1; o < 64; o <<= 1) v += __shfl_xor(v, o);
  return v;
}
template <class Map>
__device__ __forceinline__ void transpose_item(const float* W, int K, int N, bf16_t* WT, const float* g, LAS float* scr, int item, int lane, Map map) {
  const int nblk = N / 32, kb = item / nblk, nb = item % nblk, k0 = 64 * kb, n0 = 32 * nb;
#pragma unroll 8
  for (int i = 0; i < 32; ++i) { const int kk = 2 * i + (lane >> 5); scr[kk * 33 + (lane & 31)] = W[(size_t)(k0 + kk) * N + n0 + (lane & 31)] * (g ? g[k0 + kk] : 1.0f); }
  asm volatile("s_waitcnt lgkmcnt(0)" ::: "memory");
  const int c = lane & 7;
#pragma unroll
  for (int j = 0; j < 4; ++j) { const int n = (lane >> 3) + 8 * j; const LAS float* s = scr + (8 * c) * 33 + n;
    u32x4 o; o.x = pk2(s[0 * 33], s[1 * 33]); o.y = pk2(s[2 * 33], s[3 * 33]); o.z = pk2(s[4 * 33], s[5 * 33]); o.w = pk2(s[6 * 33], s[7 * 33]);
    *(u32x4*)(WT + (size_t)map(n0 + n) * K + k0 + 8 * c) = o; }
  asm volatile("s_waitcnt lgkmcnt(0)" ::: "memory");
}
template <class Map>
__device__ __forceinline__ void convert_rows(const float* src, bf16_t* dst, int R, int cshift, int gt, int ngt, Map map) {
  const long n8 = ((long)R << cshift) >> 3;
  for (long i0 = gt; i0 < n8; i0 += 4L * ngt) {
    f32x4 v[4][2];
#pragma unroll
    for (int k = 0; k < 4; ++k) { const long i = i0 + (long)k * ngt; if (i < n8) { v[k][0] = *(const f32x4*)(src + i * 8); v[k][1] = *(const f32x4*)(src + i * 8 + 4); } }
#pragma unroll
    for (int k = 0; k < 4; ++k) { const long i = i0 + (long)k * ngt; if (i < n8) { const long e = i * 8; const int r = (int)(e >> cshift), c = (int)(e & ((1 << cshift) - 1));
      st_bf8(dst + ((size_t)map(r) << cshift) + c, v[k][0], v[k][1]); } }
  }
}
__device__ __forceinline__ void zero_rows(bf16_t* dst, int cshift, int r0, int nr, int nb, int bstride, int gt, int ngt) {
  const long per = ((long)nr << cshift) >> 3, n8 = per * nb;
  for (long i = gt; i < n8; i += ngt) { const int b = (int)(i / per); const long e = (i % per) * 8; *(u32x4*)(dst + (((size_t)b * bstride + r0) << cshift) + e) = (u32x4){0u, 0u, 0u, 0u}; }
}
__device__ __forceinline__ void prologue(ParamsC p, LAS unsigned char* lds, int G) {
  const int tid = threadIdx.x, lane = tid & 63, wave = tid >> 6; unsigned char* ws = p->ws;
  const int gw = blockIdx.x * 8 + wave, NGW = G * 8, gt = blockIdx.x * NTHREADS + tid, ngt = G * NTHREADS;
  LAS float* scr = (LAS float*)(lds + wave * 16384);
  bf16_t* WinT = (bf16_t*)(ws + WS_WIN); bf16_t* WuqT = (bf16_t*)(ws + WS_WUQ); bf16_t* WkvT = (bf16_t*)(ws + WS_WKV); bf16_t* WoT = (bf16_t*)(ws + WS_WO);
  bf16_t* WguT = (bf16_t*)(ws + WS_WGU); bf16_t* WdT = (bf16_t*)(ws + WS_WD);
  constexpr int I_IN = 16 * 65, I_UQ = 4 * 24, I_UK = 4 * 16, I_O = 16 * 32, I_G = 16 * 88, I_D = 44 * 32;
  constexpr int NITEMS = I_IN + I_UQ + 2 * I_UK + I_O + 2 * I_G + I_D;
  for (int it = gw; it < NITEMS; it += NGW) {
    int r = it;
    if (r < I_IN) { transpose_item(p->w_in, 1024, 2080, WinT, p->g_attn, scr, r, lane, [](int n) { return n < 512 ? n : (n < 544 ? 2048 + (n - 512) : 512 + (n - 544)); }); continue; } r -= I_IN;
    if (r < I_UQ) { transpose_item(p->w_uq, 256, 768, WuqT, p->g_q, scr, r, lane, [](int n) { const int h = n / 96, d = n % 96; return d < 64 ? h * 64 + d : 512 + h * 32 + (d - 64); }); continue; } r -= I_UQ;
    if (r < I_UK) { transpose_item(p->w_uk, 256, 512, WkvT, nullptr, scr, r, lane, [](int n) { return n; }); continue; } r -= I_UK;
    if (r < I_UK) { transpose_item(p->w_uv, 256, 512, WkvT, nullptr, scr, r, lane, [](int n) { return 512 + n; }); continue; } r -= I_UK;
    if (r < I_O) { const int kb = r / 32; transpose_item(p->w_out, 1024, 1024, WoT, kb < 8 ? p->g_out_a : p->g_out_b - 512, scr, r, lane, [](int n) { return n; }); continue; } r -= I_O;
    if (r < I_G) { transpose_item(p->w_gate, 1024, FF, WguT, p->g_ffn, scr, r, lane, [](int n) { return 32 * (n >> 4) + (n & 15); }); continue; } r -= I_G;
    if (r < I_G) { transpose_item(p->w_up, 1024, FF, WguT, p->g_ffn, scr, r, lane, [](int n) { return 32 * (n >> 4) + 16 + (n & 15); }); continue; } r -= I_G;
    transpose_item(p->w_down, FF, 1024, WdT, nullptr, scr, r, lane, [](int n) { return n; });
  }
  zero_rows(WinT, 10, 2080, NIN - 2080, 1, 0, gt, ngt);
  bf16_t* XN = (bf16_t*)(ws + WS_XN);
  for (int row0 = gw; row0 < MT; row0 += 4 * NGW) {
    f32x4 v[4][4]; float s[4] = {0.f, 0.f, 0.f, 0.f};
#pragma unroll
    for (int k = 0; k < 4; ++k) { const int row = row0 + k * NGW; if (row < MT) { const float* xr = row < MP ? p->xp + (size_t)row * D : p->xs + (size_t)(row - MP) * D;
#pragma unroll
      for (int j = 0; j < 2; ++j) { v[k][2 * j] = *(const f32x4*)(xr + 8 * lane + 512 * j); v[k][2 * j + 1] = *(const f32x4*)(xr + 8 * lane + 512 * j + 4); } } }
#pragma unroll
    for (int k = 0; k < 4; ++k) { const int row = row0 + k * NGW; if (row < MT) {
#pragma unroll
      for (int j = 0; j < 4; ++j) s[k] += (v[k][j][0] * v[k][j][0] + v[k][j][1] * v[k][j][1]) + (v[k][j][2] * v[k][j][2] + v[k][j][3] * v[k][j][3]);
      const float rstd = __builtin_amdgcn_rsqf(wave_sum(s[k]) * (1.0f / D) + EPS);
#pragma unroll
      for (int j = 0; j < 2; ++j) st_bf8(XN + (size_t)row * D + 8 * lane + 512 * j, v[k][2 * j] * rstd, v[k][2 * j + 1] * rstd); } }
  }
  bf16_t* CKV = (bf16_t*)(ws + WS_CKV); bf16_t* KR = (bf16_t*)(ws + WS_KR); bf16_t* KB = (bf16_t*)(ws + WS_KB); bf16_t* VB = (bf16_t*)(ws + WS_VB);
  convert_rows(p->c_ckv, CKV, DB * PAST, 8, gt, ngt, [](int r) { return MP + (r >> 12) * LROW + (r & 4095); });
  convert_rows(p->c_kr, KR, DB * PAST, 5, gt, ngt, [](int r) { return MP + (r >> 12) * LROW + (r & 4095); });
  convert_rows(p->c_bk, KB, DB * 512, 9, gt, ngt, [](int r) { return MP + (r >> 9) * BROW + (r & 511); });
  convert_rows(p->c_bv, VB, DB * 512, 9, gt, ngt, [](int r) { return MP + (r >> 9) * BROW + (r & 511); });
  zero_rows(CKV + (size_t)MP * 256, 8, PAST + DSQ, LROW - PAST - DSQ, DB, LROW, gt, ngt);
  zero_rows(KR + (size_t)MP * 32, 5, PAST + DSQ, LROW - PAST - DSQ, DB, LROW, gt, ngt);
  zero_rows(KB + (size_t)MP * 512, 9, 512 + DSQ, BROW - 512 - DSQ, DB, BROW, gt, ngt);
  zero_rows(VB + (size_t)MP * 512, 9, 512 + DSQ, BROW - 512 - DSQ, DB, BROW, gt, ngt);
  float* ssq = (float*)(ws + WS_SSQ);
  for (int i = gt; i < 4 * MT; i += ngt) ssq[i] = 0.f;
}

__device__ __forceinline__ f32x16 mfma32(bf16x8 a, bf16x8 b, f32x16 c) { return __builtin_amdgcn_mfma_f32_32x32x16_bf16(a, b, c, 0, 0, 0); }
__device__ __forceinline__ s16x4 vtr(const LAS unsigned char* p) { return __builtin_bit_cast(s16x4, __builtin_amdgcn_ds_read_tr16_b64_v4i16((LAS s16x4*)p)); }
template <int NS, bool BIAS, bool QL>
__device__ __forceinline__ void attn_qk(const LAS unsigned char* Kt, const bf16x8 (&qf)[NS], const LAS unsigned char* Qt, f32x16 (&st)[2], int nvalid, const LAS float* btab, int rb, bool lookup, int lane) {
  constexpr int KP = NS == 6 ? KP_A : KP_B;
  const int r = lane & 31, h = lane >> 5;
  bf16x8 qv[NS];
#pragma unroll
  for (int s = 0; s < NS; ++s) qv[s] = QL ? *(const LAS bf16x8*)(Qt + r * KP + (2 * s + h) * 16) : qf[s];
#pragma unroll
  for (int kh = 0; kh < 2; ++kh) {
    bf16x8 kf[NS];
#pragma unroll
    for (int s = 0; s < NS; ++s) kf[s] = *(const LAS bf16x8*)(Kt + (32 * kh + r) * KP + (2 * s + h) * 16);
    __builtin_amdgcn_sched_barrier(0);
    __builtin_amdgcn_s_setprio(1);
    { const f32x16 z = {0.f, 0.f, 0.f, 0.f, 0.f, 0.f, 0.f, 0.f, 0.f, 0.f, 0.f, 0.f, 0.f, 0.f, 0.f, 0.f}; st[kh] = mfma32(kf[0], qv[0], z); }
#pragma unroll
    for (int s = 1; s < NS; ++s) st[kh] = mfma32(kf[s], qv[s], st[kh]);
    __builtin_amdgcn_s_setprio(0);
    __builtin_amdgcn_sched_barrier(0);
  }
  if (BIAS) {
    if (lookup) { const LAS float* bp = btab + rb + 4 * h;
#pragma unroll
      for (int kh = 0; kh < 2; ++kh)
#pragma unroll
        for (int i = 0; i < 16; ++i) st[kh][i] += bp[32 * kh + (i & 3) + 8 * (i >> 2)];
    } else { const float bc = btab[0];
#pragma unroll
      for (int kh = 0; kh < 2; ++kh)
#pragma unroll
        for (int i = 0; i < 16; ++i) st[kh][i] += bc; }
  }
  if (nvalid < 64) {
#pragma unroll
    for (int kh = 0; kh < 2; ++kh)
#pragma unroll
      for (int i = 0; i < 16; ++i) { const int key = 32 * kh + (i & 3) + 8 * (i >> 2) + 4 * h; if (key >= nvalid) st[kh][i] = -1e30f; }
  }
}
__device__ __forceinline__ void attn_smpv(const LAS unsigned char* Vt, f32x16 (&st)[2], f32x16 (&o)[2], float& m_run, float& l_run, LAS float* wsf, int lane) {
  const int r = lane & 31, h = lane >> 5;
  float mx = st[0][0];
#pragma unroll
  for (int kh = 0; kh < 2; ++kh)
#pragma unroll
    for (int i = 0; i < 16; ++i) mx = __builtin_fmaxf(mx, st[kh][i]);
  mx = __builtin_fmaxf(mx, __shfl_xor(mx, 32));
  const float m_new = __builtin_fmaxf(m_run, mx), alpha = __builtin_amdgcn_exp2f(m_run - m_new);
  float rs = 0.f;
#pragma unroll
  for (int kh = 0; kh < 2; ++kh)
#pragma unroll
    for (int i = 0; i < 16; ++i) { const float pv = __builtin_amdgcn_exp2f(st[kh][i] - m_new); st[kh][i] = pv; rs += pv; }
  rs += __shfl_xor(rs, 32);
  l_run = l_run * alpha + rs; m_run = m_new;
  {
    if (h == 0) wsf[r] = alpha;
    typedef float f32x8 __attribute__((ext_vector_type(8)));
    const f32x4 a0 = *(const LAS f32x4*)(wsf + 4 * h), a1 = *(const LAS f32x4*)(wsf + 8 + 4 * h), a2 = *(const LAS f32x4*)(wsf + 16 + 4 * h), a3 = *(const LAS f32x4*)(wsf + 24 + 4 * h);
    const f32x8 lo = __builtin_shufflevector(a0, a1, 0, 1, 2, 3, 4, 5, 6, 7), hi = __builtin_shufflevector(a2, a3, 0, 1, 2, 3, 4, 5, 6, 7);
    const f32x16 av = __builtin_shufflevector(lo, hi, 0, 1, 2, 3, 4, 5, 6, 7, 8, 9, 10, 11, 12, 13, 14, 15);
    o[0] = o[0] * av; o[1] = o[1] * av;
  }
  const int blk = (lane >> 4) & 1, q = (lane & 15) >> 2, p = lane & 3;
  const int vb = (4 * h + q) * 128 + 8 * (p & 1), co0 = ((2 * blk + (p >> 1)) ^ (((q >> 1) & 1) << 2)) << 4;
#pragma unroll
  for (int kh = 0; kh < 2; ++kh)
#pragma unroll
    for (int s2 = 0; s2 < 2; ++s2) {
      u32x4 pw;
#pragma unroll
      for (int k = 0; k < 4; ++k) pw[k] = pk2(st[kh][8 * s2 + 2 * k], st[kh][8 * s2 + 2 * k + 1]);
      const bf16x8 pa = __builtin_bit_cast(bf16x8, pw);
#pragma unroll
      for (int c = 0; c < 2; ++c) {
        const LAS unsigned char* vp = Vt + (32 * kh + 16 * s2) * 128 + vb + (c ? (co0 ^ 64) : co0);
        const s16x4 lo = vtr(vp), hi = vtr(vp + 8 * 128);
        const bf16x8 vf = __builtin_shufflevector(lo, hi, 0, 1, 2, 3, 4, 5, 6, 7);
        __builtin_amdgcn_s_setprio(1); o[c] = mfma32(pa, vf, o[c]); __builtin_amdgcn_s_setprio(0);
      }
    }
}
__device__ __forceinline__ void scale_o(f32x16 (&o)[2], float f, LAS float* wsf, int lane) {
  const int r = lane & 31, h = lane >> 5;
  if (h == 0) wsf[r] = f;
#pragma unroll
  for (int g = 0; g < 4; ++g) { const f32x4 a4 = *(const LAS f32x4*)(wsf + 8 * g + 4 * h);
#pragma unroll
    for (int j = 0; j < 4; ++j) { o[0][4 * g + j] *= a4[j]; o[1][4 * g + j] *= a4[j]; } }
}
__device__ __forceinline__ void store_o(const f32x16 (&o)[2], LAS bf16_t* stg, bf16_t* att  , float* ssq  , int nq, int lane) {
  const int r = lane & 31, h = lane >> 5;
#pragma unroll
  for (int c = 0; c < 2; ++c)
#pragma unroll
    for (int i = 0; i < 16; ++i) stg[((i & 3) + 8 * (i >> 2) + 4 * h) * 64 + 32 * c + r] = (bf16_t)f2bf(o[c][i]);
  const int qr = lane >> 1, half = lane & 1; float s = 0.f; u32x4 v[4];
#pragma unroll
  for (int k = 0; k < 4; ++k) { v[k] = *(const LAS u32x4*)(stg + qr * 64 + half * 32 + 8 * k);
#pragma unroll
    for (int e = 0; e < 4; ++e) { const float a = __builtin_bit_cast(float, v[k][e] << 16), b = __builtin_bit_cast(float, v[k][e] & 0xffff0000u); s += a * a + b * b; } }
  s += __shfl_xor(s, 1);
  if (qr < nq) {
#pragma unroll
    for (int k = 0; k < 4; ++k) *(u32x4*)(att + (size_t)qr * D + half * 32 + 8 * k) = v[k];
    if (half == 0 && ssq) atomic_addf(ssq + qr, s);
  }
}
struct KVSrc { const bf16_t* K; const bf16_t* KRp; const bf16_t* V; };
template <int NS>
__device__ __forceinline__ u32x4 ld_kchunk(const KVSrc& s, long krow, int id) {
  if (NS == 6) { const int row = id / 12, ch = id - row * 12;
    return ch < 8 ? *(const u32x4*)(s.K + (krow + row) * 512 + ch * 8) : *(const u32x4*)(s.KRp + (krow + row) * 32 + (ch - 8) * 8); }
  else { const int row = id >> 3, ch = id & 7; return *(const u32x4*)(s.K + (krow + row) * 512 + ch * 8); }
}
template <int NS>
__device__ __forceinline__ void st_kchunk(LAS unsigned char* Kt, int id, u32x4 v) {
  constexpr int KP = NS == 6 ? KP_A : KP_B, CPR = NS == 6 ? 12 : 8;
  const int row = id / CPR, ch = id - row * CPR; *(LAS u32x4*)(Kt + row * KP + ch * 16) = v;
}
__device__ __forceinline__ void st_vchunk(LAS unsigned char* Vt, int id, u32x4 v) { const int row = id >> 3, ch = id & 7; *(LAS u32x4*)(Vt + row * 128 + ((ch ^ (((row >> 1) & 1) << 2)) << 4)) = v; }

__device__ __forceinline__ void glds16(const void* gsrc, unsigned lds_dst) {
  unsigned keep;
  asm volatile("s_mov_b32 %0, m0\n\ts_mov_b32 m0, %2\n\ts_nop 0\n\tglobal_load_lds_dwordx4 %1, off\n\ts_mov_b32 m0, %0" : "=&s"(keep) : "v"(gsrc), "s"(lds_dst) : "memory");
}
template <int NS>
__device__ __forceinline__ void dma_tile(LAS unsigned char* Kt, LAS unsigned char* Vt, const KVSrc& src, long krow, int wave, int lane) {
  constexpr int CPR = NS == 6 ? 13 : 9, ND = CPR;
#pragma unroll
  for (int k = 0; k < 2; ++k) { const int d = wave + 8 * k;
    if (d < ND) { const int c = d * 64 + lane, row = c / CPR, ch = c - row * CPR;
      const bf16_t* g = (NS == 6 && ch >= 8 && ch < 12) ? src.KRp + (krow + row) * 32 + (ch - 8) * 8 : src.K + (krow + row) * 512 + (ch < 8 ? ch : 0) * 8;
      glds16(g, (unsigned)__builtin_amdgcn_readfirstlane((int)(unsigned)(uintptr_t)(Kt + d * 1024))); } }
  { const int c = wave * 64 + lane, row = c >> 3, ch = (c & 7) ^ (((row >> 1) & 1) << 2);
    glds16(src.V + (krow + row) * 512 + ch * 8, (unsigned)__builtin_amdgcn_readfirstlane((int)(unsigned)(uintptr_t)(Vt + wave * 1024))); }
}
#define AT_VMWAIT(n) asm volatile("s_waitcnt vmcnt(" #n ")" ::: "memory")
template <int NS, bool BIAS>
__device__ __forceinline__ void attn_unit_shared(LAS unsigned char* lds, const bf16_t* Qw  , int qpitch, const KVSrc src, long krow0,
                                                 int t_lo, int t_hi, int w_lo, int w_hi, int qpos0  , bf16_t* att, float* ssq, int bhead = 0) {
  constexpr int SLOT = 21504, ND = NS == 6 ? 13 : 9;
  int tid_ = threadIdx.x; asm volatile("" : "+v"(tid_));
  const int tid = tid_, lane = tid & 63, wave = __builtin_amdgcn_readfirstlane(tid >> 6), r = lane & 31, h = lane >> 5;
  LAS float* wsf = (LAS float*)(lds + AT_WSF) + wave * 64; const LAS float* btab = (const LAS float*)(lds + AT_BIAS) + bhead * 640;
#pragma unroll
  for (int k = 0; k < 2; ++k) if (t_lo + k <= t_hi) dma_tile<NS>(lds + AT_TILE + k * SLOT, lds + AT_TILE + k * SLOT + 13312, src, krow0 + 64L * (t_lo + k), wave, lane);
  bf16x8 qf[NS];
#pragma unroll
  for (int s = 0; s < NS; ++s) qf[s] = *(const bf16x8*)(Qw + (size_t)r * qpitch + 16 * s + 8 * h);
#pragma unroll
  for (int s = 0; s < NS; ++s) asm volatile("" : "+v"(qf[s]));
  f32x16 o[2];
#pragma unroll
  for (int i = 0; i < 16; ++i) { o[0][i] = 0.f; o[1][i] = 0.f; }
  float m_run = -1e30f, l_run = 0.f;
  AT_VMWAIT(0);
  asm volatile("s_waitcnt lgkmcnt(0)" ::: "memory"); __builtin_amdgcn_s_barrier(); asm volatile("" ::: "memory");
  for (int t0 = t_lo; t0 <= t_hi; t0 += 2) {
#pragma unroll
    for (int k = 2; k < 4; ++k) if (t0 + k <= t_hi) { const int s3 = (t0 + k - t_lo) & 3; dma_tile<NS>(lds + AT_TILE + s3 * SLOT, lds + AT_TILE + s3 * SLOT + 13312, src, krow0 + 64L * (t0 + k), wave, lane); }
#pragma unroll
    for (int k = 0; k < 2; ++k) { const int t = t0 + k; const int sl = (t - t_lo) & 3;
      if (t <= t_hi && t >= w_lo && t <= w_hi) {
        const bool lookup = BIAS && (qpos0 - (64 * t + 63) < 256);
        f32x16 st[2]; attn_qk<NS, BIAS, false>(lds + AT_TILE + sl * SLOT, qf, nullptr, st, 64, btab, 639 - (qpos0 + r - 64 * t + 256), lookup, lane);
        attn_smpv(lds + AT_TILE + sl * SLOT + 13312, st, o, m_run, l_run, wsf, lane);
      } }
    AT_VMWAIT(0);
    asm volatile("s_waitcnt lgkmcnt(0)" ::: "memory"); __builtin_amdgcn_s_barrier(); asm volatile("" ::: "memory");
  }
  scale_o(o, 1.0f / l_run, wsf, lane);
  store_o(o, (LAS bf16_t*)(lds + AT_OSTG) + wave * 2048, att, ssq, 32, lane);
}
template <int NS, bool BIAS>
__device__ __forceinline__ void attn_unit_sample(LAS unsigned char* lds, const bf16_t* Qw, int qpitch, const KVSrc src, long krow0, int ntiles, int nvalid_last, int qpos0, bf16_t* att, float* ssq, int bhead = 0) {
  constexpr int NKC = NS == 6 ? 768 : 512;
  int tid_ = threadIdx.x; asm volatile("" : "+v"(tid_));
  const int tid = tid_, lane = tid & 63, wave = tid >> 6, r = lane & 31, h = lane >> 5;
  LAS float* wsf = (LAS float*)(lds + AT_WSF) + wave * 64; const LAS float* btab = (const LAS float*)(lds + AT_BIAS) + bhead * 640;
  LAS float* cm = (LAS float*)(lds + AT_CMB);
  f32x16 o[2];
#pragma unroll
  for (int i = 0; i < 16; ++i) { o[0][i] = 0.f; o[1][i] = 0.f; }
  float m_run = -1e30f, l_run = 0.f;
  LAS unsigned char* Kt = lds + AT_TILE + (wave & 3) * AT_PRIV; LAS unsigned char* Vt = Kt + 13312;
  bf16x8 qf[NS];
#pragma unroll
  for (int s = 0; s < NS; ++s) qf[s] = *(const bf16x8*)(Qw + (size_t)(r & 15) * qpitch + 16 * s + 8 * h);
  constexpr int NK4 = 4 * NKC / 512;
  u32x4 kc[NK4], vc[4];
#define SMP_LOAD(T0) do { _Pragma("unroll") for (int i = 0; i < NK4; ++i) { const int id = tid + 512 * i, tt = id / NKC, cid = id - tt * NKC; if ((T0) + tt < ntiles) kc[i] = ld_kchunk<NS>(src, krow0 + 64L * ((T0) + tt), cid); } \
    _Pragma("unroll") for (int i = 0; i < 4; ++i) { const int id = tid + 512 * i, tt = id >> 9, cid = id & 511; if ((T0) + tt < ntiles) vc[i] = *(const u32x4*)(src.V + (krow0 + 64L * ((T0) + tt) + (cid >> 3)) * 512 + (cid & 7) * 8); } } while (0)
#define SMP_STORE(T0) do { _Pragma("unroll") for (int i = 0; i < NK4; ++i) { const int id = tid + 512 * i, tt = id / NKC, cid = id - tt * NKC; if ((T0) + tt < ntiles) st_kchunk<NS>(lds + AT_TILE + tt * AT_PRIV, cid, kc[i]); } \
    _Pragma("unroll") for (int i = 0; i < 4; ++i) { const int id = tid + 512 * i, tt = id >> 9, cid = id & 511; if ((T0) + tt < ntiles) st_vchunk(lds + AT_TILE + tt * AT_PRIV + 13312, cid, vc[i]); } } while (0)
  SMP_LOAD(0); SMP_STORE(0);
  __syncthreads();
  for (int t0 = 0; t0 < ntiles; t0 += 4) {
    if (t0 + 4 < ntiles) SMP_LOAD(t0 + 4);
    const int t = t0 + wave;
    if (wave < 4 && t < ntiles) {
      const bool lookup = BIAS && (qpos0 - (64 * t + 63) < 256);
      f32x16 st[2]; attn_qk<NS, BIAS, false>(Kt, qf, nullptr, st, (t == ntiles - 1) ? nvalid_last : 64, btab, 639 - (qpos0 + (r & 15) - 64 * t + 256), lookup, lane);
      attn_smpv(Vt, st, o, m_run, l_run, wsf, lane);
    }
    __syncthreads();
    if (t0 + 4 < ntiles) { SMP_STORE(t0 + 4); }
    __syncthreads();
  }
#undef SMP_LOAD
#undef SMP_STORE
  if (wave < 4 && h == 0) cm[wave * 32 + r] = m_run;
  __syncthreads();
  if (wave < 4) {
    const float M = __builtin_fmaxf(__builtin_fmaxf(cm[r], cm[32 + r]), __builtin_fmaxf(cm[64 + r], cm[96 + r]));
    const float f = __builtin_amdgcn_exp2f(m_run - M);
    scale_o(o, f, wsf, lane);
    if (h == 0) cm[128 + wave * 32 + r] = l_run * f;
    LAS float* po = (LAS float*)(lds + AT_TILE + wave * AT_PRIV);
#pragma unroll
    for (int c = 0; c < 2; ++c)
#pragma unroll
      for (int i = 0; i < 16; ++i) po[(c * 16 + i) * 64 + lane] = o[c][i];
  }
  __syncthreads();
  if (wave == 0) {
    const float l = (cm[128 + r] + cm[160 + r]) + (cm[192 + r] + cm[224 + r]);
#pragma unroll
    for (int w = 1; w < 4; ++w) { const LAS float* po = (const LAS float*)(lds + AT_TILE + w * AT_PRIV);
#pragma unroll
      for (int c = 0; c < 2; ++c)
#pragma unroll
        for (int i = 0; i < 16; ++i) o[c][i] += po[(c * 16 + i) * 64 + lane]; }
    scale_o(o, 1.0f / l, wsf, lane);
    store_o(o, (LAS bf16_t*)(lds + AT_OSTG), att, ssq, 16, lane);
  }
  __syncthreads();
}
__device__ __forceinline__ void load_bias_all(LAS unsigned char* lds, const float* rel_bias) {
  LAS float* btab = (LAS float*)(lds + AT_BIAS);
  for (int i = threadIdx.x; i < 8 * 640; i += NTHREADS) { const int hd = i / 640, j = 639 - (i - hd * 640); btab[i] = rel_bias[hd * 513 + (j > 512 ? 512 : j)] * LOG2E; }
  __syncthreads();
}
__device__ __forceinline__ void attention_phase(ParamsC p, LAS unsigned char* lds, int G, bool dry, int apm = 15) {
  unsigned char* ws = p->ws; const int wave = threadIdx.x >> 6;
  const bf16_t* Q = (const bf16_t*)(ws + WS_Q); const bf16_t* KN = (const bf16_t*)(ws + WS_KN); const bf16_t* V = (const bf16_t*)(ws + WS_V); const bf16_t* KR = (const bf16_t*)(ws + WS_KR);
  const bf16_t* QB = (const bf16_t*)(ws + WS_QB); const bf16_t* KB = (const bf16_t*)(ws + WS_KB); const bf16_t* VB = (const bf16_t*)(ws + WS_VB);
  bf16_t* ATT = (bf16_t*)(ws + WS_XN); float* ssq_a = (float*)(ws + WS_SSQ); float* ssq_b = ssq_a + MT;
  load_bias_all(lds, p->rel_bias);
  for (int u = blockIdx.x; u < 256; u += G) {
    const int b = (u & 127) >> 3, head = u & 7; const int row0 = MP + b * DSQ;
#ifndef AP
#define AP 15
#endif
    if (u < 128) { if (apm & 1) {
      const KVSrc src{KN + head * 64, KR, V + head * 64};
      attn_unit_sample<6, false>(lds, Q + (size_t)row0 * 768 + head * 96, 768, src, (long)MP + (long)b * LROW, 65, 16, 0, ATT + (size_t)row0 * D + head * 64, dry ? nullptr : ssq_a + row0); }
    } else if (apm & 2) {
      const KVSrc src{KB + head * 64, nullptr, VB + head * 64};
      attn_unit_sample<4, true>(lds, QB + (size_t)row0 * 512 + head * 64, 512, src, (long)MP + (long)b * BROW, 9, 16, 512, ATT + (size_t)row0 * D + 512 + head * 64, dry ? nullptr : ssq_b + row0, head);
    }
  }
  if (G == 256) {
    const int vcu = (blockIdx.x & 7) * 32 + (blockIdx.x >> 3), grp = vcu >> 3, mem = vcu & 7; const int b = grp; const long brow = (long)b * SEQ;
    if (apm & 4) for (int i = 0; i < 8; ++i) { const int head = i, qb = (mem + i) & 7; const KVSrc src{KN + head * 64, KR, V + head * 64}; const long qrow = brow + 256 * qb + 32 * wave;
      attn_unit_shared<6, false>(lds, Q + (size_t)qrow * 768 + head * 96, 768, src, brow, 0, 4 * qb + 3, 0, 4 * qb + (wave >> 1), 0, ATT + (size_t)qrow * D + head * 64, dry ? nullptr : ssq_a + qrow); }
    if (apm & 8) for (int i = 0; i < 8; ++i) { const int head = i, cb = (mem + i) & 7;
      const KVSrc src{KB + head * 64, nullptr, VB + head * 64}; const long qrow = brow + 256 * cb + 32 * wave; const int cq = 4 * cb + (wave >> 1); const int tl = 4 * cb - 8 < 0 ? 0 : 4 * cb - 8;
      attn_unit_shared<4, true>(lds, QB + (size_t)qrow * 512 + head * 64, 512, src, brow, tl, 4 * cb + 3, cq - 8, cq, 256 * cb + 32 * wave, ATT + (size_t)qrow * D + 512 + head * 64, dry ? nullptr : ssq_b + qrow, head); }
  } else {
  for (int bh = blockIdx.x; bh < NBATCH * 8; bh += G) {
    const int b = bh >> 3, head = bh & 7; const long brow = (long)b * SEQ;
    if (apm & 4) { const KVSrc src{KN + head * 64, KR, V + head * 64};
      for (int qb = 0; qb < 8; ++qb) { const long qrow = brow + 256 * qb + 32 * wave;
        attn_unit_shared<6, false>(lds, Q + (size_t)qrow * 768 + head * 96, 768, src, brow, 0, 4 * qb + 3, 0, 4 * qb + (wave >> 1), 0, ATT + (size_t)qrow * D + head * 64, dry ? nullptr : ssq_a + qrow); } }
    if (apm & 8) { const KVSrc src{KB + head * 64, nullptr, VB + head * 64};
      for (int cb = 0; cb < 8; ++cb) { const long qrow = brow + 256 * cb + 32 * wave; const int cq = 4 * cb + (wave >> 1); const int tl = 4 * cb - 8 < 0 ? 0 : 4 * cb - 8;
        attn_unit_shared<4, true>(lds, QB + (size_t)qrow * 512 + head * 64, 512, src, brow, tl, 4 * cb + 3, cq - 8, cq, 256 * cb + 32 * wave, ATT + (size_t)qrow * D + 512 + head * 64, dry ? nullptr : ssq_b + qrow, head); } }
  }
  }
}


#define XB_TMO      128
#define XB_XCNT(j)  (256  + 64 * (j))
#define XB_XSUB(j)  (1280 + 64 * (j))
#define XB_XGEN(j)  (2304 + 64 * (j))
#define XB_TOP      3328
#define XB_TOPGEN   3392
#define XCD_BAR_WORDS 3456
#define XB_SPIN_CAP (1u << 18)
__device__ __forceinline__ unsigned xb_ld(unsigned* p)              { return __hip_atomic_load(p, __ATOMIC_RELAXED, __HIP_MEMORY_SCOPE_AGENT); }
__device__ __forceinline__ unsigned xb_add(unsigned* p, unsigned v) { return __hip_atomic_fetch_add(p, v, __ATOMIC_RELAXED, __HIP_MEMORY_SCOPE_AGENT); }
__device__ __forceinline__ unsigned xb_xcc_id() { return (unsigned)__builtin_amdgcn_s_getreg((3 << 11) | 20) & 0xFu; }
#define XB_SPIN(cond, bar) do { unsigned _sp = 0; while (cond) { __builtin_amdgcn_s_sleep(1); \
    if ((++_sp & 255u) == 0u) { if (xb_ld(&(bar)[XB_TMO])) break; if (_sp > XB_SPIN_CAP) { atomicAdd(&(bar)[XB_TMO], 1u); break; } } } } while (0)
__device__ __forceinline__ void xcd_barrier_complete(unsigned* bar, unsigned x, unsigned& nloc, unsigned& nx) {
  const unsigned G = gridDim.x * gridDim.y * gridDim.z;
  unsigned sum, cnt, mine, sp = 0u;
  for (;;) {
    sum = 0u; cnt = 0u; mine = 0u;
#pragma unroll
    for (unsigned j = 0; j < 16; ++j) { const unsigned c = xb_ld(&bar[XB_XCNT(j)]); sum += c; cnt += (c > 0u) ? 1u : 0u; mine = (j == x) ? c : mine; }
    if (sum == G) break;
    __builtin_amdgcn_s_sleep(1);
    if ((++sp & 255u) == 0u) { if (xb_ld(&bar[XB_TMO])) break; if (sp > XB_SPIN_CAP) { atomicAdd(&bar[XB_TMO], 1u); break; } }
  }
  nloc = mine > 0u ? mine : 1u; nx = cnt > 0u ? cnt : 1u;
}
__device__ __forceinline__ void xcd_barrier(unsigned* bar, volatile LAS unsigned* st) {
  asm volatile("s_waitcnt vmcnt(0)" ::: "memory");
  __syncthreads();
  if (threadIdx.x == 0) {
    const unsigned x = xb_xcc_id();
    __builtin_amdgcn_s_waitcnt(0);
    unsigned nloc = st[0], nx = st[1];
    if (nloc == 0u) { xcd_barrier_complete(bar, x, nloc, nx); st[0] = nloc; st[1] = nx; }
    const unsigned old = xb_add(&bar[XB_XSUB(x)], 1u);
    const unsigned gen = old / nloc;
    if (old + 1u == (gen + 1u) * nloc) {
      __builtin_amdgcn_fence(__ATOMIC_RELEASE, "agent");
      asm volatile("s_waitcnt vmcnt(0)" ::: "memory");
      const unsigned og = xb_add(&bar[XB_TOP], 1u);
      const unsigned tg = og / nx;
      if (og + 1u == (tg + 1u) * nx) xb_add(&bar[XB_TOPGEN], 1u);
      else XB_SPIN(xb_ld(&bar[XB_TOPGEN]) == tg, bar);
      __builtin_amdgcn_fence(__ATOMIC_ACQUIRE, "agent");
      xb_add(&bar[XB_XGEN(x)], 1u);
      asm volatile("s_waitcnt vmcnt(0)" ::: "memory");
    } else {
      XB_SPIN(xb_ld(&bar[XB_XGEN(x)]) == gen, bar);
      __builtin_amdgcn_fence(__ATOMIC_ACQUIRE, "agent");
      asm volatile("s_waitcnt vmcnt(0)" ::: "memory");
    }
  }
  __syncthreads();
}

__device__ __forceinline__ ParamsC get_params() {
  ParamsC pp = (ParamsC)__builtin_amdgcn_kernarg_segment_ptr(); asm volatile("" : "+s"(pp)); return pp;
}
__global__ void __launch_bounds__(NTHREADS) mk_fwd(Params p_unused) {
  extern __shared__ __attribute__((aligned(16))) unsigned char lds_raw[];
  LAS unsigned char* lds = (LAS unsigned char*)lds_raw;
  cg::grid_group grid = cg::this_grid();
  const int G = gridDim.x;
  volatile LAS unsigned* xst = (volatile LAS unsigned*)(lds + LDS_BYTES - 16);
  if (threadIdx.x < 2) xst[threadIdx.x] = 0u;
  if (threadIdx.x == 0) (void)xb_add(&((unsigned*)(get_params()->ws + WS_BAR))[XB_XCNT(xb_xcc_id())], 1u);
  __syncthreads();
#define FAST_SYNC() xcd_barrier((unsigned*)(get_params()->ws + WS_BAR), xst)
#define WSP(T, off) ((T*)(get_params()->ws + (off)))
#define ssq WSP(float, WS_SSQ)
#define X1B WSP(bf16_t, WS_X1B)
#define XN WSP(bf16_t, WS_XN)
#define CQN WSP(bf16_t, WS_CQN)
#define CKV WSP(bf16_t, WS_CKV)
#define KR WSP(bf16_t, WS_KR)
#define QB WSP(bf16_t, WS_QB)
#define KB WSP(bf16_t, WS_KB)
#define VB WSP(bf16_t, WS_VB)
#define Q WSP(bf16_t, WS_Q)
#define KN WSP(bf16_t, WS_KN)
#define V WSP(bf16_t, WS_V)
#define H WSP(bf16_t, WS_H)
  pg8::StaticOrder S;
#ifndef PH
#define PH 255
#endif
  if (PH & 1) prologue(get_params(), lds, G);
#ifdef DUP_P0
  grid.sync(); prologue(get_params(), lds, G);
#endif
  grid.sync();
  if (PH & 2) { pg8::Gemm g{XN, (const bf16_t*)(get_params()->ws + WS_WIN), 1024, 1024, 1024}; S.init(MT, NIN, G, blockIdx.x);
    ParamsC pp = get_params(); EpiIn E{pp->out, CQN, CKV, KR, QB, KB, VB, pp->g_kv, (LAS float*)(lds + LDS_RED)};
    pg8::gemm_phase(lds, g, S, E); }
  FAST_SYNC();
  if ((PH & 4) && !(PH & 256)) { pg8::Gemm g{CQN, (const bf16_t*)(get_params()->ws + WS_WUQ), 256, 256, 256}; S.init(MT, 768, G, blockIdx.x); EpiQ E{Q}; pg8::gemm_phase(lds, g, S, E); }
  if ((PH & 4) && !(PH & 512)) { pg8::Gemm g{CKV, (const bf16_t*)(get_params()->ws + WS_WKV), 256, 256, 256}; S.init(MLAT, 1024, G, blockIdx.x); EpiKV E{KN, V}; pg8::gemm_phase(lds, g, S, E); }
  FAST_SYNC();
  if (PH & 8) attention_phase(get_params(), lds, G, false);
#ifdef DUP_ATTN
  grid.sync(); attention_phase(get_params(), lds, G, true, DUP_ATTN);
#endif
  FAST_SYNC();
  if (PH & 16) { pg8::Gemm g{XN  , (const bf16_t*)(get_params()->ws + WS_WO), 1024, 1024, 1024}; S.init(MT, 1024, G, blockIdx.x);
    ParamsC pp = get_params(); EpiO E{8, ssq, ssq + MT, pp->xp, pp->xs, X1B, ssq + 2 * MT}; pg8::gemm_phase(lds, g, S, E); }
  FAST_SYNC();
  if (PH & 32) { pg8::Gemm g{X1B, (const bf16_t*)(get_params()->ws + WS_WGU), 1024, 1024, 1024}; S.init(MT, NGU, G, blockIdx.x); EpiGU E{ssq + 2 * MT, H}; pg8::gemm_phase(lds, g, S, E);
#ifdef DUP_P5
    grid.sync(); pg8::gemm_phase(lds, g, S, E);
#endif
  }
  FAST_SYNC();
#define PART WSP(float, WS_Q)
  if (PH & 64) { pg8::Gemm g{H, (const bf16_t*)(get_params()->ws + WS_WD), FF, FF, FF}; S.init(MP, 1024, G, blockIdx.x); EpiD E{X1B, ssq + 3 * MT}; pg8::gemm_phase(lds, g, S, E);
    pg8::Gemm g2{H, (const bf16_t*)(get_params()->ws + WS_WD), FF, FF, 256}; pg8::SplitOrder S2{MP / 256, 4, 44, 256, G, (int)blockIdx.x}; EpiPart E2{PART}; pg8::gemm_phase(lds, g2, S2, E2); }
  FAST_SYNC();
  if (PH & 128) { ParamsC p = get_params(); int t7 = threadIdx.x; asm volatile("" : "+v"(t7)); const int lane = t7 & 63, gw = blockIdx.x * 8 + (t7 >> 6), NGW = G * 8; const float* s2 = ssq + 3 * MT;
    f32x4 gf[4];
#pragma unroll
    for (int j = 0; j < 2; ++j) { gf[2 * j] = *(const f32x4*)(p->g_final + 8 * lane + 512 * j); gf[2 * j + 1] = *(const f32x4*)(p->g_final + 8 * lane + 512 * j + 4); }
    for (int rr0 = gw; rr0 < MT; rr0 += 4 * NGW) {
      u32x4 raw[4][2]; int rows[4];
#pragma unroll
      for (int k = 0; k < 4; ++k) { const int rr = rr0 + k * NGW; rows[k] = rr < MS ? MP + rr : rr - MS;
        if (rr < MT) { const bf16_t* x = X1B + (size_t)rows[k] * D;
#pragma unroll
          for (int j = 0; j < 2; ++j) raw[k][j] = *(const u32x4*)(x + 8 * lane + 512 * j); } }
#pragma unroll
      for (int k = 0; k < 4; ++k) { const int rr = rr0 + k * NGW, row = rows[k]; if (rr < MT) {
        f32x4 v[4];
#pragma unroll
        for (int j = 0; j < 2; ++j) { const u32x4 w = raw[k][j];
          v[2 * j] = (f32x4){__builtin_bit_cast(float, w.x << 16), __builtin_bit_cast(float, w.x & 0xffff0000u), __builtin_bit_cast(float, w.y << 16), __builtin_bit_cast(float, w.y & 0xffff0000u)};
          v[2 * j + 1] = (f32x4){__builtin_bit_cast(float, w.z << 16), __builtin_bit_cast(float, w.z & 0xffff0000u), __builtin_bit_cast(float, w.w << 16), __builtin_bit_cast(float, w.w & 0xffff0000u)}; }
        float* y = p->out + OFF_Y + (size_t)row * D; float rstd;
        if (row >= MP) { float s = 0.f;
          for (int kc = 0; kc < 11; ++kc) { const float* pr = PART + ((size_t)kc * 256 + (row - MP)) * D;
#pragma unroll
            for (int j = 0; j < 2; ++j) { v[2 * j] = v[2 * j] + *(const f32x4*)(pr + 8 * lane + 512 * j); v[2 * j + 1] = v[2 * j + 1] + *(const f32x4*)(pr + 8 * lane + 512 * j + 4); } }
#pragma unroll
          for (int j = 0; j < 4; ++j) s += (v[j][0] * v[j][0] + v[j][1] * v[j][1]) + (v[j][2] * v[j][2] + v[j][3] * v[j][3]);
          rstd = __builtin_amdgcn_rsqf(wave_sum(s) * (1.0f / D) + EPS);
        } else rstd = __builtin_amdgcn_rsqf(s2[row] * (1.0f / D) + EPS);
#pragma unroll
        for (int j = 0; j < 2; ++j) { *(f32x4*)(y + 8 * lane + 512 * j) = v[2 * j] * rstd * gf[2 * j]; *(f32x4*)(y + 8 * lane + 512 * j + 4) = v[2 * j + 1] * rstd * gf[2 * j + 1]; } } } } }
}

#undef FAST_SYNC
#undef ssq
#undef X1B
#undef XN
#undef CQN
#undef CKV
#undef KR
#undef QB
#undef KB
#undef VB
#undef Q
#undef KN
#undef V
#undef H
#undef PART
extern "C" void kernel_launch(void* const* d_in, const int* in_sizes, int n_in, void* d_out, int out_size, void* d_ws, size_t ws_size, hipStream_t stream) {
  static int grid = 0;
  if (grid == 0) {
    if (n_in != 22 || (size_t)out_size != OUT_TOTAL || ws_size < WS_TOTAL) { fprintf(stderr, "kernel_launch: unexpected shapes (n_in %d out %d ws %zu, need ws %zu)\n", n_in, out_size, ws_size, (size_t)WS_END); grid = -1; return; }
    int dev = 0, cus = 0, per_cu = 0;
    hipGetDevice(&dev); hipDeviceGetAttribute(&cus, hipDeviceAttributeMultiprocessorCount, dev);
    hipFuncSetAttribute((const void*)mk_fwd, hipFuncAttributeMaxDynamicSharedMemorySize, LDS_BYTES);
    hipOccupancyMaxActiveBlocksPerMultiprocessor(&per_cu, (const void*)mk_fwd, NTHREADS, LDS_BYTES);
    if (per_cu < 1 || cus < 1) { fprintf(stderr, "kernel_launch: occupancy query gave %d blocks/CU on %d CUs\n", per_cu, cus); grid = -1; return; }
    grid = cus * (per_cu > 1 ? 1 : per_cu);
  }
  if (grid < 0) return;
  Params p{};
  const float** pp = (const float**)&p;
  for (int i = 0; i < 22; ++i) pp[i] = (const float*)d_in[i];
  p.out = (float*)d_out; p.ws = (unsigned char*)d_ws;
  if (hipMemsetAsync((char*)d_ws + WS_BAR, 0, 16384, stream) != hipSuccess) { fprintf(stderr, "kernel_launch: memset of barrier words failed\n"); return; }
  void* args[] = {&p};
  hipError_t e = hipLaunchCooperativeKernel((void*)mk_fwd, dim3(grid), dim3(NTHREADS), args, LDS_BYTES, stream);
  if (e != hipSuccess) fprintf(stderr, "cooperative launch failed: %s (grid %d)\n", hipGetErrorString(e), grid);
}
```

```cpp
#include <hip/hip_runtime.h>
#include <hip/hip_cooperative_groups.h>
#include <cstdio>
#include <cstdint>


namespace cg = cooperative_groups;

#define LAS __attribute__((address_space(3)))
typedef unsigned short bf16_t;
typedef short bf16x8 __attribute__((ext_vector_type(8)));
typedef short s16x4 __attribute__((ext_vector_type(4)));
typedef float f32x4 __attribute__((ext_vector_type(4)));
typedef float f32x16 __attribute__((ext_vector_type(16)));
typedef unsigned u32x4 __attribute__((ext_vector_type(4)));
typedef unsigned u32x2 __attribute__((ext_vector_type(2)));
typedef float f32x2_t __attribute__((ext_vector_type(2)));
typedef __bf16 bf16x2_t __attribute__((ext_vector_type(2)));

constexpr int D = 1024, NBATCH = 32, SEQ = 2048, MP = NBATCH * SEQ, DB = 16, DSQ = 16, MS = DB * DSQ, MT = MP + MS, PAST = 4096;
constexpr int NIN = 2304, FF = 2816, NGU = 2 * FF;
constexpr int LROW = 4352, BROW = 768;
constexpr int MLAT = MP + DB * LROW, MBND = MP + DB * BROW;
constexpr float EPS = 1e-6f, LOG2E = 1.4426950408889634f;
constexpr float QSCALE_A = 0.10206207261596575f * LOG2E;
constexpr float QSCALE_B = 0.125f * LOG2E;
constexpr int NTHREADS = 512;
constexpr size_t OFF_Y = 0, OFF_CKVP = (size_t)MT * D, OFF_KRP = OFF_CKVP + (size_t)MP * 256, OFF_BKP = OFF_KRP + (size_t)MP * 32,
                 OFF_BVP = OFF_BKP + (size_t)NBATCH * 512 * 512, OFF_CKVS = OFF_BVP + (size_t)NBATCH * 512 * 512, OFF_KRS = OFF_CKVS + (size_t)MS * 256,
                 OFF_BKS = OFF_KRS + (size_t)MS * 32, OFF_BVS = OFF_BKS + (size_t)MS * 512, OUT_TOTAL = OFF_BVS + (size_t)MS * 512;
constexpr size_t al256(size_t x) { return (x + 255) & ~(size_t)255; }
constexpr size_t WS_SSQ = 0;
constexpr size_t WS_WIN = al256(WS_SSQ + 4 * (size_t)MT * 4);
constexpr size_t WS_WUQ = al256(WS_WIN + (size_t)NIN * 1024 * 2);
constexpr size_t WS_WKV = al256(WS_WUQ + (size_t)768 * 256 * 2);
constexpr size_t WS_WO = al256(WS_WKV + (size_t)1024 * 256 * 2);
constexpr size_t WS_WGU = al256(WS_WO + (size_t)1024 * 1024 * 2);
constexpr size_t WS_WD = al256(WS_WGU + (size_t)NGU * 1024 * 2);
constexpr size_t WS_X1B = al256(WS_WD + (size_t)1024 * FF * 2);
constexpr size_t WS_XN = al256(WS_X1B + (size_t)MT * 1024 * 2);
constexpr size_t WS_CQN = al256(WS_XN + (size_t)MT * 1024 * 2);
constexpr size_t WS_CKV = al256(WS_CQN + (size_t)MT * 256 * 2);
constexpr size_t WS_KR = al256(WS_CKV + (size_t)MLAT * 256 * 2);
constexpr size_t WS_QB = al256(WS_KR + (size_t)MLAT * 32 * 2);
constexpr size_t WS_KB = al256(WS_QB + (size_t)MT * 512 * 2);
constexpr size_t WS_VB = al256(WS_KB + (size_t)MBND * 512 * 2);
constexpr size_t WS_Q = al256(WS_VB + (size_t)MBND * 512 * 2);
constexpr size_t WS_KN = al256(WS_Q + (size_t)MT * 768 * 2);
constexpr size_t WS_V = al256(WS_KN + (size_t)MLAT * 512 * 2);
constexpr size_t WS_END = al256(WS_V + (size_t)MLAT * 512 * 2);
constexpr size_t WS_BAR = WS_END;
constexpr size_t WS_TOTAL = WS_END + 16384;
constexpr size_t WS_H = WS_XN;
static_assert(WS_H + (size_t)MT * FF * 2 <= WS_VB, "H overlay must end before anything live in P5/P6 (nothing is, but keep it inside dead buffers)");
static_assert(WS_TOTAL <= (size_t)1073741824, "workspace");

constexpr int LDS_GEMM = 131072, LDS_RED = LDS_GEMM, LDS_BYTES = 143360;
constexpr int KP_A = 208, KP_B = 144;
constexpr int AT_TILE = 0, AT_PRIV = 21504  , AT_QT = 51200  , AT_BIAS = 86016  , AT_WSF = 107008, AT_OSTG = 109056, AT_CMB = 141824;
static_assert(AT_CMB + 1024 <= LDS_BYTES, "attention LDS map");

struct Params {
  const float *xp, *xs, *c_ckv, *c_kr, *c_bk, *c_bv, *w_in, *g_attn, *g_q, *w_uq, *g_kv, *w_uk, *w_uv, *rel_bias, *g_out_a, *g_out_b, *w_out, *g_ffn,
      *w_gate, *w_up, *w_down, *g_final;
  float* out; unsigned char* ws;
};

typedef const __attribute__((address_space(4))) Params* ParamsC;
__device__ __forceinline__ unsigned f2bf(float f) { unsigned u = __builtin_bit_cast(unsigned, f); return (u + 0x7fffu + ((u >> 16) & 1u)) >> 16; }
__device__ __forceinline__ unsigned pk2(float lo, float hi) { f32x2_t v = {lo, hi}; bf16x2_t b = __builtin_convertvector(v, bf16x2_t); return __builtin_bit_cast(unsigned, b); }
__device__ __forceinline__ float bf2f(unsigned short b) { return __builtin_bit_cast(float, (unsigned)b << 16); }
__device__ __forceinline__ int maprow_lat(int row) { return row < MP ? row : MP + ((row - MP) >> 4) * LROW + PAST + ((row - MP) & 15); }
__device__ __forceinline__ int maprow_bnd(int row) { return row < MP ? row : MP + ((row - MP) >> 4) * BROW + 512 + ((row - MP) & 15); }
__device__ __forceinline__ int row_pos(int row) { return row < MP ? (row & (SEQ - 1)) : PAST + ((row - MP) & 15); }
__device__ __forceinline__ void rope_cs(int pos, int i, float& c, float& s) {
  const float inv = __builtin_amdgcn_exp2f(-(float)i * (13.287712379549449f / 16.0f));
  float rev = (float)pos * inv * 0.15915494309189535f; rev = rev - __builtin_floorf(rev);
  s = __builtin_amdgcn_sinf(rev); c = __builtin_amdgcn_cosf(rev);
}

namespace pg8 {
constexpr int BM = 256, BK = 64, HALF = 128, HTB = HALF * BK * 2, STAGE_BYTES = 8 * HTB, NXCD = 8, WGM = 8;
__host__ __device__ __forceinline__ int lds_byte(int r, int c) { const int st = (r >> 4) * 2 + (c >> 5), rr = r & 15, cc = c & 31, ob = rr * 64 + cc * 2; return st * 1024 + (ob ^ (((ob >> 9) & 1) << 5)); }
__host__ __device__ __forceinline__ void stage_rc(int b, int& R, int& C) { const int st = b / 1024, sb = b % 1024, swz = sb ^ (((sb >> 9) & 1) << 5); R = (st >> 1) * 16 + swz / 64; C = (st & 1) * 32 + (swz % 64) / 2; }
struct Unit { int pm, pn, koff; };
struct Gemm { const bf16_t* A; const bf16_t* Bt; int lda, ldb, K; };
struct StaticOrder {
  int nM, nN, nwg, G, c;
  __device__ void init(int M, int N, int G_, int c_) { nM = M / BM; nN = N / BM; nwg = nM * nN; G = G_; c = c_; }
  __device__ bool next(int i, Unit& u) const {
    const long L = (long)i * G + c; if (L >= nwg) return false;
    int wgid = (int)L; { const int q = nwg / NXCD, r = nwg % NXCD, xcd = wgid % NXCD, off = wgid / NXCD; wgid = (xcd < r ? xcd * (q + 1) : r * (q + 1) + (xcd - r) * q) + off; }
    const int nig = WGM * nN, gid = wgid / nig, fm = gid * WGM, gsz = (nM - fm) < WGM ? (nM - fm) : WGM;
    u.pm = fm + ((wgid % nig) % gsz); u.pn = (wgid % nig) / gsz; u.koff = 0; return true;
  }
};
struct SplitOrder {
  int pm, nN, nsub, kchunk, G, c;
  __device__ bool next(int i, Unit& u) const { const int s = i * G + c; if (s >= nsub) return false; u.pm = pm; u.pn = s % nN; u.koff = (s / nN) * kchunk; return true; }
};
template <class Epi, class Order>
__device__ __forceinline__ void gemm_phase(LAS unsigned char* lds, const Gemm g, const Order& S, Epi& E) {
  int tid_ = threadIdx.x; asm volatile("" : "+v"(tid_));
  const int tid = tid_, wid = __builtin_amdgcn_readfirstlane(tid >> 6), lane = tid & 63, wr = wid >> 2, wc = wid & 3, fr = lane & 15, fq = lane >> 4;
  int K_ = g.K; asm volatile("" : "+s"(K_));
  const int K = K_, nt = K / BK;
  int lda_ = g.lda, ldb_ = g.ldb; asm volatile("" : "+s"(lda_), "+s"(ldb_));
  unsigned voffA[2];
#pragma unroll
  for (int i = 0; i < 2; ++i) { int R, C; stage_rc(tid * 16 + i * 8192, R, C); voffA[i] = (unsigned)(R * lda_ + C) * 2u; }
  const size_t kstep = (size_t)(BK * 2), hstepA = (size_t)HALF * lda_ * 2, tstepA = 2 * hstepA, hstepB = (size_t)HALF * ldb_ * 2, tstepB = 2 * hstepB;
  const unsigned ldsw = (unsigned)wid * 1024u;
  const int aoff = lds_byte(wr * 64 + fr, fq * 8), boff = lds_byte(wc * 32 + fr, fq * 8);
#define PG8_SA(b, h) (((b) * 2 + (h)) * HTB)
#define PG8_SB(b, h) ((4 + (b) * 2 + (h)) * HTB)
#define PG8_STAGE_(bufoff, gbase, voff) do { _Pragma("unroll") for (int _i = 0; _i < 2; ++_i) \
    __builtin_amdgcn_global_load_lds((const unsigned*)((const char*)(gbase) + (voff)[_i]), (LAS unsigned*)(lds + (bufoff) + ldsw + _i * 8192), 16, 0, 0); } while (0)
#define PG8_STA(bufoff, gbase) PG8_STAGE_(bufoff, gbase, voffA)
#define PG8_STB(bufoff, gbase) PG8_STAGE_(bufoff, gbase, voffA)
#define PG8_LDA(dst, b, h) do { _Pragma("unroll") for (int m = 0; m < 4; ++m) _Pragma("unroll") for (int k = 0; k < 2; ++k) dst[m][k] = *(const LAS bf16x8*)(lds + PG8_SA(b, h) + aoff + m * 2048 + k * 1024); } while (0)
#define PG8_LDB(dst, b, h) do { _Pragma("unroll") for (int n = 0; n < 2; ++n) _Pragma("unroll") for (int k = 0; k < 2; ++k) dst[n][k] = *(const LAS bf16x8*)(lds + PG8_SB(b, h) + boff + n * 2048 + k * 1024); } while (0)
#define PG8_MMA(ai, bj, At, Bt) do { __builtin_amdgcn_s_setprio(1); _Pragma("unroll") for (int m = 0; m < 4; ++m) _Pragma("unroll") for (int n = 0; n < 2; ++n) _Pragma("unroll") for (int k = 0; k < 2; ++k) \
    acc[ai][bj][m][n] = __builtin_amdgcn_mfma_f32_16x16x32_bf16(Bt[n][k], At[m][k], acc[ai][bj][m][n], 0, 0, 0); __builtin_amdgcn_s_setprio(0); } while (0)
#define PG8_WAIT_V(n) asm volatile("s_waitcnt vmcnt(" #n ")" ::: "memory")
#define PG8_WAIT_L(n) asm volatile("s_waitcnt lgkmcnt(" #n ")" ::: "memory")
#define PG8_BAR __builtin_amdgcn_s_barrier()
#define PG8_SCHED __builtin_amdgcn_sched_barrier(0)
  Unit cur, nxt; int ui = 0;
  if (!S.next(0, cur)) return;
  f32x4 acc[2][2][4][2];
#pragma unroll
  for (int a = 0; a < 2; ++a)
#pragma unroll
    for (int b = 0; b < 2; ++b)
#pragma unroll
      for (int m = 0; m < 4; ++m)
#pragma unroll
        for (int n = 0; n < 2; ++n) acc[a][b][m][n] = (f32x4){0.f, 0.f, 0.f, 0.f};
  bf16x8 At[4][2], B0[2][2], B1[2][2];
  const char* cA = (const char*)g.A + (size_t)cur.pm * tstepA + (size_t)cur.koff * 2; const char* cB = (const char*)g.Bt + (size_t)cur.pn * tstepB + (size_t)cur.koff * 2;
  PG8_STB(PG8_SB(0, 0), cB); PG8_STB(PG8_SB(0, 1), cB + hstepB); PG8_STA(PG8_SA(0, 0), cA); PG8_STA(PG8_SA(0, 1), cA + hstepA);
  if (wr == 1) PG8_BAR;
  PG8_WAIT_V(2); PG8_BAR;
  PG8_STB(PG8_SB(1, 0), cB + kstep); PG8_STA(PG8_SA(1, 0), cA + kstep); PG8_STB(PG8_SB(1, 1), cB + hstepB + kstep);
  PG8_WAIT_V(6); PG8_BAR;
  for (;;) {
    const bool has_next = S.next(ui + 1, nxt);
    const char* nA = has_next ? (const char*)g.A + (size_t)nxt.pm * tstepA + (size_t)nxt.koff * 2 : cA; const char* nB = has_next ? (const char*)g.Bt + (size_t)nxt.pn * tstepB + (size_t)nxt.koff * 2 : cB;
    for (int t = 0; t < nt; t += 2) {
      const bool last = (t == nt - 2);
      const char* a1 = cA + (size_t)(t + 1) * kstep;
      const char* a2 = last ? nA : cA + (size_t)(t + 2) * kstep; const char* b2 = last ? nB : cB + (size_t)(t + 2) * kstep;
      const char* a3 = a2 + kstep; const char* b3 = b2 + kstep;
      if constexpr (Epi::HAS_MID) { if (t == E.tsplit) { E.mid(acc, cur, wr, wc, fr, fq); } }
      PG8_LDB(B0, 0, 0); PG8_LDB(B1, 0, 1); PG8_SCHED; PG8_LDA(At, 0, 0); PG8_STA(PG8_SA(1, 1), a1 + hstepA);
      PG8_WAIT_V(8); PG8_WAIT_L(0); PG8_BAR; PG8_MMA(0, 0, At, B0); PG8_MMA(0, 1, At, B1); PG8_BAR; PG8_SCHED;
      PG8_LDA(At, 0, 1); PG8_STB(PG8_SB(0, 0), b2); PG8_STB(PG8_SB(0, 1), b2 + hstepB); PG8_STA(PG8_SA(0, 0), a2);
      PG8_WAIT_V(8); PG8_WAIT_L(0); PG8_BAR; PG8_MMA(1, 0, At, B0); PG8_MMA(1, 1, At, B1); PG8_BAR; PG8_SCHED;
      PG8_LDB(B0, 1, 0); PG8_LDB(B1, 1, 1); PG8_SCHED; PG8_LDA(At, 1, 0); PG8_STA(PG8_SA(0, 1), a2 + hstepA);
      PG8_WAIT_V(8); PG8_WAIT_L(0); PG8_BAR; PG8_MMA(0, 0, At, B0); PG8_MMA(0, 1, At, B1); PG8_BAR; PG8_SCHED;
      PG8_LDA(At, 1, 1); PG8_STB(PG8_SB(1, 0), b3); PG8_STB(PG8_SB(1, 1), b3 + hstepB); PG8_STA(PG8_SA(1, 0), a3);
      PG8_WAIT_V(8); PG8_WAIT_L(0); PG8_BAR; PG8_MMA(1, 0, At, B0); PG8_MMA(1, 1, At, B1); PG8_BAR; PG8_SCHED;
    }
    if (wr == 0) PG8_BAR;
    E(acc, cur, wr, wc, fr, fq);
    if (!has_next) break;
#pragma unroll
    for (int a = 0; a < 2; ++a)
#pragma unroll
      for (int b = 0; b < 2; ++b)
#pragma unroll
        for (int m = 0; m < 4; ++m)
#pragma unroll
          for (int n = 0; n < 2; ++n) acc[a][b][m][n] = (f32x4){0.f, 0.f, 0.f, 0.f};
    cur = nxt; cA = nA; cB = nB; ++ui;
    if (wr == 1) PG8_BAR;
  }
  PG8_WAIT_V(0);
  PG8_BAR;
#undef PG8_SA
#undef PG8_SB
#undef PG8_STAGE_
#undef PG8_STA
#undef PG8_STB
#undef PG8_LDA
#undef PG8_LDB
#undef PG8_MMA
#undef PG8_WAIT_V
#undef PG8_WAIT_L
#undef PG8_BAR
#undef PG8_SCHED
}
}
using pg8::Unit;
typedef f32x4 Acc[2][2][4][2];
#define FOR_AM _Pragma("unroll") for (int ai = 0; ai < 2; ++ai) _Pragma("unroll") for (int m = 0; m < 4; ++m)
#define FOR_BN _Pragma("unroll") for (int bj = 0; bj < 2; ++bj) _Pragma("unroll") for (int n = 0; n < 2; ++n)
__device__ __forceinline__ void st_bf4(bf16_t* p, f32x4 v) { u32x2 w; w.x = pk2(v[0], v[1]); w.y = pk2(v[2], v[3]); *(u32x2*)p = w; }
__device__ __forceinline__ void st_bf8(bf16_t* p, f32x4 a, f32x4 b) { u32x4 w; w.x = pk2(a[0], a[1]); w.y = pk2(a[2], a[3]); w.z = pk2(b[0], b[1]); w.w = pk2(b[2], b[3]); *(u32x4*)p = w; }
__device__ __forceinline__ void st_bf4x2(bf16_t* pa, f32x4 a, bf16_t* pb, f32x4 b, int fq) {
  const unsigned A0 = pk2(a[0], a[1]), A1 = pk2(a[2], a[3]), B0 = pk2(b[0], b[1]), B1 = pk2(b[2], b[3]);
  const auto r0 = __builtin_amdgcn_permlane16_swap(A0, B0, false, false);
  const auto r1 = __builtin_amdgcn_permlane16_swap(A1, B1, false, false);
  u32x4 w; w.x = r0[0]; w.y = r1[0]; w.z = r0[1]; w.w = r1[1];
  *(u32x4*)((fq & 1) ? pb - 4 : pa) = w;
}
__device__ __forceinline__ void atomic_addf(float* p, float v) { __hip_atomic_fetch_add(p, v, __ATOMIC_RELAXED, __HIP_MEMORY_SCOPE_AGENT); }

struct EpiIn {
  static constexpr bool HAS_MID = false;
  float* out; bf16_t *CQN, *CKV, *KR, *QB, *KB, *VB; const float* g_kv; LAS float* red;
  __device__ __forceinline__ void operator()(const Acc& acc, const Unit& u, int wr, int wc, int fr, int fq) const {
    const int pn = u.pn, rbase = u.pm * 256 + wr * 64 + fr, cw = wc * 32 + 4 * fq;
    if (pn <= 1) {
      FOR_AM { float s = 0.f; FOR_BN { const f32x4 x = acc[ai][bj][m][n]; s += (x[0] * x[0] + x[1] * x[1]) + (x[2] * x[2] + x[3] * x[3]); }
        s += __shfl_xor(s, 16); s += __shfl_xor(s, 32);
        if (fq == 0) red[(ai * 128 + wr * 64 + m * 16 + fr) * 4 + wc] = s; }
      asm volatile("s_waitcnt lgkmcnt(0)" ::: "memory"); __builtin_amdgcn_s_barrier(); asm volatile("" ::: "memory");
      FOR_AM { const f32x4 t = *(const LAS f32x4*)(red + (ai * 128 + wr * 64 + m * 16 + fr) * 4);
        const float rstd = __builtin_amdgcn_rsqf(((t[0] + t[1]) + (t[2] + t[3])) * (1.0f / 256.0f) + EPS);
        const int row = rbase + ai * 128 + m * 16;
        if (pn == 0) {
#pragma unroll
          for (int bj = 0; bj < 2; ++bj) { bf16_t* q = CQN + (size_t)row * 256 + bj * 128 + cw; st_bf4x2(q, acc[ai][bj][m][0] * rstd, q + 16, acc[ai][bj][m][1] * rstd, fq); } }
        else { const int mr = maprow_lat(row); float* o = row < MP ? out + OFF_CKVP + (size_t)row * 256 : out + OFF_CKVS + (size_t)(row - MP) * 256;
#pragma unroll
          for (int bj = 0; bj < 2; ++bj) { const int col = bj * 128 + cw; const f32x4 v0 = acc[ai][bj][m][0] * rstd * *(const f32x4*)(g_kv + col), v1 = acc[ai][bj][m][1] * rstd * *(const f32x4*)(g_kv + col + 16);
            *(f32x4*)(o + col) = v0; *(f32x4*)(o + col + 16) = v1; st_bf4x2(CKV + (size_t)mr * 256 + col, v0, CKV + (size_t)mr * 256 + col + 16, v1, fq); } } }
      asm volatile("s_waitcnt lgkmcnt(0)" ::: "memory"); __builtin_amdgcn_s_barrier(); asm volatile("" ::: "memory");
    } else if (pn <= 3) {
      FOR_AM { const int row = rbase + ai * 128 + m * 16;
#pragma unroll
        for (int bj = 0; bj < 2; ++bj) { bf16_t* q = QB + (size_t)row * 512 + (pn - 2) * 256 + bj * 128 + cw; st_bf4x2(q, acc[ai][bj][m][0] * QSCALE_B, q + 16, acc[ai][bj][m][1] * QSCALE_B, fq); } }
    } else if (pn <= 7) {
      const bool isv = pn >= 6; bf16_t* dst = isv ? VB : KB; const int c0 = (pn & 1) * 256;
      FOR_AM { const int row = rbase + ai * 128 + m * 16; const int mr = maprow_bnd(row);
        float* o = nullptr;
        if (row >= MP) o = out + (isv ? OFF_BVS : OFF_BKS) + (size_t)(row - MP) * 512;
        else if ((row & (SEQ - 1)) >= SEQ - 512) o = out + (isv ? OFF_BVP : OFF_BKP) + ((size_t)(row >> 11) * 512 + ((row & (SEQ - 1)) - (SEQ - 512))) * 512;
#pragma unroll
        for (int bj = 0; bj < 2; ++bj) { const int col = c0 + bj * 128 + cw; st_bf4x2(dst + (size_t)mr * 512 + col, acc[ai][bj][m][0], dst + (size_t)mr * 512 + col + 16, acc[ai][bj][m][1], fq);
          if (o) { *(f32x4*)(o + col) = acc[ai][bj][m][0]; *(f32x4*)(o + col + 16) = acc[ai][bj][m][1]; } } }
    } else {
      if (wc == 0) {
        FOR_AM { const int row = rbase + ai * 128 + m * 16; const int pos = row_pos(row), mr = maprow_lat(row);
          float* o = row < MP ? out + OFF_KRP + (size_t)row * 32 : out + OFF_KRS + (size_t)(row - MP) * 32;
          const f32x4 x1 = acc[ai][0][m][0], x2 = acc[ai][0][m][1]; f32x4 y1, y2;
#pragma unroll
          for (int j = 0; j < 4; ++j) { float c, s; rope_cs(pos, 4 * fq + j, c, s); y1[j] = x1[j] * c - x2[j] * s; y2[j] = x1[j] * s + x2[j] * c; }
          *(f32x4*)(o + 4 * fq) = y1; *(f32x4*)(o + 16 + 4 * fq) = y2;
          st_bf4x2(KR + (size_t)mr * 32 + 4 * fq, y1, KR + (size_t)mr * 32 + 16 + 4 * fq, y2, fq); }
      }
    }
  }
};
struct EpiQ {
  static constexpr bool HAS_MID = false;
  bf16_t* Q;
  __device__ __forceinline__ void operator()(const Acc& acc, const Unit& u, int wr, int wc, int fr, int fq) const {
    const int pn = u.pn, rbase = u.pm * 256 + wr * 64 + fr;
    if (pn <= 1) {
      FOR_AM { const int row = rbase + ai * 128 + m * 16;
#pragma unroll
        for (int bj = 0; bj < 2; ++bj) { const int col = pn * 256 + bj * 128 + wc * 32 + 4 * fq; bf16_t* q = Q + (size_t)row * 768 + (col >> 6) * 96 + (col & 63);
          st_bf4x2(q, acc[ai][bj][m][0] * QSCALE_A, q + 16, acc[ai][bj][m][1] * QSCALE_A, fq); } }
    } else {
      FOR_AM { const int row = rbase + ai * 128 + m * 16; const int pos = row_pos(row);
        float cs[4], sn[4];
#pragma unroll
        for (int j = 0; j < 4; ++j) rope_cs(pos, 4 * fq + j, cs[j], sn[j]);
#pragma unroll
        for (int bj = 0; bj < 2; ++bj) { const int head = 4 * bj + wc; const f32x4 x1 = acc[ai][bj][m][0], x2 = acc[ai][bj][m][1]; f32x4 y1, y2;
#pragma unroll
          for (int j = 0; j < 4; ++j) { y1[j] = (x1[j] * cs[j] - x2[j] * sn[j]) * QSCALE_A; y2[j] = (x1[j] * sn[j] + x2[j] * cs[j]) * QSCALE_A; }
          bf16_t* q = Q + (size_t)row * 768 + head * 96 + 64 + 4 * fq; st_bf4x2(q, y1, q + 16, y2, fq); } __builtin_amdgcn_sched_barrier(0); }
    }
  }
};
struct EpiKV {
  static constexpr bool HAS_MID = false;
  bf16_t *KN, *V;
  __device__ __forceinline__ void operator()(const Acc& acc, const Unit& u, int wr, int wc, int fr, int fq) const {
    const int pn = u.pn, rbase = u.pm * 256 + wr * 64 + fr; bf16_t* dst = pn >= 2 ? V : KN; const int c0 = (pn & 1) * 256 + wc * 32 + 4 * fq;
    FOR_AM { const int row = rbase + ai * 128 + m * 16;
#pragma unroll
      for (int bj = 0; bj < 2; ++bj) { bf16_t* q = dst + (size_t)row * 512 + c0 + bj * 128; st_bf4x2(q, acc[ai][bj][m][0], q + 16, acc[ai][bj][m][1], fq); } }
  }
};
struct EpiO {
  static constexpr bool HAS_MID = true;
  int tsplit; const float *ssq_a, *ssq_b, *xp, *xs; bf16_t* X1B; float* ssq_x1;
  __device__ __forceinline__ void mid(Acc& acc, const Unit& u, int wr, int wc, int fr, int fq) const {
    const int rbase = u.pm * 256 + wr * 64 + fr;
    FOR_AM { const int row = rbase + ai * 128 + m * 16; const float sa = ssq_a[row], sb = ssq_b[row];
      const float ratio = __builtin_amdgcn_rsqf(sa * (1.0f / 512.0f) + EPS) * __builtin_sqrtf(sb * (1.0f / 512.0f) + EPS);
      FOR_BN { acc[ai][bj][m][n] = acc[ai][bj][m][n] * ratio; }
      __builtin_amdgcn_sched_barrier(0); }
    asm volatile("s_waitcnt vmcnt(0)" ::: "memory");
  }
  __device__ __forceinline__ void operator()(const Acc& acc, const Unit& u, int wr, int wc, int fr, int fq) const {
    const int rbase = u.pm * 256 + wr * 64 + fr, c0 = u.pn * 256 + wc * 32 + 4 * fq;
    FOR_AM { const int row = rbase + ai * 128 + m * 16; const float rb = __builtin_amdgcn_rsqf(ssq_b[row] * (1.0f / 512.0f) + EPS);
      const float* xr = row < MP ? xp + (size_t)row * D : xs + (size_t)(row - MP) * D; float s = 0.f;
#pragma unroll
      for (int bj = 0; bj < 2; ++bj) { const int col = c0 + bj * 128; const f32x4 v0 = *(const f32x4*)(xr + col) + acc[ai][bj][m][0] * rb, v1 = *(const f32x4*)(xr + col + 16) + acc[ai][bj][m][1] * rb;
        st_bf4x2(X1B + (size_t)row * D + col, v0, X1B + (size_t)row * D + col + 16, v1, fq);
        s += ((v0[0] * v0[0] + v0[1] * v0[1]) + (v0[2] * v0[2] + v0[3] * v0[3])) + ((v1[0] * v1[0] + v1[1] * v1[1]) + (v1[2] * v1[2] + v1[3] * v1[3])); }
      s += __shfl_xor(s, 16); s += __shfl_xor(s, 32); if (fq == 0) atomic_addf(ssq_x1 + row, s); __builtin_amdgcn_sched_barrier(0); }
  }
};
struct EpiGU {
  static constexpr bool HAS_MID = false;
  const float* ssq_x1; bf16_t* H;
  __device__ __forceinline__ void operator()(const Acc& acc, const Unit& u, int wr, int wc, int fr, int fq) const {
    const int rbase = u.pm * 256 + wr * 64 + fr, c0 = u.pn * 128 + wc * 16 + 4 * fq;
    FOR_AM { const int row = rbase + ai * 128 + m * 16; const float rstd = __builtin_amdgcn_rsqf(ssq_x1[row] * (1.0f / 1024.0f) + EPS);
      f32x4 hv[2];
#pragma unroll
      for (int bj = 0; bj < 2; ++bj) { const f32x4 g = acc[ai][bj][m][0] * rstd, up = acc[ai][bj][m][1] * rstd;
#pragma unroll
        for (int j = 0; j < 4; ++j) hv[bj][j] = g[j] * __builtin_amdgcn_rcpf(1.0f + __builtin_amdgcn_exp2f(-g[j] * LOG2E)) * up[j]; }
      st_bf4x2(H + (size_t)row * FF + c0, hv[0], H + (size_t)row * FF + c0 + 64, hv[1], fq); }
  }
};
__device__ __forceinline__ f32x4 ld_bf4(const bf16_t* p) { const u32x2 w = *(const u32x2*)p; return (f32x4){__builtin_bit_cast(float, w.x << 16), __builtin_bit_cast(float, w.x & 0xffff0000u), __builtin_bit_cast(float, w.y << 16), __builtin_bit_cast(float, w.y & 0xffff0000u)}; }
__device__ __forceinline__ void ld_bf4x2(const bf16_t* pa, const bf16_t* pb, int fq, f32x4& a, f32x4& b) {
  const u32x4 w = *(const u32x4*)((fq & 1) ? pb - 4 : pa);
  const auto r0 = __builtin_amdgcn_permlane16_swap(w.x, w.z, false, false);
  const auto r1 = __builtin_amdgcn_permlane16_swap(w.y, w.w, false, false);
  a = (f32x4){__builtin_bit_cast(float, r0[0] << 16), __builtin_bit_cast(float, r0[0] & 0xffff0000u), __builtin_bit_cast(float, r1[0] << 16), __builtin_bit_cast(float, r1[0] & 0xffff0000u)};
  b = (f32x4){__builtin_bit_cast(float, r0[1] << 16), __builtin_bit_cast(float, r0[1] & 0xffff0000u), __builtin_bit_cast(float, r1[1] << 16), __builtin_bit_cast(float, r1[1] & 0xffff0000u)};
}
struct EpiD {
  static constexpr bool HAS_MID = false;
  bf16_t* X; float* ssq_x2;
  __device__ __forceinline__ void operator()(const Acc& acc, const Unit& u, int wr, int wc, int fr, int fq) const {
    const int rbase = u.pm * 256 + wr * 64 + fr, c0 = u.pn * 256 + wc * 32 + 4 * fq;
    FOR_AM { const int row = rbase + ai * 128 + m * 16; float s = 0.f;
#pragma unroll
      for (int bj = 0; bj < 2; ++bj) { bf16_t* x = X + (size_t)row * D + c0 + bj * 128; f32x4 x0, x1; ld_bf4x2(x, x + 16, fq, x0, x1); const f32x4 v0 = x0 + acc[ai][bj][m][0], v1 = x1 + acc[ai][bj][m][1];
        st_bf4x2(x, v0, x + 16, v1, fq);
        s += ((v0[0] * v0[0] + v0[1] * v0[1]) + (v0[2] * v0[2] + v0[3] * v0[3])) + ((v1[0] * v1[0] + v1[1] * v1[1]) + (v1[2] * v1[2] + v1[3] * v1[3])); }
      s += __shfl_xor(s, 16); s += __shfl_xor(s, 32); if (fq == 0) atomic_addf(ssq_x2 + row, s); }
  }
};
struct EpiPart {
  static constexpr bool HAS_MID = false;
  float* PART;
  __device__ __forceinline__ void operator()(const Acc& acc, const Unit& u, int wr, int wc, int fr, int fq) const {
    float* base = PART + (size_t)(u.koff >> 8) * 256 * D; const int r0 = wr * 64 + fr, c0 = u.pn * 256 + wc * 32 + 4 * fq;
    FOR_AM { FOR_BN { *(f32x4*)(base + (size_t)(r0 + ai * 128 + m * 16) * D + c0 + bj * 128 + n * 16) = acc[ai][bj][m][n]; } }
  }
};

__device__ __forceinline__ float wave_sum(float v) {
#pragma unroll
  for (int o = 1; o < 64; o <<= 1) v += __shfl_xor(v, o);
  return v;
}
template <class Map>
__device__ __forceinline__ void transpose_item(const float* W, int K, int N, bf16_t* WT, const float* g, LAS float* scr, int item, int lane, Map map) {
  const int nblk = N / 32, kb = item / nblk, nb = item % nblk, k0 = 64 * kb, n0 = 32 * nb;
#pragma unroll 8
  for (int i = 0; i < 32; ++i) { const int kk = 2 * i + (lane >> 5); scr[kk * 33 + (lane & 31)] = W[(size_t)(k0 + kk) * N + n0 + (lane & 31)] * (g ? g[k0 + kk] : 1.0f); }
  asm volatile("s_waitcnt lgkmcnt(0)" ::: "memory");
  const int c = lane & 7;
#pragma unroll
  for (int j = 0; j < 4; ++j) { const int n = (lane >> 3) + 8 * j; const LAS float* s = scr + (8 * c) * 33 + n;
    u32x4 o; o.x = pk2(s[0 * 33], s[1 * 33]); o.y = pk2(s[2 * 33], s[3 * 33]); o.z = pk2(s[4 * 33], s[5 * 33]); o.w = pk2(s[6 * 33], s[7 * 33]);
    *(u32x4*)(WT + (size_t)map(n0 + n) * K + k0 + 8 * c) = o; }
  asm volatile("s_waitcnt lgkmcnt(0)" ::: "memory");
}
template <class Map>
__device__ __forceinline__ void convert_rows(const float* src, bf16_t* dst, int R, int cshift, int gt, int ngt, Map map) {
  const long n8 = ((long)R << cshift) >> 3;
  for (long i0 = gt; i0 < n8; i0 += 4L * ngt) {
    f32x4 v[4][2];
#pragma unroll
    for (int k = 0; k < 4; ++k) { const long i = i0 + (long)k * ngt; if (i < n8) { v[k][0] = *(const f32x4*)(src + i * 8); v[k][1] = *(const f32x4*)(src + i * 8 + 4); } }
#pragma unroll
    for (int k = 0; k < 4; ++k) { const long i = i0 + (long)k * ngt; if (i < n8) { const long e = i * 8; const int r = (int)(e >> cshift), c = (int)(e & ((1 << cshift) - 1));
      st_bf8(dst + ((size_t)map(r) << cshift) + c, v[k][0], v[k][1]); } }
  }
}
__device__ __forceinline__ void zero_rows(bf16_t* dst, int cshift, int r0, int nr, int nb, int bstride, int gt, int ngt) {
  const long per = ((long)nr << cshift) >> 3, n8 = per * nb;
  for (long i = gt; i < n8; i += ngt) { const int b = (int)(i / per); const long e = (i % per) * 8; *(u32x4*)(dst + (((size_t)b * bstride + r0) << cshift) + e) = (u32x4){0u, 0u, 0u, 0u}; }
}
__device__ __forceinline__ void prologue(ParamsC p, LAS unsigned char* lds, int G) {
  const int tid = threadIdx.x, lane = tid & 63, wave = tid >> 6; unsigned char* ws = p->ws;
  const int gw = blockIdx.x * 8 + wave, NGW = G * 8, gt = blockIdx.x * NTHREADS + tid, ngt = G * NTHREADS;
  LAS float* scr = (LAS float*)(lds + wave * 16384);
  bf16_t* WinT = (bf16_t*)(ws + WS_WIN); bf16_t* WuqT = (bf16_t*)(ws + WS_WUQ); bf16_t* WkvT = (bf16_t*)(ws + WS_WKV); bf16_t* WoT = (bf16_t*)(ws + WS_WO);
  bf16_t* WguT = (bf16_t*)(ws + WS_WGU); bf16_t* WdT = (bf16_t*)(ws + WS_WD);
  constexpr int I_IN = 16 * 65, I_UQ = 4 * 24, I_UK = 4 * 16, I_O = 16 * 32, I_G = 16 * 88, I_D = 44 * 32;
  constexpr int NITEMS = I_IN + I_UQ + 2 * I_UK + I_O + 2 * I_G + I_D;
  for (int it = gw; it < NITEMS; it += NGW) {
    int r = it;
    if (r < I_IN) { transpose_item(p->w_in, 1024, 2080, WinT, p->g_attn, scr, r, lane, [](int n) { return n < 512 ? n : (n < 544 ? 2048 + (n - 512) : 512 + (n - 544)); }); continue; } r -= I_IN;
    if (r < I_UQ) { transpose_item(p->w_uq, 256, 768, WuqT, p->g_q, scr, r, lane, [](int n) { const int h = n / 96, d = n % 96; return d < 64 ? h * 64 + d : 512 + h * 32 + (d - 64); }); continue; } r -= I_UQ;
    if (r < I_UK) { transpose_item(p->w_uk, 256, 512, WkvT, nullptr, scr, r, lane, [](int n) { return n; }); continue; } r -= I_UK;
    if (r < I_UK) { transpose_item(p->w_uv, 256, 512, WkvT, nullptr, scr, r, lane, [](int n) { return 512 + n; }); continue; } r -= I_UK;
    if (r < I_O) { const int kb = r / 32; transpose_item(p->w_out, 1024, 1024, WoT, kb < 8 ? p->g_out_a : p->g_out_b - 512, scr, r, lane, [](int n) { return n; }); continue; } r -= I_O;
    if (r < I_G) { transpose_item(p->w_gate, 1024, FF, WguT, p->g_ffn, scr, r, lane, [](int n) { return 32 * (n >> 4) + (n & 15); }); continue; } r -= I_G;
    if (r < I_G) { transpose_item(p->w_up, 1024, FF, WguT, p->g_ffn, scr, r, lane, [](int n) { return 32 * (n >> 4) + 16 + (n & 15); }); continue; } r -= I_G;
    transpose_item(p->w_down, FF, 1024, WdT, nullptr, scr, r, lane, [](int n) { return n; });
  }
  zero_rows(WinT, 10, 2080, NIN - 2080, 1, 0, gt, ngt);
  bf16_t* XN = (bf16_t*)(ws + WS_XN);
  for (int row0 = gw; row0 < MT; row0 += 4 * NGW) {
    f32x4 v[4][4]; float s[4] = {0.f, 0.f, 0.f, 0.f};
#pragma unroll
    for (int k = 0; k < 4; ++k) { const int row = row0 + k * NGW; if (row < MT) { const float* xr = row < MP ? p->xp + (size_t)row * D : p->xs + (size_t)(row - MP) * D;
#pragma unroll
      for (int j = 0; j < 2; ++j) { v[k][2 * j] = *(const f32x4*)(xr + 8 * lane + 512 * j); v[k][2 * j + 1] = *(const f32x4*)(xr + 8 * lane + 512 * j + 4); } } }
#pragma unroll
    for (int k = 0; k < 4; ++k) { const int row = row0 + k * NGW; if (row < MT) {
#pragma unroll
      for (int j = 0; j < 4; ++j) s[k] += (v[k][j][0] * v[k][j][0] + v[k][j][1] * v[k][j][1]) + (v[k][j][2] * v[k][j][2] + v[k][j][3] * v[k][j][3]);
      const float rstd = __builtin_amdgcn_rsqf(wave_sum(s[k]) * (1.0f / D) + EPS);
#pragma unroll
      for (int j = 0; j < 2; ++j) st_bf8(XN + (size_t)row * D + 8 * lane + 512 * j, v[k][2 * j] * rstd, v[k][2 * j + 1] * rstd); } }
  }
  bf16_t* CKV = (bf16_t*)(ws + WS_CKV); bf16_t* KR = (bf16_t*)(ws + WS_KR); bf16_t* KB = (bf16_t*)(ws + WS_KB); bf16_t* VB = (bf16_t*)(ws + WS_VB);
  convert_rows(p->c_ckv, CKV, DB * PAST, 8, gt, ngt, [](int r) { return MP + (r >> 12) * LROW + (r & 4095); });
  convert_rows(p->c_kr, KR, DB * PAST, 5, gt, ngt, [](int r) { return MP + (r >> 12) * LROW + (r & 4095); });
  convert_rows(p->c_bk, KB, DB * 512, 9, gt, ngt, [](int r) { return MP + (r >> 9) * BROW + (r & 511); });
  convert_rows(p->c_bv, VB, DB * 512, 9, gt, ngt, [](int r) { return MP + (r >> 9) * BROW + (r & 511); });
  zero_rows(CKV + (size_t)MP * 256, 8, PAST + DSQ, LROW - PAST - DSQ, DB, LROW, gt, ngt);
  zero_rows(KR + (size_t)MP * 32, 5, PAST + DSQ, LROW - PAST - DSQ, DB, LROW, gt, ngt);
  zero_rows(KB + (size_t)MP * 512, 9, 512 + DSQ, BROW - 512 - DSQ, DB, BROW, gt, ngt);
  zero_rows(VB + (size_t)MP * 512, 9, 512 + DSQ, BROW - 512 - DSQ, DB, BROW, gt, ngt);
  float* ssq = (float*)(ws + WS_SSQ);
  for (int i = gt; i < 4 * MT; i += ngt) ssq[i] = 0.f;
}

__device__ __forceinline__ f32x16 mfma32(bf16x8 a, bf16x8 b, f32x16 c) { return __builtin_amdgcn_mfma_f32_32x32x16_bf16(a, b, c, 0, 0, 0); }
__device__ __forceinline__ s16x4 vtr(const LAS unsigned char* p) { return __builtin_bit_cast(s16x4, __builtin_amdgcn_ds_read_tr16_b64_v4i16((LAS s16x4*)p)); }
template <int NS, bool BIAS, bool QL>
__device__ __forceinline__ void attn_qk(const LAS unsigned char* Kt, const bf16x8 (&qf)[NS], const LAS unsigned char* Qt, f32x16 (&st)[2], int nvalid, const LAS float* btab, int rb, bool lookup, int lane) {
  constexpr int KP = NS == 6 ? KP_A : KP_B;
  const int r = lane & 31, h = lane >> 5;
  bf16x8 qv[NS];
#pragma unroll
  for (int s = 0; s < NS; ++s) qv[s] = QL ? *(const LAS bf16x8*)(Qt + r * KP + (2 * s + h) * 16) : qf[s];
#pragma unroll
  for (int kh = 0; kh < 2; ++kh) {
    bf16x8 kf[NS];
#pragma unroll
    for (int s = 0; s < NS; ++s) kf[s] = *(const LAS bf16x8*)(Kt + (32 * kh + r) * KP + (2 * s + h) * 16);
    __builtin_amdgcn_sched_barrier(0);
    __builtin_amdgcn_s_setprio(1);
    { const f32x16 z = {0.f, 0.f, 0.f, 0.f, 0.f, 0.f, 0.f, 0.f, 0.f, 0.f, 0.f, 0.f, 0.f, 0.f, 0.f, 0.f}; st[kh] = mfma32(kf[0], qv[0], z); }
#pragma unroll
    for (int s = 1; s < NS; ++s) st[kh] = mfma32(kf[s], qv[s], st[kh]);
    __builtin_amdgcn_s_setprio(0);
    __builtin_amdgcn_sched_barrier(0);
  }
  if (BIAS) {
    if (lookup) { const LAS float* bp = btab + rb + 4 * h;
#pragma unroll
      for (int kh = 0; kh < 2; ++kh)
#pragma unroll
        for (int i = 0; i < 16; ++i) st[kh][i] += bp[32 * kh + (i & 3) + 8 * (i >> 2)];
    } else { const float bc = btab[0];
#pragma unroll
      for (int kh = 0; kh < 2; ++kh)
#pragma unroll
        for (int i = 0; i < 16; ++i) st[kh][i] += bc; }
  }
  if (nvalid < 64) {
#pragma unroll
    for (int kh = 0; kh < 2; ++kh)
#pragma unroll
      for (int i = 0; i < 16; ++i) { const int key = 32 * kh + (i & 3) + 8 * (i >> 2) + 4 * h; if (key >= nvalid) st[kh][i] = -1e30f; }
  }
}
__device__ __forceinline__ void attn_smpv(const LAS unsigned char* Vt, f32x16 (&st)[2], f32x16 (&o)[2], float& m_run, float& l_run, LAS float* wsf, int lane) {
  const int r = lane & 31, h = lane >> 5;
  float mx = st[0][0];
#pragma unroll
  for (int kh = 0; kh < 2; ++kh)
#pragma unroll
    for (int i = 0; i < 16; ++i) mx = __builtin_fmaxf(mx, st[kh][i]);
  mx = __builtin_fmaxf(mx, __shfl_xor(mx, 32));
  const float m_new = __builtin_fmaxf(m_run, mx), alpha = __builtin_amdgcn_exp2f(m_run - m_new);
  float rs = 0.f;
#pragma unroll
  for (int kh = 0; kh < 2; ++kh)
#pragma unroll
    for (int i = 0; i < 16; ++i) { const float pv = __builtin_amdgcn_exp2f(st[kh][i] - m_new); st[kh][i] = pv; rs += pv; }
  rs += __shfl_xor(rs, 32);
  l_run = l_run * alpha + rs; m_run = m_new;
  {
    if (h == 0) wsf[r] = alpha;
    typedef float f32x8 __attribute__((ext_vector_type(8)));
    const f32x4 a0 = *(const LAS f32x4*)(wsf + 4 * h), a1 = *(const LAS f32x4*)(wsf + 8 + 4 * h), a2 = *(const LAS f32x4*)(wsf + 16 + 4 * h), a3 = *(const LAS f32x4*)(wsf + 24 + 4 * h);
    const f32x8 lo = __builtin_shufflevector(a0, a1, 0, 1, 2, 3, 4, 5, 6, 7), hi = __builtin_shufflevector(a2, a3, 0, 1, 2, 3, 4, 5, 6, 7);
    const f32x16 av = __builtin_shufflevector(lo, hi, 0, 1, 2, 3, 4, 5, 6, 7, 8, 9, 10, 11, 12, 13, 14, 15);
    o[0] = o[0] * av; o[1] = o[1] * av;
  }
  const int blk = (lane >> 4) & 1, q = (lane & 15) >> 2, p = lane & 3;
  const int vb = (4 * h + q) * 128 + 8 * (p & 1), co0 = ((2 * blk + (p >> 1)) ^ (((q >> 1) & 1) << 2)) << 4;
#pragma unroll
  for (int kh = 0; kh < 2; ++kh)
#pragma unroll
    for (int s2 = 0; s2 < 2; ++s2) {
      u32x4 pw;
#pragma unroll
      for (int k = 0; k < 4; ++k) pw[k] = pk2(st[kh][8 * s2 + 2 * k], st[kh][8 * s2 + 2 * k + 1]);
      const bf16x8 pa = __builtin_bit_cast(bf16x8, pw);
#pragma unroll
      for (int c = 0; c < 2; ++c) {
        const LAS unsigned char* vp = Vt + (32 * kh + 16 * s2) * 128 + vb + (c ? (co0 ^ 64) : co0);
        const s16x4 lo = vtr(vp), hi = vtr(vp + 8 * 128);
        const bf16x8 vf = __builtin_shufflevector(lo, hi, 0, 1, 2, 3, 4, 5, 6, 7);
        __builtin_amdgcn_s_setprio(1); o[c] = mfma32(pa, vf, o[c]); __builtin_amdgcn_s_setprio(0);
      }
    }
}
__device__ __forceinline__ void scale_o(f32x16 (&o)[2], float f, LAS float* wsf, int lane) {
  const int r = lane & 31, h = lane >> 5;
  if (h == 0) wsf[r] = f;
#pragma unroll
  for (int g = 0; g < 4; ++g) { const f32x4 a4 = *(const LAS f32x4*)(wsf + 8 * g + 4 * h);
#pragma unroll
    for (int j = 0; j < 4; ++j) { o[0][4 * g + j] *= a4[j]; o[1][4 * g + j] *= a4[j]; } }
}
__device__ __forceinline__ void store_o(const f32x16 (&o)[2], LAS bf16_t* stg, bf16_t* att  , float* ssq  , int nq, int lane) {
  const int r = lane & 31, h = lane >> 5;
#pragma unroll
  for (int c = 0; c < 2; ++c)
#pragma unroll
    for (int i = 0; i < 16; ++i) stg[((i & 3) + 8 * (i >> 2) + 4 * h) * 64 + 32 * c + r] = (bf16_t)f2bf(o[c][i]);
  const int qr = lane >> 1, half = lane & 1; float s = 0.f; u32x4 v[4];
#pragma unroll
  for (int k = 0; k < 4; ++k) { v[k] = *(const LAS u32x4*)(stg + qr * 64 + half * 32 + 8 * k);
#pragma unroll
    for (int e = 0; e < 4; ++e) { const float a = __builtin_bit_cast(float, v[k][e] << 16), b = __builtin_bit_cast(float, v[k][e] & 0xffff0000u); s += a * a + b * b; } }
  s += __shfl_xor(s, 1);
  if (qr < nq) {
#pragma unroll
    for (int k = 0; k < 4; ++k) *(u32x4*)(att + (size_t)qr * D + half * 32 + 8 * k) = v[k];
    if (half == 0 && ssq) atomic_addf(ssq + qr, s);
  }
}
struct KVSrc { const bf16_t* K; const bf16_t* KRp; const bf16_t* V; };
template <int NS>
__device__ __forceinline__ u32x4 ld_kchunk(const KVSrc& s, long krow, int id) {
  if (NS == 6) { const int row = id / 12, ch = id - row * 12;
    return ch < 8 ? *(const u32x4*)(s.K + (krow + row) * 512 + ch * 8) : *(const u32x4*)(s.KRp + (krow + row) * 32 + (ch - 8) * 8); }
  else { const int row = id >> 3, ch = id & 7; return *(const u32x4*)(s.K + (krow + row) * 512 + ch * 8); }
}
template <int NS>
__device__ __forceinline__ void st_kchunk(LAS unsigned char* Kt, int id, u32x4 v) {
  constexpr int KP = NS == 6 ? KP_A : KP_B, CPR = NS == 6 ? 12 : 8;
  const int row = id / CPR, ch = id - row * CPR; *(LAS u32x4*)(Kt + row * KP + ch * 16) = v;
}
__device__ __forceinline__ void st_vchunk(LAS unsigned char* Vt, int id, u32x4 v) { const int row = id >> 3, ch = id & 7; *(LAS u32x4*)(Vt + row * 128 + ((ch ^ (((row >> 1) & 1) << 2)) << 4)) = v; }

__device__ __forceinline__ void glds16(const void* gsrc, unsigned lds_dst) {
  unsigned keep;
  asm volatile("s_mov_b32 %0, m0\n\ts_mov_b32 m0, %2\n\ts_nop 0\n\tglobal_load_lds_dwordx4 %1, off\n\ts_mov_b32 m0, %0" : "=&s"(keep) : "v"(gsrc), "s"(lds_dst) : "memory");
}
template <int NS>
__device__ __forceinline__ void dma_tile(LAS unsigned char* Kt, LAS unsigned char* Vt, const KVSrc& src, long krow, int wave, int lane) {
  constexpr int CPR = NS == 6 ? 13 : 9, ND = CPR;
#pragma unroll
  for (int k = 0; k < 2; ++k) { const int d = wave + 8 * k;
    if (d < ND) { const int c = d * 64 + lane, row = c / CPR, ch = c - row * CPR;
      const bf16_t* g = (NS == 6 && ch >= 8 && ch < 12) ? src.KRp + (krow + row) * 32 + (ch - 8) * 8 : src.K + (krow + row) * 512 + (ch < 8 ? ch : 0) * 8;
      glds16(g, (unsigned)__builtin_amdgcn_readfirstlane((int)(unsigned)(uintptr_t)(Kt + d * 1024))); } }
  { const int c = wave * 64 + lane, row = c >> 3, ch = (c & 7) ^ (((row >> 1) & 1) << 2);
    glds16(src.V + (krow + row) * 512 + ch * 8, (unsigned)__builtin_amdgcn_readfirstlane((int)(unsigned)(uintptr_t)(Vt + wave * 1024))); }
}
#define AT_VMWAIT(n) asm volatile("s_waitcnt vmcnt(" #n ")" ::: "memory")
template <int NS, bool BIAS>
__device__ __forceinline__ void attn_unit_shared(LAS unsigned char* lds, const bf16_t* Qw  , int qpitch, const KVSrc src, long krow0,
                                                 int t_lo, int t_hi, int w_lo, int w_hi, int qpos0  , bf16_t* att, float* ssq, int bhead = 0) {
  constexpr int SLOT = 21504, ND = NS == 6 ? 13 : 9;
  int tid_ = threadIdx.x; asm volatile("" : "+v"(tid_));
  const int tid = tid_, lane = tid & 63, wave = __builtin_amdgcn_readfirstlane(tid >> 6), r = lane & 31, h = lane >> 5;
  LAS float* wsf = (LAS float*)(lds + AT_WSF) + wave * 64; const LAS float* btab = (const LAS float*)(lds + AT_BIAS) + bhead * 640;
#pragma unroll
  for (int k = 0; k < 2; ++k) if (t_lo + k <= t_hi) dma_tile<NS>(lds + AT_TILE + k * SLOT, lds + AT_TILE + k * SLOT + 13312, src, krow0 + 64L * (t_lo + k), wave, lane);
  bf16x8 qf[NS];
#pragma unroll
  for (int s = 0; s < NS; ++s) qf[s] = *(const bf16x8*)(Qw + (size_t)r * qpitch + 16 * s + 8 * h);
#pragma unroll
  for (int s = 0; s < NS; ++s) asm volatile("" : "+v"(qf[s]));
  f32x16 o[2];
#pragma unroll
  for (int i = 0; i < 16; ++i) { o[0][i] = 0.f; o[1][i] = 0.f; }
  float m_run = -1e30f, l_run = 0.f;
  AT_VMWAIT(0);
  asm volatile("s_waitcnt lgkmcnt(0)" ::: "memory"); __builtin_amdgcn_s_barrier(); asm volatile("" ::: "memory");
  for (int t0 = t_lo; t0 <= t_hi; t0 += 2) {
#pragma unroll
    for (int k = 2; k < 4; ++k) if (t0 + k <= t_hi) { const int s3 = (t0 + k - t_lo) & 3; dma_tile<NS>(lds + AT_TILE + s3 * SLOT, lds + AT_TILE + s3 * SLOT + 13312, src, krow0 + 64L * (t0 + k), wave, lane); }
#pragma unroll
    for (int k = 0; k < 2; ++k) { const int t = t0 + k; const int sl = (t - t_lo) & 3;
      if (t <= t_hi && t >= w_lo && t <= w_hi) {
        const bool lookup = BIAS && (qpos0 - (64 * t + 63) < 256);
        f32x16 st[2]; attn_qk<NS, BIAS, false>(lds + AT_TILE + sl * SLOT, qf, nullptr, st, 64, btab, 639 - (qpos0 + r - 64 * t + 256), lookup, lane);
        attn_smpv(lds + AT_TILE + sl * SLOT + 13312, st, o, m_run, l_run, wsf, lane);
      } }
    AT_VMWAIT(0);
    asm volatile("s_waitcnt lgkmcnt(0)" ::: "memory"); __builtin_amdgcn_s_barrier(); asm volatile("" ::: "memory");
  }
  scale_o(o, 1.0f / l_run, wsf, lane);
  store_o(o, (LAS bf16_t*)(lds + AT_OSTG) + wave * 2048, att, ssq, 32, lane);
}
template <int NS, bool BIAS>
__device__ __forceinline__ void attn_unit_sample(LAS unsigned char* lds, const bf16_t* Qw, int qpitch, const KVSrc src, long krow0, int ntiles, int nvalid_last, int qpos0, bf16_t* att, float* ssq, int bhead = 0) {
  constexpr int NKC = NS == 6 ? 768 : 512;
  int tid_ = threadIdx.x; asm volatile("" : "+v"(tid_));
  const int tid = tid_, lane = tid & 63, wave = tid >> 6, r = lane & 31, h = lane >> 5;
  LAS float* wsf = (LAS float*)(lds + AT_WSF) + wave * 64; const LAS float* btab = (const LAS float*)(lds + AT_BIAS) + bhead * 640;
  LAS float* cm = (LAS float*)(lds + AT_CMB);
  f32x16 o[2];
#pragma unroll
  for (int i = 0; i < 16; ++i) { o[0][i] = 0.f; o[1][i] = 0.f; }
  float m_run = -1e30f, l_run = 0.f;
  LAS unsigned char* Kt = lds + AT_TILE + (wave & 3) * AT_PRIV; LAS unsigned char* Vt = Kt + 13312;
  bf16x8 qf[NS];
#pragma unroll
  for (int s = 0; s < NS; ++s) qf[s] = *(const bf16x8*)(Qw + (size_t)(r & 15) * qpitch + 16 * s + 8 * h);
  constexpr int NK4 = 4 * NKC / 512;
  u32x4 kc[NK4], vc[4];
#define SMP_LOAD(T0) do { _Pragma("unroll") for (int i = 0; i < NK4; ++i) { const int id = tid + 512 * i, tt = id / NKC, cid = id - tt * NKC; if ((T0) + tt < ntiles) kc[i] = ld_kchunk<NS>(src, krow0 + 64L * ((T0) + tt), cid); } \
    _Pragma("unroll") for (int i = 0; i < 4; ++i) { const int id = tid + 512 * i, tt = id >> 9, cid = id & 511; if ((T0) + tt < ntiles) vc[i] = *(const u32x4*)(src.V + (krow0 + 64L * ((T0) + tt) + (cid >> 3)) * 512 + (cid & 7) * 8); } } while (0)
#define SMP_STORE(T0) do { _Pragma("unroll") for (int i = 0; i < NK4; ++i) { const int id = tid + 512 * i, tt = id / NKC, cid = id - tt * NKC; if ((T0) + tt < ntiles) st_kchunk<NS>(lds + AT_TILE + tt * AT_PRIV, cid, kc[i]); } \
    _Pragma("unroll") for (int i = 0; i < 4; ++i) { const int id = tid + 512 * i, tt = id >> 9, cid = id & 511; if ((T0) + tt < ntiles) st_vchunk(lds + AT_TILE + tt * AT_PRIV + 13312, cid, vc[i]); } } while (0)
  SMP_LOAD(0); SMP_STORE(0);
  __syncthreads();
  for (int t0 = 0; t0 < ntiles; t0 += 4) {
    if (t0 + 4 < ntiles) SMP_LOAD(t0 + 4);
    const int t = t0 + wave;
    if (wave < 4 && t < ntiles) {
      const bool lookup = BIAS && (qpos0 - (64 * t + 63) < 256);
      f32x16 st[2]; attn_qk<NS, BIAS, false>(Kt, qf, nullptr, st, (t == ntiles - 1) ? nvalid_last : 64, btab, 639 - (qpos0 + (r & 15) - 64 * t + 256), lookup, lane);
      attn_smpv(Vt, st, o, m_run, l_run, wsf, lane);
    }
    __syncthreads();
    if (t0 + 4 < ntiles) { SMP_STORE(t0 + 4); }
    __syncthreads();
  }
#undef SMP_LOAD
#undef SMP_STORE
  if (wave < 4 && h == 0) cm[wave * 32 + r] = m_run;
  __syncthreads();
  if (wave < 4) {
    const float M = __builtin_fmaxf(__builtin_fmaxf(cm[r], cm[32 + r]), __builtin_fmaxf(cm[64 + r], cm[96 + r]));
    const float f = __builtin_amdgcn_exp2f(m_run - M);
    scale_o(o, f, wsf, lane);
    if (h == 0) cm[128 + wave * 32 + r] = l_run * f;
    LAS float* po = (LAS float*)(lds + AT_TILE + wave * AT_PRIV);
#pragma unroll
    for (int c = 0; c < 2; ++c)
#pragma unroll
      for (int i = 0; i < 16; ++i) po[(c * 16 + i) * 64 + lane] = o[c][i];
  }
  __syncthreads();
  if (wave == 0) {
    const float l = (cm[128 + r] + cm[160 + r]) + (cm[192 + r] + cm[224 + r]);
#pragma unroll
    for (int w = 1; w < 4; ++w) { const LAS float* po = (const LAS float*)(lds + AT_TILE + w * AT_PRIV);
#pragma unroll
      for (int c = 0; c < 2; ++c)
#pragma unroll
        for (int i = 0; i < 16; ++i) o[c][i] += po[(c * 16 + i) * 64 + lane]; }
    scale_o(o, 1.0f / l, wsf, lane);
    store_o(o, (LAS bf16_t*)(lds + AT_OSTG), att, ssq, 16, lane);
  }
  __syncthreads();
}
__device__ __forceinline__ void load_bias_all(LAS unsigned char* lds, const float* rel_bias) {
  LAS float* btab = (LAS float*)(lds + AT_BIAS);
  for (int i = threadIdx.x; i < 8 * 640; i += NTHREADS) { const int hd = i / 640, j = 639 - (i - hd * 640); btab[i] = rel_bias[hd * 513 + (j > 512 ? 512 : j)] * LOG2E; }
  __syncthreads();
}
__device__ __forceinline__ void attention_phase(ParamsC p, LAS unsigned char* lds, int G, bool dry, int apm = 15) {
  unsigned char* ws = p->ws; const int wave = threadIdx.x >> 6;
  const bf16_t* Q = (const bf16_t*)(ws + WS_Q); const bf16_t* KN = (const bf16_t*)(ws + WS_KN); const bf16_t* V = (const bf16_t*)(ws + WS_V); const bf16_t* KR = (const bf16_t*)(ws + WS_KR);
  const bf16_t* QB = (const bf16_t*)(ws + WS_QB); const bf16_t* KB = (const bf16_t*)(ws + WS_KB); const bf16_t* VB = (const bf16_t*)(ws + WS_VB);
  bf16_t* ATT = (bf16_t*)(ws + WS_XN); float* ssq_a = (float*)(ws + WS_SSQ); float* ssq_b = ssq_a + MT;
  load_bias_all(lds, p->rel_bias);
  for (int u = blockIdx.x; u < 256; u += G) {
    const int b = (u & 127) >> 3, head = u & 7; const int row0 = MP + b * DSQ;
#ifndef AP
#define AP 15
#endif
    if (u < 128) { if (apm & 1) {
      const KVSrc src{KN + head * 64, KR, V + head * 64};
      attn_unit_sample<6, false>(lds, Q + (size_t)row0 * 768 + head * 96, 768, src, (long)MP + (long)b * LROW, 65, 16, 0, ATT + (size_t)row0 * D + head * 64, dry ? nullptr : ssq_a + row0); }
    } else if (apm & 2) {
      const KVSrc src{KB + head * 64, nullptr, VB + head * 64};
      attn_unit_sample<4, true>(lds, QB + (size_t)row0 * 512 + head * 64, 512, src, (long)MP + (long)b * BROW, 9, 16, 512, ATT + (size_t)row0 * D + 512 + head * 64, dry ? nullptr : ssq_b + row0, head);
    }
  }
  if (G == 256) {
    const int vcu = (blockIdx.x & 7) * 32 + (blockIdx.x >> 3), grp = vcu >> 3, mem = vcu & 7; const int b = grp; const long brow = (long)b * SEQ;
    if (apm & 4) for (int i = 0; i < 8; ++i) { const int head = i, qb = (mem + i) & 7; const KVSrc src{KN + head * 64, KR, V + head * 64}; const long qrow = brow + 256 * qb + 32 * wave;
      attn_unit_shared<6, false>(lds, Q + (size_t)qrow * 768 + head * 96, 768, src, brow, 0, 4 * qb + 3, 0, 4 * qb + (wave >> 1), 0, ATT + (size_t)qrow * D + head * 64, dry ? nullptr : ssq_a + qrow); }
    if (apm & 8) for (int i = 0; i < 8; ++i) { const int head = i, cb = (mem + i) & 7;
      const KVSrc src{KB + head * 64, nullptr, VB + head * 64}; const long qrow = brow + 256 * cb + 32 * wave; const int cq = 4 * cb + (wave >> 1); const int tl = 4 * cb - 8 < 0 ? 0 : 4 * cb - 8;
      attn_unit_shared<4, true>(lds, QB + (size_t)qrow * 512 + head * 64, 512, src, brow, tl, 4 * cb + 3, cq - 8, cq, 256 * cb + 32 * wave, ATT + (size_t)qrow * D + 512 + head * 64, dry ? nullptr : ssq_b + qrow, head); }
  } else {
  for (int bh = blockIdx.x; bh < NBATCH * 8; bh += G) {
    const int b = bh >> 3, head = bh & 7; const long brow = (long)b * SEQ;
    if (apm & 4) { const KVSrc src{KN + head * 64, KR, V + head * 64};
      for (int qb = 0; qb < 8; ++qb) { const long qrow = brow + 256 * qb + 32 * wave;
        attn_unit_shared<6, false>(lds, Q + (size_t)qrow * 768 + head * 96, 768, src, brow, 0, 4 * qb + 3, 0, 4 * qb + (wave >> 1), 0, ATT + (size_t)qrow * D + head * 64, dry ? nullptr : ssq_a + qrow); } }
    if (apm & 8) { const KVSrc src{KB + head * 64, nullptr, VB + head * 64};
      for (int cb = 0; cb < 8; ++cb) { const long qrow = brow + 256 * cb + 32 * wave; const int cq = 4 * cb + (wave >> 1); const int tl = 4 * cb - 8 < 0 ? 0 : 4 * cb - 8;
        attn_unit_shared<4, true>(lds, QB + (size_t)qrow * 512 + head * 64, 512, src, brow, tl, 4 * cb + 3, cq - 8, cq, 256 * cb + 32 * wave, ATT + (size_t)qrow * D + 512 + head * 64, dry ? nullptr : ssq_b + qrow, head); } }
  }
  }
}


#define XB_TMO      128
#define XB_XCNT(j)  (256  + 64 * (j))
#define XB_XSUB(j)  (1280 + 64 * (j))
#define XB_XGEN(j)  (2304 + 64 * (j))
#define XB_TOP      3328
#define XB_TOPGEN   3392
#define XCD_BAR_WORDS 3456
#define XB_SPIN_CAP (1u << 18)
__device__ __forceinline__ unsigned xb_ld(unsigned* p)              { return __hip_atomic_load(p, __ATOMIC_RELAXED, __HIP_MEMORY_SCOPE_AGENT); }
__device__ __forceinline__ unsigned xb_add(unsigned* p, unsigned v) { return __hip_atomic_fetch_add(p, v, __ATOMIC_RELAXED, __HIP_MEMORY_SCOPE_AGENT); }
__device__ __forceinline__ unsigned xb_xcc_id() { return (unsigned)__builtin_amdgcn_s_getreg((3 << 11) | 20) & 0xFu; }
#define XB_SPIN(cond, bar) do { unsigned _sp = 0; while (cond) { __builtin_amdgcn_s_sleep(1); \
    if ((++_sp & 255u) == 0u) { if (xb_ld(&(bar)[XB_TMO])) break; if (_sp > XB_SPIN_CAP) { atomicAdd(&(bar)[XB_TMO], 1u); break; } } } } while (0)
__device__ __forceinline__ void xcd_barrier_complete(unsigned* bar, unsigned x, unsigned& nloc, unsigned& nx) {
  const unsigned G = gridDim.x * gridDim.y * gridDim.z;
  unsigned sum, cnt, mine, sp = 0u;
  for (;;) {
    sum = 0u; cnt = 0u; mine = 0u;
#pragma unroll
    for (unsigned j = 0; j < 16; ++j) { const unsigned c = xb_ld(&bar[XB_XCNT(j)]); sum += c; cnt += (c > 0u) ? 1u : 0u; mine = (j == x) ? c : mine; }
    if (sum == G) break;
    __builtin_amdgcn_s_sleep(1);
    if ((++sp & 255u) == 0u) { if (xb_ld(&bar[XB_TMO])) break; if (sp > XB_SPIN_CAP) { atomicAdd(&bar[XB_TMO], 1u); break; } }
  }
  nloc = mine > 0u ? mine : 1u; nx = cnt > 0u ? cnt : 1u;
}
__device__ __forceinline__ void xcd_barrier(unsigned* bar, volatile LAS unsigned* st) {
  asm volatile("s_waitcnt vmcnt(0)" ::: "memory");
  __syncthreads();
  if (threadIdx.x == 0) {
    const unsigned x = xb_xcc_id();
    __builtin_amdgcn_s_waitcnt(0);
    unsigned nloc = st[0], nx = st[1];
    if (nloc == 0u) { xcd_barrier_complete(bar, x, nloc, nx); st[0] = nloc; st[1] = nx; }
    const unsigned old = xb_add(&bar[XB_XSUB(x)], 1u);
    const unsigned gen = old / nloc;
    if (old + 1u == (gen + 1u) * nloc) {
      __builtin_amdgcn_fence(__ATOMIC_RELEASE, "agent");
      asm volatile("s_waitcnt vmcnt(0)" ::: "memory");
      const unsigned og = xb_add(&bar[XB_TOP], 1u);
      const unsigned tg = og / nx;
      if (og + 1u == (tg + 1u) * nx) xb_add(&bar[XB_TOPGEN], 1u);
      else XB_SPIN(xb_ld(&bar[XB_TOPGEN]) == tg, bar);
      __builtin_amdgcn_fence(__ATOMIC_ACQUIRE, "agent");
      xb_add(&bar[XB_XGEN(x)], 1u);
      asm volatile("s_waitcnt vmcnt(0)" ::: "memory");
    } else {
      XB_SPIN(xb_ld(&bar[XB_XGEN(x)]) == gen, bar);
      __builtin_amdgcn_fence(__ATOMIC_ACQUIRE, "agent");
      asm volatile("s_waitcnt vmcnt(0)" ::: "memory");
    }
  }
  __syncthreads();
}

__device__ __forceinline__ ParamsC get_params() {
  ParamsC pp = (ParamsC)__builtin_amdgcn_kernarg_segment_ptr(); asm volatile("" : "+s"(pp)); return pp;
}
__global__ void __launch_bounds__(NTHREADS) mk_fwd(Params p_unused) {
  extern __shared__ __attribute__((aligned(16))) unsigned char lds_raw[];
  LAS unsigned char* lds = (LAS unsigned char*)lds_raw;
  cg::grid_group grid = cg::this_grid();
  const int G = gridDim.x;
  volatile LAS unsigned* xst = (volatile LAS unsigned*)(lds + LDS_BYTES - 16);
  if (threadIdx.x < 2) xst[threadIdx.x] = 0u;
  if (threadIdx.x == 0) (void)xb_add(&((unsigned*)(get_params()->ws + WS_BAR))[XB_XCNT(xb_xcc_id())], 1u);
  __syncthreads();
#define FAST_SYNC() xcd_barrier((unsigned*)(get_params()->ws + WS_BAR), xst)
#define WSP(T, off) ((T*)(get_params()->ws + (off)))
#define ssq WSP(float, WS_SSQ)
#define X1B WSP(bf16_t, WS_X1B)
#define XN WSP(bf16_t, WS_XN)
#define CQN WSP(bf16_t, WS_CQN)
#define CKV WSP(bf16_t, WS_CKV)
#define KR WSP(bf16_t, WS_KR)
#define QB WSP(bf16_t, WS_QB)
#define KB WSP(bf16_t, WS_KB)
#define VB WSP(bf16_t, WS_VB)
#define Q WSP(bf16_t, WS_Q)
#define KN WSP(bf16_t, WS_KN)
#define V WSP(bf16_t, WS_V)
#define H WSP(bf16_t, WS_H)
  pg8::StaticOrder S;
#ifndef PH
#define PH 255
#endif
  if (PH & 1) prologue(get_params(), lds, G);
#ifdef DUP_P0
  grid.sync(); prologue(get_params(), lds, G);
#endif
  grid.sync();
  if (PH & 2) { pg8::Gemm g{XN, (const bf16_t*)(get_params()->ws + WS_WIN), 1024, 1024, 1024}; S.init(MT, NIN, G, blockIdx.x);
    ParamsC pp = get_params(); EpiIn E{pp->out, CQN, CKV, KR, QB, KB, VB, pp->g_kv, (LAS float*)(lds + LDS_RED)};
    pg8::gemm_phase(lds, g, S, E); }
  FAST_SYNC();
  if ((PH & 4) && !(PH & 256)) { pg8::Gemm g{CQN, (const bf16_t*)(get_params()->ws + WS_WUQ), 256, 256, 256}; S.init(MT, 768, G, blockIdx.x); EpiQ E{Q}; pg8::gemm_phase(lds, g, S, E); }
  if ((PH & 4) && !(PH & 512)) { pg8::Gemm g{CKV, (const bf16_t*)(get_params()->ws + WS_WKV), 256, 256, 256}; S.init(MLAT, 1024, G, blockIdx.x); EpiKV E{KN, V}; pg8::gemm_phase(lds, g, S, E); }
  FAST_SYNC();
  if (PH & 8) attention_phase(get_params(), lds, G, false);
#ifdef DUP_ATTN
  grid.sync(); attention_phase(get_params(), lds, G, true, DUP_ATTN);
#endif
  FAST_SYNC();
  if (PH & 16) { pg8::Gemm g{XN  , (const bf16_t*)(get_params()->ws + WS_WO), 1024, 1024, 1024}; S.init(MT, 1024, G, blockIdx.x);
    ParamsC pp = get_params(); EpiO E{8, ssq, ssq + MT, pp->xp, pp->xs, X1B, ssq + 2 * MT}; pg8::gemm_phase(lds, g, S, E); }
  FAST_SYNC();
  if (PH & 32) { pg8::Gemm g{X1B, (const bf16_t*)(get_params()->ws + WS_WGU), 1024, 1024, 1024}; S.init(MT, NGU, G, blockIdx.x); EpiGU E{ssq + 2 * MT, H}; pg8::gemm_phase(lds, g, S, E);
#ifdef DUP_P5
    grid.sync(); pg8::gemm_phase(lds, g, S, E);
#endif
  }
  FAST_SYNC();
#define PART WSP(float, WS_Q)
  if (PH & 64) { pg8::Gemm g{H, (const bf16_t*)(get_params()->ws + WS_WD), FF, FF, FF}; S.init(MP, 1024, G, blockIdx.x); EpiD E{X1B, ssq + 3 * MT}; pg8::gemm_phase(lds, g, S, E);
    pg8::Gemm g2{H, (const bf16_t*)(get_params()->ws + WS_WD), FF, FF, 256}; pg8::SplitOrder S2{MP / 256, 4, 44, 256, G, (int)blockIdx.x}; EpiPart E2{PART}; pg8::gemm_phase(lds, g2, S2, E2); }
  FAST_SYNC();
  if (PH & 128) { ParamsC p = get_params(); int t7 = threadIdx.x; asm volatile("" : "+v"(t7)); const int lane = t7 & 63, gw = blockIdx.x * 8 + (t7 >> 6), NGW = G * 8; const float* s2 = ssq + 3 * MT;
    f32x4 gf[4];
#pragma unroll
    for (int j = 0; j < 2; ++j) { gf[2 * j] = *(const f32x4*)(p->g_final + 8 * lane + 512 * j); gf[2 * j + 1] = *(const f32x4*)(p->g_final + 8 * lane + 512 * j + 4); }
    for (int rr0 = gw; rr0 < MT; rr0 += 4 * NGW) {
      u32x4 raw[4][2]; int rows[4];
#pragma unroll
      for (int k = 0; k < 4; ++k) { const int rr = rr0 + k * NGW; rows[k] = rr < MS ? MP + rr : rr - MS;
        if (rr < MT) { const bf16_t* x = X1B + (size_t)rows[k] * D;
#pragma unroll
          for (int j = 0; j < 2; ++j) raw[k][j] = *(const u32x4*)(x + 8 * lane + 512 * j); } }
#pragma unroll
      for (int k = 0; k < 4; ++k) { const int rr = rr0 + k * NGW, row = rows[k]; if (rr < MT) {
        f32x4 v[4];
#pragma unroll
        for (int j = 0; j < 2; ++j) { const u32x4 w = raw[k][j];
          v[2 * j] = (f32x4){__builtin_bit_cast(float, w.x << 16), __builtin_bit_cast(float, w.x & 0xffff0000u), __builtin_bit_cast(float, w.y << 16), __builtin_bit_cast(float, w.y & 0xffff0000u)};
          v[2 * j + 1] = (f32x4){__builtin_bit_cast(float, w.z << 16), __builtin_bit_cast(float, w.z & 0xffff0000u), __builtin_bit_cast(float, w.w << 16), __builtin_bit_cast(float, w.w & 0xffff0000u)}; }
        float* y = p->out + OFF_Y + (size_t)row * D; float rstd;
        if (row >= MP) { float s = 0.f;
          for (int kc = 0; kc < 11; ++kc) { const float* pr = PART + ((size_t)kc * 256 + (row - MP)) * D;
#pragma unroll
            for (int j = 0; j < 2; ++j) { v[2 * j] = v[2 * j] + *(const f32x4*)(pr + 8 * lane + 512 * j); v[2 * j + 1] = v[2 * j + 1] + *(const f32x4*)(pr + 8 * lane + 512 * j + 4); } }
#pragma unroll
          for (int j = 0; j < 4; ++j) s += (v[j][0] * v[j][0] + v[j][1] * v[j][1]) + (v[j][2] * v[j][2] + v[j][3] * v[j][3]);
          rstd = __builtin_amdgcn_rsqf(wave_sum(s) * (1.0f / D) + EPS);
        } else rstd = __builtin_amdgcn_rsqf(s2[row] * (1.0f / D) + EPS);
#pragma unroll
        for (int j = 0; j < 2; ++j) { *(f32x4*)(y + 8 * lane + 512 * j) = v[2 * j] * rstd * gf[2 * j]; *(f32x4*)(y + 8 * lane + 512 * j + 4) = v[2 * j + 1] * rstd * gf[2 * j + 1]; } } } } }
}

#undef FAST_SYNC
#undef ssq
#undef X1B
#undef XN
#undef CQN
#undef CKV
#undef KR
#undef QB
#undef KB
#undef VB
#undef Q
#undef KN
#undef V
#undef H
#undef PART
extern "C" void kernel_launch(void* const* d_in, const int* in_sizes, int n_in, void* d_out, int out_size, void* d_ws, size_t ws_size, hipStream_t stream) {
  static int grid = 0;
  if (grid == 0) {
    if (n_in != 22 || (size_t)out_size != OUT_TOTAL || ws_size < WS_TOTAL) { fprintf(stderr, "kernel_launch: unexpected shapes (n_in %d out %d ws %zu, need ws %zu)\n", n_in, out_size, ws_size, (size_t)WS_END); grid = -1; return; }
    int dev = 0, cus = 0, per_cu = 0;
    hipGetDevice(&dev); hipDeviceGetAttribute(&cus, hipDeviceAttributeMultiprocessorCount, dev);
    hipFuncSetAttribute((const void*)mk_fwd, hipFuncAttributeMaxDynamicSharedMemorySize, LDS_BYTES);
    hipOccupancyMaxActiveBlocksPerMultiprocessor(&per_cu, (const void*)mk_fwd, NTHREADS, LDS_BYTES);
    if (per_cu < 1 || cus < 1) { fprintf(stderr, "kernel_launch: occupancy query gave %d blocks/CU on %d CUs\n", per_cu, cus); grid = -1; return; }
    grid = cus * (per_cu > 1 ? 1 : per_cu);
  }
  if (grid < 0) return;
  Params p{};
  const float** pp = (const float**)&p;
  for (int i = 0; i < 22; ++i) pp[i] = (const float*)d_in[i];
  p.out = (float*)d_out; p.ws = (unsigned char*)d_ws;
  if (hipMemsetAsync((char*)d_ws + WS_BAR, 0, 16384, stream) != hipSuccess) { fprintf(stderr, "kernel_launch: memset of barrier words failed\n"); return; }
  void* args[] = {&p};
  hipError_t e = hipLaunchCooperativeKernel((void*)mk_fwd, dim3(grid), dim3(NTHREADS), args, LDS_BYTES, stream);
  if (e != hipSuccess) fprintf(stderr, "cooperative launch failed: %s (grid %d)\n", hipGetErrorString(e), grid);
}
```

```cpp
#include <hip/hip_runtime.h>
#include <hip/hip_cooperative_groups.h>
#include <cstdio>
#include <cstdint>


namespace cg = cooperative_groups;

#define LAS __attribute__((address_space(3)))
typedef unsigned short bf16_t;
typedef short bf16x8 __attribute__((ext_vector_type(8)));
typedef short s16x4 __attribute__((ext_vector_type(4)));
typedef float f32x4 __attribute__((ext_vector_type(4)));
typedef float f32x16 __attribute__((ext_vector_type(16)));
typedef unsigned u32x4 __attribute__((ext_vector_type(4)));
typedef unsigned u32x2 __attribute__((ext_vector_type(2)));
typedef float f32x2_t __attribute__((ext_vector_type(2)));
typedef __bf16 bf16x2_t __attribute__((ext_vector_type(2)));

constexpr int D = 1024, NBATCH = 32, SEQ = 2048, MP = NBATCH * SEQ, DB = 16, DSQ = 16, MS = DB * DSQ, MT = MP + MS, PAST = 4096;
constexpr int NIN = 2304, FF = 2816, NGU = 2 * FF;
constexpr int LROW = 4352, BROW = 768;
constexpr int MLAT = MP + DB * LROW, MBND = MP + DB * BROW;
constexpr float EPS = 1e-6f, LOG2E = 1.4426950408889634f;
constexpr float QSCALE_A = 0.10206207261596575f * LOG2E;
constexpr float QSCALE_B = 0.125f * LOG2E;
constexpr int NTHREADS = 512;
constexpr size_t OFF_Y = 0, OFF_CKVP = (size_t)MT * D, OFF_KRP = OFF_CKVP + (size_t)MP * 256, OFF_BKP = OFF_KRP + (size_t)MP * 32,
                 OFF_BVP = OFF_BKP + (size_t)NBATCH * 512 * 512, OFF_CKVS = OFF_BVP + (size_t)NBATCH * 512 * 512, OFF_KRS = OFF_CKVS + (size_t)MS * 256,
                 OFF_BKS = OFF_KRS + (size_t)MS * 32, OFF_BVS = OFF_BKS + (size_t)MS * 512, OUT_TOTAL = OFF_BVS + (size_t)MS * 512;
constexpr size_t al256(size_t x) { return (x + 255) & ~(size_t)255; }
constexpr size_t WS_SSQ = 0;
constexpr size_t WS_WIN = al256(WS_SSQ + 4 * (size_t)MT * 4);
constexpr size_t WS_WUQ = al256(WS_WIN + (size_t)NIN * 1024 * 2);
constexpr size_t WS_WKV = al256(WS_WUQ + (size_t)768 * 256 * 2);
constexpr size_t WS_WO = al256(WS_WKV + (size_t)1024 * 256 * 2);
constexpr size_t WS_WGU = al256(WS_WO + (size_t)1024 * 1024 * 2);
constexpr size_t WS_WD = al256(WS_WGU + (size_t)NGU * 1024 * 2);
constexpr size_t WS_X1B = al256(WS_WD + (size_t)1024 * FF * 2);
constexpr size_t WS_XN = al256(WS_X1B + (size_t)MT * 1024 * 2);
constexpr size_t WS_CQN = al256(WS_XN + (size_t)MT * 1024 * 2);
constexpr size_t WS_CKV = al256(WS_CQN + (size_t)MT * 256 * 2);
constexpr size_t WS_KR = al256(WS_CKV + (size_t)MLAT * 256 * 2);
constexpr size_t WS_QB = al256(WS_KR + (size_t)MLAT * 32 * 2);
constexpr size_t WS_KB = al256(WS_QB + (size_t)MT * 512 * 2);
constexpr size_t WS_VB = al256(WS_KB + (size_t)MBND * 512 * 2);
constexpr size_t WS_Q = al256(WS_VB + (size_t)MBND * 512 * 2);
constexpr size_t WS_KN = al256(WS_Q + (size_t)MT * 768 * 2);
constexpr size_t WS_V = al256(WS_KN + (size_t)MLAT * 512 * 2);
constexpr size_t WS_END = al256(WS_V + (size_t)MLAT * 512 * 2);
constexpr size_t WS_BAR = WS_END;
constexpr size_t WS_TOTAL = WS_END + 16384;
constexpr size_t WS_H = WS_XN;
static_assert(WS_H + (size_t)MT * FF * 2 <= WS_VB, "H overlay must end before anything live in P5/P6 (nothing is, but keep it inside dead buffers)");
static_assert(WS_TOTAL <= (size_t)1073741824, "workspace");

constexpr int LDS_GEMM = 131072, LDS_RED = LDS_GEMM, LDS_BYTES = 143360;
constexpr int KP_A = 208, KP_B = 144;
constexpr int AT_TILE = 0, AT_PRIV = 21504  , AT_QT = 51200  , AT_BIAS = 86016  , AT_WSF = 107008, AT_OSTG = 109056, AT_CMB = 141824;
static_assert(AT_CMB + 1024 <= LDS_BYTES, "attention LDS map");

struct Params {
  const float *xp, *xs, *c_ckv, *c_kr, *c_bk, *c_bv, *w_in, *g_attn, *g_q, *w_uq, *g_kv, *w_uk, *w_uv, *rel_bias, *g_out_a, *g_out_b, *w_out, *g_ffn,
      *w_gate, *w_up, *w_down, *g_final;
  float* out; unsigned char* ws;
};

typedef const __attribute__((address_space(4))) Params* ParamsC;
__device__ __forceinline__ unsigned f2bf(float f) { unsigned u = __builtin_bit_cast(unsigned, f); return (u + 0x7fffu + ((u >> 16) & 1u)) >> 16; }
__device__ __forceinline__ unsigned pk2(float lo, float hi) { f32x2_t v = {lo, hi}; bf16x2_t b = __builtin_convertvector(v, bf16x2_t); return __builtin_bit_cast(unsigned, b); }
__device__ __forceinline__ float bf2f(unsigned short b) { return __builtin_bit_cast(float, (unsigned)b << 16); }
__device__ __forceinline__ int maprow_lat(int row) { return row < MP ? row : MP + ((row - MP) >> 4) * LROW + PAST + ((row - MP) & 15); }
__device__ __forceinline__ int maprow_bnd(int row) { return row < MP ? row : MP + ((row - MP) >> 4) * BROW + 512 + ((row - MP) & 15); }
__device__ __forceinline__ int row_pos(int row) { return row < MP ? (row & (SEQ - 1)) : PAST + ((row - MP) & 15); }
__device__ __forceinline__ void rope_cs(int pos, int i, float& c, float& s) {
  const float inv = __builtin_amdgcn_exp2f(-(float)i * (13.287712379549449f / 16.0f));
  float rev = (float)pos * inv * 0.15915494309189535f; rev = rev - __builtin_floorf(rev);
  s = __builtin_amdgcn_sinf(rev); c = __builtin_amdgcn_cosf(rev);
}

namespace pg8 {
constexpr int BM = 256, BK = 64, HALF = 128, HTB = HALF * BK * 2, STAGE_BYTES = 8 * HTB, NXCD = 8, WGM = 8;
__host__ __device__ __forceinline__ int lds_byte(int r, int c) { const int st = (r >> 4) * 2 + (c >> 5), rr = r & 15, cc = c & 31, ob = rr * 64 + cc * 2; return st * 1024 + (ob ^ (((ob >> 9) & 1) << 5)); }
__host__ __device__ __forceinline__ void stage_rc(int b, int& R, int& C) { const int st = b / 1024, sb = b % 1024, swz = sb ^ (((sb >> 9) & 1) << 5); R = (st >> 1) * 16 + swz / 64; C = (st & 1) * 32 + (swz % 64) / 2; }
struct Unit { int pm, pn, koff; };
struct Gemm { const bf16_t* A; const bf16_t* Bt; int lda, ldb, K; };
struct StaticOrder {
  int nM, nN, nwg, G, c;
  __device__ void init(int M, int N, int G_, int c_) { nM = M / BM; nN = N / BM; nwg = nM * nN; G = G_; c = c_; }
  __device__ bool next(int i, Unit& u) const {
    const long L = (long)i * G + c; if (L >= nwg) return false;
    int wgid = (int)L; { const int q = nwg / NXCD, r = nwg % NXCD, xcd = wgid % NXCD, off = wgid / NXCD; wgid = (xcd < r ? xcd * (q + 1) : r * (q + 1) + (xcd - r) * q) + off; }
    const int nig = WGM * nN, gid = wgid / nig, fm = gid * WGM, gsz = (nM - fm) < WGM ? (nM - fm) : WGM;
    u.pm = fm + ((wgid % nig) % gsz); u.pn = (wgid % nig) / gsz; u.koff = 0; return true;
  }
};
struct SplitOrder {
  int pm, nN, nsub, kchunk, G, c;
  __device__ bool next(int i, Unit& u) const { const int s = i * G + c; if (s >= nsub) return false; u.pm = pm; u.pn = s % nN; u.koff = (s / nN) * kchunk; return true; }
};
template <class Epi, class Order>
__device__ __forceinline__ void gemm_phase(LAS unsigned char* lds, const Gemm g, const Order& S, Epi& E) {
  int tid_ = threadIdx.x; asm volatile("" : "+v"(tid_));
  const int tid = tid_, wid = __builtin_amdgcn_readfirstlane(tid >> 6), lane = tid & 63, wr = wid >> 2, wc = wid & 3, fr = lane & 15, fq = lane >> 4;
  int K_ = g.K; asm volatile("" : "+s"(K_));
  const int K = K_, nt = K / BK;
  int lda_ = g.lda, ldb_ = g.ldb; asm volatile("" : "+s"(lda_), "+s"(ldb_));
  unsigned voffA[2];
#pragma unroll
  for (int i = 0; i < 2; ++i) { int R, C; stage_rc(tid * 16 + i * 8192, R, C); voffA[i] = (unsigned)(R * lda_ + C) * 2u; }
  const size_t kstep = (size_t)(BK * 2), hstepA = (size_t)HALF * lda_ * 2, tstepA = 2 * hstepA, hstepB = (size_t)HALF * ldb_ * 2, tstepB = 2 * hstepB;
  const unsigned ldsw = (unsigned)wid * 1024u;
  const int aoff = lds_byte(wr * 64 + fr, fq * 8), boff = lds_byte(wc * 32 + fr, fq * 8);
#define PG8_SA(b, h) (((b) * 2 + (h)) * HTB)
#define PG8_SB(b, h) ((4 + (b) * 2 + (h)) * HTB)
#define PG8_STAGE_(bufoff, gbase, voff) do { _Pragma("unroll") for (int _i = 0; _i < 2; ++_i) \
    __builtin_amdgcn_global_load_lds((const unsigned*)((const char*)(gbase) + (voff)[_i]), (LAS unsigned*)(lds + (bufoff) + ldsw + _i * 8192), 16, 0, 0); } while (0)
#define PG8_STA(bufoff, gbase) PG8_STAGE_(bufoff, gbase, voffA)
#define PG8_STB(bufoff, gbase) PG8_STAGE_(bufoff, gbase, voffA)
#define PG8_LDA(dst, b, h) do { _Pragma("unroll") for (int m = 0; m < 4; ++m) _Pragma("unroll") for (int k = 0; k < 2; ++k) dst[m][k] = *(const LAS bf16x8*)(lds + PG8_SA(b, h) + aoff + m * 2048 + k * 1024); } while (0)
#define PG8_LDB(dst, b, h) do { _Pragma("unroll") for (int n = 0; n < 2; ++n) _Pragma("unroll") for (int k = 0; k < 2; ++k) dst[n][k] = *(const LAS bf16x8*)(lds + PG8_SB(b, h) + boff + n * 2048 + k * 1024); } while (0)
#define PG8_MMA(ai, bj, At, Bt) do { __builtin_amdgcn_s_setprio(1); _Pragma("unroll") for (int m = 0; m < 4; ++m) _Pragma("unroll") for (int n = 0; n < 2; ++n) _Pragma("unroll") for (int k = 0; k < 2; ++k) \
    acc[ai][bj][m][n] = __builtin_amdgcn_mfma_f32_16x16x32_bf16(Bt[n][k], At[m][k], acc[ai][bj][m][n], 0, 0, 0); __builtin_amdgcn_s_setprio(0); } while (0)
#define PG8_WAIT_V(n) asm volatile("s_waitcnt vmcnt(" #n ")" ::: "memory")
#define PG8_WAIT_L(n) asm volatile("s_waitcnt lgkmcnt(" #n ")" ::: "memory")
#define PG8_BAR __builtin_amdgcn_s_barrier()
#define PG8_SCHED __builtin_amdgcn_sched_barrier(0)
  Unit cur, nxt; int ui = 0;
  if (!S.next(0, cur)) return;
  f32x4 acc[2][2][4][2];
#pragma unroll
  for (int a = 0; a < 2; ++a)
#pragma unroll
    for (int b = 0; b < 2; ++b)
#pragma unroll
      for (int m = 0; m < 4; ++m)
#pragma unroll
        for (int n = 0; n < 2; ++n) acc[a][b][m][n] = (f32x4){0.f, 0.f, 0.f, 0.f};
  bf16x8 At[4][2], B0[2][2], B1[2][2];
  const char* cA = (const char*)g.A + (size_t)cur.pm * tstepA + (size_t)cur.koff * 2; const char* cB = (const char*)g.Bt + (size_t)cur.pn * tstepB + (size_t)cur.koff * 2;
  PG8_STB(PG8_SB(0, 0), cB); PG8_STB(PG8_SB(0, 1), cB + hstepB); PG8_STA(PG8_SA(0, 0), cA); PG8_STA(PG8_SA(0, 1), cA + hstepA);
  if (wr == 1) PG8_BAR;
  PG8_WAIT_V(2); PG8_BAR;
  PG8_STB(PG8_SB(1, 0), cB + kstep); PG8_STA(PG8_SA(1, 0), cA + kstep); PG8_STB(PG8_SB(1, 1), cB + hstepB + kstep);
  PG8_WAIT_V(6); PG8_BAR;
  for (;;) {
    const bool has_next = S.next(ui + 1, nxt);
    const char* nA = has_next ? (const char*)g.A + (size_t)nxt.pm * tstepA + (size_t)nxt.koff * 2 : cA; const char* nB = has_next ? (const char*)g.Bt + (size_t)nxt.pn * tstepB + (size_t)nxt.koff * 2 : cB;
    for (int t = 0; t < nt; t += 2) {
      const bool last = (t == nt - 2);
      const char* a1 = cA + (size_t)(t + 1) * kstep;
      const char* a2 = last ? nA : cA + (size_t)(t + 2) * kstep; const char* b2 = last ? nB : cB + (size_t)(t + 2) * kstep;
      const char* a3 = a2 + kstep; const char* b3 = b2 + kstep;
      if constexpr (Epi::HAS_MID) { if (t == E.tsplit) { asm volatile("" : "+s"(cur.pm)); E.mid(acc, cur, wr, wc, fr, fq); } }
      PG8_LDB(B0, 0, 0); PG8_LDB(B1, 0, 1); PG8_SCHED; PG8_LDA(At, 0, 0); PG8_STA(PG8_SA(1, 1), a1 + hstepA);
      PG8_WAIT_V(8); PG8_WAIT_L(0); PG8_BAR; PG8_MMA(0, 0, At, B0); PG8_MMA(0, 1, At, B1); PG8_BAR; PG8_SCHED;
      PG8_LDA(At, 0, 1); PG8_STB(PG8_SB(0, 0), b2); PG8_STB(PG8_SB(0, 1), b2 + hstepB); PG8_STA(PG8_SA(0, 0), a2);
      PG8_WAIT_V(8); PG8_WAIT_L(0); PG8_BAR; PG8_MMA(1, 0, At, B0); PG8_MMA(1, 1, At, B1); PG8_BAR; PG8_SCHED;
      PG8_LDB(B0, 1, 0); PG8_LDB(B1, 1, 1); PG8_SCHED; PG8_LDA(At, 1, 0); PG8_STA(PG8_SA(0, 1), a2 + hstepA);
      PG8_WAIT_V(8); PG8_WAIT_L(0); PG8_BAR; PG8_MMA(0, 0, At, B0); PG8_MMA(0, 1, At, B1); PG8_BAR; PG8_SCHED;
      PG8_LDA(At, 1, 1); PG8_STB(PG8_SB(1, 0), b3); PG8_STB(PG8_SB(1, 1), b3 + hstepB); PG8_STA(PG8_SA(1, 0), a3);
      PG8_WAIT_V(8); PG8_WAIT_L(0); PG8_BAR; PG8_MMA(1, 0, At, B0); PG8_MMA(1, 1, At, B1); PG8_BAR; PG8_SCHED;
    }
    if (wr == 0) PG8_BAR;
    asm volatile("" : "+s"(cur.pm), "+s"(cur.pn));
    E(acc, cur, wr, wc, fr, fq);
    if (!has_next) break;
#pragma unroll
    for (int a = 0; a < 2; ++a)
#pragma unroll
      for (int b = 0; b < 2; ++b)
#pragma unroll
        for (int m = 0; m < 4; ++m)
#pragma unroll
          for (int n = 0; n < 2; ++n) acc[a][b][m][n] = (f32x4){0.f, 0.f, 0.f, 0.f};
    cur = nxt; cA = nA; cB = nB; ++ui;
    if (wr == 1) PG8_BAR;
  }
  PG8_WAIT_V(0);
  PG8_BAR;
#undef PG8_SA
#undef PG8_SB
#undef PG8_STAGE_
#undef PG8_STA
#undef PG8_STB
#undef PG8_LDA
#undef PG8_LDB
#undef PG8_MMA
#undef PG8_WAIT_V
#undef PG8_WAIT_L
#undef PG8_BAR
#undef PG8_SCHED
}
}
using pg8::Unit;
typedef f32x4 Acc[2][2][4][2];
#define FOR_AM _Pragma("unroll") for (int ai = 0; ai < 2; ++ai) _Pragma("unroll") for (int m = 0; m < 4; ++m)
#define FOR_BN _Pragma("unroll") for (int bj = 0; bj < 2; ++bj) _Pragma("unroll") for (int n = 0; n < 2; ++n)
__device__ __forceinline__ void st_bf4(bf16_t* p, f32x4 v) { u32x2 w; w.x = pk2(v[0], v[1]); w.y = pk2(v[2], v[3]); *(u32x2*)p = w; }
__device__ __forceinline__ void st_bf8(bf16_t* p, f32x4 a, f32x4 b) { u32x4 w; w.x = pk2(a[0], a[1]); w.y = pk2(a[2], a[3]); w.z = pk2(b[0], b[1]); w.w = pk2(b[2], b[3]); *(u32x4*)p = w; }
__device__ __forceinline__ void st_bf4x2(bf16_t* pa, f32x4 a, bf16_t* pb, f32x4 b, int fq) {
  const unsigned A0 = pk2(a[0], a[1]), A1 = pk2(a[2], a[3]), B0 = pk2(b[0], b[1]), B1 = pk2(b[2], b[3]);
  const auto r0 = __builtin_amdgcn_permlane16_swap(A0, B0, false, false);
  const auto r1 = __builtin_amdgcn_permlane16_swap(A1, B1, false, false);
  u32x4 w; w.x = r0[0]; w.y = r1[0]; w.z = r0[1]; w.w = r1[1];
  *(u32x4*)((fq & 1) ? pb - 4 : pa) = w;
}
__device__ __forceinline__ void atomic_addf(float* p, float v) { __hip_atomic_fetch_add(p, v, __ATOMIC_RELAXED, __HIP_MEMORY_SCOPE_AGENT); }

struct EpiIn {
  static constexpr bool HAS_MID = false;
  float* out; bf16_t *CQN, *CKV, *KR, *QB, *KB, *VB; const float* g_kv; LAS float* red;
  __device__ __forceinline__ void operator()(const Acc& acc, const Unit& u, int wr, int wc, int fr, int fq) const {
    const int pn = u.pn, rbase = u.pm * 256 + wr * 64 + fr, cw = wc * 32 + 4 * fq;
    if (pn <= 1) {
      FOR_AM { float s = 0.f; FOR_BN { const f32x4 x = acc[ai][bj][m][n]; s += (x[0] * x[0] + x[1] * x[1]) + (x[2] * x[2] + x[3] * x[3]); }
        s += __shfl_xor(s, 16); s += __shfl_xor(s, 32);
        if (fq == 0) red[(ai * 128 + wr * 64 + m * 16 + fr) * 4 + wc] = s; }
      asm volatile("s_waitcnt lgkmcnt(0)" ::: "memory"); __builtin_amdgcn_s_barrier(); asm volatile("" ::: "memory");
      FOR_AM { const f32x4 t = *(const LAS f32x4*)(red + (ai * 128 + wr * 64 + m * 16 + fr) * 4);
        const float rstd = __builtin_amdgcn_rsqf(((t[0] + t[1]) + (t[2] + t[3])) * (1.0f / 256.0f) + EPS);
        const int row = rbase + ai * 128 + m * 16;
        if (pn == 0) {
#pragma unroll
          for (int bj = 0; bj < 2; ++bj) { bf16_t* q = CQN + (size_t)row * 256 + bj * 128 + cw; st_bf4x2(q, acc[ai][bj][m][0] * rstd, q + 16, acc[ai][bj][m][1] * rstd, fq); } }
        else { const int mr = maprow_lat(row); float* o = row < MP ? out + OFF_CKVP + (size_t)row * 256 : out + OFF_CKVS + (size_t)(row - MP) * 256;
#pragma unroll
          for (int bj = 0; bj < 2; ++bj) { const int col = bj * 128 + cw; const f32x4 v0 = acc[ai][bj][m][0] * rstd * *(const f32x4*)(g_kv + col), v1 = acc[ai][bj][m][1] * rstd * *(const f32x4*)(g_kv + col + 16);
            *(f32x4*)(o + col) = v0; *(f32x4*)(o + col + 16) = v1; st_bf4x2(CKV + (size_t)mr * 256 + col, v0, CKV + (size_t)mr * 256 + col + 16, v1, fq); } } }
      asm volatile("s_waitcnt lgkmcnt(0)" ::: "memory"); __builtin_amdgcn_s_barrier(); asm volatile("" ::: "memory");
    } else if (pn <= 3) {
      FOR_AM { const int row = rbase + ai * 128 + m * 16;
#pragma unroll
        for (int bj = 0; bj < 2; ++bj) { bf16_t* q = QB + (size_t)row * 512 + (pn - 2) * 256 + bj * 128 + cw; st_bf4x2(q, acc[ai][bj][m][0] * QSCALE_B, q + 16, acc[ai][bj][m][1] * QSCALE_B, fq); } }
    } else if (pn <= 7) {
      const bool isv = pn >= 6; bf16_t* dst = isv ? VB : KB; const int c0 = (pn & 1) * 256;
      FOR_AM { const int row = rbase + ai * 128 + m * 16; const int mr = maprow_bnd(row);
        float* o = nullptr;
        if (row >= MP) o = out + (isv ? OFF_BVS : OFF_BKS) + (size_t)(row - MP) * 512;
        else if ((row & (SEQ - 1)) >= SEQ - 512) o = out + (isv ? OFF_BVP : OFF_BKP) + ((size_t)(row >> 11) * 512 + ((row & (SEQ - 1)) - (SEQ - 512))) * 512;
#pragma unroll
        for (int bj = 0; bj < 2; ++bj) { const int col = c0 + bj * 128 + cw; st_bf4x2(dst + (size_t)mr * 512 + col, acc[ai][bj][m][0], dst + (size_t)mr * 512 + col + 16, acc[ai][bj][m][1], fq);
          if (o) { *(f32x4*)(o + col) = acc[ai][bj][m][0]; *(f32x4*)(o + col + 16) = acc[ai][bj][m][1]; } } }
    } else {
      if (wc == 0) {
        FOR_AM { const int row = rbase + ai * 128 + m * 16; const int pos = row_pos(row), mr = maprow_lat(row);
          float* o = row < MP ? out + OFF_KRP + (size_t)row * 32 : out + OFF_KRS + (size_t)(row - MP) * 32;
          const f32x4 x1 = acc[ai][0][m][0], x2 = acc[ai][0][m][1]; f32x4 y1, y2;
#pragma unroll
          for (int j = 0; j < 4; ++j) { float c, s; rope_cs(pos, 4 * fq + j, c, s); y1[j] = x1[j] * c - x2[j] * s; y2[j] = x1[j] * s + x2[j] * c; }
          *(f32x4*)(o + 4 * fq) = y1; *(f32x4*)(o + 16 + 4 * fq) = y2;
          st_bf4x2(KR + (size_t)mr * 32 + 4 * fq, y1, KR + (size_t)mr * 32 + 16 + 4 * fq, y2, fq); }
      }
    }
  }
};
struct EpiQ {
  static constexpr bool HAS_MID = false;
  bf16_t* Q;
  __device__ __forceinline__ void operator()(const Acc& acc, const Unit& u, int wr, int wc, int fr, int fq) const {
    const int pn = u.pn, rbase = u.pm * 256 + wr * 64 + fr;
    if (pn <= 1) {
      FOR_AM { const int row = rbase + ai * 128 + m * 16;
#pragma unroll
        for (int bj = 0; bj < 2; ++bj) { const int col = pn * 256 + bj * 128 + wc * 32 + 4 * fq; bf16_t* q = Q + (size_t)row * 768 + (col >> 6) * 96 + (col & 63);
          st_bf4x2(q, acc[ai][bj][m][0] * QSCALE_A, q + 16, acc[ai][bj][m][1] * QSCALE_A, fq); } }
    } else {
      FOR_AM { const int row = rbase + ai * 128 + m * 16; const int pos = row_pos(row);
        float cs[4], sn[4];
#pragma unroll
        for (int j = 0; j < 4; ++j) rope_cs(pos, 4 * fq + j, cs[j], sn[j]);
#pragma unroll
        for (int bj = 0; bj < 2; ++bj) { const int head = 4 * bj + wc; const f32x4 x1 = acc[ai][bj][m][0], x2 = acc[ai][bj][m][1]; f32x4 y1, y2;
#pragma unroll
          for (int j = 0; j < 4; ++j) { y1[j] = (x1[j] * cs[j] - x2[j] * sn[j]) * QSCALE_A; y2[j] = (x1[j] * sn[j] + x2[j] * cs[j]) * QSCALE_A; }
          bf16_t* q = Q + (size_t)row * 768 + head * 96 + 64 + 4 * fq; st_bf4x2(q, y1, q + 16, y2, fq); } __builtin_amdgcn_sched_barrier(0); }
    }
  }
};
struct EpiKV {
  static constexpr bool HAS_MID = false;
  bf16_t *KN, *V;
  __device__ __forceinline__ void operator()(const Acc& acc, const Unit& u, int wr, int wc, int fr, int fq) const {
    const int pn = u.pn, rbase = u.pm * 256 + wr * 64 + fr; bf16_t* dst = pn >= 2 ? V : KN; const int c0 = (pn & 1) * 256 + wc * 32 + 4 * fq;
    FOR_AM { const int row = rbase + ai * 128 + m * 16;
#pragma unroll
      for (int bj = 0; bj < 2; ++bj) { bf16_t* q = dst + (size_t)row * 512 + c0 + bj * 128; st_bf4x2(q, acc[ai][bj][m][0], q + 16, acc[ai][bj][m][1], fq); } }
  }
};
struct EpiO {
  static constexpr bool HAS_MID = true;
  int tsplit; const float *ssq_a, *ssq_b, *xp, *xs; bf16_t* X1B; float* ssq_x1;
  __device__ __forceinline__ void mid(Acc& acc, const Unit& u, int wr, int wc, int fr, int fq) const {
    const int rbase = u.pm * 256 + wr * 64 + fr;
    FOR_AM { const int row = rbase + ai * 128 + m * 16; const float sa = ssq_a[row], sb = ssq_b[row];
      const float ratio = __builtin_amdgcn_rsqf(sa * (1.0f / 512.0f) + EPS) * __builtin_sqrtf(sb * (1.0f / 512.0f) + EPS);
      FOR_BN { acc[ai][bj][m][n] = acc[ai][bj][m][n] * ratio; }
      __builtin_amdgcn_sched_barrier(0); }
    asm volatile("s_waitcnt vmcnt(0)" ::: "memory");
  }
  __device__ __forceinline__ void operator()(const Acc& acc, const Unit& u, int wr, int wc, int fr, int fq) const {
    const int rbase = u.pm * 256 + wr * 64 + fr, c0 = u.pn * 256 + wc * 32 + 4 * fq;
    FOR_AM { const int row = rbase + ai * 128 + m * 16; const float rb = __builtin_amdgcn_rsqf(ssq_b[row] * (1.0f / 512.0f) + EPS);
      const float* xr = row < MP ? xp + (size_t)row * D : xs + (size_t)(row - MP) * D; float s = 0.f;
#pragma unroll
      for (int bj = 0; bj < 2; ++bj) { const int col = c0 + bj * 128; const f32x4 v0 = *(const f32x4*)(xr + col) + acc[ai][bj][m][0] * rb, v1 = *(const f32x4*)(xr + col + 16) + acc[ai][bj][m][1] * rb;
        st_bf4x2(X1B + (size_t)row * D + col, v0, X1B + (size_t)row * D + col + 16, v1, fq);
        s += ((v0[0] * v0[0] + v0[1] * v0[1]) + (v0[2] * v0[2] + v0[3] * v0[3])) + ((v1[0] * v1[0] + v1[1] * v1[1]) + (v1[2] * v1[2] + v1[3] * v1[3])); }
      s += __shfl_xor(s, 16); s += __shfl_xor(s, 32); if (fq == 0) atomic_addf(ssq_x1 + row, s); __builtin_amdgcn_sched_barrier(0); }
  }
};
struct EpiGU {
  static constexpr bool HAS_MID = false;
  const float* ssq_x1; bf16_t* H;
  __device__ __forceinline__ void operator()(const Acc& acc, const Unit& u, int wr, int wc, int fr, int fq) const {
    const int rbase = u.pm * 256 + wr * 64 + fr, c0 = u.pn * 128 + wc * 16 + 4 * fq;
    FOR_AM { const int row = rbase + ai * 128 + m * 16; const float rstd = __builtin_amdgcn_rsqf(ssq_x1[row] * (1.0f / 1024.0f) + EPS);
      f32x4 hv[2];
#pragma unroll
      for (int bj = 0; bj < 2; ++bj) { const f32x4 g = acc[ai][bj][m][0] * rstd, up = acc[ai][bj][m][1] * rstd;
#pragma unroll
        for (int j = 0; j < 4; ++j) hv[bj][j] = g[j] * __builtin_amdgcn_rcpf(1.0f + __builtin_amdgcn_exp2f(-g[j] * LOG2E)) * up[j]; }
      st_bf4x2(H + (size_t)row * FF + c0, hv[0], H + (size_t)row * FF + c0 + 64, hv[1], fq); }
  }
};
__device__ __forceinline__ f32x4 ld_bf4(const bf16_t* p) { const u32x2 w = *(const u32x2*)p; return (f32x4){__builtin_bit_cast(float, w.x << 16), __builtin_bit_cast(float, w.x & 0xffff0000u), __builtin_bit_cast(float, w.y << 16), __builtin_bit_cast(float, w.y & 0xffff0000u)}; }
__device__ __forceinline__ void ld_bf4x2(const bf16_t* pa, const bf16_t* pb, int fq, f32x4& a, f32x4& b) {
  const u32x4 w = *(const u32x4*)((fq & 1) ? pb - 4 : pa);
  const auto r0 = __builtin_amdgcn_permlane16_swap(w.x, w.z, false, false);
  const auto r1 = __builtin_amdgcn_permlane16_swap(w.y, w.w, false, false);
  a = (f32x4){__builtin_bit_cast(float, r0[0] << 16), __builtin_bit_cast(float, r0[0] & 0xffff0000u), __builtin_bit_cast(float, r1[0] << 16), __builtin_bit_cast(float, r1[0] & 0xffff0000u)};
  b = (f32x4){__builtin_bit_cast(float, r0[1] << 16), __builtin_bit_cast(float, r0[1] & 0xffff0000u), __builtin_bit_cast(float, r1[1] << 16), __builtin_bit_cast(float, r1[1] & 0xffff0000u)};
}
struct EpiD {
  static constexpr bool HAS_MID = false;
  bf16_t* X; float* ssq_x2;
  __device__ __forceinline__ void operator()(const Acc& acc, const Unit& u, int wr, int wc, int fr, int fq) const {
    const int rbase = u.pm * 256 + wr * 64 + fr, c0 = u.pn * 256 + wc * 32 + 4 * fq;
    FOR_AM { const int row = rbase + ai * 128 + m * 16; float s = 0.f;
#pragma unroll
      for (int bj = 0; bj < 2; ++bj) { bf16_t* x = X + (size_t)row * D + c0 + bj * 128; f32x4 x0, x1; ld_bf4x2(x, x + 16, fq, x0, x1); const f32x4 v0 = x0 + acc[ai][bj][m][0], v1 = x1 + acc[ai][bj][m][1];
        st_bf4x2(x, v0, x + 16, v1, fq);
        s += ((v0[0] * v0[0] + v0[1] * v0[1]) + (v0[2] * v0[2] + v0[3] * v0[3])) + ((v1[0] * v1[0] + v1[1] * v1[1]) + (v1[2] * v1[2] + v1[3] * v1[3])); }
      s += __shfl_xor(s, 16); s += __shfl_xor(s, 32); if (fq == 0) atomic_addf(ssq_x2 + row, s); }
  }
};
struct EpiPart {
  static constexpr bool HAS_MID = false;
  float* PART;
  __device__ __forceinline__ void operator()(const Acc& acc, const Unit& u, int wr, int wc, int fr, int fq) const {
    float* base = PART + (size_t)(u.koff >> 8) * 256 * D; const int r0 = wr * 64 + fr, c0 = u.pn * 256 + wc * 32 + 4 * fq;
    FOR_AM { FOR_BN { *(f32x4*)(base + (size_t)(r0 + ai * 128 + m * 16) * D + c0 + bj * 128 + n * 16) = acc[ai][bj][m][n]; } }
  }
};

__device__ __forceinline__ float wave_sum(float v) {
#pragma unroll
  for (int o = 1; o < 64; o <<= 1) v += __shfl_xor(v, o);
  return v;
}
template <class Map>
__device__ __forceinline__ void transpose_item(const float* W, int K, int N, bf16_t* WT, const float* g, LAS float* scr, int item, int lane, Map map) {
  const int nblk = N / 32, kb = item / nblk, nb = item % nblk, k0 = 64 * kb, n0 = 32 * nb;
  f32x4 wv[8];
#pragma unroll
  for (int i = 0; i < 8; ++i) { const int kk = 8 * i + (lane >> 3); wv[i] = *(const f32x4*)(W + (size_t)(k0 + kk) * N + n0 + 4 * (lane & 7)) * (g ? g[k0 + kk] : 1.0f); }
#pragma unroll
  for (int i = 0; i < 8; ++i) { const int kk = 8 * i + (lane >> 3); LAS float* d = scr + kk * 33 + 4 * (lane & 7); d[0] = wv[i][0]; d[1] = wv[i][1]; d[2] = wv[i][2]; d[3] = wv[i][3]; }
  asm volatile("s_waitcnt lgkmcnt(0)" ::: "memory");
  const int c = lane & 7;
#pragma unroll
  for (int j = 0; j < 4; ++j) { const int n = (lane >> 3) + 8 * j; const LAS float* s = scr + (8 * c) * 33 + n;
    u32x4 o; o.x = pk2(s[0 * 33], s[1 * 33]); o.y = pk2(s[2 * 33], s[3 * 33]); o.z = pk2(s[4 * 33], s[5 * 33]); o.w = pk2(s[6 * 33], s[7 * 33]);
    *(u32x4*)(WT + (size_t)map(n0 + n) * K + k0 + 8 * c) = o; }
  asm volatile("s_waitcnt lgkmcnt(0)" ::: "memory");
}
template <class Map>
__device__ __forceinline__ void convert_rows(const float* src, bf16_t* dst, int R, int cshift, int gt, int ngt, Map map) {
  const long n8 = ((long)R << cshift) >> 3;
  for (long i0 = gt; i0 < n8; i0 += 4L * ngt) {
    f32x4 v[4][2];
#pragma unroll
    for (int k = 0; k < 4; ++k) { const long i = i0 + (long)k * ngt; if (i < n8) { v[k][0] = *(const f32x4*)(src + i * 8); v[k][1] = *(const f32x4*)(src + i * 8 + 4); } }
#pragma unroll
    for (int k = 0; k < 4; ++k) { const long i = i0 + (long)k * ngt; if (i < n8) { const long e = i * 8; const int r = (int)(e >> cshift), c = (int)(e & ((1 << cshift) - 1));
      st_bf8(dst + ((size_t)map(r) << cshift) + c, v[k][0], v[k][1]); } }
  }
}
__device__ __forceinline__ void zero_rows(bf16_t* dst, int cshift, int r0, int nr, int nb, int bstride, int gt, int ngt) {
  const long per = ((long)nr << cshift) >> 3, n8 = per * nb;
  for (long i = gt; i < n8; i += ngt) { const int b = (int)(i / per); const long e = (i % per) * 8; *(u32x4*)(dst + (((size_t)b * bstride + r0) << cshift) + e) = (u32x4){0u, 0u, 0u, 0u}; }
}
__device__ __forceinline__ void prologue(ParamsC p, LAS unsigned char* lds, int G) {
  const int tid = threadIdx.x, lane = tid & 63, wave = tid >> 6; unsigned char* ws = p->ws;
  const int gw = blockIdx.x * 8 + wave, NGW = G * 8, gt = blockIdx.x * NTHREADS + tid, ngt = G * NTHREADS;
  LAS float* scr = (LAS float*)(lds + wave * 16384);
  bf16_t* WinT = (bf16_t*)(ws + WS_WIN); bf16_t* WuqT = (bf16_t*)(ws + WS_WUQ); bf16_t* WkvT = (bf16_t*)(ws + WS_WKV); bf16_t* WoT = (bf16_t*)(ws + WS_WO);
  bf16_t* WguT = (bf16_t*)(ws + WS_WGU); bf16_t* WdT = (bf16_t*)(ws + WS_WD);
  constexpr int I_IN = 16 * 65, I_UQ = 4 * 24, I_UK = 4 * 16, I_O = 16 * 32, I_G = 16 * 88, I_D = 44 * 32;
  constexpr int NITEMS = I_IN + I_UQ + 2 * I_UK + I_O + 2 * I_G + I_D;
  for (int it = gw; it < NITEMS; it += NGW) {
    int r = it;
    if (r < I_IN) { transpose_item(p->w_in, 1024, 2080, WinT, p->g_attn, scr, r, lane, [](int n) { return n < 512 ? n : (n < 544 ? 2048 + (n - 512) : 512 + (n - 544)); }); continue; } r -= I_IN;
    if (r < I_UQ) { transpose_item(p->w_uq, 256, 768, WuqT, p->g_q, scr, r, lane, [](int n) { const int h = n / 96, d = n % 96; return d < 64 ? h * 64 + d : 512 + h * 32 + (d - 64); }); continue; } r -= I_UQ;
    if (r < I_UK) { transpose_item(p->w_uk, 256, 512, WkvT, nullptr, scr, r, lane, [](int n) { return n; }); continue; } r -= I_UK;
    if (r < I_UK) { transpose_item(p->w_uv, 256, 512, WkvT, nullptr, scr, r, lane, [](int n) { return 512 + n; }); continue; } r -= I_UK;
    if (r < I_O) { const int kb = r / 32; transpose_item(p->w_out, 1024, 1024, WoT, kb < 8 ? p->g_out_a : p->g_out_b - 512, scr, r, lane, [](int n) { return n; }); continue; } r -= I_O;
    if (r < I_G) { transpose_item(p->w_gate, 1024, FF, WguT, p->g_ffn, scr, r, lane, [](int n) { return 32 * (n >> 4) + (n & 15); }); continue; } r -= I_G;
    if (r < I_G) { transpose_item(p->w_up, 1024, FF, WguT, p->g_ffn, scr, r, lane, [](int n) { return 32 * (n >> 4) + 16 + (n & 15); }); continue; } r -= I_G;
    transpose_item(p->w_down, FF, 1024, WdT, nullptr, scr, r, lane, [](int n) { return n; });
  }
  zero_rows(WinT, 10, 2080, NIN - 2080, 1, 0, gt, ngt);
  bf16_t* XN = (bf16_t*)(ws + WS_XN);
  for (int row0 = gw; row0 < MT; row0 += 4 * NGW) {
    f32x4 v[4][4]; float s[4] = {0.f, 0.f, 0.f, 0.f};
#pragma unroll
    for (int k = 0; k < 4; ++k) { const int row = row0 + k * NGW; if (row < MT) { const float* xr = row < MP ? p->xp + (size_t)row * D : p->xs + (size_t)(row - MP) * D;
#pragma unroll
      for (int j = 0; j < 2; ++j) { v[k][2 * j] = *(const f32x4*)(xr + 8 * lane + 512 * j); v[k][2 * j + 1] = *(const f32x4*)(xr + 8 * lane + 512 * j + 4); } } }
#pragma unroll
    for (int k = 0; k < 4; ++k) { const int row = row0 + k * NGW; if (row < MT) {
#pragma unroll
      for (int j = 0; j < 4; ++j) s[k] += (v[k][j][0] * v[k][j][0] + v[k][j][1] * v[k][j][1]) + (v[k][j][2] * v[k][j][2] + v[k][j][3] * v[k][j][3]);
      const float rstd = __builtin_amdgcn_rsqf(wave_sum(s[k]) * (1.0f / D) + EPS);
#pragma unroll
      for (int j = 0; j < 2; ++j) st_bf8(XN + (size_t)row * D + 8 * lane + 512 * j, v[k][2 * j] * rstd, v[k][2 * j + 1] * rstd); } }
  }
  bf16_t* CKV = (bf16_t*)(ws + WS_CKV); bf16_t* KR = (bf16_t*)(ws + WS_KR); bf16_t* KB = (bf16_t*)(ws + WS_KB); bf16_t* VB = (bf16_t*)(ws + WS_VB);
  convert_rows(p->c_ckv, CKV, DB * PAST, 8, gt, ngt, [](int r) { return MP + (r >> 12) * LROW + (r & 4095); });
  convert_rows(p->c_kr, KR, DB * PAST, 5, gt, ngt, [](int r) { return MP + (r >> 12) * LROW + (r & 4095); });
  convert_rows(p->c_bk, KB, DB * 512, 9, gt, ngt, [](int r) { return MP + (r >> 9) * BROW + (r & 511); });
  convert_rows(p->c_bv, VB, DB * 512, 9, gt, ngt, [](int r) { return MP + (r >> 9) * BROW + (r & 511); });
  zero_rows(CKV + (size_t)MP * 256, 8, PAST + DSQ, LROW - PAST - DSQ, DB, LROW, gt, ngt);
  zero_rows(KR + (size_t)MP * 32, 5, PAST + DSQ, LROW - PAST - DSQ, DB, LROW, gt, ngt);
  zero_rows(KB + (size_t)MP * 512, 9, 512 + DSQ, BROW - 512 - DSQ, DB, BROW, gt, ngt);
  zero_rows(VB + (size_t)MP * 512, 9, 512 + DSQ, BROW - 512 - DSQ, DB, BROW, gt, ngt);
  float* ssq = (float*)(ws + WS_SSQ);
  for (int i = gt; i < 4 * MT; i += ngt) ssq[i] = 0.f;
}

__device__ __forceinline__ f32x16 mfma32(bf16x8 a, bf16x8 b, f32x16 c) { return __builtin_amdgcn_mfma_f32_32x32x16_bf16(a, b, c, 0, 0, 0); }
__device__ __forceinline__ s16x4 vtr(const LAS unsigned char* p) { return __builtin_bit_cast(s16x4, __builtin_amdgcn_ds_read_tr16_b64_v4i16((LAS s16x4*)p)); }
template <int NS, bool BIAS, bool QL>
__device__ __forceinline__ void attn_qk(const LAS unsigned char* Kt, const bf16x8 (&qf)[NS], const LAS unsigned char* Qt, f32x16 (&st)[2], int nvalid, const LAS float* btab, int rb, bool lookup, int lane) {
  constexpr int KP = NS == 6 ? KP_A : KP_B;
  const int r = lane & 31, h = lane >> 5;
  bf16x8 qv[NS];
#pragma unroll
  for (int s = 0; s < NS; ++s) qv[s] = QL ? *(const LAS bf16x8*)(Qt + r * KP + (2 * s + h) * 16) : qf[s];
#pragma unroll
  for (int kh = 0; kh < 2; ++kh) {
    bf16x8 kf[NS];
#pragma unroll
    for (int s = 0; s < NS; ++s) kf[s] = *(const LAS bf16x8*)(Kt + (32 * kh + r) * KP + (2 * s + h) * 16);
    __builtin_amdgcn_sched_barrier(0);
    __builtin_amdgcn_s_setprio(1);
    { const f32x16 z = {0.f, 0.f, 0.f, 0.f, 0.f, 0.f, 0.f, 0.f, 0.f, 0.f, 0.f, 0.f, 0.f, 0.f, 0.f, 0.f}; st[kh] = mfma32(kf[0], qv[0], z); }
#pragma unroll
    for (int s = 1; s < NS; ++s) st[kh] = mfma32(kf[s], qv[s], st[kh]);
    __builtin_amdgcn_s_setprio(0);
    __builtin_amdgcn_sched_barrier(0);
  }
  if (BIAS) {
    if (lookup) { const LAS float* bp = btab + rb + 4 * h;
#pragma unroll
      for (int kh = 0; kh < 2; ++kh)
#pragma unroll
        for (int i = 0; i < 16; ++i) st[kh][i] += bp[32 * kh + (i & 3) + 8 * (i >> 2)];
    } else { const float bc = btab[0];
#pragma unroll
      for (int kh = 0; kh < 2; ++kh)
#pragma unroll
        for (int i = 0; i < 16; ++i) st[kh][i] += bc; }
  }
  if (nvalid < 64) {
#pragma unroll
    for (int kh = 0; kh < 2; ++kh)
#pragma unroll
      for (int i = 0; i < 16; ++i) { const int key = 32 * kh + (i & 3) + 8 * (i >> 2) + 4 * h; if (key >= nvalid) st[kh][i] = -1e30f; }
  }
}
__device__ __forceinline__ void attn_smpv(const LAS unsigned char* Vt, f32x16 (&st)[2], f32x16 (&o)[2], float& m_run, float& l_run, LAS float* wsf, int lane) {
  const int r = lane & 31, h = lane >> 5;
  float mx = st[0][0];
#pragma unroll
  for (int kh = 0; kh < 2; ++kh)
#pragma unroll
    for (int i = 0; i < 16; ++i) mx = __builtin_fmaxf(mx, st[kh][i]);
  mx = __builtin_fmaxf(mx, __shfl_xor(mx, 32));
  const float m_new = __builtin_fmaxf(m_run, mx), alpha = __builtin_amdgcn_exp2f(m_run - m_new);
  float rs = 0.f;
#pragma unroll
  for (int kh = 0; kh < 2; ++kh)
#pragma unroll
    for (int i = 0; i < 16; ++i) { const float pv = __builtin_amdgcn_exp2f(st[kh][i] - m_new); st[kh][i] = pv; rs += pv; }
  rs += __shfl_xor(rs, 32);
  l_run = l_run * alpha + rs; m_run = m_new;
  {
    if (h == 0) wsf[r] = alpha;
    typedef float f32x8 __attribute__((ext_vector_type(8)));
    const f32x4 a0 = *(const LAS f32x4*)(wsf + 4 * h), a1 = *(const LAS f32x4*)(wsf + 8 + 4 * h), a2 = *(const LAS f32x4*)(wsf + 16 + 4 * h), a3 = *(const LAS f32x4*)(wsf + 24 + 4 * h);
    const f32x8 lo = __builtin_shufflevector(a0, a1, 0, 1, 2, 3, 4, 5, 6, 7), hi = __builtin_shufflevector(a2, a3, 0, 1, 2, 3, 4, 5, 6, 7);
    const f32x16 av = __builtin_shufflevector(lo, hi, 0, 1, 2, 3, 4, 5, 6, 7, 8, 9, 10, 11, 12, 13, 14, 15);
    o[0] = o[0] * av; o[1] = o[1] * av;
  }
  const int blk = (lane >> 4) & 1, q = (lane & 15) >> 2, p = lane & 3;
  const int vb = (4 * h + q) * 128 + 8 * (p & 1), co0 = ((2 * blk + (p >> 1)) ^ (((q >> 1) & 1) << 2)) << 4;
#pragma unroll
  for (int kh = 0; kh < 2; ++kh)
#pragma unroll
    for (int s2 = 0; s2 < 2; ++s2) {
      u32x4 pw;
#pragma unroll
      for (int k = 0; k < 4; ++k) pw[k] = pk2(st[kh][8 * s2 + 2 * k], st[kh][8 * s2 + 2 * k + 1]);
      const bf16x8 pa = __builtin_bit_cast(bf16x8, pw);
#pragma unroll
      for (int c = 0; c < 2; ++c) {
        const LAS unsigned char* vp = Vt + (32 * kh + 16 * s2) * 128 + vb + (c ? (co0 ^ 64) : co0);
        const s16x4 lo = vtr(vp), hi = vtr(vp + 8 * 128);
        const bf16x8 vf = __builtin_shufflevector(lo, hi, 0, 1, 2, 3, 4, 5, 6, 7);
        __builtin_amdgcn_s_setprio(1); o[c] = mfma32(pa, vf, o[c]); __builtin_amdgcn_s_setprio(0);
      }
    }
}
__device__ __forceinline__ void scale_o(f32x16 (&o)[2], float f, LAS float* wsf, int lane) {
  const int r = lane & 31, h = lane >> 5;
  if (h == 0) wsf[r] = f;
#pragma unroll
  for (int g = 0; g < 4; ++g) { const f32x4 a4 = *(const LAS f32x4*)(wsf + 8 * g + 4 * h);
#pragma unroll
    for (int j = 0; j < 4; ++j) { o[0][4 * g + j] *= a4[j]; o[1][4 * g + j] *= a4[j]; } }
}
__device__ __forceinline__ void store_o(const f32x16 (&o)[2], LAS bf16_t* stg, bf16_t* att  , float* ssq  , int nq, int lane) {
  const int r = lane & 31, h = lane >> 5;
#pragma unroll
  for (int c = 0; c < 2; ++c)
#pragma unroll
    for (int i = 0; i < 16; ++i) stg[((i & 3) + 8 * (i >> 2) + 4 * h) * 64 + 32 * c + r] = (bf16_t)f2bf(o[c][i]);
  const int qr = lane >> 1, half = lane & 1; float s = 0.f; u32x4 v[4];
#pragma unroll
  for (int k = 0; k < 4; ++k) { v[k] = *(const LAS u32x4*)(stg + qr * 64 + half * 32 + 8 * k);
#pragma unroll
    for (int e = 0; e < 4; ++e) { const float a = __builtin_bit_cast(float, v[k][e] << 16), b = __builtin_bit_cast(float, v[k][e] & 0xffff0000u); s += a * a + b * b; } }
  s += __shfl_xor(s, 1);
  if (qr < nq) {
#pragma unroll
    for (int k = 0; k < 4; ++k) *(u32x4*)(att + (size_t)qr * D + half * 32 + 8 * k) = v[k];
    if (half == 0 && ssq) atomic_addf(ssq + qr, s);
  }
}
struct KVSrc { const bf16_t* K; const bf16_t* KRp; const bf16_t* V; };
template <int NS>
__device__ __forceinline__ u32x4 ld_kchunk(const KVSrc& s, long krow, int id) {
  if (NS == 6) { const int row = id / 12, ch = id - row * 12;
    return ch < 8 ? *(const u32x4*)(s.K + (krow + row) * 512 + ch * 8) : *(const u32x4*)(s.KRp + (krow + row) * 32 + (ch - 8) * 8); }
  else { const int row = id >> 3, ch = id & 7; return *(const u32x4*)(s.K + (krow + row) * 512 + ch * 8); }
}
template <int NS>
__device__ __forceinline__ void st_kchunk(LAS unsigned char* Kt, int id, u32x4 v) {
  constexpr int KP = NS == 6 ? KP_A : KP_B, CPR = NS == 6 ? 12 : 8;
  const int row = id / CPR, ch = id - row * CPR; *(LAS u32x4*)(Kt + row * KP + ch * 16) = v;
}
__device__ __forceinline__ void st_vchunk(LAS unsigned char* Vt, int id, u32x4 v) { const int row = id >> 3, ch = id & 7; *(LAS u32x4*)(Vt + row * 128 + ((ch ^ (((row >> 1) & 1) << 2)) << 4)) = v; }

__device__ __forceinline__ void glds16(const void* gsrc, unsigned lds_dst) {
  unsigned keep;
  asm volatile("s_mov_b32 %0, m0\n\ts_mov_b32 m0, %2\n\ts_nop 0\n\tglobal_load_lds_dwordx4 %1, off\n\ts_mov_b32 m0, %0" : "=&s"(keep) : "v"(gsrc), "s"(lds_dst) : "memory");
}
template <int NS>
__device__ __forceinline__ void dma_tile(LAS unsigned char* Kt, LAS unsigned char* Vt, const KVSrc& src, long krow, int wave, int lane) {
  constexpr int CPR = NS == 6 ? 13 : 9, ND = CPR;
#pragma unroll
  for (int k = 0; k < 2; ++k) { const int d = wave + 8 * k;
    if (d < ND) { const int c = d * 64 + lane, row = c / CPR, ch = c - row * CPR;
      const bf16_t* g = (NS == 6 && ch >= 8 && ch < 12) ? src.KRp + (krow + row) * 32 + (ch - 8) * 8 : src.K + (krow + row) * 512 + (ch < 8 ? ch : 0) * 8;
      glds16(g, (unsigned)__builtin_amdgcn_readfirstlane((int)(unsigned)(uintptr_t)(Kt + d * 1024))); } }
  { const int c = wave * 64 + lane, row = c >> 3, ch = (c & 7) ^ (((row >> 1) & 1) << 2);
    glds16(src.V + (krow + row) * 512 + ch * 8, (unsigned)__builtin_amdgcn_readfirstlane((int)(unsigned)(uintptr_t)(Vt + wave * 1024))); }
}
#define AT_VMWAIT(n) asm volatile("s_waitcnt vmcnt(" #n ")" ::: "memory")
template <int NS, bool BIAS>
__device__ __forceinline__ void attn_unit_shared(LAS unsigned char* lds, const bf16_t* Qw  , int qpitch, const KVSrc src, long krow0,
                                                 int t_lo, int t_hi, int w_lo, int w_hi, int qpos0  , bf16_t* att, float* ssq, int bhead = 0) {
  constexpr int SLOT = 21504, ND = NS == 6 ? 13 : 9;
  int tid_ = threadIdx.x; asm volatile("" : "+v"(tid_));
  const int tid = tid_, lane = tid & 63, wave = __builtin_amdgcn_readfirstlane(tid >> 6), r = lane & 31, h = lane >> 5;
  LAS float* wsf = (LAS float*)(lds + AT_WSF) + wave * 64; const LAS float* btab = (const LAS float*)(lds + AT_BIAS) + bhead * 640;
#pragma unroll
  for (int k = 0; k < 2; ++k) if (t_lo + k <= t_hi) dma_tile<NS>(lds + AT_TILE + k * SLOT, lds + AT_TILE + k * SLOT + 13312, src, krow0 + 64L * (t_lo + k), wave, lane);
  bf16x8 qf[NS];
#pragma unroll
  for (int s = 0; s < NS; ++s) qf[s] = *(const bf16x8*)(Qw + (size_t)r * qpitch + 16 * s + 8 * h);
#pragma unroll
  for (int s = 0; s < NS; ++s) asm volatile("" : "+v"(qf[s]));
  f32x16 o[2];
#pragma unroll
  for (int i = 0; i < 16; ++i) { o[0][i] = 0.f; o[1][i] = 0.f; }
  float m_run = -1e30f, l_run = 0.f;
  AT_VMWAIT(0);
  asm volatile("s_waitcnt lgkmcnt(0)" ::: "memory"); __builtin_amdgcn_s_barrier(); asm volatile("" ::: "memory");
  for (int t0 = t_lo; t0 <= t_hi; t0 += 2) {
#pragma unroll
    for (int k = 2; k < 4; ++k) if (t0 + k <= t_hi) { const int s3 = (t0 + k - t_lo) & 3; dma_tile<NS>(lds + AT_TILE + s3 * SLOT, lds + AT_TILE + s3 * SLOT + 13312, src, krow0 + 64L * (t0 + k), wave, lane); }
#pragma unroll
    for (int k = 0; k < 2; ++k) { const int t = t0 + k; const int sl = (t - t_lo) & 3;
      if (t <= t_hi && t >= w_lo && t <= w_hi) {
        const bool lookup = BIAS && (qpos0 - (64 * t + 63) < 256);
        f32x16 st[2]; attn_qk<NS, BIAS, false>(lds + AT_TILE + sl * SLOT, qf, nullptr, st, 64, btab, 639 - (qpos0 + r - 64 * t + 256), lookup, lane);
        attn_smpv(lds + AT_TILE + sl * SLOT + 13312, st, o, m_run, l_run, wsf, lane);
      } }
    AT_VMWAIT(0);
    asm volatile("s_waitcnt lgkmcnt(0)" ::: "memory"); __builtin_amdgcn_s_barrier(); asm volatile("" ::: "memory");
  }
  scale_o(o, 1.0f / l_run, wsf, lane);
  store_o(o, (LAS bf16_t*)(lds + AT_OSTG) + wave * 2048, att, ssq, 32, lane);
}
template <int NS, bool BIAS>
__device__ __forceinline__ void attn_unit_sample(LAS unsigned char* lds, const bf16_t* Qw, int qpitch, const KVSrc src, long krow0, int ntiles, int nvalid_last, int qpos0, bf16_t* att, float* ssq, int bhead = 0) {
  constexpr int NKC = NS == 6 ? 768 : 512;
  int tid_ = threadIdx.x; asm volatile("" : "+v"(tid_));
  const int tid = tid_, lane = tid & 63, wave = tid >> 6, r = lane & 31, h = lane >> 5;
  LAS float* wsf = (LAS float*)(lds + AT_WSF) + wave * 64; const LAS float* btab = (const LAS float*)(lds + AT_BIAS) + bhead * 640;
  LAS float* cm = (LAS float*)(lds + AT_CMB);
  f32x16 o[2];
#pragma unroll
  for (int i = 0; i < 16; ++i) { o[0][i] = 0.f; o[1][i] = 0.f; }
  float m_run = -1e30f, l_run = 0.f;
  LAS unsigned char* Kt = lds + AT_TILE + (wave & 3) * AT_PRIV; LAS unsigned char* Vt = Kt + 13312;
  bf16x8 qf[NS];
#pragma unroll
  for (int s = 0; s < NS; ++s) qf[s] = *(const bf16x8*)(Qw + (size_t)(r & 15) * qpitch + 16 * s + 8 * h);
  constexpr int NK4 = 4 * NKC / 512;
  u32x4 kc[NK4], vc[4];
#define SMP_LOAD(T0) do { _Pragma("unroll") for (int i = 0; i < NK4; ++i) { const int id = tid + 512 * i, tt = id / NKC, cid = id - tt * NKC; if ((T0) + tt < ntiles) kc[i] = ld_kchunk<NS>(src, krow0 + 64L * ((T0) + tt), cid); } \
    _Pragma("unroll") for (int i = 0; i < 4; ++i) { const int id = tid + 512 * i, tt = id >> 9, cid = id & 511; if ((T0) + tt < ntiles) vc[i] = *(const u32x4*)(src.V + (krow0 + 64L * ((T0) + tt) + (cid >> 3)) * 512 + (cid & 7) * 8); } } while (0)
#define SMP_STORE(T0) do { _Pragma("unroll") for (int i = 0; i < NK4; ++i) { const int id = tid + 512 * i, tt = id / NKC, cid = id - tt * NKC; if ((T0) + tt < ntiles) st_kchunk<NS>(lds + AT_TILE + tt * AT_PRIV, cid, kc[i]); } \
    _Pragma("unroll") for (int i = 0; i < 4; ++i) { const int id = tid + 512 * i, tt = id >> 9, cid = id & 511; if ((T0) + tt < ntiles) st_vchunk(lds + AT_TILE + tt * AT_PRIV + 13312, cid, vc[i]); } } while (0)
  SMP_LOAD(0); SMP_STORE(0);
  __syncthreads();
  for (int t0 = 0; t0 < ntiles; t0 += 4) {
    if (t0 + 4 < ntiles) SMP_LOAD(t0 + 4);
    const int t = t0 + wave;
    if (wave < 4 && t < ntiles) {
      const bool lookup = BIAS && (qpos0 - (64 * t + 63) < 256);
      f32x16 st[2]; attn_qk<NS, BIAS, false>(Kt, qf, nullptr, st, (t == ntiles - 1) ? nvalid_last : 64, btab, 639 - (qpos0 + (r & 15) - 64 * t + 256), lookup, lane);
      attn_smpv(Vt, st, o, m_run, l_run, wsf, lane);
    }
    __syncthreads();
    if (t0 + 4 < ntiles) { SMP_STORE(t0 + 4); }
    __syncthreads();
  }
#undef SMP_LOAD
#undef SMP_STORE
  if (wave < 4 && h == 0) cm[wave * 32 + r] = m_run;
  __syncthreads();
  if (wave < 4) {
    const float M = __builtin_fmaxf(__builtin_fmaxf(cm[r], cm[32 + r]), __builtin_fmaxf(cm[64 + r], cm[96 + r]));
    const float f = __builtin_amdgcn_exp2f(m_run - M);
    scale_o(o, f, wsf, lane);
    if (h == 0) cm[128 + wave * 32 + r] = l_run * f;
    LAS float* po = (LAS float*)(lds + AT_TILE + wave * AT_PRIV);
#pragma unroll
    for (int c = 0; c < 2; ++c)
#pragma unroll
      for (int i = 0; i < 16; ++i) po[(c * 16 + i) * 64 + lane] = o[c][i];
  }
  __syncthreads();
  if (wave == 0) {
    const float l = (cm[128 + r] + cm[160 + r]) + (cm[192 + r] + cm[224 + r]);
#pragma unroll
    for (int w = 1; w < 4; ++w) { const LAS float* po = (const LAS float*)(lds + AT_TILE + w * AT_PRIV);
#pragma unroll
      for (int c = 0; c < 2; ++c)
#pragma unroll
        for (int i = 0; i < 16; ++i) o[c][i] += po[(c * 16 + i) * 64 + lane]; }
    scale_o(o, 1.0f / l, wsf, lane);
    store_o(o, (LAS bf16_t*)(lds + AT_OSTG), att, ssq, 16, lane);
  }
  __syncthreads();
}
__device__ __forceinline__ void load_bias_all(LAS unsigned char* lds, const float* rel_bias) {
  LAS float* btab = (LAS float*)(lds + AT_BIAS);
  for (int i = threadIdx.x; i < 8 * 640; i += NTHREADS) { const int hd = i / 640, j = 639 - (i - hd * 640); btab[i] = rel_bias[hd * 513 + (j > 512 ? 512 : j)] * LOG2E; }
  __syncthreads();
}
__device__ __forceinline__ void attention_phase(ParamsC p, LAS unsigned char* lds, int G, bool dry, int apm = 15) {
  unsigned char* ws = p->ws; const int wave = threadIdx.x >> 6;
  const bf16_t* Q = (const bf16_t*)(ws + WS_Q); const bf16_t* KN = (const bf16_t*)(ws + WS_KN); const bf16_t* V = (const bf16_t*)(ws + WS_V); const bf16_t* KR = (const bf16_t*)(ws + WS_KR);
  const bf16_t* QB = (const bf16_t*)(ws + WS_QB); const bf16_t* KB = (const bf16_t*)(ws + WS_KB); const bf16_t* VB = (const bf16_t*)(ws + WS_VB);
  bf16_t* ATT = (bf16_t*)(ws + WS_XN); float* ssq_a = (float*)(ws + WS_SSQ); float* ssq_b = ssq_a + MT;
  load_bias_all(lds, p->rel_bias);
  for (int u = blockIdx.x; u < 256; u += G) {
    const int b = (u & 127) >> 3, head = u & 7; const int row0 = MP + b * DSQ;
#ifndef AP
#define AP 15
#endif
    if (u < 128) { if (apm & 1) {
      const KVSrc src{KN + head * 64, KR, V + head * 64};
      attn_unit_sample<6, false>(lds, Q + (size_t)row0 * 768 + head * 96, 768, src, (long)MP + (long)b * LROW, 65, 16, 0, ATT + (size_t)row0 * D + head * 64, dry ? nullptr : ssq_a + row0); }
    } else if (apm & 2) {
      const KVSrc src{KB + head * 64, nullptr, VB + head * 64};
      attn_unit_sample<4, true>(lds, QB + (size_t)row0 * 512 + head * 64, 512, src, (long)MP + (long)b * BROW, 9, 16, 512, ATT + (size_t)row0 * D + 512 + head * 64, dry ? nullptr : ssq_b + row0, head);
    }
  }
  if (G == 256) {
    const int vcu = (blockIdx.x & 7) * 32 + (blockIdx.x >> 3), grp = vcu >> 3, mem = vcu & 7; const int b = grp; const long brow = (long)b * SEQ;
    if (apm & 4) for (int i = 0; i < 8; ++i) { const int head = i, qb = (mem + i) & 7; const KVSrc src{KN + head * 64, KR, V + head * 64}; const long qrow = brow + 256 * qb + 32 * wave;
      attn_unit_shared<6, false>(lds, Q + (size_t)qrow * 768 + head * 96, 768, src, brow, 0, 4 * qb + 3, 0, 4 * qb + (wave >> 1), 0, ATT + (size_t)qrow * D + head * 64, dry ? nullptr : ssq_a + qrow); }
    if (apm & 8) for (int i = 0; i < 8; ++i) { const int head = i, cb = (mem + i) & 7;
      const KVSrc src{KB + head * 64, nullptr, VB + head * 64}; const long qrow = brow + 256 * cb + 32 * wave; const int cq = 4 * cb + (wave >> 1); const int tl = 4 * cb - 8 < 0 ? 0 : 4 * cb - 8;
      attn_unit_shared<4, true>(lds, QB + (size_t)qrow * 512 + head * 64, 512, src, brow, tl, 4 * cb + 3, cq - 8, cq, 256 * cb + 32 * wave, ATT + (size_t)qrow * D + 512 + head * 64, dry ? nullptr : ssq_b + qrow, head); }
  } else {
  for (int bh = blockIdx.x; bh < NBATCH * 8; bh += G) {
    const int b = bh >> 3, head = bh & 7; const long brow = (long)b * SEQ;
    if (apm & 4) { const KVSrc src{KN + head * 64, KR, V + head * 64};
      for (int qb = 0; qb < 8; ++qb) { const long qrow = brow + 256 * qb + 32 * wave;
        attn_unit_shared<6, false>(lds, Q + (size_t)qrow * 768 + head * 96, 768, src, brow, 0, 4 * qb + 3, 0, 4 * qb + (wave >> 1), 0, ATT + (size_t)qrow * D + head * 64, dry ? nullptr : ssq_a + qrow); } }
    if (apm & 8) { const KVSrc src{KB + head * 64, nullptr, VB + head * 64};
      for (int cb = 0; cb < 8; ++cb) { const long qrow = brow + 256 * cb + 32 * wave; const int cq = 4 * cb + (wave >> 1); const int tl = 4 * cb - 8 < 0 ? 0 : 4 * cb - 8;
        attn_unit_shared<4, true>(lds, QB + (size_t)qrow * 512 + head * 64, 512, src, brow, tl, 4 * cb + 3, cq - 8, cq, 256 * cb + 32 * wave, ATT + (size_t)qrow * D + 512 + head * 64, dry ? nullptr : ssq_b + qrow, head); } }
  }
  }
}


#define XB_TMO      128
#define XB_XCNT(j)  (256  + 64 * (j))
#define XB_XSUB(j)  (1280 + 64 * (j))
#define XB_XGEN(j)  (2304 + 64 * (j))
#define XB_TOP      3328
#define XB_TOPGEN   3392
#define XCD_BAR_WORDS 3456
#define XB_SPIN_CAP (1u << 18)
__device__ __forceinline__ unsigned xb_ld(unsigned* p)              { return __hip_atomic_load(p, __ATOMIC_RELAXED, __HIP_MEMORY_SCOPE_AGENT); }
__device__ __forceinline__ unsigned xb_add(unsigned* p, unsigned v) { return __hip_atomic_fetch_add(p, v, __ATOMIC_RELAXED, __HIP_MEMORY_SCOPE_AGENT); }
__device__ __forceinline__ unsigned xb_xcc_id() { return (unsigned)__builtin_amdgcn_s_getreg((3 << 11) | 20) & 0xFu; }
#define XB_SPIN(cond, bar) do { unsigned _sp = 0; while (cond) { __builtin_amdgcn_s_sleep(1); \
    if ((++_sp & 255u) == 0u) { if (xb_ld(&(bar)[XB_TMO])) break; if (_sp > XB_SPIN_CAP) { atomicAdd(&(bar)[XB_TMO], 1u); break; } } } } while (0)
__device__ __forceinline__ void xcd_barrier_complete(unsigned* bar, unsigned x, unsigned& nloc, unsigned& nx) {
  const unsigned G = gridDim.x * gridDim.y * gridDim.z;
  unsigned sum, cnt, mine, sp = 0u;
  for (;;) {
    sum = 0u; cnt = 0u; mine = 0u;
#pragma unroll
    for (unsigned j = 0; j < 16; ++j) { const unsigned c = xb_ld(&bar[XB_XCNT(j)]); sum += c; cnt += (c > 0u) ? 1u : 0u; mine = (j == x) ? c : mine; }
    if (sum == G) break;
    __builtin_amdgcn_s_sleep(1);
    if ((++sp & 255u) == 0u) { if (xb_ld(&bar[XB_TMO])) break; if (sp > XB_SPIN_CAP) { atomicAdd(&bar[XB_TMO], 1u); break; } }
  }
  nloc = mine > 0u ? mine : 1u; nx = cnt > 0u ? cnt : 1u;
}
__device__ __forceinline__ void xcd_barrier(unsigned* bar, volatile LAS unsigned* st) {
  asm volatile("s_waitcnt vmcnt(0)" ::: "memory");
  __syncthreads();
  if (threadIdx.x == 0) {
    const unsigned x = xb_xcc_id();
    __builtin_amdgcn_s_waitcnt(0);
    unsigned nloc = st[0], nx = st[1];
    if (nloc == 0u) { xcd_barrier_complete(bar, x, nloc, nx); st[0] = nloc; st[1] = nx; }
    const unsigned old = xb_add(&bar[XB_XSUB(x)], 1u);
    const unsigned gen = old / nloc;
    if (old + 1u == (gen + 1u) * nloc) {
      __builtin_amdgcn_fence(__ATOMIC_RELEASE, "agent");
      asm volatile("s_waitcnt vmcnt(0)" ::: "memory");
      const unsigned og = xb_add(&bar[XB_TOP], 1u);
      const unsigned tg = og / nx;
      if (og + 1u == (tg + 1u) * nx) xb_add(&bar[XB_TOPGEN], 1u);
      else XB_SPIN(xb_ld(&bar[XB_TOPGEN]) == tg, bar);
      __builtin_amdgcn_fence(__ATOMIC_ACQUIRE, "agent");
      xb_add(&bar[XB_XGEN(x)], 1u);
      asm volatile("s_waitcnt vmcnt(0)" ::: "memory");
    } else {
      XB_SPIN(xb_ld(&bar[XB_XGEN(x)]) == gen, bar);
      __builtin_amdgcn_fence(__ATOMIC_ACQUIRE, "agent");
      asm volatile("s_waitcnt vmcnt(0)" ::: "memory");
    }
  }
  __syncthreads();
}

__device__ __forceinline__ ParamsC get_params() {
  ParamsC pp = (ParamsC)__builtin_amdgcn_kernarg_segment_ptr(); asm volatile("" : "+s"(pp)); return pp;
}
__global__ void __launch_bounds__(NTHREADS) mk_fwd(Params p_unused) {
  extern __shared__ __attribute__((aligned(16))) unsigned char lds_raw[];
  LAS unsigned char* lds = (LAS unsigned char*)lds_raw;
  cg::grid_group grid = cg::this_grid();
  const int G = gridDim.x;
  volatile LAS unsigned* xst = (volatile LAS unsigned*)(lds + LDS_BYTES - 16);
  if (threadIdx.x < 2) xst[threadIdx.x] = 0u;
  if (threadIdx.x == 0) (void)xb_add(&((unsigned*)(get_params()->ws + WS_BAR))[XB_XCNT(xb_xcc_id())], 1u);
  __syncthreads();
#define FAST_SYNC() xcd_barrier((unsigned*)(get_params()->ws + WS_BAR), xst)
#define WSP(T, off) ((T*)(get_params()->ws + (off)))
#define ssq WSP(float, WS_SSQ)
#define X1B WSP(bf16_t, WS_X1B)
#define XN WSP(bf16_t, WS_XN)
#define CQN WSP(bf16_t, WS_CQN)
#define CKV WSP(bf16_t, WS_CKV)
#define KR WSP(bf16_t, WS_KR)
#define QB WSP(bf16_t, WS_QB)
#define KB WSP(bf16_t, WS_KB)
#define VB WSP(bf16_t, WS_VB)
#define Q WSP(bf16_t, WS_Q)
#define KN WSP(bf16_t, WS_KN)
#define V WSP(bf16_t, WS_V)
#define H WSP(bf16_t, WS_H)
  pg8::StaticOrder S;
#ifndef PH
#define PH 255
#endif
  if (PH & 1) prologue(get_params(), lds, G);
#ifdef DUP_P0
  grid.sync(); prologue(get_params(), lds, G);
#endif
  grid.sync();
  if (PH & 2) { pg8::Gemm g{XN, (const bf16_t*)(get_params()->ws + WS_WIN), 1024, 1024, 1024}; S.init(MT, NIN, G, blockIdx.x);
    ParamsC pp = get_params(); EpiIn E{pp->out, CQN, CKV, KR, QB, KB, VB, pp->g_kv, (LAS float*)(lds + LDS_RED)};
    pg8::gemm_phase(lds, g, S, E); }
  FAST_SYNC();
  if ((PH & 4) && !(PH & 256)) { pg8::Gemm g{CQN, (const bf16_t*)(get_params()->ws + WS_WUQ), 256, 256, 256}; S.init(MT, 768, G, blockIdx.x); EpiQ E{Q}; pg8::gemm_phase(lds, g, S, E); }
  if ((PH & 4) && !(PH & 512)) { pg8::Gemm g{CKV, (const bf16_t*)(get_params()->ws + WS_WKV), 256, 256, 256}; S.init(MLAT, 1024, G, blockIdx.x); EpiKV E{KN, V}; pg8::gemm_phase(lds, g, S, E); }
  FAST_SYNC();
  if (PH & 8) attention_phase(get_params(), lds, G, false);
#ifdef DUP_ATTN
  grid.sync(); attention_phase(get_params(), lds, G, true, DUP_ATTN);
#endif
  FAST_SYNC();
  if (PH & 16) { pg8::Gemm g{XN  , (const bf16_t*)(get_params()->ws + WS_WO), 1024, 1024, 1024}; S.init(MT, 1024, G, blockIdx.x);
    ParamsC pp = get_params(); EpiO E{8, ssq, ssq + MT, pp->xp, pp->xs, X1B, ssq + 2 * MT}; pg8::gemm_phase(lds, g, S, E); }
  FAST_SYNC();
  if (PH & 32) { pg8::Gemm g{X1B, (const bf16_t*)(get_params()->ws + WS_WGU), 1024, 1024, 1024}; S.init(MT, NGU, G, blockIdx.x); EpiGU E{ssq + 2 * MT, H}; pg8::gemm_phase(lds, g, S, E);
#ifdef DUP_P5
    grid.sync(); pg8::gemm_phase(lds, g, S, E);
#endif
  }
  FAST_SYNC();
#define PART WSP(float, WS_Q)
  if (PH & 64) { pg8::Gemm g{H, (const bf16_t*)(get_params()->ws + WS_WD), FF, FF, FF}; S.init(MP, 1024, G, blockIdx.x); EpiD E{X1B, ssq + 3 * MT}; pg8::gemm_phase(lds, g, S, E);
    pg8::Gemm g2{H, (const bf16_t*)(get_params()->ws + WS_WD), FF, FF, 256}; pg8::SplitOrder S2{MP / 256, 4, 44, 256, G, (int)blockIdx.x}; EpiPart E2{PART}; pg8::gemm_phase(lds, g2, S2, E2); }
  FAST_SYNC();
  if (PH & 128) { ParamsC p = get_params(); int t7 = threadIdx.x; asm volatile("" : "+v"(t7)); const int lane = t7 & 63, gw = blockIdx.x * 8 + (t7 >> 6), NGW = G * 8; const float* s2 = ssq + 3 * MT;
    f32x4 gf[4];
#pragma unroll
    for (int j = 0; j < 2; ++j) { gf[2 * j] = *(const f32x4*)(p->g_final + 8 * lane + 512 * j); gf[2 * j + 1] = *(const f32x4*)(p->g_final + 8 * lane + 512 * j + 4); }
    for (int rr0 = gw; rr0 < MT; rr0 += 4 * NGW) {
      u32x4 raw[4][2]; int rows[4];
#pragma unroll
      for (int k = 0; k < 4; ++k) { const int rr = rr0 + k * NGW; rows[k] = rr < MS ? MP + rr : rr - MS;
        if (rr < MT) { const bf16_t* x = X1B + (size_t)rows[k] * D;
#pragma unroll
          for (int j = 0; j < 2; ++j) raw[k][j] = *(const u32x4*)(x + 8 * lane + 512 * j); } }
#pragma unroll
      for (int k = 0; k < 4; ++k) { const int rr = rr0 + k * NGW, row = rows[k]; if (rr < MT) {
        f32x4 v[4];
#pragma unroll
        for (int j = 0; j < 2; ++j) { const u32x4 w = raw[k][j];
          v[2 * j] = (f32x4){__builtin_bit_cast(float, w.x << 16), __builtin_bit_cast(float, w.x & 0xffff0000u), __builtin_bit_cast(float, w.y << 16), __builtin_bit_cast(float, w.y & 0xffff0000u)};
          v[2 * j + 1] = (f32x4){__builtin_bit_cast(float, w.z << 16), __builtin_bit_cast(float, w.z & 0xffff0000u), __builtin_bit_cast(float, w.w << 16), __builtin_bit_cast(float, w.w & 0xffff0000u)}; }
        float* y = p->out + OFF_Y + (size_t)row * D; float rstd;
        if (row >= MP) { float s = 0.f;
          for (int kc = 0; kc < 11; ++kc) { const float* pr = PART + ((size_t)kc * 256 + (row - MP)) * D;
#pragma unroll
            for (int j = 0; j < 2; ++j) { v[2 * j] = v[2 * j] + *(const f32x4*)(pr + 8 * lane + 512 * j); v[2 * j + 1] = v[2 * j + 1] + *(const f32x4*)(pr + 8 * lane + 512 * j + 4); } }
#pragma unroll
          for (int j = 0; j < 4; ++j) s += (v[j][0] * v[j][0] + v[j][1] * v[j][1]) + (v[j][2] * v[j][2] + v[j][3] * v[j][3]);
          rstd = __builtin_amdgcn_rsqf(wave_sum(s) * (1.0f / D) + EPS);
        } else rstd = __builtin_amdgcn_rsqf(s2[row] * (1.0f / D) + EPS);
#pragma unroll
        for (int j = 0; j < 2; ++j) { *(f32x4*)(y + 8 * lane + 512 * j) = v[2 * j] * rstd * gf[2 * j]; *(f32x4*)(y + 8 * lane + 512 * j + 4) = v[2 * j + 1] * rstd * gf[2 * j + 1]; } } } } }
}

#undef FAST_SYNC
#undef ssq
#undef X1B
#undef XN
#undef CQN
#undef CKV
#undef KR
#undef QB
#undef KB
#undef VB
#undef Q
#undef KN
#undef V
#undef H
#undef PART
extern "C" void kernel_launch(void* const* d_in, const int* in_sizes, int n_in, void* d_out, int out_size, void* d_ws, size_t ws_size, hipStream_t stream) {
  static int grid = 0;
  if (grid == 0) {
    if (n_in != 22 || (size_t)out_size != OUT_TOTAL || ws_size < WS_TOTAL) { fprintf(stderr, "kernel_launch: unexpected shapes (n_in %d out %d ws %zu, need ws %zu)\n", n_in, out_size, ws_size, (size_t)WS_END); grid = -1; return; }
    int dev = 0, cus = 0, per_cu = 0;
    hipGetDevice(&dev); hipDeviceGetAttribute(&cus, hipDeviceAttributeMultiprocessorCount, dev);
    hipFuncSetAttribute((const void*)mk_fwd, hipFuncAttributeMaxDynamicSharedMemorySize, LDS_BYTES);
    hipOccupancyMaxActiveBlocksPerMultiprocessor(&per_cu, (const void*)mk_fwd, NTHREADS, LDS_BYTES);
    if (per_cu < 1 || cus < 1) { fprintf(stderr, "kernel_launch: occupancy query gave %d blocks/CU on %d CUs\n", per_cu, cus); grid = -1; return; }
    grid = cus * (per_cu > 1 ? 1 : per_cu);
  }
  if (grid < 0) return;
  Params p{};
  const float** pp = (const float**)&p;
  for (int i = 0; i < 22; ++i) pp[i] = (const float*)d_in[i];
  p.out = (float*)d_out; p.ws = (unsigned char*)d_ws;
  if (hipMemsetAsync((char*)d_ws + WS_BAR, 0, 16384, stream) != hipSuccess) { fprintf(stderr, "kernel_launch: memset of barrier words failed\n"); return; }
  void* args[] = {&p};
  hipError_t e = hipLaunchCooperativeKernel((void*)mk_fwd, dim3(grid), dim3(NTHREADS), args, LDS_BYTES, stream);
  if (e != hipSuccess) fprintf(stderr, "cooperative launch failed: %s (grid %d)\n", hipGetErrorString(e), grid);
}
```

```cpp
#include <hip/hip_runtime.h>
#include <hip/hip_cooperative_groups.h>
#include <cstdio>
#include <cstdint>


namespace cg = cooperative_groups;

#define LAS __attribute__((address_space(3)))
typedef unsigned short bf16_t;
typedef short bf16x8 __attribute__((ext_vector_type(8)));
typedef short s16x4 __attribute__((ext_vector_type(4)));
typedef float f32x4 __attribute__((ext_vector_type(4)));
typedef float f32x16 __attribute__((ext_vector_type(16)));
typedef unsigned u32x4 __attribute__((ext_vector_type(4)));
typedef unsigned u32x2 __attribute__((ext_vector_type(2)));
typedef float f32x2_t __attribute__((ext_vector_type(2)));
typedef __bf16 bf16x2_t __attribute__((ext_vector_type(2)));

constexpr int D = 1024, NBATCH = 32, SEQ = 2048, MP = NBATCH * SEQ, DB = 16, DSQ = 16, MS = DB * DSQ, MT = MP + MS, PAST = 4096;
constexpr int NIN = 2304, FF = 2816, NGU = 2 * FF;
constexpr int LROW = 4352, BROW = 768;
constexpr int MLAT = MP + DB * LROW, MBND = MP + DB * BROW;
constexpr float EPS = 1e-6f, LOG2E = 1.4426950408889634f;
constexpr float QSCALE_A = 0.10206207261596575f * LOG2E;
constexpr float QSCALE_B = 0.125f * LOG2E;
constexpr int NTHREADS = 512;
constexpr size_t OFF_Y = 0, OFF_CKVP = (size_t)MT * D, OFF_KRP = OFF_CKVP + (size_t)MP * 256, OFF_BKP = OFF_KRP + (size_t)MP * 32,
                 OFF_BVP = OFF_BKP + (size_t)NBATCH * 512 * 512, OFF_CKVS = OFF_BVP + (size_t)NBATCH * 512 * 512, OFF_KRS = OFF_CKVS + (size_t)MS * 256,
                 OFF_BKS = OFF_KRS + (size_t)MS * 32, OFF_BVS = OFF_BKS + (size_t)MS * 512, OUT_TOTAL = OFF_BVS + (size_t)MS * 512;
constexpr size_t al256(size_t x) { return (x + 255) & ~(size_t)255; }
constexpr size_t WS_SSQ = 0;
constexpr size_t WS_WIN = al256(WS_SSQ + 4 * (size_t)MT * 4);
constexpr size_t WS_WUQ = al256(WS_WIN + (size_t)NIN * 1024 * 2);
constexpr size_t WS_WKV = al256(WS_WUQ + (size_t)768 * 256 * 2);
constexpr size_t WS_WO = al256(WS_WKV + (size_t)1024 * 256 * 2);
constexpr size_t WS_WGU = al256(WS_WO + (size_t)1024 * 1024 * 2);
constexpr size_t WS_WD = al256(WS_WGU + (size_t)NGU * 1024 * 2);
constexpr size_t WS_X1B = al256(WS_WD + (size_t)1024 * FF * 2);
constexpr size_t WS_XN = al256(WS_X1B + (size_t)MT * 1024 * 2);
constexpr size_t WS_CQN = al256(WS_XN + (size_t)MT * 1024 * 2);
constexpr size_t WS_CKV = al256(WS_CQN + (size_t)MT * 256 * 2);
constexpr size_t WS_KR = al256(WS_CKV + (size_t)MLAT * 256 * 2);
constexpr size_t WS_QB = al256(WS_KR + (size_t)MLAT * 32 * 2);
constexpr size_t WS_KB = al256(WS_QB + (size_t)MT * 512 * 2);
constexpr size_t WS_VB = al256(WS_KB + (size_t)MBND * 512 * 2);
constexpr size_t WS_Q = al256(WS_VB + (size_t)MBND * 512 * 2);
constexpr size_t WS_KN = al256(WS_Q + (size_t)MT * 768 * 2);
constexpr size_t WS_V = al256(WS_KN + (size_t)MLAT * 512 * 2);
constexpr size_t WS_END = al256(WS_V + (size_t)MLAT * 512 * 2);
constexpr size_t WS_BAR = WS_END;
constexpr size_t WS_TOTAL = WS_END + 16384;
constexpr size_t WS_H = WS_XN;
static_assert(WS_H + (size_t)MT * FF * 2 <= WS_VB, "H overlay must end before anything live in P5/P6 (nothing is, but keep it inside dead buffers)");
static_assert(WS_TOTAL <= (size_t)1073741824, "workspace");

constexpr int LDS_GEMM = 131072, LDS_RED = LDS_GEMM, LDS_BYTES = 143360;
constexpr int KP_A = 208, KP_B = 144;
constexpr int AT_TILE = 0, AT_PRIV = 21504  , AT_QT = 51200  , AT_BIAS = 86016  , AT_WSF = 107008, AT_OSTG = 109056, AT_CMB = 141824;
static_assert(AT_CMB + 1024 <= LDS_BYTES, "attention LDS map");

struct Params {
  const float *xp, *xs, *c_ckv, *c_kr, *c_bk, *c_bv, *w_in, *g_attn, *g_q, *w_uq, *g_kv, *w_uk, *w_uv, *rel_bias, *g_out_a, *g_out_b, *w_out, *g_ffn,
      *w_gate, *w_up, *w_down, *g_final;
  float* out; unsigned char* ws;
};

typedef const __attribute__((address_space(4))) Params* ParamsC;
__device__ __forceinline__ unsigned f2bf(float f) { unsigned u = __builtin_bit_cast(unsigned, f); return (u + 0x7fffu + ((u >> 16) & 1u)) >> 16; }
__device__ __forceinline__ unsigned pk2(float lo, float hi) { f32x2_t v = {lo, hi}; bf16x2_t b = __builtin_convertvector(v, bf16x2_t); return __builtin_bit_cast(unsigned, b); }
__device__ __forceinline__ float bf2f(unsigned short b) { return __builtin_bit_cast(float, (unsigned)b << 16); }
__device__ __forceinline__ int maprow_lat(int row) { return row < MP ? row : MP + ((row - MP) >> 4) * LROW + PAST + ((row - MP) & 15); }
__device__ __forceinline__ int maprow_bnd(int row) { return row < MP ? row : MP + ((row - MP) >> 4) * BROW + 512 + ((row - MP) & 15); }
__device__ __forceinline__ int row_pos(int row) { return row < MP ? (row & (SEQ - 1)) : PAST + ((row - MP) & 15); }
__device__ __forceinline__ void rope_cs(int pos, int i, float& c, float& s) {
  const float inv = __builtin_amdgcn_exp2f(-(float)i * (13.287712379549449f / 16.0f));
  float rev = (float)pos * inv * 0.15915494309189535f; rev = rev - __builtin_floorf(rev);
  s = __builtin_amdgcn_sinf(rev); c = __builtin_amdgcn_cosf(rev);
}

namespace pg8 {
constexpr int BM = 256, BK = 64, HALF = 128, HTB = HALF * BK * 2, STAGE_BYTES = 8 * HTB, NXCD = 8, WGM = 8;
__host__ __device__ __forceinline__ int lds_byte(int r, int c) { const int st = (r >> 4) * 2 + (c >> 5), rr = r & 15, cc = c & 31, ob = rr * 64 + cc * 2; return st * 1024 + (ob ^ (((ob >> 9) & 1) << 5)); }
__host__ __device__ __forceinline__ void stage_rc(int b, int& R, int& C) { const int st = b / 1024, sb = b % 1024, swz = sb ^ (((sb >> 9) & 1) << 5); R = (st >> 1) * 16 + swz / 64; C = (st & 1) * 32 + (swz % 64) / 2; }
struct Unit { int pm, pn, koff; };
struct Gemm { const bf16_t* A; const bf16_t* Bt; int lda, ldb, K; };
struct StaticOrder {
  int nM, nN, nwg, G, c;
  __device__ void init(int M, int N, int G_, int c_) { nM = M / BM; nN = N / BM; nwg = nM * nN; G = G_; c = c_; }
  __device__ bool next(int i, Unit& u) const {
    const long L = (long)i * G + c; if (L >= nwg) return false;
    int wgid = (int)L; { const int q = nwg / NXCD, r = nwg % NXCD, xcd = wgid % NXCD, off = wgid / NXCD; wgid = (xcd < r ? xcd * (q + 1) : r * (q + 1) + (xcd - r) * q) + off; }
    const int nig = WGM * nN, gid = wgid / nig, fm = gid * WGM, gsz = (nM - fm) < WGM ? (nM - fm) : WGM;
    u.pm = fm + ((wgid % nig) % gsz); u.pn = (wgid % nig) / gsz; u.koff = 0; return true;
  }
};
struct SplitOrder {
  int pm, nN, nsub, kchunk, G, c;
  __device__ bool next(int i, Unit& u) const { const int s = i * G + c; if (s >= nsub) return false; u.pm = pm; u.pn = s % nN; u.koff = (s / nN) * kchunk; return true; }
};
template <class Epi, class Order>
__device__ __forceinline__ void gemm_phase(LAS unsigned char* lds, const Gemm g, const Order& S, Epi& E) {
  int tid_ = threadIdx.x; asm volatile("" : "+v"(tid_));
  const int tid = tid_, wid = __builtin_amdgcn_readfirstlane(tid >> 6), lane = tid & 63, wr = wid >> 2, wc = wid & 3, fr = lane & 15, fq = lane >> 4;
  int K_ = g.K; asm volatile("" : "+s"(K_));
  const int K = K_, nt = K / BK;
  int lda_ = g.lda, ldb_ = g.ldb; asm volatile("" : "+s"(lda_), "+s"(ldb_));
  unsigned voffA[2];
#pragma unroll
  for (int i = 0; i < 2; ++i) { int R, C; stage_rc(tid * 16 + i * 8192, R, C); voffA[i] = (unsigned)(R * lda_ + C) * 2u; }
  const size_t kstep = (size_t)(BK * 2), hstepA = (size_t)HALF * lda_ * 2, tstepA = 2 * hstepA, hstepB = (size_t)HALF * ldb_ * 2, tstepB = 2 * hstepB;
  const unsigned ldsw = (unsigned)wid * 1024u;
  const int aoff = lds_byte(wr * 64 + fr, fq * 8), boff = lds_byte(wc * 32 + fr, fq * 8);
#define PG8_SA(b, h) (((b) * 2 + (h)) * HTB)
#define PG8_SB(b, h) ((4 + (b) * 2 + (h)) * HTB)
#define PG8_STAGE_(bufoff, gbase, voff) do { _Pragma("unroll") for (int _i = 0; _i < 2; ++_i) \
    __builtin_amdgcn_global_load_lds((const unsigned*)((const char*)(gbase) + (voff)[_i]), (LAS unsigned*)(lds + (bufoff) + ldsw + _i * 8192), 16, 0, 0); } while (0)
#define PG8_STA(bufoff, gbase) PG8_STAGE_(bufoff, gbase, voffA)
#define PG8_STB(bufoff, gbase) PG8_STAGE_(bufoff, gbase, voffA)
#define PG8_LDA(dst, b, h) do { _Pragma("unroll") for (int m = 0; m < 4; ++m) _Pragma("unroll") for (int k = 0; k < 2; ++k) dst[m][k] = *(const LAS bf16x8*)(lds + PG8_SA(b, h) + aoff + m * 2048 + k * 1024); } while (0)
#define PG8_LDB(dst, b, h) do { _Pragma("unroll") for (int n = 0; n < 2; ++n) _Pragma("unroll") for (int k = 0; k < 2; ++k) dst[n][k] = *(const LAS bf16x8*)(lds + PG8_SB(b, h) + boff + n * 2048 + k * 1024); } while (0)
#define PG8_MMA(ai, bj, At, Bt) do { __builtin_amdgcn_s_setprio(1); _Pragma("unroll") for (int m = 0; m < 4; ++m) _Pragma("unroll") for (int n = 0; n < 2; ++n) _Pragma("unroll") for (int k = 0; k < 2; ++k) \
    acc[ai][bj][m][n] = __builtin_amdgcn_mfma_f32_16x16x32_bf16(Bt[n][k], At[m][k], acc[ai][bj][m][n], 0, 0, 0); __builtin_amdgcn_s_setprio(0); } while (0)
#define PG8_WAIT_V(n) asm volatile("s_waitcnt vmcnt(" #n ")" ::: "memory")
#define PG8_WAIT_L(n) asm volatile("s_waitcnt lgkmcnt(" #n ")" ::: "memory")
#define PG8_BAR __builtin_amdgcn_s_barrier()
#define PG8_SCHED __builtin_amdgcn_sched_barrier(0)
  Unit cur, nxt; int ui = 0;
  if (!S.next(0, cur)) return;
  f32x4 acc[2][2][4][2];
#pragma unroll
  for (int a = 0; a < 2; ++a)
#pragma unroll
    for (int b = 0; b < 2; ++b)
#pragma unroll
      for (int m = 0; m < 4; ++m)
#pragma unroll
        for (int n = 0; n < 2; ++n) acc[a][b][m][n] = (f32x4){0.f, 0.f, 0.f, 0.f};
  bf16x8 At[4][2], B0[2][2], B1[2][2];
  const char* cA = (const char*)g.A + (size_t)cur.pm * tstepA + (size_t)cur.koff * 2; const char* cB = (const char*)g.Bt + (size_t)cur.pn * tstepB + (size_t)cur.koff * 2;
  PG8_STB(PG8_SB(0, 0), cB); PG8_STB(PG8_SB(0, 1), cB + hstepB); PG8_STA(PG8_SA(0, 0), cA); PG8_STA(PG8_SA(0, 1), cA + hstepA);
  if (wr == 1) PG8_BAR;
  PG8_WAIT_V(2); PG8_BAR;
  PG8_STB(PG8_SB(1, 0), cB + kstep); PG8_STA(PG8_SA(1, 0), cA + kstep); PG8_STB(PG8_SB(1, 1), cB + hstepB + kstep);
  PG8_WAIT_V(6); PG8_BAR;
  for (;;) {
    const bool has_next = S.next(ui + 1, nxt);
    const char* nA = has_next ? (const char*)g.A + (size_t)nxt.pm * tstepA + (size_t)nxt.koff * 2 : cA; const char* nB = has_next ? (const char*)g.Bt + (size_t)nxt.pn * tstepB + (size_t)nxt.koff * 2 : cB;
    for (int t = 0; t < nt; t += 2) {
      const bool last = (t == nt - 2);
      const char* a1 = cA + (size_t)(t + 1) * kstep;
      const char* a2 = last ? nA : cA + (size_t)(t + 2) * kstep; const char* b2 = last ? nB : cB + (size_t)(t + 2) * kstep;
      const char* a3 = a2 + kstep; const char* b3 = b2 + kstep;
      if constexpr (Epi::HAS_PRE) { if (t == 0) E.pre_load(cur, tid); if (t == 2) E.pre_store(ui, tid); }
      if constexpr (Epi::HAS_MID) { if (t == E.tsplit) { asm volatile("" : "+s"(cur.pm)); E.mid(acc, cur, wr, wc, fr, fq); } }
      PG8_LDB(B0, 0, 0); PG8_LDB(B1, 0, 1); PG8_SCHED; PG8_LDA(At, 0, 0); PG8_STA(PG8_SA(1, 1), a1 + hstepA);
      PG8_WAIT_V(8); PG8_WAIT_L(0); PG8_BAR; PG8_MMA(0, 0, At, B0); PG8_MMA(0, 1, At, B1); PG8_BAR; PG8_SCHED;
      PG8_LDA(At, 0, 1); PG8_STB(PG8_SB(0, 0), b2); PG8_STB(PG8_SB(0, 1), b2 + hstepB); PG8_STA(PG8_SA(0, 0), a2);
      PG8_WAIT_V(8); PG8_WAIT_L(0); PG8_BAR; PG8_MMA(1, 0, At, B0); PG8_MMA(1, 1, At, B1); PG8_BAR; PG8_SCHED;
      PG8_LDB(B0, 1, 0); PG8_LDB(B1, 1, 1); PG8_SCHED; PG8_LDA(At, 1, 0); PG8_STA(PG8_SA(0, 1), a2 + hstepA);
      PG8_WAIT_V(8); PG8_WAIT_L(0); PG8_BAR; PG8_MMA(0, 0, At, B0); PG8_MMA(0, 1, At, B1); PG8_BAR; PG8_SCHED;
      PG8_LDA(At, 1, 1); PG8_STB(PG8_SB(1, 0), b3); PG8_STB(PG8_SB(1, 1), b3 + hstepB); PG8_STA(PG8_SA(1, 0), a3);
      PG8_WAIT_V(8); PG8_WAIT_L(0); PG8_BAR; PG8_MMA(1, 0, At, B0); PG8_MMA(1, 1, At, B1); PG8_BAR; PG8_SCHED;
    }
    if (wr == 0) PG8_BAR;
    asm volatile("" : "+s"(cur.pm), "+s"(cur.pn));
    E(acc, cur, wr, wc, fr, fq);
    if (!has_next) break;
#pragma unroll
    for (int a = 0; a < 2; ++a)
#pragma unroll
      for (int b = 0; b < 2; ++b)
#pragma unroll
        for (int m = 0; m < 4; ++m)
#pragma unroll
          for (int n = 0; n < 2; ++n) acc[a][b][m][n] = (f32x4){0.f, 0.f, 0.f, 0.f};
    cur = nxt; cA = nA; cB = nB; ++ui;
    if (wr == 1) PG8_BAR;
  }
  PG8_WAIT_V(0);
  PG8_BAR;
#undef PG8_SA
#undef PG8_SB
#undef PG8_STAGE_
#undef PG8_STA
#undef PG8_STB
#undef PG8_LDA
#undef PG8_LDB
#undef PG8_MMA
#undef PG8_WAIT_V
#undef PG8_WAIT_L
#undef PG8_BAR
#undef PG8_SCHED
}
}
using pg8::Unit;
typedef f32x4 Acc[2][2][4][2];
#define FOR_AM _Pragma("unroll") for (int ai = 0; ai < 2; ++ai) _Pragma("unroll") for (int m = 0; m < 4; ++m)
#define FOR_BN _Pragma("unroll") for (int bj = 0; bj < 2; ++bj) _Pragma("unroll") for (int n = 0; n < 2; ++n)
__device__ __forceinline__ void st_bf4(bf16_t* p, f32x4 v) { u32x2 w; w.x = pk2(v[0], v[1]); w.y = pk2(v[2], v[3]); *(u32x2*)p = w; }
__device__ __forceinline__ void st_bf8(bf16_t* p, f32x4 a, f32x4 b) { u32x4 w; w.x = pk2(a[0], a[1]); w.y = pk2(a[2], a[3]); w.z = pk2(b[0], b[1]); w.w = pk2(b[2], b[3]); *(u32x4*)p = w; }
__device__ __forceinline__ void st_bf4x2(bf16_t* pa, f32x4 a, bf16_t* pb, f32x4 b, int fq) {
  const unsigned A0 = pk2(a[0], a[1]), A1 = pk2(a[2], a[3]), B0 = pk2(b[0], b[1]), B1 = pk2(b[2], b[3]);
  const auto r0 = __builtin_amdgcn_permlane16_swap(A0, B0, false, false);
  const auto r1 = __builtin_amdgcn_permlane16_swap(A1, B1, false, false);
  u32x4 w; w.x = r0[0]; w.y = r1[0]; w.z = r0[1]; w.w = r1[1];
  *(u32x4*)((fq & 1) ? pb - 4 : pa) = w;
}
__device__ __forceinline__ void atomic_addf(float* p, float v) { __hip_atomic_fetch_add(p, v, __ATOMIC_RELAXED, __HIP_MEMORY_SCOPE_AGENT); }

struct EpiIn {
  static constexpr bool HAS_MID = false, HAS_PRE = false;
  float* out; bf16_t *CQN, *CKV, *KR, *QB, *KB, *VB; const float* g_kv; LAS float* red;
  __device__ __forceinline__ void operator()(const Acc& acc, const Unit& u, int wr, int wc, int fr, int fq) const {
    const int pn = u.pn, rbase = u.pm * 256 + wr * 64 + fr, cw = wc * 32 + 4 * fq;
    if (pn <= 1) {
      FOR_AM { float s = 0.f; FOR_BN { const f32x4 x = acc[ai][bj][m][n]; s += (x[0] * x[0] + x[1] * x[1]) + (x[2] * x[2] + x[3] * x[3]); }
        s += __shfl_xor(s, 16); s += __shfl_xor(s, 32);
        if (fq == 0) red[(ai * 128 + wr * 64 + m * 16 + fr) * 4 + wc] = s; }
      asm volatile("s_waitcnt lgkmcnt(0)" ::: "memory"); __builtin_amdgcn_s_barrier(); asm volatile("" ::: "memory");
      FOR_AM { const f32x4 t = *(const LAS f32x4*)(red + (ai * 128 + wr * 64 + m * 16 + fr) * 4);
        const float rstd = __builtin_amdgcn_rsqf(((t[0] + t[1]) + (t[2] + t[3])) * (1.0f / 256.0f) + EPS);
        const int row = rbase + ai * 128 + m * 16;
        if (pn == 0) {
#pragma unroll
          for (int bj = 0; bj < 2; ++bj) { bf16_t* q = CQN + (size_t)row * 256 + bj * 128 + cw; st_bf4x2(q, acc[ai][bj][m][0] * rstd, q + 16, acc[ai][bj][m][1] * rstd, fq); } }
        else { const int mr = maprow_lat(row); float* o = row < MP ? out + OFF_CKVP + (size_t)row * 256 : out + OFF_CKVS + (size_t)(row - MP) * 256;
#pragma unroll
          for (int bj = 0; bj < 2; ++bj) { const int col = bj * 128 + cw; const f32x4 v0 = acc[ai][bj][m][0] * rstd * *(const f32x4*)(g_kv + col), v1 = acc[ai][bj][m][1] * rstd * *(const f32x4*)(g_kv + col + 16);
            *(f32x4*)(o + col) = v0; *(f32x4*)(o + col + 16) = v1; st_bf4x2(CKV + (size_t)mr * 256 + col, v0, CKV + (size_t)mr * 256 + col + 16, v1, fq); } } }
      asm volatile("s_waitcnt lgkmcnt(0)" ::: "memory"); __builtin_amdgcn_s_barrier(); asm volatile("" ::: "memory");
    } else if (pn <= 3) {
      FOR_AM { const int row = rbase + ai * 128 + m * 16;
#pragma unroll
        for (int bj = 0; bj < 2; ++bj) { bf16_t* q = QB + (size_t)row * 512 + (pn - 2) * 256 + bj * 128 + cw; st_bf4x2(q, acc[ai][bj][m][0] * QSCALE_B, q + 16, acc[ai][bj][m][1] * QSCALE_B, fq); } }
    } else if (pn <= 7) {
      const bool isv = pn >= 6; bf16_t* dst = isv ? VB : KB; const int c0 = (pn & 1) * 256;
      FOR_AM { const int row = rbase + ai * 128 + m * 16; const int mr = maprow_bnd(row);
        float* o = nullptr;
        if (row >= MP) o = out + (isv ? OFF_BVS : OFF_BKS) + (size_t)(row - MP) * 512;
        else if ((row & (SEQ - 1)) >= SEQ - 512) o = out + (isv ? OFF_BVP : OFF_BKP) + ((size_t)(row >> 11) * 512 + ((row & (SEQ - 1)) - (SEQ - 512))) * 512;
#pragma unroll
        for (int bj = 0; bj < 2; ++bj) { const int col = c0 + bj * 128 + cw; st_bf4x2(dst + (size_t)mr * 512 + col, acc[ai][bj][m][0], dst + (size_t)mr * 512 + col + 16, acc[ai][bj][m][1], fq);
          if (o) { *(f32x4*)(o + col) = acc[ai][bj][m][0]; *(f32x4*)(o + col + 16) = acc[ai][bj][m][1]; } } }
    } else {
      if (wc == 0) {
        FOR_AM { const int row = rbase + ai * 128 + m * 16; const int pos = row_pos(row), mr = maprow_lat(row);
          float* o = row < MP ? out + OFF_KRP + (size_t)row * 32 : out + OFF_KRS + (size_t)(row - MP) * 32;
          const f32x4 x1 = acc[ai][0][m][0], x2 = acc[ai][0][m][1]; f32x4 y1, y2;
#pragma unroll
          for (int j = 0; j < 4; ++j) { float c, s; rope_cs(pos, 4 * fq + j, c, s); y1[j] = x1[j] * c - x2[j] * s; y2[j] = x1[j] * s + x2[j] * c; }
          *(f32x4*)(o + 4 * fq) = y1; *(f32x4*)(o + 16 + 4 * fq) = y2;
          st_bf4x2(KR + (size_t)mr * 32 + 4 * fq, y1, KR + (size_t)mr * 32 + 16 + 4 * fq, y2, fq); }
      }
    }
  }
};
struct EpiQ {
  static constexpr bool HAS_MID = false, HAS_PRE = false;
  bf16_t* Q;
  __device__ __forceinline__ void operator()(const Acc& acc, const Unit& u, int wr, int wc, int fr, int fq) const {
    const int pn = u.pn, rbase = u.pm * 256 + wr * 64 + fr;
    if (pn <= 1) {
      FOR_AM { const int row = rbase + ai * 128 + m * 16;
#pragma unroll
        for (int bj = 0; bj < 2; ++bj) { const int col = pn * 256 + bj * 128 + wc * 32 + 4 * fq; bf16_t* q = Q + (size_t)row * 768 + (col >> 6) * 96 + (col & 63);
          st_bf4x2(q, acc[ai][bj][m][0] * QSCALE_A, q + 16, acc[ai][bj][m][1] * QSCALE_A, fq); } }
    } else {
      FOR_AM { const int row = rbase + ai * 128 + m * 16; const int pos = row_pos(row);
        float cs[4], sn[4];
#pragma unroll
        for (int j = 0; j < 4; ++j) rope_cs(pos, 4 * fq + j, cs[j], sn[j]);
#pragma unroll
        for (int bj = 0; bj < 2; ++bj) { const int head = 4 * bj + wc; const f32x4 x1 = acc[ai][bj][m][0], x2 = acc[ai][bj][m][1]; f32x4 y1, y2;
#pragma unroll
          for (int j = 0; j < 4; ++j) { y1[j] = (x1[j] * cs[j] - x2[j] * sn[j]) * QSCALE_A; y2[j] = (x1[j] * sn[j] + x2[j] * cs[j]) * QSCALE_A; }
          bf16_t* q = Q + (size_t)row * 768 + head * 96 + 64 + 4 * fq; st_bf4x2(q, y1, q + 16, y2, fq); } __builtin_amdgcn_sched_barrier(0); }
    }
  }
};
struct EpiKV {
  static constexpr bool HAS_MID = false, HAS_PRE = false;
  bf16_t *KN, *V;
  __device__ __forceinline__ void operator()(const Acc& acc, const Unit& u, int wr, int wc, int fr, int fq) const {
    const int pn = u.pn, rbase = u.pm * 256 + wr * 64 + fr; bf16_t* dst = pn >= 2 ? V : KN; const int c0 = (pn & 1) * 256 + wc * 32 + 4 * fq;
    FOR_AM { const int row = rbase + ai * 128 + m * 16;
#pragma unroll
      for (int bj = 0; bj < 2; ++bj) { bf16_t* q = dst + (size_t)row * 512 + c0 + bj * 128; st_bf4x2(q, acc[ai][bj][m][0], q + 16, acc[ai][bj][m][1], fq); } }
  }
};
struct EpiO {
  static constexpr bool HAS_MID = true, HAS_PRE = true;
  int tsplit; const float *ssq_a, *ssq_b, *xp, *xs; bf16_t* X1B; float* ssq_x1; LAS float* pre; float p0, p1; int par;
  __device__ __forceinline__ void pre_load(const Unit& u, int tid) { if (tid < 256) { p0 = ssq_a[u.pm * 256 + tid]; p1 = ssq_b[u.pm * 256 + tid]; } }
  __device__ __forceinline__ void pre_store(int ui, int tid) { par = ui & 1; if (tid < 256) { pre[par * 512 + tid] = p0; pre[par * 512 + 256 + tid] = p1; } }
  __device__ __forceinline__ void mid(Acc& acc, const Unit& u, int wr, int wc, int fr, int fq) const {
    FOR_AM { const int rl = par * 512 + ai * 128 + wr * 64 + m * 16 + fr;
      const float ratio = __builtin_amdgcn_rsqf(pre[rl] * (1.0f / 512.0f) + EPS) * __builtin_sqrtf(pre[rl + 256] * (1.0f / 512.0f) + EPS);
      FOR_BN { acc[ai][bj][m][n] = acc[ai][bj][m][n] * ratio; }
      __builtin_amdgcn_sched_barrier(0); }
  }
  __device__ __forceinline__ void operator()(const Acc& acc, const Unit& u, int wr, int wc, int fr, int fq) const {
    const int rbase = u.pm * 256 + wr * 64 + fr, c0 = u.pn * 256 + wc * 32 + 4 * fq;
    FOR_AM { const int row = rbase + ai * 128 + m * 16; const float rb = __builtin_amdgcn_rsqf(pre[par * 512 + 256 + ai * 128 + wr * 64 + m * 16 + fr] * (1.0f / 512.0f) + EPS);
      const float* xr = row < MP ? xp + (size_t)row * D : xs + (size_t)(row - MP) * D; float s = 0.f;
#pragma unroll
      for (int bj = 0; bj < 2; ++bj) { const int col = c0 + bj * 128; const f32x4 v0 = *(const f32x4*)(xr + col) + acc[ai][bj][m][0] * rb, v1 = *(const f32x4*)(xr + col + 16) + acc[ai][bj][m][1] * rb;
        st_bf4x2(X1B + (size_t)row * D + col, v0, X1B + (size_t)row * D + col + 16, v1, fq);
        s += ((v0[0] * v0[0] + v0[1] * v0[1]) + (v0[2] * v0[2] + v0[3] * v0[3])) + ((v1[0] * v1[0] + v1[1] * v1[1]) + (v1[2] * v1[2] + v1[3] * v1[3])); }
      s += __shfl_xor(s, 16); s += __shfl_xor(s, 32); if (fq == 0) atomic_addf(ssq_x1 + row, s); __builtin_amdgcn_sched_barrier(0); }
  }
};
struct EpiGU {
  static constexpr bool HAS_MID = false, HAS_PRE = true;
  const float* ssq_x1; bf16_t* H; LAS float* pre; float p0; int par;
  __device__ __forceinline__ void pre_load(const Unit& u, int tid) { if (tid < 256) p0 = ssq_x1[u.pm * 256 + tid]; }
  __device__ __forceinline__ void pre_store(int ui, int tid) { par = ui & 1; if (tid < 256) pre[par * 512 + tid] = p0; }
  __device__ __forceinline__ void operator()(const Acc& acc, const Unit& u, int wr, int wc, int fr, int fq) const {
    const int rbase = u.pm * 256 + wr * 64 + fr, c0 = u.pn * 128 + wc * 16 + 4 * fq;
    FOR_AM { const int row = rbase + ai * 128 + m * 16; const float rstd = __builtin_amdgcn_rsqf(pre[par * 512 + ai * 128 + wr * 64 + m * 16 + fr] * (1.0f / 1024.0f) + EPS);
      f32x4 hv[2];
#pragma unroll
      for (int bj = 0; bj < 2; ++bj) { const f32x4 g = acc[ai][bj][m][0] * rstd, up = acc[ai][bj][m][1] * rstd;
#pragma unroll
        for (int j = 0; j < 4; ++j) hv[bj][j] = g[j] * __builtin_amdgcn_rcpf(1.0f + __builtin_amdgcn_exp2f(-g[j] * LOG2E)) * up[j]; }
      st_bf4x2(H + (size_t)row * FF + c0, hv[0], H + (size_t)row * FF + c0 + 64, hv[1], fq); }
  }
};
__device__ __forceinline__ f32x4 ld_bf4(const bf16_t* p) { const u32x2 w = *(const u32x2*)p; return (f32x4){__builtin_bit_cast(float, w.x << 16), __builtin_bit_cast(float, w.x & 0xffff0000u), __builtin_bit_cast(float, w.y << 16), __builtin_bit_cast(float, w.y & 0xffff0000u)}; }
__device__ __forceinline__ void ld_bf4x2(const bf16_t* pa, const bf16_t* pb, int fq, f32x4& a, f32x4& b) {
  const u32x4 w = *(const u32x4*)((fq & 1) ? pb - 4 : pa);
  const auto r0 = __builtin_amdgcn_permlane16_swap(w.x, w.z, false, false);
  const auto r1 = __builtin_amdgcn_permlane16_swap(w.y, w.w, false, false);
  a = (f32x4){__builtin_bit_cast(float, r0[0] << 16), __builtin_bit_cast(float, r0[0] & 0xffff0000u), __builtin_bit_cast(float, r1[0] << 16), __builtin_bit_cast(float, r1[0] & 0xffff0000u)};
  b = (f32x4){__builtin_bit_cast(float, r0[1] << 16), __builtin_bit_cast(float, r0[1] & 0xffff0000u), __builtin_bit_cast(float, r1[1] << 16), __builtin_bit_cast(float, r1[1] & 0xffff0000u)};
}
struct EpiD {
  static constexpr bool HAS_MID = false, HAS_PRE = false;
  bf16_t* X; float* ssq_x2;
  __device__ __forceinline__ void operator()(const Acc& acc, const Unit& u, int wr, int wc, int fr, int fq) const {
    const int rbase = u.pm * 256 + wr * 64 + fr, c0 = u.pn * 256 + wc * 32 + 4 * fq;
    FOR_AM { const int row = rbase + ai * 128 + m * 16; float s = 0.f;
#pragma unroll
      for (int bj = 0; bj < 2; ++bj) { bf16_t* x = X + (size_t)row * D + c0 + bj * 128; f32x4 x0, x1; ld_bf4x2(x, x + 16, fq, x0, x1); const f32x4 v0 = x0 + acc[ai][bj][m][0], v1 = x1 + acc[ai][bj][m][1];
        st_bf4x2(x, v0, x + 16, v1, fq);
        s += ((v0[0] * v0[0] + v0[1] * v0[1]) + (v0[2] * v0[2] + v0[3] * v0[3])) + ((v1[0] * v1[0] + v1[1] * v1[1]) + (v1[2] * v1[2] + v1[3] * v1[3])); }
      s += __shfl_xor(s, 16); s += __shfl_xor(s, 32); if (fq == 0) atomic_addf(ssq_x2 + row, s); }
  }
};
struct EpiPart {
  static constexpr bool HAS_MID = false, HAS_PRE = false;
  float* PART;
  __device__ __forceinline__ void operator()(const Acc& acc, const Unit& u, int wr, int wc, int fr, int fq) const {
    float* base = PART + (size_t)(u.koff >> 8) * 256 * D; const int r0 = wr * 64 + fr, c0 = u.pn * 256 + wc * 32 + 4 * fq;
    FOR_AM { FOR_BN { *(f32x4*)(base + (size_t)(r0 + ai * 128 + m * 16) * D + c0 + bj * 128 + n * 16) = acc[ai][bj][m][n]; } }
  }
};

__device__ __forceinline__ float wave_sum(float v) {
#pragma unroll
  for (int o = 1; o < 64; o <<= 1) v += __shfl_xor(v, o);
  return v;
}
template <class Map>
__device__ __forceinline__ void transpose_item(const float* W, int K, int N, bf16_t* WT, const float* g, LAS float* scr, int item, int lane, Map map) {
  const int nblk = N / 32, kb = item / nblk, nb = item % nblk, k0 = 64 * kb, n0 = 32 * nb;
  f32x4 wv[8];
#pragma unroll
  for (int i = 0; i < 8; ++i) { const int kk = 8 * i + (lane >> 3); wv[i] = *(const f32x4*)(W + (size_t)(k0 + kk) * N + n0 + 4 * (lane & 7)) * (g ? g[k0 + kk] : 1.0f); }
#pragma unroll
  for (int i = 0; i < 8; ++i) { const int kk = 8 * i + (lane >> 3); LAS float* d = scr + kk * 33 + 4 * (lane & 7); d[0] = wv[i][0]; d[1] = wv[i][1]; d[2] = wv[i][2]; d[3] = wv[i][3]; }
  asm volatile("s_waitcnt lgkmcnt(0)" ::: "memory");
  const int c = lane & 7;
#pragma unroll
  for (int j = 0; j < 4; ++j) { const int n = (lane >> 3) + 8 * j; const LAS float* s = scr + (8 * c) * 33 + n;
    u32x4 o; o.x = pk2(s[0 * 33], s[1 * 33]); o.y = pk2(s[2 * 33], s[3 * 33]); o.z = pk2(s[4 * 33], s[5 * 33]); o.w = pk2(s[6 * 33], s[7 * 33]);
    *(u32x4*)(WT + (size_t)map(n0 + n) * K + k0 + 8 * c) = o; }
  asm volatile("s_waitcnt lgkmcnt(0)" ::: "memory");
}
template <class Map>
__device__ __forceinline__ void convert_rows(const float* src, bf16_t* dst, int R, int cshift, int gt, int ngt, Map map) {
  const long n8 = ((long)R << cshift) >> 3;
  for (long i0 = gt; i0 < n8; i0 += 4L * ngt) {
    f32x4 v[4][2];
#pragma unroll
    for (int k = 0; k < 4; ++k) { const long i = i0 + (long)k * ngt; if (i < n8) { v[k][0] = *(const f32x4*)(src + i * 8); v[k][1] = *(const f32x4*)(src + i * 8 + 4); } }
#pragma unroll
    for (int k = 0; k < 4; ++k) { const long i = i0 + (long)k * ngt; if (i < n8) { const long e = i * 8; const int r = (int)(e >> cshift), c = (int)(e & ((1 << cshift) - 1));
      st_bf8(dst + ((size_t)map(r) << cshift) + c, v[k][0], v[k][1]); } }
  }
}
__device__ __forceinline__ void zero_rows(bf16_t* dst, int cshift, int r0, int nr, int nb, int bstride, int gt, int ngt) {
  const long per = ((long)nr << cshift) >> 3, n8 = per * nb;
  for (long i = gt; i < n8; i += ngt) { const int b = (int)(i / per); const long e = (i % per) * 8; *(u32x4*)(dst + (((size_t)b * bstride + r0) << cshift) + e) = (u32x4){0u, 0u, 0u, 0u}; }
}
__device__ __forceinline__ void prologue(ParamsC p, LAS unsigned char* lds, int G) {
  const int tid = threadIdx.x, lane = tid & 63, wave = tid >> 6; unsigned char* ws = p->ws;
  const int gw = blockIdx.x * 8 + wave, NGW = G * 8, gt = blockIdx.x * NTHREADS + tid, ngt = G * NTHREADS;
  LAS float* scr = (LAS float*)(lds + wave * 16384);
  bf16_t* WinT = (bf16_t*)(ws + WS_WIN); bf16_t* WuqT = (bf16_t*)(ws + WS_WUQ); bf16_t* WkvT = (bf16_t*)(ws + WS_WKV); bf16_t* WoT = (bf16_t*)(ws + WS_WO);
  bf16_t* WguT = (bf16_t*)(ws + WS_WGU); bf16_t* WdT = (bf16_t*)(ws + WS_WD);
  constexpr int I_IN = 16 * 65, I_UQ = 4 * 24, I_UK = 4 * 16, I_O = 16 * 32, I_G = 16 * 88, I_D = 44 * 32;
  constexpr int NITEMS = I_IN + I_UQ + 2 * I_UK + I_O + 2 * I_G + I_D;
  for (int it = gw; it < NITEMS; it += NGW) {
    int r = it;
    if (r < I_IN) { transpose_item(p->w_in, 1024, 2080, WinT, p->g_attn, scr, r, lane, [](int n) { return n < 512 ? n : (n < 544 ? 2048 + (n - 512) : 512 + (n - 544)); }); continue; } r -= I_IN;
    if (r < I_UQ) { transpose_item(p->w_uq, 256, 768, WuqT, p->g_q, scr, r, lane, [](int n) { const int h = n / 96, d = n % 96; return d < 64 ? h * 64 + d : 512 + h * 32 + (d - 64); }); continue; } r -= I_UQ;
    if (r < I_UK) { transpose_item(p->w_uk, 256, 512, WkvT, nullptr, scr, r, lane, [](int n) { return n; }); continue; } r -= I_UK;
    if (r < I_UK) { transpose_item(p->w_uv, 256, 512, WkvT, nullptr, scr, r, lane, [](int n) { return 512 + n; }); continue; } r -= I_UK;
    if (r < I_O) { const int kb = r / 32; transpose_item(p->w_out, 1024, 1024, WoT, kb < 8 ? p->g_out_a : p->g_out_b - 512, scr, r, lane, [](int n) { return n; }); continue; } r -= I_O;
    if (r < I_G) { transpose_item(p->w_gate, 1024, FF, WguT, p->g_ffn, scr, r, lane, [](int n) { return 32 * (n >> 4) + (n & 15); }); continue; } r -= I_G;
    if (r < I_G) { transpose_item(p->w_up, 1024, FF, WguT, p->g_ffn, scr, r, lane, [](int n) { return 32 * (n >> 4) + 16 + (n & 15); }); continue; } r -= I_G;
    transpose_item(p->w_down, FF, 1024, WdT, nullptr, scr, r, lane, [](int n) { return n; });
  }
  zero_rows(WinT, 10, 2080, NIN - 2080, 1, 0, gt, ngt);
  bf16_t* XN = (bf16_t*)(ws + WS_XN);
  for (int row0 = gw; row0 < MT; row0 += 4 * NGW) {
    f32x4 v[4][4]; float s[4] = {0.f, 0.f, 0.f, 0.f};
#pragma unroll
    for (int k = 0; k < 4; ++k) { const int row = row0 + k * NGW; if (row < MT) { const float* xr = row < MP ? p->xp + (size_t)row * D : p->xs + (size_t)(row - MP) * D;
#pragma unroll
      for (int j = 0; j < 2; ++j) { v[k][2 * j] = *(const f32x4*)(xr + 8 * lane + 512 * j); v[k][2 * j + 1] = *(const f32x4*)(xr + 8 * lane + 512 * j + 4); } } }
#pragma unroll
    for (int k = 0; k < 4; ++k) { const int row = row0 + k * NGW; if (row < MT) {
#pragma unroll
      for (int j = 0; j < 4; ++j) s[k] += (v[k][j][0] * v[k][j][0] + v[k][j][1] * v[k][j][1]) + (v[k][j][2] * v[k][j][2] + v[k][j][3] * v[k][j][3]);
      const float rstd = __builtin_amdgcn_rsqf(wave_sum(s[k]) * (1.0f / D) + EPS);
#pragma unroll
      for (int j = 0; j < 2; ++j) st_bf8(XN + (size_t)row * D + 8 * lane + 512 * j, v[k][2 * j] * rstd, v[k][2 * j + 1] * rstd); } }
  }
  bf16_t* CKV = (bf16_t*)(ws + WS_CKV); bf16_t* KR = (bf16_t*)(ws + WS_KR); bf16_t* KB = (bf16_t*)(ws + WS_KB); bf16_t* VB = (bf16_t*)(ws + WS_VB);
  convert_rows(p->c_ckv, CKV, DB * PAST, 8, gt, ngt, [](int r) { return MP + (r >> 12) * LROW + (r & 4095); });
  convert_rows(p->c_kr, KR, DB * PAST, 5, gt, ngt, [](int r) { return MP + (r >> 12) * LROW + (r & 4095); });
  convert_rows(p->c_bk, KB, DB * 512, 9, gt, ngt, [](int r) { return MP + (r >> 9) * BROW + (r & 511); });
  convert_rows(p->c_bv, VB, DB * 512, 9, gt, ngt, [](int r) { return MP + (r >> 9) * BROW + (r & 511); });
  zero_rows(CKV + (size_t)MP * 256, 8, PAST + DSQ, LROW - PAST - DSQ, DB, LROW, gt, ngt);
  zero_rows(KR + (size_t)MP * 32, 5, PAST + DSQ, LROW - PAST - DSQ, DB, LROW, gt, ngt);
  zero_rows(KB + (size_t)MP * 512, 9, 512 + DSQ, BROW - 512 - DSQ, DB, BROW, gt, ngt);
  zero_rows(VB + (size_t)MP * 512, 9, 512 + DSQ, BROW - 512 - DSQ, DB, BROW, gt, ngt);
  float* ssq = (float*)(ws + WS_SSQ);
  for (int i = gt; i < 4 * MT; i += ngt) ssq[i] = 0.f;
}

__device__ __forceinline__ f32x16 mfma32(bf16x8 a, bf16x8 b, f32x16 c) { return __builtin_amdgcn_mfma_f32_32x32x16_bf16(a, b, c, 0, 0, 0); }
__device__ __forceinline__ s16x4 vtr(const LAS unsigned char* p) { return __builtin_bit_cast(s16x4, __builtin_amdgcn_ds_read_tr16_b64_v4i16((LAS s16x4*)p)); }
template <int NS, bool BIAS, bool QL>
__device__ __forceinline__ void attn_qk(const LAS unsigned char* Kt, const bf16x8 (&qf)[NS], const LAS unsigned char* Qt, f32x16 (&st)[2], int nvalid, const LAS float* btab, int rb, bool lookup, int lane) {
  constexpr int KP = NS == 6 ? KP_A : KP_B;
  const int r = lane & 31, h = lane >> 5;
  bf16x8 qv[NS];
#pragma unroll
  for (int s = 0; s < NS; ++s) qv[s] = QL ? *(const LAS bf16x8*)(Qt + r * KP + (2 * s + h) * 16) : qf[s];
#pragma unroll
  for (int kh = 0; kh < 2; ++kh) {
    bf16x8 kf[NS];
#pragma unroll
    for (int s = 0; s < NS; ++s) kf[s] = *(const LAS bf16x8*)(Kt + (32 * kh + r) * KP + (2 * s + h) * 16);
    __builtin_amdgcn_sched_barrier(0);
    __builtin_amdgcn_s_setprio(1);
    { const f32x16 z = {0.f, 0.f, 0.f, 0.f, 0.f, 0.f, 0.f, 0.f, 0.f, 0.f, 0.f, 0.f, 0.f, 0.f, 0.f, 0.f}; st[kh] = mfma32(kf[0], qv[0], z); }
#pragma unroll
    for (int s = 1; s < NS; ++s) st[kh] = mfma32(kf[s], qv[s], st[kh]);
    __builtin_amdgcn_s_setprio(0);
    __builtin_amdgcn_sched_barrier(0);
  }
  if (BIAS) {
    if (lookup) { const LAS float* bp = btab + rb + 4 * h;
#pragma unroll
      for (int kh = 0; kh < 2; ++kh)
#pragma unroll
        for (int i = 0; i < 16; ++i) st[kh][i] += bp[32 * kh + (i & 3) + 8 * (i >> 2)];
    } else { const float bc = btab[0];
#pragma unroll
      for (int kh = 0; kh < 2; ++kh)
#pragma unroll
        for (int i = 0; i < 16; ++i) st[kh][i] += bc; }
  }
  if (nvalid < 64) {
#pragma unroll
    for (int kh = 0; kh < 2; ++kh)
#pragma unroll
      for (int i = 0; i < 16; ++i) { const int key = 32 * kh + (i & 3) + 8 * (i >> 2) + 4 * h; if (key >= nvalid) st[kh][i] = -1e30f; }
  }
}
__device__ __forceinline__ void attn_smpv(const LAS unsigned char* Vt, f32x16 (&st)[2], f32x16 (&o)[2], float& m_run, float& l_run, LAS float* wsf, int lane) {
  const int r = lane & 31, h = lane >> 5;
  float mx = st[0][0];
#pragma unroll
  for (int kh = 0; kh < 2; ++kh)
#pragma unroll
    for (int i = 0; i < 16; ++i) mx = __builtin_fmaxf(mx, st[kh][i]);
  mx = __builtin_fmaxf(mx, __shfl_xor(mx, 32));
  const float m_new = __builtin_fmaxf(m_run, mx), alpha = __builtin_amdgcn_exp2f(m_run - m_new);
  float rs = 0.f;
#pragma unroll
  for (int kh = 0; kh < 2; ++kh)
#pragma unroll
    for (int i = 0; i < 16; ++i) { const float pv = __builtin_amdgcn_exp2f(st[kh][i] - m_new); st[kh][i] = pv; rs += pv; }
  rs += __shfl_xor(rs, 32);
  l_run = l_run * alpha + rs; m_run = m_new;
  {
    if (h == 0) wsf[r] = alpha;
    typedef float f32x8 __attribute__((ext_vector_type(8)));
    const f32x4 a0 = *(const LAS f32x4*)(wsf + 4 * h), a1 = *(const LAS f32x4*)(wsf + 8 + 4 * h), a2 = *(const LAS f32x4*)(wsf + 16 + 4 * h), a3 = *(const LAS f32x4*)(wsf + 24 + 4 * h);
    const f32x8 lo = __builtin_shufflevector(a0, a1, 0, 1, 2, 3, 4, 5, 6, 7), hi = __builtin_shufflevector(a2, a3, 0, 1, 2, 3, 4, 5, 6, 7);
    const f32x16 av = __builtin_shufflevector(lo, hi, 0, 1, 2, 3, 4, 5, 6, 7, 8, 9, 10, 11, 12, 13, 14, 15);
    o[0] = o[0] * av; o[1] = o[1] * av;
  }
  const int blk = (lane >> 4) & 1, q = (lane & 15) >> 2, p = lane & 3;
  const int vb = (4 * h + q) * 128 + 8 * (p & 1), co0 = ((2 * blk + (p >> 1)) ^ (((q >> 1) & 1) << 2)) << 4;
#pragma unroll
  for (int kh = 0; kh < 2; ++kh)
#pragma unroll
    for (int s2 = 0; s2 < 2; ++s2) {
      u32x4 pw;
#pragma unroll
      for (int k = 0; k < 4; ++k) pw[k] = pk2(st[kh][8 * s2 + 2 * k], st[kh][8 * s2 + 2 * k + 1]);
      const bf16x8 pa = __builtin_bit_cast(bf16x8, pw);
#pragma unroll
      for (int c = 0; c < 2; ++c) {
        const LAS unsigned char* vp = Vt + (32 * kh + 16 * s2) * 128 + vb + (c ? (co0 ^ 64) : co0);
        const s16x4 lo = vtr(vp), hi = vtr(vp + 8 * 128);
        const bf16x8 vf = __builtin_shufflevector(lo, hi, 0, 1, 2, 3, 4, 5, 6, 7);
        __builtin_amdgcn_s_setprio(1); o[c] = mfma32(pa, vf, o[c]); __builtin_amdgcn_s_setprio(0);
      }
    }
}
__device__ __forceinline__ void scale_o(f32x16 (&o)[2], float f, LAS float* wsf, int lane) {
  const int r = lane & 31, h = lane >> 5;
  if (h == 0) wsf[r] = f;
#pragma unroll
  for (int g = 0; g < 4; ++g) { const f32x4 a4 = *(const LAS f32x4*)(wsf + 8 * g + 4 * h);
#pragma unroll
    for (int j = 0; j < 4; ++j) { o[0][4 * g + j] *= a4[j]; o[1][4 * g + j] *= a4[j]; } }
}
__device__ __forceinline__ void store_o(const f32x16 (&o)[2], LAS bf16_t* stg, bf16_t* att  , float* ssq  , int nq, int lane) {
  const int r = lane & 31, h = lane >> 5;
#pragma unroll
  for (int c = 0; c < 2; ++c)
#pragma unroll
    for (int i = 0; i < 16; ++i) stg[((i & 3) + 8 * (i >> 2) + 4 * h) * 64 + 32 * c + r] = (bf16_t)f2bf(o[c][i]);
  const int qr = lane >> 1, half = lane & 1; float s = 0.f; u32x4 v[4];
#pragma unroll
  for (int k = 0; k < 4; ++k) { v[k] = *(const LAS u32x4*)(stg + qr * 64 + half * 32 + 8 * k);
#pragma unroll
    for (int e = 0; e < 4; ++e) { const float a = __builtin_bit_cast(float, v[k][e] << 16), b = __builtin_bit_cast(float, v[k][e] & 0xffff0000u); s += a * a + b * b; } }
  s += __shfl_xor(s, 1);
  if (qr < nq) {
#pragma unroll
    for (int k = 0; k < 4; ++k) *(u32x4*)(att + (size_t)qr * D + half * 32 + 8 * k) = v[k];
    if (half == 0 && ssq) atomic_addf(ssq + qr, s);
  }
}
struct KVSrc { const bf16_t* K; const bf16_t* KRp; const bf16_t* V; };
template <int NS>
__device__ __forceinline__ u32x4 ld_kchunk(const KVSrc& s, long krow, int id) {
  if (NS == 6) { const int row = id / 12, ch = id - row * 12;
    return ch < 8 ? *(const u32x4*)(s.K + (krow + row) * 512 + ch * 8) : *(const u32x4*)(s.KRp + (krow + row) * 32 + (ch - 8) * 8); }
  else { const int row = id >> 3, ch = id & 7; return *(const u32x4*)(s.K + (krow + row) * 512 + ch * 8); }
}
template <int NS>
__device__ __forceinline__ void st_kchunk(LAS unsigned char* Kt, int id, u32x4 v) {
  constexpr int KP = NS == 6 ? KP_A : KP_B, CPR = NS == 6 ? 12 : 8;
  const int row = id / CPR, ch = id - row * CPR; *(LAS u32x4*)(Kt + row * KP + ch * 16) = v;
}
__device__ __forceinline__ void st_vchunk(LAS unsigned char* Vt, int id, u32x4 v) { const int row = id >> 3, ch = id & 7; *(LAS u32x4*)(Vt + row * 128 + ((ch ^ (((row >> 1) & 1) << 2)) << 4)) = v; }

__device__ __forceinline__ void glds16(const void* gsrc, unsigned lds_dst) {
  unsigned keep;
  asm volatile("s_mov_b32 %0, m0\n\ts_mov_b32 m0, %2\n\ts_nop 0\n\tglobal_load_lds_dwordx4 %1, off\n\ts_mov_b32 m0, %0" : "=&s"(keep) : "v"(gsrc), "s"(lds_dst) : "memory");
}
template <int NS>
__device__ __forceinline__ void dma_tile(LAS unsigned char* Kt, LAS unsigned char* Vt, const KVSrc& src, long krow, int wave, int lane) {
  constexpr int CPR = NS == 6 ? 13 : 9, ND = CPR;
#pragma unroll
  for (int k = 0; k < 2; ++k) { const int d = wave + 8 * k;
    if (d < ND) { const int c = d * 64 + lane, row = c / CPR, ch = c - row * CPR;
      const bf16_t* g = (NS == 6 && ch >= 8 && ch < 12) ? src.KRp + (krow + row) * 32 + (ch - 8) * 8 : src.K + (krow + row) * 512 + (ch < 8 ? ch : 0) * 8;
      glds16(g, (unsigned)__builtin_amdgcn_readfirstlane((int)(unsigned)(uintptr_t)(Kt + d * 1024))); } }
  { const int c = wave * 64 + lane, row = c >> 3, ch = (c & 7) ^ (((row >> 1) & 1) << 2);
    glds16(src.V + (krow + row) * 512 + ch * 8, (unsigned)__builtin_amdgcn_readfirstlane((int)(unsigned)(uintptr_t)(Vt + wave * 1024))); }
}
#define AT_VMWAIT(n) asm volatile("s_waitcnt vmcnt(" #n ")" ::: "memory")
template <int NS, bool BIAS>
__device__ __forceinline__ void attn_unit_shared(LAS unsigned char* lds, const bf16_t* Qw  , int qpitch, const KVSrc src, long krow0,
                                                 int t_lo, int t_hi, int w_lo, int w_hi, int qpos0  , bf16_t* att, float* ssq, int bhead = 0) {
  constexpr int SLOT = 21504, ND = NS == 6 ? 13 : 9;
  int tid_ = threadIdx.x; asm volatile("" : "+v"(tid_));
  const int tid = tid_, lane = tid & 63, wave = __builtin_amdgcn_readfirstlane(tid >> 6), r = lane & 31, h = lane >> 5;
  LAS float* wsf = (LAS float*)(lds + AT_WSF) + wave * 64; const LAS float* btab = (const LAS float*)(lds + AT_BIAS) + bhead * 640;
#pragma unroll
  for (int k = 0; k < 2; ++k) if (t_lo + k <= t_hi) dma_tile<NS>(lds + AT_TILE + k * SLOT, lds + AT_TILE + k * SLOT + 13312, src, krow0 + 64L * (t_lo + k), wave, lane);
  bf16x8 qf[NS];
#pragma unroll
  for (int s = 0; s < NS; ++s) qf[s] = *(const bf16x8*)(Qw + (size_t)r * qpitch + 16 * s + 8 * h);
#pragma unroll
  for (int s = 0; s < NS; ++s) asm volatile("" : "+v"(qf[s]));
  f32x16 o[2];
#pragma unroll
  for (int i = 0; i < 16; ++i) { o[0][i] = 0.f; o[1][i] = 0.f; }
  float m_run = -1e30f, l_run = 0.f;
  AT_VMWAIT(0);
  asm volatile("s_waitcnt lgkmcnt(0)" ::: "memory"); __builtin_amdgcn_s_barrier(); asm volatile("" ::: "memory");
  for (int t0 = t_lo; t0 <= t_hi; t0 += 2) {
#pragma unroll
    for (int k = 2; k < 4; ++k) if (t0 + k <= t_hi) { const int s3 = (t0 + k - t_lo) & 3; dma_tile<NS>(lds + AT_TILE + s3 * SLOT, lds + AT_TILE + s3 * SLOT + 13312, src, krow0 + 64L * (t0 + k), wave, lane); }
#pragma unroll
    for (int k = 0; k < 2; ++k) { const int t = t0 + k; const int sl = (t - t_lo) & 3;
      if (t <= t_hi && t >= w_lo && t <= w_hi) {
        const bool lookup = BIAS && (qpos0 - (64 * t + 63) < 256);
        f32x16 st[2]; attn_qk<NS, BIAS, false>(lds + AT_TILE + sl * SLOT, qf, nullptr, st, 64, btab, 639 - (qpos0 + r - 64 * t + 256), lookup, lane);
        attn_smpv(lds + AT_TILE + sl * SLOT + 13312, st, o, m_run, l_run, wsf, lane);
      } }
    AT_VMWAIT(0);
    asm volatile("s_waitcnt lgkmcnt(0)" ::: "memory"); __builtin_amdgcn_s_barrier(); asm volatile("" ::: "memory");
  }
  scale_o(o, 1.0f / l_run, wsf, lane);
  store_o(o, (LAS bf16_t*)(lds + AT_OSTG) + wave * 2048, att, ssq, 32, lane);
}
template <int NS, bool BIAS>
__device__ __forceinline__ void attn_unit_sample(LAS unsigned char* lds, const bf16_t* Qw, int qpitch, const KVSrc src, long krow0, int ntiles, int nvalid_last, int qpos0, bf16_t* att, float* ssq, int bhead = 0) {
  constexpr int NKC = NS == 6 ? 768 : 512;
  int tid_ = threadIdx.x; asm volatile("" : "+v"(tid_));
  const int tid = tid_, lane = tid & 63, wave = tid >> 6, r = lane & 31, h = lane >> 5;
  LAS float* wsf = (LAS float*)(lds + AT_WSF) + wave * 64; const LAS float* btab = (const LAS float*)(lds + AT_BIAS) + bhead * 640;
  LAS float* cm = (LAS float*)(lds + AT_CMB);
  f32x16 o[2];
#pragma unroll
  for (int i = 0; i < 16; ++i) { o[0][i] = 0.f; o[1][i] = 0.f; }
  float m_run = -1e30f, l_run = 0.f;
  LAS unsigned char* Kt = lds + AT_TILE + (wave & 3) * AT_PRIV; LAS unsigned char* Vt = Kt + 13312;
  bf16x8 qf[NS];
#pragma unroll
  for (int s = 0; s < NS; ++s) qf[s] = *(const bf16x8*)(Qw + (size_t)(r & 15) * qpitch + 16 * s + 8 * h);
  constexpr int NK4 = 4 * NKC / 512;
  u32x4 kc[NK4], vc[4];
#define SMP_LOAD(T0) do { _Pragma("unroll") for (int i = 0; i < NK4; ++i) { const int id = tid + 512 * i, tt = id / NKC, cid = id - tt * NKC; if ((T0) + tt < ntiles) kc[i] = ld_kchunk<NS>(src, krow0 + 64L * ((T0) + tt), cid); } \
    _Pragma("unroll") for (int i = 0; i < 4; ++i) { const int id = tid + 512 * i, tt = id >> 9, cid = id & 511; if ((T0) + tt < ntiles) vc[i] = *(const u32x4*)(src.V + (krow0 + 64L * ((T0) + tt) + (cid >> 3)) * 512 + (cid & 7) * 8); } } while (0)
#define SMP_STORE(T0) do { _Pragma("unroll") for (int i = 0; i < NK4; ++i) { const int id = tid + 512 * i, tt = id / NKC, cid = id - tt * NKC; if ((T0) + tt < ntiles) st_kchunk<NS>(lds + AT_TILE + tt * AT_PRIV, cid, kc[i]); } \
    _Pragma("unroll") for (int i = 0; i < 4; ++i) { const int id = tid + 512 * i, tt = id >> 9, cid = id & 511; if ((T0) + tt < ntiles) st_vchunk(lds + AT_TILE + tt * AT_PRIV + 13312, cid, vc[i]); } } while (0)
  SMP_LOAD(0); SMP_STORE(0);
  __syncthreads();
  for (int t0 = 0; t0 < ntiles; t0 += 4) {
    if (t0 + 4 < ntiles) SMP_LOAD(t0 + 4);
    const int t = t0 + wave;
    if (wave < 4 && t < ntiles) {
      const bool lookup = BIAS && (qpos0 - (64 * t + 63) < 256);
      f32x16 st[2]; attn_qk<NS, BIAS, false>(Kt, qf, nullptr, st, (t == ntiles - 1) ? nvalid_last : 64, btab, 639 - (qpos0 + (r & 15) - 64 * t + 256), lookup, lane);
      attn_smpv(Vt, st, o, m_run, l_run, wsf, lane);
    }
    __syncthreads();
    if (t0 + 4 < ntiles) { SMP_STORE(t0 + 4); }
    __syncthreads();
  }
#undef SMP_LOAD
#undef SMP_STORE
  if (wave < 4 && h == 0) cm[wave * 32 + r] = m_run;
  __syncthreads();
  if (wave < 4) {
    const float M = __builtin_fmaxf(__builtin_fmaxf(cm[r], cm[32 + r]), __builtin_fmaxf(cm[64 + r], cm[96 + r]));
    const float f = __builtin_amdgcn_exp2f(m_run - M);
    scale_o(o, f, wsf, lane);
    if (h == 0) cm[128 + wave * 32 + r] = l_run * f;
    LAS float* po = (LAS float*)(lds + AT_TILE + wave * AT_PRIV);
#pragma unroll
    for (int c = 0; c < 2; ++c)
#pragma unroll
      for (int i = 0; i < 16; ++i) po[(c * 16 + i) * 64 + lane] = o[c][i];
  }
  __syncthreads();
  if (wave == 0) {
    const float l = (cm[128 + r] + cm[160 + r]) + (cm[192 + r] + cm[224 + r]);
#pragma unroll
    for (int w = 1; w < 4; ++w) { const LAS float* po = (const LAS float*)(lds + AT_TILE + w * AT_PRIV);
#pragma unroll
      for (int c = 0; c < 2; ++c)
#pragma unroll
        for (int i = 0; i < 16; ++i) o[c][i] += po[(c * 16 + i) * 64 + lane]; }
    scale_o(o, 1.0f / l, wsf, lane);
    store_o(o, (LAS bf16_t*)(lds + AT_OSTG), att, ssq, 16, lane);
  }
  __syncthreads();
}
__device__ __forceinline__ void load_bias_all(LAS unsigned char* lds, const float* rel_bias) {
  LAS float* btab = (LAS float*)(lds + AT_BIAS);
  for (int i = threadIdx.x; i < 8 * 640; i += NTHREADS) { const int hd = i / 640, j = 639 - (i - hd * 640); btab[i] = rel_bias[hd * 513 + (j > 512 ? 512 : j)] * LOG2E; }
  __syncthreads();
}
__device__ __forceinline__ void attention_phase(ParamsC p, LAS unsigned char* lds, int G, bool dry, int apm = 15) {
  unsigned char* ws = p->ws; const int wave = threadIdx.x >> 6;
  const bf16_t* Q = (const bf16_t*)(ws + WS_Q); const bf16_t* KN = (const bf16_t*)(ws + WS_KN); const bf16_t* V = (const bf16_t*)(ws + WS_V); const bf16_t* KR = (const bf16_t*)(ws + WS_KR);
  const bf16_t* QB = (const bf16_t*)(ws + WS_QB); const bf16_t* KB = (const bf16_t*)(ws + WS_KB); const bf16_t* VB = (const bf16_t*)(ws + WS_VB);
  bf16_t* ATT = (bf16_t*)(ws + WS_XN); float* ssq_a = (float*)(ws + WS_SSQ); float* ssq_b = ssq_a + MT;
  load_bias_all(lds, p->rel_bias);
  for (int u = blockIdx.x; u < 256; u += G) {
    const int b = (u & 127) >> 3, head = u & 7; const int row0 = MP + b * DSQ;
#ifndef AP
#define AP 15
#endif
    if (u < 128) { if (apm & 1) {
      const KVSrc src{KN + head * 64, KR, V + head * 64};
      attn_unit_sample<6, false>(lds, Q + (size_t)row0 * 768 + head * 96, 768, src, (long)MP + (long)b * LROW, 65, 16, 0, ATT + (size_t)row0 * D + head * 64, dry ? nullptr : ssq_a + row0); }
    } else if (apm & 2) {
      const KVSrc src{KB + head * 64, nullptr, VB + head * 64};
      attn_unit_sample<4, true>(lds, QB + (size_t)row0 * 512 + head * 64, 512, src, (long)MP + (long)b * BROW, 9, 16, 512, ATT + (size_t)row0 * D + 512 + head * 64, dry ? nullptr : ssq_b + row0, head);
    }
  }
  if (G == 256) {
    const int vcu = (blockIdx.x & 7) * 32 + (blockIdx.x >> 3), grp = vcu >> 3, mem = vcu & 7; const int b = grp; const long brow = (long)b * SEQ;
    if (apm & 4) for (int i = 0; i < 8; ++i) { const int head = i, qb = (mem + i) & 7; const KVSrc src{KN + head * 64, KR, V + head * 64}; const long qrow = brow + 256 * qb + 32 * wave;
      attn_unit_shared<6, false>(lds, Q + (size_t)qrow * 768 + head * 96, 768, src, brow, 0, 4 * qb + 3, 0, 4 * qb + (wave >> 1), 0, ATT + (size_t)qrow * D + head * 64, dry ? nullptr : ssq_a + qrow); }
    if (apm & 8) for (int i = 0; i < 8; ++i) { const int head = i, cb = (mem + i) & 7;
      const KVSrc src{KB + head * 64, nullptr, VB + head * 64}; const long qrow = brow + 256 * cb + 32 * wave; const int cq = 4 * cb + (wave >> 1); const int tl = 4 * cb - 8 < 0 ? 0 : 4 * cb - 8;
      attn_unit_shared<4, true>(lds, QB + (size_t)qrow * 512 + head * 64, 512, src, brow, tl, 4 * cb + 3, cq - 8, cq, 256 * cb + 32 * wave, ATT + (size_t)qrow * D + 512 + head * 64, dry ? nullptr : ssq_b + qrow, head); }
  } else {
  for (int bh = blockIdx.x; bh < NBATCH * 8; bh += G) {
    const int b = bh >> 3, head = bh & 7; const long brow = (long)b * SEQ;
    if (apm & 4) { const KVSrc src{KN + head * 64, KR, V + head * 64};
      for (int qb = 0; qb < 8; ++qb) { const long qrow = brow + 256 * qb + 32 * wave;
        attn_unit_shared<6, false>(lds, Q + (size_t)qrow * 768 + head * 96, 768, src, brow, 0, 4 * qb + 3, 0, 4 * qb + (wave >> 1), 0, ATT + (size_t)qrow * D + head * 64, dry ? nullptr : ssq_a + qrow); } }
    if (apm & 8) { const KVSrc src{KB + head * 64, nullptr, VB + head * 64};
      for (int cb = 0; cb < 8; ++cb) { const long qrow = brow + 256 * cb + 32 * wave; const int cq = 4 * cb + (wave >> 1); const int tl = 4 * cb - 8 < 0 ? 0 : 4 * cb - 8;
        attn_unit_shared<4, true>(lds, QB + (size_t)qrow * 512 + head * 64, 512, src, brow, tl, 4 * cb + 3, cq - 8, cq, 256 * cb + 32 * wave, ATT + (size_t)qrow * D + 512 + head * 64, dry ? nullptr : ssq_b + qrow, head); } }
  }
  }
}


#define XB_TMO      128
#define XB_XCNT(j)  (256  + 64 * (j))
#define XB_XSUB(j)  (1280 + 64 * (j))
#define XB_XGEN(j)  (2304 + 64 * (j))
#define XB_TOP      3328
#define XB_TOPGEN   3392
#define XCD_BAR_WORDS 3456
#define XB_SPIN_CAP (1u << 18)
__device__ __forceinline__ unsigned xb_ld(unsigned* p)              { return __hip_atomic_load(p, __ATOMIC_RELAXED, __HIP_MEMORY_SCOPE_AGENT); }
__device__ __forceinline__ unsigned xb_add(unsigned* p, unsigned v) { return __hip_atomic_fetch_add(p, v, __ATOMIC_RELAXED, __HIP_MEMORY_SCOPE_AGENT); }
__device__ __forceinline__ unsigned xb_xcc_id() { return (unsigned)__builtin_amdgcn_s_getreg((3 << 11) | 20) & 0xFu; }
#define XB_SPIN(cond, bar) do { unsigned _sp = 0; while (cond) { __builtin_amdgcn_s_sleep(1); \
    if ((++_sp & 255u) == 0u) { if (xb_ld(&(bar)[XB_TMO])) break; if (_sp > XB_SPIN_CAP) { atomicAdd(&(bar)[XB_TMO], 1u); break; } } } } while (0)
__device__ __forceinline__ void xcd_barrier_complete(unsigned* bar, unsigned x, unsigned& nloc, unsigned& nx) {
  const unsigned G = gridDim.x * gridDim.y * gridDim.z;
  unsigned sum, cnt, mine, sp = 0u;
  for (;;) {
    sum = 0u; cnt = 0u; mine = 0u;
#pragma unroll
    for (unsigned j = 0; j < 16; ++j) { const unsigned c = xb_ld(&bar[XB_XCNT(j)]); sum += c; cnt += (c > 0u) ? 1u : 0u; mine = (j == x) ? c : mine; }
    if (sum == G) break;
    __builtin_amdgcn_s_sleep(1);
    if ((++sp & 255u) == 0u) { if (xb_ld(&bar[XB_TMO])) break; if (sp > XB_SPIN_CAP) { atomicAdd(&bar[XB_TMO], 1u); break; } }
  }
  nloc = mine > 0u ? mine : 1u; nx = cnt > 0u ? cnt : 1u;
}
__device__ __forceinline__ void xcd_barrier(unsigned* bar, volatile LAS unsigned* st) {
  asm volatile("s_waitcnt vmcnt(0)" ::: "memory");
  __syncthreads();
  if (threadIdx.x == 0) {
    const unsigned x = xb_xcc_id();
    __builtin_amdgcn_s_waitcnt(0);
    unsigned nloc = st[0], nx = st[1];
    if (nloc == 0u) { xcd_barrier_complete(bar, x, nloc, nx); st[0] = nloc; st[1] = nx; }
    const unsigned old = xb_add(&bar[XB_XSUB(x)], 1u);
    const unsigned gen = old / nloc;
    if (old + 1u == (gen + 1u) * nloc) {
      __builtin_amdgcn_fence(__ATOMIC_RELEASE, "agent");
      asm volatile("s_waitcnt vmcnt(0)" ::: "memory");
      const unsigned og = xb_add(&bar[XB_TOP], 1u);
      const unsigned tg = og / nx;
      if (og + 1u == (tg + 1u) * nx) xb_add(&bar[XB_TOPGEN], 1u);
      else XB_SPIN(xb_ld(&bar[XB_TOPGEN]) == tg, bar);
      __builtin_amdgcn_fence(__ATOMIC_ACQUIRE, "agent");
      xb_add(&bar[XB_XGEN(x)], 1u);
      asm volatile("s_waitcnt vmcnt(0)" ::: "memory");
    } else {
      XB_SPIN(xb_ld(&bar[XB_XGEN(x)]) == gen, bar);
      __builtin_amdgcn_fence(__ATOMIC_ACQUIRE, "agent");
      asm volatile("s_waitcnt vmcnt(0)" ::: "memory");
    }
  }
  __syncthreads();
}

__device__ __forceinline__ ParamsC get_params() {
  ParamsC pp = (ParamsC)__builtin_amdgcn_kernarg_segment_ptr(); asm volatile("" : "+s"(pp)); return pp;
}
__global__ void __launch_bounds__(NTHREADS) mk_fwd(Params p_unused) {
  extern __shared__ __attribute__((aligned(16))) unsigned char lds_raw[];
  LAS unsigned char* lds = (LAS unsigned char*)lds_raw;
  cg::grid_group grid = cg::this_grid();
  const int G = gridDim.x;
  volatile LAS unsigned* xst = (volatile LAS unsigned*)(lds + LDS_BYTES - 16);
  if (threadIdx.x < 2) xst[threadIdx.x] = 0u;
  if (threadIdx.x == 0) (void)xb_add(&((unsigned*)(get_params()->ws + WS_BAR))[XB_XCNT(xb_xcc_id())], 1u);
  __syncthreads();
#define FAST_SYNC() xcd_barrier((unsigned*)(get_params()->ws + WS_BAR), xst)
#define WSP(T, off) ((T*)(get_params()->ws + (off)))
#define ssq WSP(float, WS_SSQ)
#define X1B WSP(bf16_t, WS_X1B)
#define XN WSP(bf16_t, WS_XN)
#define CQN WSP(bf16_t, WS_CQN)
#define CKV WSP(bf16_t, WS_CKV)
#define KR WSP(bf16_t, WS_KR)
#define QB WSP(bf16_t, WS_QB)
#define KB WSP(bf16_t, WS_KB)
#define VB WSP(bf16_t, WS_VB)
#define Q WSP(bf16_t, WS_Q)
#define KN WSP(bf16_t, WS_KN)
#define V WSP(bf16_t, WS_V)
#define H WSP(bf16_t, WS_H)
  pg8::StaticOrder S;
#ifndef PH
#define PH 255
#endif
  if (PH & 1) prologue(get_params(), lds, G);
#ifdef DUP_P0
  grid.sync(); prologue(get_params(), lds, G);
#endif
  grid.sync();
  if (PH & 2) { pg8::Gemm g{XN, (const bf16_t*)(get_params()->ws + WS_WIN), 1024, 1024, 1024}; S.init(MT, NIN, G, blockIdx.x);
    ParamsC pp = get_params(); EpiIn E{pp->out, CQN, CKV, KR, QB, KB, VB, pp->g_kv, (LAS float*)(lds + LDS_RED)};
    pg8::gemm_phase(lds, g, S, E); }
  FAST_SYNC();
  if ((PH & 4) && !(PH & 256)) { pg8::Gemm g{CQN, (const bf16_t*)(get_params()->ws + WS_WUQ), 256, 256, 256}; S.init(MT, 768, G, blockIdx.x); EpiQ E{Q}; pg8::gemm_phase(lds, g, S, E); }
  if ((PH & 4) && !(PH & 512)) { pg8::Gemm g{CKV, (const bf16_t*)(get_params()->ws + WS_WKV), 256, 256, 256}; S.init(MLAT, 1024, G, blockIdx.x); EpiKV E{KN, V}; pg8::gemm_phase(lds, g, S, E); }
  FAST_SYNC();
  if (PH & 8) attention_phase(get_params(), lds, G, false);
#ifdef DUP_ATTN
  grid.sync(); attention_phase(get_params(), lds, G, true, DUP_ATTN);
#endif
  FAST_SYNC();
  if (PH & 16) { pg8::Gemm g{XN  , (const bf16_t*)(get_params()->ws + WS_WO), 1024, 1024, 1024}; S.init(MT, 1024, G, blockIdx.x);
    ParamsC pp = get_params(); EpiO E{8, ssq, ssq + MT, pp->xp, pp->xs, X1B, ssq + 2 * MT, (LAS float*)(lds + LDS_RED), 0.f, 0.f, 0}; pg8::gemm_phase(lds, g, S, E); }
  FAST_SYNC();
  if (PH & 32) { pg8::Gemm g{X1B, (const bf16_t*)(get_params()->ws + WS_WGU), 1024, 1024, 1024}; S.init(MT, NGU, G, blockIdx.x); EpiGU E{ssq + 2 * MT, H, (LAS float*)(lds + LDS_RED), 0.f, 0}; pg8::gemm_phase(lds, g, S, E);
#ifdef DUP_P5
    grid.sync(); pg8::gemm_phase(lds, g, S, E);
#endif
  }
  FAST_SYNC();
#define PART WSP(float, WS_Q)
  if (PH & 64) { pg8::Gemm g{H, (const bf16_t*)(get_params()->ws + WS_WD), FF, FF, FF}; S.init(MP, 1024, G, blockIdx.x); EpiD E{X1B, ssq + 3 * MT}; pg8::gemm_phase(lds, g, S, E);
    pg8::Gemm g2{H, (const bf16_t*)(get_params()->ws + WS_WD), FF, FF, 256}; pg8::SplitOrder S2{MP / 256, 4, 44, 256, G, (int)blockIdx.x}; EpiPart E2{PART}; pg8::gemm_phase(lds, g2, S2, E2); }
  FAST_SYNC();
  if (PH & 128) { ParamsC p = get_params(); int t7 = threadIdx.x; asm volatile("" : "+v"(t7)); const int lane = t7 & 63, gw = blockIdx.x * 8 + (t7 >> 6), NGW = G * 8; const float* s2 = ssq + 3 * MT;
    f32x4 gf[4];
#pragma unroll
    for (int j = 0; j < 2; ++j) { gf[2 * j] = *(const f32x4*)(p->g_final + 8 * lane + 512 * j); gf[2 * j + 1] = *(const f32x4*)(p->g_final + 8 * lane + 512 * j + 4); }
    for (int rr0 = gw; rr0 < MT; rr0 += 4 * NGW) {
      u32x4 raw[4][2]; int rows[4];
#pragma unroll
      for (int k = 0; k < 4; ++k) { const int rr = rr0 + k * NGW; rows[k] = rr < MS ? MP + rr : rr - MS;
        if (rr < MT) { const bf16_t* x = X1B + (size_t)rows[k] * D;
#pragma unroll
          for (int j = 0; j < 2; ++j) raw[k][j] = *(const u32x4*)(x + 8 * lane + 512 * j); } }
#pragma unroll
      for (int k = 0; k < 4; ++k) { const int rr = rr0 + k * NGW, row = rows[k]; if (rr < MT) {
        f32x4 v[4];
#pragma unroll
        for (int j = 0; j < 2; ++j) { const u32x4 w = raw[k][j];
          v[2 * j] = (f32x4){__builtin_bit_cast(float, w.x << 16), __builtin_bit_cast(float, w.x & 0xffff0000u), __builtin_bit_cast(float, w.y << 16), __builtin_bit_cast(float, w.y & 0xffff0000u)};
          v[2 * j + 1] = (f32x4){__builtin_bit_cast(float, w.z << 16), __builtin_bit_cast(float, w.z & 0xffff0000u), __builtin_bit_cast(float, w.w << 16), __builtin_bit_cast(float, w.w & 0xffff0000u)}; }
        float* y = p->out + OFF_Y + (size_t)row * D; float rstd;
        if (row >= MP) { float s = 0.f;
          for (int kc = 0; kc < 11; ++kc) { const float* pr = PART + ((size_t)kc * 256 + (row - MP)) * D;
#pragma unroll
            for (int j = 0; j < 2; ++j) { v[2 * j] = v[2 * j] + *(const f32x4*)(pr + 8 * lane + 512 * j); v[2 * j + 1] = v[2 * j + 1] + *(const f32x4*)(pr + 8 * lane + 512 * j + 4); } }
#pragma unroll
          for (int j = 0; j < 4; ++j) s += (v[j][0] * v[j][0] + v[j][1] * v[j][1]) + (v[j][2] * v[j][2] + v[j][3] * v[j][3]);
          rstd = __builtin_amdgcn_rsqf(wave_sum(s) * (1.0f / D) + EPS);
        } else rstd = __builtin_amdgcn_rsqf(s2[row] * (1.0f / D) + EPS);
#pragma unroll
        for (int j = 0; j < 2; ++j) { *(f32x4*)(y + 8 * lane + 512 * j) = v[2 * j] * rstd * gf[2 * j]; *(f32x4*)(y + 8 * lane + 512 * j + 4) = v[2 * j + 1] * rstd * gf[2 * j + 1]; } } } } }
}

#undef FAST_SYNC
#undef ssq
#undef X1B
#undef XN
#undef CQN
#undef CKV
#undef KR
#undef QB
#undef KB
#undef VB
#undef Q
#undef KN
#undef V
#undef H
#undef PART
extern "C" void kernel_launch(void* const* d_in, const int* in_sizes, int n_in, void* d_out, int out_size, void* d_ws, size_t ws_size, hipStream_t stream) {
  static int grid = 0;
  if (grid == 0) {
    if (n_in != 22 || (size_t)out_size != OUT_TOTAL || ws_size < WS_TOTAL) { fprintf(stderr, "kernel_launch: unexpected shapes (n_in %d out %d ws %zu, need ws %zu)\n", n_in, out_size, ws_size, (size_t)WS_END); grid = -1; return; }
    int dev = 0, cus = 0, per_cu = 0;
    hipGetDevice(&dev); hipDeviceGetAttribute(&cus, hipDeviceAttributeMultiprocessorCount, dev);
    hipFuncSetAttribute((const void*)mk_fwd, hipFuncAttributeMaxDynamicSharedMemorySize, LDS_BYTES);
    hipOccupancyMaxActiveBlocksPerMultiprocessor(&per_cu, (const void*)mk_fwd, NTHREADS, LDS_BYTES);
    if (per_cu < 1 || cus < 1) { fprintf(stderr, "kernel_launch: occupancy query gave %d blocks/CU on %d CUs\n", per_cu, cus); grid = -1; return; }
    grid = cus * (per_cu > 1 ? 1 : per_cu);
  }
  if (grid < 0) return;
  Params p{};
  const float** pp = (const float**)&p;
  for (int i = 0; i < 22; ++i) pp[i] = (const float*)d_in[i];
  p.out = (float*)d_out; p.ws = (unsigned char*)d_ws;
  if (hipMemsetAsync((char*)d_ws + WS_BAR, 0, 16384, stream) != hipSuccess) { fprintf(stderr, "kernel_launch: memset of barrier words failed\n"); return; }
  void* args[] = {&p};
  hipError_t e = hipLaunchCooperativeKernel((void*)mk_fwd, dim3(grid), dim3(NTHREADS), args, LDS_BYTES, stream);
  if (e != hipSuccess) fprintf(stderr, "cooperative launch failed: %s (grid %d)\n", hipGetErrorString(e), grid);
}
```

```cpp
#include <hip/hip_runtime.h>
#include <hip/hip_cooperative_groups.h>
#include <cstdio>
#include <cstdint>


namespace cg = cooperative_groups;

#define LAS __attribute__((address_space(3)))
typedef unsigned short bf16_t;
typedef short bf16x8 __attribute__((ext_vector_type(8)));
typedef short s16x4 __attribute__((ext_vector_type(4)));
typedef float f32x4 __attribute__((ext_vector_type(4)));
typedef float f32x16 __attribute__((ext_vector_type(16)));
typedef unsigned u32x4 __attribute__((ext_vector_type(4)));
typedef unsigned u32x2 __attribute__((ext_vector_type(2)));
typedef float f32x2_t __attribute__((ext_vector_type(2)));
typedef __bf16 bf16x2_t __attribute__((ext_vector_type(2)));

constexpr int D = 1024, NBATCH = 32, SEQ = 2048, MP = NBATCH * SEQ, DB = 16, DSQ = 16, MS = DB * DSQ, MT = MP + MS, PAST = 4096;
constexpr int NIN = 2304, FF = 2816, NGU = 2 * FF;
constexpr int LROW = 4352, BROW = 768;
constexpr int MLAT = MP + DB * LROW, MBND = MP + DB * BROW;
constexpr float EPS = 1e-6f, LOG2E = 1.4426950408889634f;
constexpr float QSCALE_A = 0.10206207261596575f * LOG2E;
constexpr float QSCALE_B = 0.125f * LOG2E;
constexpr int NTHREADS = 512;
constexpr size_t OFF_Y = 0, OFF_CKVP = (size_t)MT * D, OFF_KRP = OFF_CKVP + (size_t)MP * 256, OFF_BKP = OFF_KRP + (size_t)MP * 32,
                 OFF_BVP = OFF_BKP + (size_t)NBATCH * 512 * 512, OFF_CKVS = OFF_BVP + (size_t)NBATCH * 512 * 512, OFF_KRS = OFF_CKVS + (size_t)MS * 256,
                 OFF_BKS = OFF_KRS + (size_t)MS * 32, OFF_BVS = OFF_BKS + (size_t)MS * 512, OUT_TOTAL = OFF_BVS + (size_t)MS * 512;
constexpr size_t al256(size_t x) { return (x + 255) & ~(size_t)255; }
constexpr size_t WS_SSQ = 0;
constexpr size_t WS_WIN = al256(WS_SSQ + 4 * (size_t)MT * 4);
constexpr size_t WS_WUQ = al256(WS_WIN + (size_t)NIN * 1024 * 2);
constexpr size_t WS_WKV = al256(WS_WUQ + (size_t)768 * 256 * 2);
constexpr size_t WS_WO = al256(WS_WKV + (size_t)1024 * 256 * 2);
constexpr size_t WS_WGU = al256(WS_WO + (size_t)1024 * 1024 * 2);
constexpr size_t WS_WD = al256(WS_WGU + (size_t)NGU * 1024 * 2);
constexpr size_t WS_X1B = al256(WS_WD + (size_t)1024 * FF * 2);
constexpr size_t WS_XN = al256(WS_X1B + (size_t)MT * 1024 * 2);
constexpr size_t WS_CQN = al256(WS_XN + (size_t)MT * 1024 * 2);
constexpr size_t WS_CKV = al256(WS_CQN + (size_t)MT * 256 * 2);
constexpr size_t WS_KR = al256(WS_CKV + (size_t)MLAT * 256 * 2);
constexpr size_t WS_QB = al256(WS_KR + (size_t)MLAT * 32 * 2);
constexpr size_t WS_KB = al256(WS_QB + (size_t)MT * 512 * 2);
constexpr size_t WS_VB = al256(WS_KB + (size_t)MBND * 512 * 2);
constexpr size_t WS_Q = al256(WS_VB + (size_t)MBND * 512 * 2);
constexpr size_t WS_KN = al256(WS_Q + (size_t)MT * 768 * 2);
constexpr size_t WS_V = al256(WS_KN + (size_t)MLAT * 512 * 2);
constexpr size_t WS_END = al256(WS_V + (size_t)MLAT * 512 * 2);
constexpr size_t WS_BAR = WS_END;
constexpr size_t WS_TOTAL = WS_END + 16384;
constexpr size_t WS_H = WS_XN;
static_assert(WS_H + (size_t)MT * FF * 2 <= WS_VB, "H overlay must end before anything live in P5/P6 (nothing is, but keep it inside dead buffers)");
static_assert(WS_TOTAL <= (size_t)1073741824, "workspace");

constexpr int LDS_GEMM = 131072, LDS_RED = LDS_GEMM, LDS_BYTES = 143360;
constexpr int KP_A = 208, KP_B = 144;
constexpr int AT_TILE = 0, AT_PRIV = 21504  , AT_QT = 51200  , AT_BIAS = 86016  , AT_WSF = 107008, AT_OSTG = 109056, AT_CMB = 141824;
static_assert(AT_CMB + 1024 <= LDS_BYTES, "attention LDS map");

struct Params {
  const float *xp, *xs, *c_ckv, *c_kr, *c_bk, *c_bv, *w_in, *g_attn, *g_q, *w_uq, *g_kv, *w_uk, *w_uv, *rel_bias, *g_out_a, *g_out_b, *w_out, *g_ffn,
      *w_gate, *w_up, *w_down, *g_final;
  float* out; unsigned char* ws;
};

typedef const __attribute__((address_space(4))) Params* ParamsC;
__device__ __forceinline__ unsigned f2bf(float f) { unsigned u = __builtin_bit_cast(unsigned, f); return (u + 0x7fffu + ((u >> 16) & 1u)) >> 16; }
__device__ __forceinline__ unsigned pk2(float lo, float hi) { f32x2_t v = {lo, hi}; bf16x2_t b = __builtin_convertvector(v, bf16x2_t); return __builtin_bit_cast(unsigned, b); }
__device__ __forceinline__ float bf2f(unsigned short b) { return __builtin_bit_cast(float, (unsigned)b << 16); }
__device__ __forceinline__ int maprow_lat(int row) { return row < MP ? row : MP + ((row - MP) >> 4) * LROW + PAST + ((row - MP) & 15); }
__device__ __forceinline__ int maprow_bnd(int row) { return row < MP ? row : MP + ((row - MP) >> 4) * BROW + 512 + ((row - MP) & 15); }
__device__ __forceinline__ int row_pos(int row) { return row < MP ? (row & (SEQ - 1)) : PAST + ((row - MP) & 15); }
__device__ __forceinline__ void rope_cs(int pos, int i, float& c, float& s) {
  const float inv = __builtin_amdgcn_exp2f(-(float)i * (13.287712379549449f / 16.0f));
  float rev = (float)pos * inv * 0.15915494309189535f; rev = rev - __builtin_floorf(rev);
  s = __builtin_amdgcn_sinf(rev); c = __builtin_amdgcn_cosf(rev);
}

namespace pg8 {
constexpr int BM = 256, BK = 64, HALF = 128, HTB = HALF * BK * 2, STAGE_BYTES = 8 * HTB, NXCD = 8, WGM = 8;
__host__ __device__ __forceinline__ int lds_byte(int r, int c) { const int st = (r >> 4) * 2 + (c >> 5), rr = r & 15, cc = c & 31, ob = rr * 64 + cc * 2; return st * 1024 + (ob ^ (((ob >> 9) & 1) << 5)); }
__host__ __device__ __forceinline__ void stage_rc(int b, int& R, int& C) { const int st = b / 1024, sb = b % 1024, swz = sb ^ (((sb >> 9) & 1) << 5); R = (st >> 1) * 16 + swz / 64; C = (st & 1) * 32 + (swz % 64) / 2; }
struct Unit { int pm, pn, koff; };
struct Gemm { const bf16_t* A; const bf16_t* Bt; int lda, ldb, K; };
struct StaticOrder {
  int nM, nN, nwg, G, c;
  __device__ void init(int M, int N, int G_, int c_) { nM = M / BM; nN = N / BM; nwg = nM * nN; G = G_; c = c_; }
  __device__ bool next(int i, Unit& u) const {
    const long L = (long)i * G + c; if (L >= nwg) return false;
    int wgid = (int)L; { const int q = nwg / NXCD, r = nwg % NXCD, xcd = wgid % NXCD, off = wgid / NXCD; wgid = (xcd < r ? xcd * (q + 1) : r * (q + 1) + (xcd - r) * q) + off; }
    const int nig = WGM * nN, gid = wgid / nig, fm = gid * WGM, gsz = (nM - fm) < WGM ? (nM - fm) : WGM;
    u.pm = fm + ((wgid % nig) % gsz); u.pn = (wgid % nig) / gsz; u.koff = 0; return true;
  }
};
struct SplitOrder {
  int pm, nN, nsub, kchunk, G, c;
  __device__ bool next(int i, Unit& u) const { const int s = i * G + c; if (s >= nsub) return false; u.pm = pm; u.pn = s % nN; u.koff = (s / nN) * kchunk; return true; }
};
template <class Epi, class Order>
__device__ __forceinline__ void gemm_phase(LAS unsigned char* lds, const Gemm g, const Order& S, Epi& E) {
  int tid_ = threadIdx.x; asm volatile("" : "+v"(tid_));
  const int tid = tid_, wid = __builtin_amdgcn_readfirstlane(tid >> 6), lane = tid & 63, wr = wid >> 2, wc = wid & 3, fr = lane & 15, fq = lane >> 4;
  int K_ = g.K; asm volatile("" : "+s"(K_));
  const int K = K_, nt = K / BK;
  int lda_ = g.lda, ldb_ = g.ldb; asm volatile("" : "+s"(lda_), "+s"(ldb_));
  unsigned voffA[2];
#pragma unroll
  for (int i = 0; i < 2; ++i) { int R, C; stage_rc(tid * 16 + i * 8192, R, C); voffA[i] = (unsigned)(R * lda_ + C) * 2u; }
  const size_t kstep = (size_t)(BK * 2), hstepA = (size_t)HALF * lda_ * 2, tstepA = 2 * hstepA, hstepB = (size_t)HALF * ldb_ * 2, tstepB = 2 * hstepB;
  const unsigned ldsw = (unsigned)wid * 1024u;
  const int aoff = lds_byte(wr * 64 + fr, fq * 8), boff = lds_byte(wc * 32 + fr, fq * 8);
#define PG8_SA(b, h) (((b) * 2 + (h)) * HTB)
#define PG8_SB(b, h) ((4 + (b) * 2 + (h)) * HTB)
#define PG8_STAGE_(bufoff, gbase, voff) do { _Pragma("unroll") for (int _i = 0; _i < 2; ++_i) \
    __builtin_amdgcn_global_load_lds((const unsigned*)((const char*)(gbase) + (voff)[_i]), (LAS unsigned*)(lds + (bufoff) + ldsw + _i * 8192), 16, 0, 0); } while (0)
#define PG8_STA(bufoff, gbase) PG8_STAGE_(bufoff, gbase, voffA)
#define PG8_STB(bufoff, gbase) PG8_STAGE_(bufoff, gbase, voffA)
#define PG8_LDA(dst, b, h) do { _Pragma("unroll") for (int m = 0; m < 4; ++m) _Pragma("unroll") for (int k = 0; k < 2; ++k) dst[m][k] = *(const LAS bf16x8*)(lds + PG8_SA(b, h) + aoff + m * 2048 + k * 1024); } while (0)
#define PG8_LDB(dst, b, h) do { _Pragma("unroll") for (int n = 0; n < 2; ++n) _Pragma("unroll") for (int k = 0; k < 2; ++k) dst[n][k] = *(const LAS bf16x8*)(lds + PG8_SB(b, h) + boff + n * 2048 + k * 1024); } while (0)
#define PG8_MMA(ai, bj, At, Bt) do { __builtin_amdgcn_s_setprio(1); _Pragma("unroll") for (int m = 0; m < 4; ++m) _Pragma("unroll") for (int n = 0; n < 2; ++n) _Pragma("unroll") for (int k = 0; k < 2; ++k) \
    acc[ai][bj][m][n] = __builtin_amdgcn_mfma_f32_16x16x32_bf16(Bt[n][k], At[m][k], acc[ai][bj][m][n], 0, 0, 0); __builtin_amdgcn_s_setprio(0); } while (0)
#define PG8_WAIT_V(n) asm volatile("s_waitcnt vmcnt(" #n ")" ::: "memory")
#define PG8_WAIT_L(n) asm volatile("s_waitcnt lgkmcnt(" #n ")" ::: "memory")
#define PG8_BAR __builtin_amdgcn_s_barrier()
#define PG8_SCHED __builtin_amdgcn_sched_barrier(0)
  Unit cur, nxt; int ui = 0;
  if (!S.next(0, cur)) return;
  f32x4 acc[2][2][4][2];
#pragma unroll
  for (int a = 0; a < 2; ++a)
#pragma unroll
    for (int b = 0; b < 2; ++b)
#pragma unroll
      for (int m = 0; m < 4; ++m)
#pragma unroll
        for (int n = 0; n < 2; ++n) acc[a][b][m][n] = (f32x4){0.f, 0.f, 0.f, 0.f};
  bf16x8 At[4][2], B0[2][2], B1[2][2];
  const char* cA = (const char*)g.A + (size_t)cur.pm * tstepA + (size_t)cur.koff * 2; const char* cB = (const char*)g.Bt + (size_t)cur.pn * tstepB + (size_t)cur.koff * 2;
  PG8_STB(PG8_SB(0, 0), cB); PG8_STB(PG8_SB(0, 1), cB + hstepB); PG8_STA(PG8_SA(0, 0), cA); PG8_STA(PG8_SA(0, 1), cA + hstepA);
  if (wr == 1) PG8_BAR;
  PG8_WAIT_V(2); PG8_BAR;
  PG8_STB(PG8_SB(1, 0), cB + kstep); PG8_STA(PG8_SA(1, 0), cA + kstep); PG8_STB(PG8_SB(1, 1), cB + hstepB + kstep);
  PG8_WAIT_V(6); PG8_BAR;
  for (;;) {
    const bool has_next = S.next(ui + 1, nxt);
    const char* nA = has_next ? (const char*)g.A + (size_t)nxt.pm * tstepA + (size_t)nxt.koff * 2 : cA; const char* nB = has_next ? (const char*)g.Bt + (size_t)nxt.pn * tstepB + (size_t)nxt.koff * 2 : cB;
    for (int t = 0; t < nt; t += 2) {
      const bool last = (t == nt - 2);
      const char* a1 = cA + (size_t)(t + 1) * kstep;
      const char* a2 = last ? nA : cA + (size_t)(t + 2) * kstep; const char* b2 = last ? nB : cB + (size_t)(t + 2) * kstep;
      const char* a3 = a2 + kstep; const char* b3 = b2 + kstep;
      if constexpr (Epi::HAS_PRE) { if (t == 0) E.pre_load(cur, tid); if (t == 2) E.pre_store(ui, tid); }
      if constexpr (Epi::HAS_MID) { if (t == E.tsplit) { asm volatile("" : "+s"(cur.pm)); E.mid(acc, cur, wr, wc, fr, fq); } }
      PG8_LDB(B0, 0, 0); PG8_LDB(B1, 0, 1); PG8_SCHED; PG8_LDA(At, 0, 0); PG8_STA(PG8_SA(1, 1), a1 + hstepA);
      PG8_WAIT_V(8); PG8_WAIT_L(0); PG8_BAR; PG8_MMA(0, 0, At, B0); PG8_MMA(0, 1, At, B1); PG8_BAR; PG8_SCHED;
      PG8_LDA(At, 0, 1); PG8_STB(PG8_SB(0, 0), b2); PG8_STB(PG8_SB(0, 1), b2 + hstepB); PG8_STA(PG8_SA(0, 0), a2);
      PG8_WAIT_V(8); PG8_WAIT_L(0); PG8_BAR; PG8_MMA(1, 0, At, B0); PG8_MMA(1, 1, At, B1); PG8_BAR; PG8_SCHED;
      PG8_LDB(B0, 1, 0); PG8_LDB(B1, 1, 1); PG8_SCHED; PG8_LDA(At, 1, 0); PG8_STA(PG8_SA(0, 1), a2 + hstepA);
      PG8_WAIT_V(8); PG8_WAIT_L(0); PG8_BAR; PG8_MMA(0, 0, At, B0); PG8_MMA(0, 1, At, B1); PG8_BAR; PG8_SCHED;
      PG8_LDA(At, 1, 1); PG8_STB(PG8_SB(1, 0), b3); PG8_STB(PG8_SB(1, 1), b3 + hstepB); PG8_STA(PG8_SA(1, 0), a3);
      PG8_WAIT_V(8); PG8_WAIT_L(0); PG8_BAR; PG8_MMA(1, 0, At, B0); PG8_MMA(1, 1, At, B1); PG8_BAR; PG8_SCHED;
    }
    if (wr == 0) PG8_BAR;
    asm volatile("" : "+s"(cur.pm), "+s"(cur.pn));
    E(acc, cur, wr, wc, fr, fq);
    if (!has_next) break;
#pragma unroll
    for (int a = 0; a < 2; ++a)
#pragma unroll
      for (int b = 0; b < 2; ++b)
#pragma unroll
        for (int m = 0; m < 4; ++m)
#pragma unroll
          for (int n = 0; n < 2; ++n) acc[a][b][m][n] = (f32x4){0.f, 0.f, 0.f, 0.f};
    cur = nxt; cA = nA; cB = nB; ++ui;
    if (wr == 1) PG8_BAR;
  }
  PG8_WAIT_V(0);
  PG8_BAR;
#undef PG8_SA
#undef PG8_SB
#undef PG8_STAGE_
#undef PG8_STA
#undef PG8_STB
#undef PG8_LDA
#undef PG8_LDB
#undef PG8_MMA
#undef PG8_WAIT_V
#undef PG8_WAIT_L
#undef PG8_BAR
#undef PG8_SCHED
}
}
using pg8::Unit;
typedef f32x4 Acc[2][2][4][2];
#define FOR_AM _Pragma("unroll") for (int ai = 0; ai < 2; ++ai) _Pragma("unroll") for (int m = 0; m < 4; ++m)
#define FOR_BN _Pragma("unroll") for (int bj = 0; bj < 2; ++bj) _Pragma("unroll") for (int n = 0; n < 2; ++n)
__device__ __forceinline__ void st_bf4(bf16_t* p, f32x4 v) { u32x2 w; w.x = pk2(v[0], v[1]); w.y = pk2(v[2], v[3]); *(u32x2*)p = w; }
__device__ __forceinline__ void st_bf8(bf16_t* p, f32x4 a, f32x4 b) { u32x4 w; w.x = pk2(a[0], a[1]); w.y = pk2(a[2], a[3]); w.z = pk2(b[0], b[1]); w.w = pk2(b[2], b[3]); *(u32x4*)p = w; }
__device__ __forceinline__ void st_bf4x2(bf16_t* pa, f32x4 a, bf16_t* pb, f32x4 b, int fq) {
  const unsigned A0 = pk2(a[0], a[1]), A1 = pk2(a[2], a[3]), B0 = pk2(b[0], b[1]), B1 = pk2(b[2], b[3]);
  const auto r0 = __builtin_amdgcn_permlane16_swap(A0, B0, false, false);
  const auto r1 = __builtin_amdgcn_permlane16_swap(A1, B1, false, false);
  u32x4 w; w.x = r0[0]; w.y = r1[0]; w.z = r0[1]; w.w = r1[1];
  *(u32x4*)((fq & 1) ? pb - 4 : pa) = w;
}
__device__ __forceinline__ void atomic_addf(float* p, float v) { __hip_atomic_fetch_add(p, v, __ATOMIC_RELAXED, __HIP_MEMORY_SCOPE_AGENT); }

struct EpiIn {
  static constexpr bool HAS_MID = false, HAS_PRE = false;
  float* out; bf16_t *CQN, *CKV, *KR, *QB, *KB, *VB; const float* g_kv; LAS float* red;
  __device__ __forceinline__ void operator()(const Acc& acc, const Unit& u, int wr, int wc, int fr, int fq) const {
    const int pn = u.pn, rbase = u.pm * 256 + wr * 64 + fr, cw = wc * 32 + 4 * fq;
    if (pn <= 1) {
      FOR_AM { float s = 0.f; FOR_BN { const f32x4 x = acc[ai][bj][m][n]; s += (x[0] * x[0] + x[1] * x[1]) + (x[2] * x[2] + x[3] * x[3]); }
        s += __shfl_xor(s, 16); s += __shfl_xor(s, 32);
        if (fq == 0) red[(ai * 128 + wr * 64 + m * 16 + fr) * 4 + wc] = s; }
      asm volatile("s_waitcnt lgkmcnt(0)" ::: "memory"); __builtin_amdgcn_s_barrier(); asm volatile("" ::: "memory");
      FOR_AM { const f32x4 t = *(const LAS f32x4*)(red + (ai * 128 + wr * 64 + m * 16 + fr) * 4);
        const float rstd = __builtin_amdgcn_rsqf(((t[0] + t[1]) + (t[2] + t[3])) * (1.0f / 256.0f) + EPS);
        const int row = rbase + ai * 128 + m * 16;
        if (pn == 0) {
#pragma unroll
          for (int bj = 0; bj < 2; ++bj) { bf16_t* q = CQN + (size_t)row * 256 + bj * 128 + cw; st_bf4x2(q, acc[ai][bj][m][0] * rstd, q + 16, acc[ai][bj][m][1] * rstd, fq); } }
        else { const int mr = maprow_lat(row); float* o = row < MP ? out + OFF_CKVP + (size_t)row * 256 : out + OFF_CKVS + (size_t)(row - MP) * 256;
#pragma unroll
          for (int bj = 0; bj < 2; ++bj) { const int col = bj * 128 + cw; const f32x4 v0 = acc[ai][bj][m][0] * rstd * *(const f32x4*)(g_kv + col), v1 = acc[ai][bj][m][1] * rstd * *(const f32x4*)(g_kv + col + 16);
            *(f32x4*)(o + col) = v0; *(f32x4*)(o + col + 16) = v1; st_bf4x2(CKV + (size_t)mr * 256 + col, v0, CKV + (size_t)mr * 256 + col + 16, v1, fq); } } }
      asm volatile("s_waitcnt lgkmcnt(0)" ::: "memory"); __builtin_amdgcn_s_barrier(); asm volatile("" ::: "memory");
    } else if (pn <= 3) {
      FOR_AM { const int row = rbase + ai * 128 + m * 16;
#pragma unroll
        for (int bj = 0; bj < 2; ++bj) { bf16_t* q = QB + (size_t)row * 512 + (pn - 2) * 256 + bj * 128 + cw; st_bf4x2(q, acc[ai][bj][m][0] * QSCALE_B, q + 16, acc[ai][bj][m][1] * QSCALE_B, fq); } }
    } else if (pn <= 7) {
      const bool isv = pn >= 6; bf16_t* dst = isv ? VB : KB; const int c0 = (pn & 1) * 256;
      FOR_AM { const int row = rbase + ai * 128 + m * 16; const int mr = maprow_bnd(row);
        float* o = nullptr;
        if (row >= MP) o = out + (isv ? OFF_BVS : OFF_BKS) + (size_t)(row - MP) * 512;
        else if ((row & (SEQ - 1)) >= SEQ - 512) o = out + (isv ? OFF_BVP : OFF_BKP) + ((size_t)(row >> 11) * 512 + ((row & (SEQ - 1)) - (SEQ - 512))) * 512;
#pragma unroll
        for (int bj = 0; bj < 2; ++bj) { const int col = c0 + bj * 128 + cw; st_bf4x2(dst + (size_t)mr * 512 + col, acc[ai][bj][m][0], dst + (size_t)mr * 512 + col + 16, acc[ai][bj][m][1], fq);
          if (o) { *(f32x4*)(o + col) = acc[ai][bj][m][0]; *(f32x4*)(o + col + 16) = acc[ai][bj][m][1]; } } }
    } else {
      if (wc == 0) {
        FOR_AM { const int row = rbase + ai * 128 + m * 16; const int pos = row_pos(row), mr = maprow_lat(row);
          float* o = row < MP ? out + OFF_KRP + (size_t)row * 32 : out + OFF_KRS + (size_t)(row - MP) * 32;
          const f32x4 x1 = acc[ai][0][m][0], x2 = acc[ai][0][m][1]; f32x4 y1, y2;
#pragma unroll
          for (int j = 0; j < 4; ++j) { float c, s; rope_cs(pos, 4 * fq + j, c, s); y1[j] = x1[j] * c - x2[j] * s; y2[j] = x1[j] * s + x2[j] * c; }
          *(f32x4*)(o + 4 * fq) = y1; *(f32x4*)(o + 16 + 4 * fq) = y2;
          st_bf4x2(KR + (size_t)mr * 32 + 4 * fq, y1, KR + (size_t)mr * 32 + 16 + 4 * fq, y2, fq); }
      }
    }
  }
};
struct EpiQ {
  static constexpr bool HAS_MID = false, HAS_PRE = false;
  bf16_t* Q;
  __device__ __forceinline__ void operator()(const Acc& acc, const Unit& u, int wr, int wc, int fr, int fq) const {
    const int pn = u.pn, rbase = u.pm * 256 + wr * 64 + fr;
    if (pn <= 1) {
      FOR_AM { const int row = rbase + ai * 128 + m * 16;
#pragma unroll
        for (int bj = 0; bj < 2; ++bj) { const int col = pn * 256 + bj * 128 + wc * 32 + 4 * fq; bf16_t* q = Q + (size_t)row * 768 + (col >> 6) * 96 + (col & 63);
          st_bf4x2(q, acc[ai][bj][m][0] * QSCALE_A, q + 16, acc[ai][bj][m][1] * QSCALE_A, fq); } }
    } else {
      FOR_AM { const int row = rbase + ai * 128 + m * 16; const int pos = row_pos(row);
        float cs[4], sn[4];
#pragma unroll
        for (int j = 0; j < 4; ++j) rope_cs(pos, 4 * fq + j, cs[j], sn[j]);
#pragma unroll
        for (int bj = 0; bj < 2; ++bj) { const int head = 4 * bj + wc; const f32x4 x1 = acc[ai][bj][m][0], x2 = acc[ai][bj][m][1]; f32x4 y1, y2;
#pragma unroll
          for (int j = 0; j < 4; ++j) { y1[j] = (x1[j] * cs[j] - x2[j] * sn[j]) * QSCALE_A; y2[j] = (x1[j] * sn[j] + x2[j] * cs[j]) * QSCALE_A; }
          bf16_t* q = Q + (size_t)row * 768 + head * 96 + 64 + 4 * fq; st_bf4x2(q, y1, q + 16, y2, fq); } __builtin_amdgcn_sched_barrier(0); }
    }
  }
};
struct EpiKV {
  static constexpr bool HAS_MID = false, HAS_PRE = false;
  bf16_t *KN, *V;
  __device__ __forceinline__ void operator()(const Acc& acc, const Unit& u, int wr, int wc, int fr, int fq) const {
    const int pn = u.pn, rbase = u.pm * 256 + wr * 64 + fr; bf16_t* dst = pn >= 2 ? V : KN; const int c0 = (pn & 1) * 256 + wc * 32 + 4 * fq;
    FOR_AM { const int row = rbase + ai * 128 + m * 16;
#pragma unroll
      for (int bj = 0; bj < 2; ++bj) { bf16_t* q = dst + (size_t)row * 512 + c0 + bj * 128; st_bf4x2(q, acc[ai][bj][m][0], q + 16, acc[ai][bj][m][1], fq); } }
  }
};
struct EpiO {
  static constexpr bool HAS_MID = true, HAS_PRE = true;
  int tsplit; const float *ssq_a, *ssq_b, *xp, *xs; bf16_t* X1B; float* ssq_x1; LAS float* pre; float p0, p1; int par;
  __device__ __forceinline__ void pre_load(const Unit& u, int tid) { if (tid < 256) { p0 = ssq_a[u.pm * 256 + tid]; p1 = ssq_b[u.pm * 256 + tid]; } }
  __device__ __forceinline__ void pre_store(int ui, int tid) { par = ui & 1; if (tid < 256) { pre[par * 512 + tid] = p0; pre[par * 512 + 256 + tid] = p1; } }
  __device__ __forceinline__ void mid(Acc& acc, const Unit& u, int wr, int wc, int fr, int fq) const {
    FOR_AM { const int rl = par * 512 + ai * 128 + wr * 64 + m * 16 + fr;
      const float ratio = __builtin_amdgcn_rsqf(pre[rl] * (1.0f / 512.0f) + EPS) * __builtin_sqrtf(pre[rl + 256] * (1.0f / 512.0f) + EPS);
      FOR_BN { acc[ai][bj][m][n] = acc[ai][bj][m][n] * ratio; }
      __builtin_amdgcn_sched_barrier(0); }
  }
  __device__ __forceinline__ void operator()(const Acc& acc, const Unit& u, int wr, int wc, int fr, int fq) const {
    const int rbase = u.pm * 256 + wr * 64 + fr, c0 = u.pn * 256 + wc * 32 + 4 * fq;
    f32x4 xb[2][4];
    { const int row = rbase; const float* xr = row < MP ? xp + (size_t)row * D : xs + (size_t)(row - MP) * D;
#pragma unroll
      for (int bj = 0; bj < 2; ++bj) { xb[0][2 * bj] = *(const f32x4*)(xr + c0 + bj * 128); xb[0][2 * bj + 1] = *(const f32x4*)(xr + c0 + bj * 128 + 16); } }
#pragma unroll
    for (int idx = 0; idx < 8; ++idx) { const int ai = idx >> 2, m = idx & 3; const int row = rbase + ai * 128 + m * 16;
      if (idx < 7) { const int rown = rbase + ((idx + 1) >> 2) * 128 + ((idx + 1) & 3) * 16; const float* xr = rown < MP ? xp + (size_t)rown * D : xs + (size_t)(rown - MP) * D;
#pragma unroll
        for (int bj = 0; bj < 2; ++bj) { xb[(idx + 1) & 1][2 * bj] = *(const f32x4*)(xr + c0 + bj * 128); xb[(idx + 1) & 1][2 * bj + 1] = *(const f32x4*)(xr + c0 + bj * 128 + 16); } }
      const float rb = u.koff < 0 ? 1.0f : __builtin_amdgcn_rsqf(pre[par * 512 + 256 + ai * 128 + wr * 64 + m * 16 + fr] * (1.0f / 512.0f) + EPS);
      float s = 0.f;
#pragma unroll
      for (int bj = 0; bj < 2; ++bj) { const int col = c0 + bj * 128; const f32x4 v0 = xb[idx & 1][2 * bj] + acc[ai][bj][m][0] * rb, v1 = xb[idx & 1][2 * bj + 1] + acc[ai][bj][m][1] * rb;
        st_bf4x2(X1B + (size_t)row * D + col, v0, X1B + (size_t)row * D + col + 16, v1, fq);
        s += ((v0[0] * v0[0] + v0[1] * v0[1]) + (v0[2] * v0[2] + v0[3] * v0[3])) + ((v1[0] * v1[0] + v1[1] * v1[1]) + (v1[2] * v1[2] + v1[3] * v1[3])); }
      s += __shfl_xor(s, 16); s += __shfl_xor(s, 32); if (fq == 0) atomic_addf(ssq_x1 + row, s); __builtin_amdgcn_sched_barrier(0); }
  }
};
struct EpiGU {
  static constexpr bool HAS_MID = false, HAS_PRE = true;
  const float* ssq_x1; bf16_t* H; LAS float* pre; float p0; int par;
  __device__ __forceinline__ void pre_load(const Unit& u, int tid) { if (tid < 256) p0 = ssq_x1[u.pm * 256 + tid]; }
  __device__ __forceinline__ void pre_store(int ui, int tid) { par = ui & 1; if (tid < 256) pre[par * 512 + tid] = p0; }
  __device__ __forceinline__ void operator()(const Acc& acc, const Unit& u, int wr, int wc, int fr, int fq) const {
    const int rbase = u.pm * 256 + wr * 64 + fr, c0 = u.pn * 128 + wc * 16 + 4 * fq;
    FOR_AM { const int row = rbase + ai * 128 + m * 16; const float rstd = __builtin_amdgcn_rsqf(pre[par * 512 + ai * 128 + wr * 64 + m * 16 + fr] * (1.0f / 1024.0f) + EPS);
      f32x4 hv[2];
#pragma unroll
      for (int bj = 0; bj < 2; ++bj) { const f32x4 g = acc[ai][bj][m][0] * rstd, up = acc[ai][bj][m][1] * rstd;
#pragma unroll
        for (int j = 0; j < 4; ++j) hv[bj][j] = g[j] * __builtin_amdgcn_rcpf(1.0f + __builtin_amdgcn_exp2f(-g[j] * LOG2E)) * up[j]; }
      st_bf4x2(H + (size_t)row * FF + c0, hv[0], H + (size_t)row * FF + c0 + 64, hv[1], fq); }
  }
};
__device__ __forceinline__ f32x4 ld_bf4(const bf16_t* p) { const u32x2 w = *(const u32x2*)p; return (f32x4){__builtin_bit_cast(float, w.x << 16), __builtin_bit_cast(float, w.x & 0xffff0000u), __builtin_bit_cast(float, w.y << 16), __builtin_bit_cast(float, w.y & 0xffff0000u)}; }
__device__ __forceinline__ void ld_bf4x2(const bf16_t* pa, const bf16_t* pb, int fq, f32x4& a, f32x4& b) {
  const u32x4 w = *(const u32x4*)((fq & 1) ? pb - 4 : pa);
  const auto r0 = __builtin_amdgcn_permlane16_swap(w.x, w.z, false, false);
  const auto r1 = __builtin_amdgcn_permlane16_swap(w.y, w.w, false, false);
  a = (f32x4){__builtin_bit_cast(float, r0[0] << 16), __builtin_bit_cast(float, r0[0] & 0xffff0000u), __builtin_bit_cast(float, r1[0] << 16), __builtin_bit_cast(float, r1[0] & 0xffff0000u)};
  b = (f32x4){__builtin_bit_cast(float, r0[1] << 16), __builtin_bit_cast(float, r0[1] & 0xffff0000u), __builtin_bit_cast(float, r1[1] << 16), __builtin_bit_cast(float, r1[1] & 0xffff0000u)};
}
struct EpiD {
  static constexpr bool HAS_MID = false, HAS_PRE = false;
  bf16_t* X; float* ssq_x2;
  __device__ __forceinline__ void operator()(const Acc& acc, const Unit& u, int wr, int wc, int fr, int fq) const {
    const int rbase = u.pm * 256 + wr * 64 + fr, c0 = u.pn * 256 + wc * 32 + 4 * fq;
    FOR_AM { const int row = rbase + ai * 128 + m * 16; float s = 0.f;
#pragma unroll
      for (int bj = 0; bj < 2; ++bj) { bf16_t* x = X + (size_t)row * D + c0 + bj * 128; f32x4 x0, x1; ld_bf4x2(x, x + 16, fq, x0, x1); const f32x4 v0 = x0 + acc[ai][bj][m][0], v1 = x1 + acc[ai][bj][m][1];
        st_bf4x2(x, v0, x + 16, v1, fq);
        s += ((v0[0] * v0[0] + v0[1] * v0[1]) + (v0[2] * v0[2] + v0[3] * v0[3])) + ((v1[0] * v1[0] + v1[1] * v1[1]) + (v1[2] * v1[2] + v1[3] * v1[3])); }
      s += __shfl_xor(s, 16); s += __shfl_xor(s, 32); if (fq == 0) atomic_addf(ssq_x2 + row, s); }
  }
};
struct EpiPart {
  static constexpr bool HAS_MID = false, HAS_PRE = false;
  float* PART;
  __device__ __forceinline__ void operator()(const Acc& acc, const Unit& u, int wr, int wc, int fr, int fq) const {
    float* base = PART + (size_t)(u.koff >> 8) * 256 * D; const int r0 = wr * 64 + fr, c0 = u.pn * 256 + wc * 32 + 4 * fq;
    FOR_AM { FOR_BN { *(f32x4*)(base + (size_t)(r0 + ai * 128 + m * 16) * D + c0 + bj * 128 + n * 16) = acc[ai][bj][m][n]; } }
  }
};

__device__ __forceinline__ float wave_sum(float v) {
#pragma unroll
  for (int o = 1; o < 64; o <<= 1) v += __shfl_xor(v, o);
  return v;
}
template <class Map>
__device__ __forceinline__ void transpose_item(const float* W, int K, int N, bf16_t* WT, const float* g, LAS float* scr, int item, int lane, Map map) {
  const int nblk = N / 32, kb = item / nblk, nb = item % nblk, k0 = 64 * kb, n0 = 32 * nb;
  f32x4 wv[8];
#pragma unroll
  for (int i = 0; i < 8; ++i) { const int kk = 8 * i + (lane >> 3); wv[i] = *(const f32x4*)(W + (size_t)(k0 + kk) * N + n0 + 4 * (lane & 7)) * (g ? g[k0 + kk] : 1.0f); }
#pragma unroll
  for (int i = 0; i < 8; ++i) { const int kk = 8 * i + (lane >> 3); LAS float* d = scr + kk * 33 + 4 * (lane & 7); d[0] = wv[i][0]; d[1] = wv[i][1]; d[2] = wv[i][2]; d[3] = wv[i][3]; }
  asm volatile("s_waitcnt lgkmcnt(0)" ::: "memory");
  const int c = lane & 7;
#pragma unroll
  for (int j = 0; j < 4; ++j) { const int n = (lane >> 3) + 8 * j; const LAS float* s = scr + (8 * c) * 33 + n;
    u32x4 o; o.x = pk2(s[0 * 33], s[1 * 33]); o.y = pk2(s[2 * 33], s[3 * 33]); o.z = pk2(s[4 * 33], s[5 * 33]); o.w = pk2(s[6 * 33], s[7 * 33]);
    *(u32x4*)(WT + (size_t)map(n0 + n) * K + k0 + 8 * c) = o; }
  asm volatile("s_waitcnt lgkmcnt(0)" ::: "memory");
}
template <class Map>
__device__ __forceinline__ void convert_rows(const float* src, bf16_t* dst, int R, int cshift, int gt, int ngt, Map map) {
  const long n8 = ((long)R << cshift) >> 3;
  for (long i0 = gt; i0 < n8; i0 += 4L * ngt) {
    f32x4 v[4][2];
#pragma unroll
    for (int k = 0; k < 4; ++k) { const long i = i0 + (long)k * ngt; if (i < n8) { v[k][0] = *(const f32x4*)(src + i * 8); v[k][1] = *(const f32x4*)(src + i * 8 + 4); } }
#pragma unroll
    for (int k = 0; k < 4; ++k) { const long i = i0 + (long)k * ngt; if (i < n8) { const long e = i * 8; const int r = (int)(e >> cshift), c = (int)(e & ((1 << cshift) - 1));
      st_bf8(dst + ((size_t)map(r) << cshift) + c, v[k][0], v[k][1]); } }
  }
}
__device__ __forceinline__ void zero_rows(bf16_t* dst, int cshift, int r0, int nr, int nb, int bstride, int gt, int ngt) {
  const long per = ((long)nr << cshift) >> 3, n8 = per * nb;
  for (long i = gt; i < n8; i += ngt) { const int b = (int)(i / per); const long e = (i % per) * 8; *(u32x4*)(dst + (((size_t)b * bstride + r0) << cshift) + e) = (u32x4){0u, 0u, 0u, 0u}; }
}
__device__ __forceinline__ void prologue(ParamsC p, LAS unsigned char* lds, int G) {
  const int tid = threadIdx.x, lane = tid & 63, wave = tid >> 6; unsigned char* ws = p->ws;
  const int gw = blockIdx.x * 8 + wave, NGW = G * 8, gt = blockIdx.x * NTHREADS + tid, ngt = G * NTHREADS;
  LAS float* scr = (LAS float*)(lds + wave * 16384);
  bf16_t* WinT = (bf16_t*)(ws + WS_WIN); bf16_t* WuqT = (bf16_t*)(ws + WS_WUQ); bf16_t* WkvT = (bf16_t*)(ws + WS_WKV); bf16_t* WoT = (bf16_t*)(ws + WS_WO);
  bf16_t* WguT = (bf16_t*)(ws + WS_WGU); bf16_t* WdT = (bf16_t*)(ws + WS_WD);
  constexpr int I_IN = 16 * 65, I_UQ = 4 * 24, I_UK = 4 * 16, I_O = 16 * 32, I_G = 16 * 88, I_D = 44 * 32;
  constexpr int NITEMS = I_IN + I_UQ + 2 * I_UK + I_O + 2 * I_G + I_D;
  for (int it = gw; it < NITEMS; it += NGW) {
    int r = it;
    if (r < I_IN) { transpose_item(p->w_in, 1024, 2080, WinT, p->g_attn, scr, r, lane, [](int n) { return n < 512 ? n : (n < 544 ? 2048 + (n - 512) : 512 + (n - 544)); }); continue; } r -= I_IN;
    if (r < I_UQ) { transpose_item(p->w_uq, 256, 768, WuqT, p->g_q, scr, r, lane, [](int n) { const int h = n / 96, d = n % 96; return d < 64 ? h * 64 + d : 512 + h * 32 + (d - 64); }); continue; } r -= I_UQ;
    if (r < I_UK) { transpose_item(p->w_uk, 256, 512, WkvT, nullptr, scr, r, lane, [](int n) { return n; }); continue; } r -= I_UK;
    if (r < I_UK) { transpose_item(p->w_uv, 256, 512, WkvT, nullptr, scr, r, lane, [](int n) { return 512 + n; }); continue; } r -= I_UK;
    if (r < I_O) { const int kb = r / 32; transpose_item(p->w_out, 1024, 1024, WoT, kb < 8 ? p->g_out_a : p->g_out_b - 512, scr, r, lane, [](int n) { return n; }); continue; } r -= I_O;
    if (r < I_G) { transpose_item(p->w_gate, 1024, FF, WguT, p->g_ffn, scr, r, lane, [](int n) { return 32 * (n >> 4) + (n & 15); }); continue; } r -= I_G;
    if (r < I_G) { transpose_item(p->w_up, 1024, FF, WguT, p->g_ffn, scr, r, lane, [](int n) { return 32 * (n >> 4) + 16 + (n & 15); }); continue; } r -= I_G;
    transpose_item(p->w_down, FF, 1024, WdT, nullptr, scr, r, lane, [](int n) { return n; });
  }
  zero_rows(WinT, 10, 2080, NIN - 2080, 1, 0, gt, ngt);
  bf16_t* XN = (bf16_t*)(ws + WS_XN);
  for (int row0 = gw; row0 < MT; row0 += 4 * NGW) {
    f32x4 v[4][4]; float s[4] = {0.f, 0.f, 0.f, 0.f};
#pragma unroll
    for (int k = 0; k < 4; ++k) { const int row = row0 + k * NGW; if (row < MT) { const float* xr = row < MP ? p->xp + (size_t)row * D : p->xs + (size_t)(row - MP) * D;
#pragma unroll
      for (int j = 0; j < 2; ++j) { v[k][2 * j] = *(const f32x4*)(xr + 8 * lane + 512 * j); v[k][2 * j + 1] = *(const f32x4*)(xr + 8 * lane + 512 * j + 4); } } }
#pragma unroll
    for (int k = 0; k < 4; ++k) { const int row = row0 + k * NGW; if (row < MT) {
#pragma unroll
      for (int j = 0; j < 4; ++j) s[k] += (v[k][j][0] * v[k][j][0] + v[k][j][1] * v[k][j][1]) + (v[k][j][2] * v[k][j][2] + v[k][j][3] * v[k][j][3]);
      const float rstd = __builtin_amdgcn_rsqf(wave_sum(s[k]) * (1.0f / D) + EPS);
#pragma unroll
      for (int j = 0; j < 2; ++j) st_bf8(XN + (size_t)row * D + 8 * lane + 512 * j, v[k][2 * j] * rstd, v[k][2 * j + 1] * rstd); } }
  }
  bf16_t* CKV = (bf16_t*)(ws + WS_CKV); bf16_t* KR = (bf16_t*)(ws + WS_KR); bf16_t* KB = (bf16_t*)(ws + WS_KB); bf16_t* VB = (bf16_t*)(ws + WS_VB);
  convert_rows(p->c_ckv, CKV, DB * PAST, 8, gt, ngt, [](int r) { return MP + (r >> 12) * LROW + (r & 4095); });
  convert_rows(p->c_kr, KR, DB * PAST, 5, gt, ngt, [](int r) { return MP + (r >> 12) * LROW + (r & 4095); });
  convert_rows(p->c_bk, KB, DB * 512, 9, gt, ngt, [](int r) { return MP + (r >> 9) * BROW + (r & 511); });
  convert_rows(p->c_bv, VB, DB * 512, 9, gt, ngt, [](int r) { return MP + (r >> 9) * BROW + (r & 511); });
  zero_rows(CKV + (size_t)MP * 256, 8, PAST + DSQ, LROW - PAST - DSQ, DB, LROW, gt, ngt);
  zero_rows(KR + (size_t)MP * 32, 5, PAST + DSQ, LROW - PAST - DSQ, DB, LROW, gt, ngt);
  zero_rows(KB + (size_t)MP * 512, 9, 512 + DSQ, BROW - 512 - DSQ, DB, BROW, gt, ngt);
  zero_rows(VB + (size_t)MP * 512, 9, 512 + DSQ, BROW - 512 - DSQ, DB, BROW, gt, ngt);
  float* ssq = (float*)(ws + WS_SSQ);
  for (int i = gt; i < 4 * MT; i += ngt) ssq[i] = 0.f;
}

__device__ __forceinline__ f32x16 mfma32(bf16x8 a, bf16x8 b, f32x16 c) { return __builtin_amdgcn_mfma_f32_32x32x16_bf16(a, b, c, 0, 0, 0); }
__device__ __forceinline__ s16x4 vtr(const LAS unsigned char* p) { return __builtin_bit_cast(s16x4, __builtin_amdgcn_ds_read_tr16_b64_v4i16((LAS s16x4*)p)); }
template <int NS, bool BIAS, bool QL>
__device__ __forceinline__ void attn_qk(const LAS unsigned char* Kt, const bf16x8 (&qf)[NS], const LAS unsigned char* Qt, f32x16 (&st)[2], int nvalid, const LAS float* btab, int rb, bool lookup, int lane) {
  constexpr int KP = NS == 6 ? KP_A : KP_B;
  const int r = lane & 31, h = lane >> 5;
  bf16x8 qv[NS];
#pragma unroll
  for (int s = 0; s < NS; ++s) qv[s] = QL ? *(const LAS bf16x8*)(Qt + r * KP + (2 * s + h) * 16) : qf[s];
#pragma unroll
  for (int kh = 0; kh < 2; ++kh) {
    bf16x8 kf[NS];
#pragma unroll
    for (int s = 0; s < NS; ++s) kf[s] = *(const LAS bf16x8*)(Kt + (32 * kh + r) * KP + (2 * s + h) * 16);
    __builtin_amdgcn_sched_barrier(0);
    __builtin_amdgcn_s_setprio(1);
    { const f32x16 z = {0.f, 0.f, 0.f, 0.f, 0.f, 0.f, 0.f, 0.f, 0.f, 0.f, 0.f, 0.f, 0.f, 0.f, 0.f, 0.f}; st[kh] = mfma32(kf[0], qv[0], z); }
#pragma unroll
    for (int s = 1; s < NS; ++s) st[kh] = mfma32(kf[s], qv[s], st[kh]);
    __builtin_amdgcn_s_setprio(0);
    __builtin_amdgcn_sched_barrier(0);
  }
  if (BIAS) {
    if (lookup) { const LAS float* bp = btab + rb + 4 * h;
#pragma unroll
      for (int kh = 0; kh < 2; ++kh)
#pragma unroll
        for (int i = 0; i < 16; ++i) st[kh][i] += bp[32 * kh + (i & 3) + 8 * (i >> 2)];
    } else { const float bc = btab[0];
#pragma unroll
      for (int kh = 0; kh < 2; ++kh)
#pragma unroll
        for (int i = 0; i < 16; ++i) st[kh][i] += bc; }
  }
  if (nvalid < 64) {
#pragma unroll
    for (int kh = 0; kh < 2; ++kh)
#pragma unroll
      for (int i = 0; i < 16; ++i) { const int key = 32 * kh + (i & 3) + 8 * (i >> 2) + 4 * h; if (key >= nvalid) st[kh][i] = -1e30f; }
  }
}
__device__ __forceinline__ void attn_smpv(const LAS unsigned char* Vt, f32x16 (&st)[2], f32x16 (&o)[2], float& m_run, float& l_run, LAS float* wsf, int lane) {
  const int r = lane & 31, h = lane >> 5;
  float mx = st[0][0];
#pragma unroll
  for (int kh = 0; kh < 2; ++kh)
#pragma unroll
    for (int i = 0; i < 16; ++i) mx = __builtin_fmaxf(mx, st[kh][i]);
  mx = __builtin_fmaxf(mx, __shfl_xor(mx, 32));
  const float m_new = __builtin_fmaxf(m_run, mx), alpha = __builtin_amdgcn_exp2f(m_run - m_new);
  float rs = 0.f;
#pragma unroll
  for (int kh = 0; kh < 2; ++kh)
#pragma unroll
    for (int i = 0; i < 16; ++i) { const float pv = __builtin_amdgcn_exp2f(st[kh][i] - m_new); st[kh][i] = pv; rs += pv; }
  rs += __shfl_xor(rs, 32);
  l_run = l_run * alpha + rs; m_run = m_new;
  {
    if (h == 0) wsf[r] = alpha;
    typedef float f32x8 __attribute__((ext_vector_type(8)));
    const f32x4 a0 = *(const LAS f32x4*)(wsf + 4 * h), a1 = *(const LAS f32x4*)(wsf + 8 + 4 * h), a2 = *(const LAS f32x4*)(wsf + 16 + 4 * h), a3 = *(const LAS f32x4*)(wsf + 24 + 4 * h);
    const f32x8 lo = __builtin_shufflevector(a0, a1, 0, 1, 2, 3, 4, 5, 6, 7), hi = __builtin_shufflevector(a2, a3, 0, 1, 2, 3, 4, 5, 6, 7);
    const f32x16 av = __builtin_shufflevector(lo, hi, 0, 1, 2, 3, 4, 5, 6, 7, 8, 9, 10, 11, 12, 13, 14, 15);
    o[0] = o[0] * av; o[1] = o[1] * av;
  }
  const int blk = (lane >> 4) & 1, q = (lane & 15) >> 2, p = lane & 3;
  const int vb = (4 * h + q) * 128 + 8 * (p & 1), co0 = ((2 * blk + (p >> 1)) ^ (((q >> 1) & 1) << 2)) << 4;
#pragma unroll
  for (int kh = 0; kh < 2; ++kh)
#pragma unroll
    for (int s2 = 0; s2 < 2; ++s2) {
      u32x4 pw;
#pragma unroll
      for (int k = 0; k < 4; ++k) pw[k] = pk2(st[kh][8 * s2 + 2 * k], st[kh][8 * s2 + 2 * k + 1]);
      const bf16x8 pa = __builtin_bit_cast(bf16x8, pw);
#pragma unroll
      for (int c = 0; c < 2; ++c) {
        const LAS unsigned char* vp = Vt + (32 * kh + 16 * s2) * 128 + vb + (c ? (co0 ^ 64) : co0);
        const s16x4 lo = vtr(vp), hi = vtr(vp + 8 * 128);
        const bf16x8 vf = __builtin_shufflevector(lo, hi, 0, 1, 2, 3, 4, 5, 6, 7);
        __builtin_amdgcn_s_setprio(1); o[c] = mfma32(pa, vf, o[c]); __builtin_amdgcn_s_setprio(0);
      }
    }
}
__device__ __forceinline__ void scale_o(f32x16 (&o)[2], float f, LAS float* wsf, int lane) {
  const int r = lane & 31, h = lane >> 5;
  if (h == 0) wsf[r] = f;
#pragma unroll
  for (int g = 0; g < 4; ++g) { const f32x4 a4 = *(const LAS f32x4*)(wsf + 8 * g + 4 * h);
#pragma unroll
    for (int j = 0; j < 4; ++j) { o[0][4 * g + j] *= a4[j]; o[1][4 * g + j] *= a4[j]; } }
}
__device__ __forceinline__ void store_o(const f32x16 (&o)[2], LAS bf16_t* stg, bf16_t* att  , float* ssq  , int nq, int lane) {
  const int r = lane & 31, h = lane >> 5;
#pragma unroll
  for (int c = 0; c < 2; ++c)
#pragma unroll
    for (int i = 0; i < 16; ++i) stg[((i & 3) + 8 * (i >> 2) + 4 * h) * 64 + 32 * c + r] = (bf16_t)f2bf(o[c][i]);
  const int qr = lane >> 1, half = lane & 1; float s = 0.f; u32x4 v[4];
#pragma unroll
  for (int k = 0; k < 4; ++k) { v[k] = *(const LAS u32x4*)(stg + qr * 64 + half * 32 + 8 * k);
#pragma unroll
    for (int e = 0; e < 4; ++e) { const float a = __builtin_bit_cast(float, v[k][e] << 16), b = __builtin_bit_cast(float, v[k][e] & 0xffff0000u); s += a * a + b * b; } }
  s += __shfl_xor(s, 1);
  if (qr < nq) {
#pragma unroll
    for (int k = 0; k < 4; ++k) *(u32x4*)(att + (size_t)qr * D + half * 32 + 8 * k) = v[k];
    if (half == 0 && ssq) atomic_addf(ssq + qr, s);
  }
}
struct KVSrc { const bf16_t* K; const bf16_t* KRp; const bf16_t* V; };
template <int NS>
__device__ __forceinline__ u32x4 ld_kchunk(const KVSrc& s, long krow, int id) {
  if (NS == 6) { const int row = id / 12, ch = id - row * 12;
    return ch < 8 ? *(const u32x4*)(s.K + (krow + row) * 512 + ch * 8) : *(const u32x4*)(s.KRp + (krow + row) * 32 + (ch - 8) * 8); }
  else { const int row = id >> 3, ch = id & 7; return *(const u32x4*)(s.K + (krow + row) * 512 + ch * 8); }
}
template <int NS>
__device__ __forceinline__ void st_kchunk(LAS unsigned char* Kt, int id, u32x4 v) {
  constexpr int KP = NS == 6 ? KP_A : KP_B, CPR = NS == 6 ? 12 : 8;
  const int row = id / CPR, ch = id - row * CPR; *(LAS u32x4*)(Kt + row * KP + ch * 16) = v;
}
__device__ __forceinline__ void st_vchunk(LAS unsigned char* Vt, int id, u32x4 v) { const int row = id >> 3, ch = id & 7; *(LAS u32x4*)(Vt + row * 128 + ((ch ^ (((row >> 1) & 1) << 2)) << 4)) = v; }

__device__ __forceinline__ void glds16(const void* gsrc, unsigned lds_dst) {
  unsigned keep;
  asm volatile("s_mov_b32 %0, m0\n\ts_mov_b32 m0, %2\n\ts_nop 0\n\tglobal_load_lds_dwordx4 %1, off\n\ts_mov_b32 m0, %0" : "=&s"(keep) : "v"(gsrc), "s"(lds_dst) : "memory");
}
template <int NS>
__device__ __forceinline__ void dma_tile(LAS unsigned char* Kt, LAS unsigned char* Vt, const KVSrc& src, long krow, int wave, int lane) {
  constexpr int CPR = NS == 6 ? 13 : 9, ND = CPR;
#pragma unroll
  for (int k = 0; k < 2; ++k) { const int d = wave + 8 * k;
    if (d < ND) { const int c = d * 64 + lane, row = c / CPR, ch = c - row * CPR;
      const bf16_t* g = (NS == 6 && ch >= 8 && ch < 12) ? src.KRp + (krow + row) * 32 + (ch - 8) * 8 : src.K + (krow + row) * 512 + (ch < 8 ? ch : 0) * 8;
      glds16(g, (unsigned)__builtin_amdgcn_readfirstlane((int)(unsigned)(uintptr_t)(Kt + d * 1024))); } }
  { const int c = wave * 64 + lane, row = c >> 3, ch = (c & 7) ^ (((row >> 1) & 1) << 2);
    glds16(src.V + (krow + row) * 512 + ch * 8, (unsigned)__builtin_amdgcn_readfirstlane((int)(unsigned)(uintptr_t)(Vt + wave * 1024))); }
}
#define AT_VMWAIT(n) asm volatile("s_waitcnt vmcnt(" #n ")" ::: "memory")
template <int NS, bool BIAS>
__device__ __forceinline__ void attn_unit_shared(LAS unsigned char* lds, const bf16_t* Qw  , int qpitch, const KVSrc src, long krow0,
                                                 int t_lo, int t_hi, int w_lo, int w_hi, int qpos0  , bf16_t* att, float* ssq, int bhead = 0) {
  constexpr int SLOT = 21504, ND = NS == 6 ? 13 : 9;
  int tid_ = threadIdx.x; asm volatile("" : "+v"(tid_));
  const int tid = tid_, lane = tid & 63, wave = __builtin_amdgcn_readfirstlane(tid >> 6), r = lane & 31, h = lane >> 5;
  LAS float* wsf = (LAS float*)(lds + AT_WSF) + wave * 64; const LAS float* btab = (const LAS float*)(lds + AT_BIAS) + bhead * 640;
#pragma unroll
  for (int k = 0; k < 2; ++k) if (t_lo + k <= t_hi) dma_tile<NS>(lds + AT_TILE + k * SLOT, lds + AT_TILE + k * SLOT + 13312, src, krow0 + 64L * (t_lo + k), wave, lane);
  bf16x8 qf[NS];
#pragma unroll
  for (int s = 0; s < NS; ++s) qf[s] = *(const bf16x8*)(Qw + (size_t)r * qpitch + 16 * s + 8 * h);
#pragma unroll
  for (int s = 0; s < NS; ++s) asm volatile("" : "+v"(qf[s]));
  f32x16 o[2];
#pragma unroll
  for (int i = 0; i < 16; ++i) { o[0][i] = 0.f; o[1][i] = 0.f; }
  float m_run = -1e30f, l_run = 0.f;
  AT_VMWAIT(0);
  asm volatile("s_waitcnt lgkmcnt(0)" ::: "memory"); __builtin_amdgcn_s_barrier(); asm volatile("" ::: "memory");
  for (int t0 = t_lo; t0 <= t_hi; t0 += 2) {
#pragma unroll
    for (int k = 2; k < 4; ++k) if (t0 + k <= t_hi) { const int s3 = (t0 + k - t_lo) & 3; dma_tile<NS>(lds + AT_TILE + s3 * SLOT, lds + AT_TILE + s3 * SLOT + 13312, src, krow0 + 64L * (t0 + k), wave, lane); }
#pragma unroll
    for (int k = 0; k < 2; ++k) { const int t = t0 + k; const int sl = (t - t_lo) & 3;
      if (t <= t_hi && t >= w_lo && t <= w_hi) {
        const bool lookup = BIAS && (qpos0 - (64 * t + 63) < 256);
        f32x16 st[2]; attn_qk<NS, BIAS, false>(lds + AT_TILE + sl * SLOT, qf, nullptr, st, 64, btab, 639 - (qpos0 + r - 64 * t + 256), lookup, lane);
        attn_smpv(lds + AT_TILE + sl * SLOT + 13312, st, o, m_run, l_run, wsf, lane);
      } }
    AT_VMWAIT(0);
    asm volatile("s_waitcnt lgkmcnt(0)" ::: "memory"); __builtin_amdgcn_s_barrier(); asm volatile("" ::: "memory");
  }
  scale_o(o, 1.0f / l_run, wsf, lane);
  store_o(o, (LAS bf16_t*)(lds + AT_OSTG) + wave * 2048, att, ssq, 32, lane);
}
template <int NS, bool BIAS>
__device__ __forceinline__ void attn_unit_sample(LAS unsigned char* lds, const bf16_t* Qw, int qpitch, const KVSrc src, long krow0, int ntiles, int nvalid_last, int qpos0, bf16_t* att, float* ssq, int bhead = 0) {
  constexpr int NKC = NS == 6 ? 768 : 512;
  int tid_ = threadIdx.x; asm volatile("" : "+v"(tid_));
  const int tid = tid_, lane = tid & 63, wave = tid >> 6, r = lane & 31, h = lane >> 5;
  LAS float* wsf = (LAS float*)(lds + AT_WSF) + wave * 64; const LAS float* btab = (const LAS float*)(lds + AT_BIAS) + bhead * 640;
  LAS float* cm = (LAS float*)(lds + AT_CMB);
  f32x16 o[2];
#pragma unroll
  for (int i = 0; i < 16; ++i) { o[0][i] = 0.f; o[1][i] = 0.f; }
  float m_run = -1e30f, l_run = 0.f;
  LAS unsigned char* Kt = lds + AT_TILE + (wave & 3) * AT_PRIV; LAS unsigned char* Vt = Kt + 13312;
  bf16x8 qf[NS];
#pragma unroll
  for (int s = 0; s < NS; ++s) qf[s] = *(const bf16x8*)(Qw + (size_t)(r & 15) * qpitch + 16 * s + 8 * h);
  constexpr int NK4 = 4 * NKC / 512;
  u32x4 kc[NK4], vc[4];
#define SMP_LOAD(T0) do { _Pragma("unroll") for (int i = 0; i < NK4; ++i) { const int id = tid + 512 * i, tt = id / NKC, cid = id - tt * NKC; if ((T0) + tt < ntiles) kc[i] = ld_kchunk<NS>(src, krow0 + 64L * ((T0) + tt), cid); } \
    _Pragma("unroll") for (int i = 0; i < 4; ++i) { const int id = tid + 512 * i, tt = id >> 9, cid = id & 511; if ((T0) + tt < ntiles) vc[i] = *(const u32x4*)(src.V + (krow0 + 64L * ((T0) + tt) + (cid >> 3)) * 512 + (cid & 7) * 8); } } while (0)
#define SMP_STORE(T0) do { _Pragma("unroll") for (int i = 0; i < NK4; ++i) { const int id = tid + 512 * i, tt = id / NKC, cid = id - tt * NKC; if ((T0) + tt < ntiles) st_kchunk<NS>(lds + AT_TILE + tt * AT_PRIV, cid, kc[i]); } \
    _Pragma("unroll") for (int i = 0; i < 4; ++i) { const int id = tid + 512 * i, tt = id >> 9, cid = id & 511; if ((T0) + tt < ntiles) st_vchunk(lds + AT_TILE + tt * AT_PRIV + 13312, cid, vc[i]); } } while (0)
  SMP_LOAD(0); SMP_STORE(0);
  __syncthreads();
  for (int t0 = 0; t0 < ntiles; t0 += 4) {
    if (t0 + 4 < ntiles) SMP_LOAD(t0 + 4);
    const int t = t0 + wave;
    if (wave < 4 && t < ntiles) {
      const bool lookup = BIAS && (qpos0 - (64 * t + 63) < 256);
      f32x16 st[2]; attn_qk<NS, BIAS, false>(Kt, qf, nullptr, st, (t == ntiles - 1) ? nvalid_last : 64, btab, 639 - (qpos0 + (r & 15) - 64 * t + 256), lookup, lane);
      attn_smpv(Vt, st, o, m_run, l_run, wsf, lane);
    }
    __syncthreads();
    if (t0 + 4 < ntiles) { SMP_STORE(t0 + 4); }
    __syncthreads();
  }
#undef SMP_LOAD
#undef SMP_STORE
  if (wave < 4 && h == 0) cm[wave * 32 + r] = m_run;
  __syncthreads();
  if (wave < 4) {
    const float M = __builtin_fmaxf(__builtin_fmaxf(cm[r], cm[32 + r]), __builtin_fmaxf(cm[64 + r], cm[96 + r]));
    const float f = __builtin_amdgcn_exp2f(m_run - M);
    scale_o(o, f, wsf, lane);
    if (h == 0) cm[128 + wave * 32 + r] = l_run * f;
    LAS float* po = (LAS float*)(lds + AT_TILE + wave * AT_PRIV);
#pragma unroll
    for (int c = 0; c < 2; ++c)
#pragma unroll
      for (int i = 0; i < 16; ++i) po[(c * 16 + i) * 64 + lane] = o[c][i];
  }
  __syncthreads();
  if (wave == 0) {
    const float l = (cm[128 + r] + cm[160 + r]) + (cm[192 + r] + cm[224 + r]);
#pragma unroll
    for (int w = 1; w < 4; ++w) { const LAS float* po = (const LAS float*)(lds + AT_TILE + w * AT_PRIV);
#pragma unroll
      for (int c = 0; c < 2; ++c)
#pragma unroll
        for (int i = 0; i < 16; ++i) o[c][i] += po[(c * 16 + i) * 64 + lane]; }
    scale_o(o, 1.0f / l, wsf, lane);
    store_o(o, (LAS bf16_t*)(lds + AT_OSTG), att, ssq, 16, lane);
  }
  __syncthreads();
}
__device__ __forceinline__ void load_bias_all(LAS unsigned char* lds, const float* rel_bias) {
  LAS float* btab = (LAS float*)(lds + AT_BIAS);
  for (int i = threadIdx.x; i < 8 * 640; i += NTHREADS) { const int hd = i / 640, j = 639 - (i - hd * 640); btab[i] = rel_bias[hd * 513 + (j > 512 ? 512 : j)] * LOG2E; }
  __syncthreads();
}
__device__ __forceinline__ void attention_phase(ParamsC p, LAS unsigned char* lds, int G, bool dry, int apm = 15) {
  unsigned char* ws = p->ws; const int wave = threadIdx.x >> 6;
  const bf16_t* Q = (const bf16_t*)(ws + WS_Q); const bf16_t* KN = (const bf16_t*)(ws + WS_KN); const bf16_t* V = (const bf16_t*)(ws + WS_V); const bf16_t* KR = (const bf16_t*)(ws + WS_KR);
  const bf16_t* QB = (const bf16_t*)(ws + WS_QB); const bf16_t* KB = (const bf16_t*)(ws + WS_KB); const bf16_t* VB = (const bf16_t*)(ws + WS_VB);
  bf16_t* ATT = (bf16_t*)(ws + WS_XN); float* ssq_a = (float*)(ws + WS_SSQ); float* ssq_b = ssq_a + MT;
  load_bias_all(lds, p->rel_bias);
  for (int u = blockIdx.x; u < 256; u += G) {
    const int b = (u & 127) >> 3, head = u & 7; const int row0 = MP + b * DSQ;
#ifndef AP
#define AP 15
#endif
    if (u < 128) { if (apm & 1) {
      const KVSrc src{KN + head * 64, KR, V + head * 64};
      attn_unit_sample<6, false>(lds, Q + (size_t)row0 * 768 + head * 96, 768, src, (long)MP + (long)b * LROW, 65, 16, 0, ATT + (size_t)row0 * D + head * 64, dry ? nullptr : ssq_a + row0); }
    } else if (apm & 2) {
      const KVSrc src{KB + head * 64, nullptr, VB + head * 64};
      attn_unit_sample<4, true>(lds, QB + (size_t)row0 * 512 + head * 64, 512, src, (long)MP + (long)b * BROW, 9, 16, 512, ATT + (size_t)row0 * D + 512 + head * 64, dry ? nullptr : ssq_b + row0, head);
    }
  }
  if (G == 256) {
    const int vcu = (blockIdx.x & 7) * 32 + (blockIdx.x >> 3), grp = vcu >> 3, mem = vcu & 7; const int b = grp; const long brow = (long)b * SEQ;
    if (apm & 4) for (int i = 0; i < 8; ++i) { const int head = i, qb = (mem + i) & 7; const KVSrc src{KN + head * 64, KR, V + head * 64}; const long qrow = brow + 256 * qb + 32 * wave;
      attn_unit_shared<6, false>(lds, Q + (size_t)qrow * 768 + head * 96, 768, src, brow, 0, 4 * qb + 3, 0, 4 * qb + (wave >> 1), 0, ATT + (size_t)qrow * D + head * 64, dry ? nullptr : ssq_a + qrow); }
    if (apm & 8) for (int i = 0; i < 8; ++i) { const int head = i, cb = (mem + i) & 7;
      const KVSrc src{KB + head * 64, nullptr, VB + head * 64}; const long qrow = brow + 256 * cb + 32 * wave; const int cq = 4 * cb + (wave >> 1); const int tl = 4 * cb - 8 < 0 ? 0 : 4 * cb - 8;
      attn_unit_shared<4, true>(lds, QB + (size_t)qrow * 512 + head * 64, 512, src, brow, tl, 4 * cb + 3, cq - 8, cq, 256 * cb + 32 * wave, ATT + (size_t)qrow * D + 512 + head * 64, dry ? nullptr : ssq_b + qrow, head); }
  } else {
  for (int bh = blockIdx.x; bh < NBATCH * 8; bh += G) {
    const int b = bh >> 3, head = bh & 7; const long brow = (long)b * SEQ;
    if (apm & 4) { const KVSrc src{KN + head * 64, KR, V + head * 64};
      for (int qb = 0; qb < 8; ++qb) { const long qrow = brow + 256 * qb + 32 * wave;
        attn_unit_shared<6, false>(lds, Q + (size_t)qrow * 768 + head * 96, 768, src, brow, 0, 4 * qb + 3, 0, 4 * qb + (wave >> 1), 0, ATT + (size_t)qrow * D + head * 64, dry ? nullptr : ssq_a + qrow); } }
    if (apm & 8) { const KVSrc src{KB + head * 64, nullptr, VB + head * 64};
      for (int cb = 0; cb < 8; ++cb) { const long qrow = brow + 256 * cb + 32 * wave; const int cq = 4 * cb + (wave >> 1); const int tl = 4 * cb - 8 < 0 ? 0 : 4 * cb - 8;
        attn_unit_shared<4, true>(lds, QB + (size_t)qrow * 512 + head * 64, 512, src, brow, tl, 4 * cb + 3, cq - 8, cq, 256 * cb + 32 * wave, ATT + (size_t)qrow * D + 512 + head * 64, dry ? nullptr : ssq_b + qrow, head); } }
  }
  }
}


#define XB_TMO      128
#define XB_XCNT(j)  (256  + 64 * (j))
#define XB_XSUB(j)  (1280 + 64 * (j))
#define XB_XGEN(j)  (2304 + 64 * (j))
#define XB_TOP      3328
#define XB_TOPGEN   3392
#define XCD_BAR_WORDS 3456
#define XB_SPIN_CAP (1u << 18)
__device__ __forceinline__ unsigned xb_ld(unsigned* p)              { return __hip_atomic_load(p, __ATOMIC_RELAXED, __HIP_MEMORY_SCOPE_AGENT); }
__device__ __forceinline__ unsigned xb_add(unsigned* p, unsigned v) { return __hip_atomic_fetch_add(p, v, __ATOMIC_RELAXED, __HIP_MEMORY_SCOPE_AGENT); }
__device__ __forceinline__ unsigned xb_xcc_id() { return (unsigned)__builtin_amdgcn_s_getreg((3 << 11) | 20) & 0xFu; }
#define XB_SPIN(cond, bar) do { unsigned _sp = 0; while (cond) { __builtin_amdgcn_s_sleep(1); \
    if ((++_sp & 255u) == 0u) { if (xb_ld(&(bar)[XB_TMO])) break; if (_sp > XB_SPIN_CAP) { atomicAdd(&(bar)[XB_TMO], 1u); break; } } } } while (0)
__device__ __forceinline__ void xcd_barrier_complete(unsigned* bar, unsigned x, unsigned& nloc, unsigned& nx) {
  const unsigned G = gridDim.x * gridDim.y * gridDim.z;
  unsigned sum, cnt, mine, sp = 0u;
  for (;;) {
    sum = 0u; cnt = 0u; mine = 0u;
#pragma unroll
    for (unsigned j = 0; j < 16; ++j) { const unsigned c = xb_ld(&bar[XB_XCNT(j)]); sum += c; cnt += (c > 0u) ? 1u : 0u; mine = (j == x) ? c : mine; }
    if (sum == G) break;
    __builtin_amdgcn_s_sleep(1);
    if ((++sp & 255u) == 0u) { if (xb_ld(&bar[XB_TMO])) break; if (sp > XB_SPIN_CAP) { atomicAdd(&bar[XB_TMO], 1u); break; } }
  }
  nloc = mine > 0u ? mine : 1u; nx = cnt > 0u ? cnt : 1u;
}
__device__ __forceinline__ void xcd_barrier(unsigned* bar, volatile LAS unsigned* st) {
  asm volatile("s_waitcnt vmcnt(0)" ::: "memory");
  __syncthreads();
  if (threadIdx.x == 0) {
    const unsigned x = xb_xcc_id();
    __builtin_amdgcn_s_waitcnt(0);
    unsigned nloc = st[0], nx = st[1];
    if (nloc == 0u) { xcd_barrier_complete(bar, x, nloc, nx); st[0] = nloc; st[1] = nx; }
    const unsigned old = xb_add(&bar[XB_XSUB(x)], 1u);
    const unsigned gen = old / nloc;
    if (old + 1u == (gen + 1u) * nloc) {
      __builtin_amdgcn_fence(__ATOMIC_RELEASE, "agent");
      asm volatile("s_waitcnt vmcnt(0)" ::: "memory");
      const unsigned og = xb_add(&bar[XB_TOP], 1u);
      const unsigned tg = og / nx;
      if (og + 1u == (tg + 1u) * nx) xb_add(&bar[XB_TOPGEN], 1u);
      else XB_SPIN(xb_ld(&bar[XB_TOPGEN]) == tg, bar);
      __builtin_amdgcn_fence(__ATOMIC_ACQUIRE, "agent");
      xb_add(&bar[XB_XGEN(x)], 1u);
      asm volatile("s_waitcnt vmcnt(0)" ::: "memory");
    } else {
      XB_SPIN(xb_ld(&bar[XB_XGEN(x)]) == gen, bar);
      __builtin_amdgcn_fence(__ATOMIC_ACQUIRE, "agent");
      asm volatile("s_waitcnt vmcnt(0)" ::: "memory");
    }
  }
  __syncthreads();
}

__device__ __forceinline__ ParamsC get_params() {
  ParamsC pp = (ParamsC)__builtin_amdgcn_kernarg_segment_ptr(); asm volatile("" : "+s"(pp)); return pp;
}
__global__ void __launch_bounds__(NTHREADS) mk_fwd(Params p_unused) {
  extern __shared__ __attribute__((aligned(16))) unsigned char lds_raw[];
  LAS unsigned char* lds = (LAS unsigned char*)lds_raw;
  cg::grid_group grid = cg::this_grid();
  const int G = gridDim.x;
  volatile LAS unsigned* xst = (volatile LAS unsigned*)(lds + LDS_BYTES - 16);
  if (threadIdx.x < 2) xst[threadIdx.x] = 0u;
  if (threadIdx.x == 0) (void)xb_add(&((unsigned*)(get_params()->ws + WS_BAR))[XB_XCNT(xb_xcc_id())], 1u);
  __syncthreads();
#define FAST_SYNC() xcd_barrier((unsigned*)(get_params()->ws + WS_BAR), xst)
#define WSP(T, off) ((T*)(get_params()->ws + (off)))
#define ssq WSP(float, WS_SSQ)
#define X1B WSP(bf16_t, WS_X1B)
#define XN WSP(bf16_t, WS_XN)
#define CQN WSP(bf16_t, WS_CQN)
#define CKV WSP(bf16_t, WS_CKV)
#define KR WSP(bf16_t, WS_KR)
#define QB WSP(bf16_t, WS_QB)
#define KB WSP(bf16_t, WS_KB)
#define VB WSP(bf16_t, WS_VB)
#define Q WSP(bf16_t, WS_Q)
#define KN WSP(bf16_t, WS_KN)
#define V WSP(bf16_t, WS_V)
#define H WSP(bf16_t, WS_H)
  pg8::StaticOrder S;
#ifndef PH
#define PH 255
#endif
  if (PH & 1) prologue(get_params(), lds, G);
#ifdef DUP_P0
  grid.sync(); prologue(get_params(), lds, G);
#endif
  grid.sync();
  if (PH & 2) { pg8::Gemm g{XN, (const bf16_t*)(get_params()->ws + WS_WIN), 1024, 1024, 1024}; S.init(MT, NIN, G, blockIdx.x);
    ParamsC pp = get_params(); EpiIn E{pp->out, CQN, CKV, KR, QB, KB, VB, pp->g_kv, (LAS float*)(lds + LDS_RED)};
    pg8::gemm_phase(lds, g, S, E); }
  FAST_SYNC();
  if ((PH & 4) && !(PH & 256)) { pg8::Gemm g{CQN, (const bf16_t*)(get_params()->ws + WS_WUQ), 256, 256, 256}; S.init(MT, 768, G, blockIdx.x); EpiQ E{Q}; pg8::gemm_phase(lds, g, S, E); }
  if ((PH & 4) && !(PH & 512)) { pg8::Gemm g{CKV, (const bf16_t*)(get_params()->ws + WS_WKV), 256, 256, 256}; S.init(MLAT, 1024, G, blockIdx.x); EpiKV E{KN, V}; pg8::gemm_phase(lds, g, S, E); }
  FAST_SYNC();
  if (PH & 8) attention_phase(get_params(), lds, G, false);
#ifdef DUP_ATTN
  grid.sync(); attention_phase(get_params(), lds, G, true, DUP_ATTN);
#endif
  FAST_SYNC();
  if (PH & 16) { pg8::Gemm g{XN  , (const bf16_t*)(get_params()->ws + WS_WO), 1024, 1024, 1024}; S.init(MT, 1024, G, blockIdx.x);
    ParamsC pp = get_params(); EpiO E{8, ssq, ssq + MT, pp->xp, pp->xs, X1B, ssq + 2 * MT, (LAS float*)(lds + LDS_RED), 0.f, 0.f, 0}; pg8::gemm_phase(lds, g, S, E); }
  FAST_SYNC();
  if (PH & 32) { pg8::Gemm g{X1B, (const bf16_t*)(get_params()->ws + WS_WGU), 1024, 1024, 1024}; S.init(MT, NGU, G, blockIdx.x); EpiGU E{ssq + 2 * MT, H, (LAS float*)(lds + LDS_RED), 0.f, 0}; pg8::gemm_phase(lds, g, S, E);
#ifdef DUP_P5
    grid.sync(); pg8::gemm_phase(lds, g, S, E);
#endif
  }
  FAST_SYNC();
#define PART WSP(float, WS_Q)
  if (PH & 64) { pg8::Gemm g{H, (const bf16_t*)(get_params()->ws + WS_WD), FF, FF, FF}; S.init(MP, 1024, G, blockIdx.x); EpiD E{X1B, ssq + 3 * MT}; pg8::gemm_phase(lds, g, S, E);
    pg8::Gemm g2{H, (const bf16_t*)(get_params()->ws + WS_WD), FF, FF, 256}; pg8::SplitOrder S2{MP / 256, 4, 44, 256, G, (int)blockIdx.x}; EpiPart E2{PART}; pg8::gemm_phase(lds, g2, S2, E2); }
  FAST_SYNC();
  if (PH & 128) { ParamsC p = get_params(); int t7 = threadIdx.x; asm volatile("" : "+v"(t7)); const int lane = t7 & 63, gw = blockIdx.x * 8 + (t7 >> 6), NGW = G * 8; const float* s2 = ssq + 3 * MT;
    f32x4 gf[4];
#pragma unroll
    for (int j = 0; j < 2; ++j) { gf[2 * j] = *(const f32x4*)(p->g_final + 8 * lane + 512 * j); gf[2 * j + 1] = *(const f32x4*)(p->g_final + 8 * lane + 512 * j + 4); }
    for (int rr0 = gw; rr0 < MT; rr0 += 4 * NGW) {
      u32x4 raw[4][2]; int rows[4];
#pragma unroll
      for (int k = 0; k < 4; ++k) { const int rr = rr0 + k * NGW; rows[k] = rr < MS ? MP + rr : rr - MS;
        if (rr < MT) { const bf16_t* x = X1B + (size_t)rows[k] * D;
#pragma unroll
          for (int j = 0; j < 2; ++j) raw[k][j] = *(const u32x4*)(x + 8 * lane + 512 * j); } }
#pragma unroll
      for (int k = 0; k < 4; ++k) { const int rr = rr0 + k * NGW, row = rows[k]; if (rr < MT) {
        f32x4 v[4];
#pragma unroll
        for (int j = 0; j < 2; ++j) { const u32x4 w = raw[k][j];
          v[2 * j] = (f32x4){__builtin_bit_cast(float, w.x << 16), __builtin_bit_cast(float, w.x & 0xffff0000u), __builtin_bit_cast(float, w.y << 16), __builtin_bit_cast(float, w.y & 0xffff0000u)};
          v[2 * j + 1] = (f32x4){__builtin_bit_cast(float, w.z << 16), __builtin_bit_cast(float, w.z & 0xffff0000u), __builtin_bit_cast(float, w.w << 16), __builtin_bit_cast(float, w.w & 0xffff0000u)}; }
        float* y = p->out + OFF_Y + (size_t)row * D; float rstd;
        if (row >= MP) { float s = 0.f;
          for (int kc = 0; kc < 11; ++kc) { const float* pr = PART + ((size_t)kc * 256 + (row - MP)) * D;
#pragma unroll
            for (int j = 0; j < 2; ++j) { v[2 * j] = v[2 * j] + *(const f32x4*)(pr + 8 * lane + 512 * j); v[2 * j + 1] = v[2 * j + 1] + *(const f32x4*)(pr + 8 * lane + 512 * j + 4); } }
#pragma unroll
          for (int j = 0; j < 4; ++j) s += (v[j][0] * v[j][0] + v[j][1] * v[j][1]) + (v[j][2] * v[j][2] + v[j][3] * v[j][3]);
          rstd = __builtin_amdgcn_rsqf(wave_sum(s) * (1.0f / D) + EPS);
        } else rstd = __builtin_amdgcn_rsqf(s2[row] * (1.0f / D) + EPS);
#pragma unroll
        for (int j = 0; j < 2; ++j) { *(f32x4*)(y + 8 * lane + 512 * j) = v[2 * j] * rstd * gf[2 * j]; *(f32x4*)(y + 8 * lane + 512 * j + 4) = v[2 * j + 1] * rstd * gf[2 * j + 1]; } } } } }
}

#undef FAST_SYNC
#undef ssq
#undef X1B
#undef XN
#undef CQN
#undef CKV
#undef KR
#undef QB
#undef KB
#undef VB
#undef Q
#undef KN
#undef V
#undef H
#undef PART
extern "C" void kernel_launch(void* const* d_in, const int* in_sizes, int n_in, void* d_out, int out_size, void* d_ws, size_t ws_size, hipStream_t stream) {
  static int grid = 0;
  if (grid == 0) {
    if (n_in != 22 || (size_t)out_size != OUT_TOTAL || ws_size < WS_TOTAL) { fprintf(stderr, "kernel_launch: unexpected shapes (n_in %d out %d ws %zu, need ws %zu)\n", n_in, out_size, ws_size, (size_t)WS_END); grid = -1; return; }
    int dev = 0, cus = 0, per_cu = 0;
    hipGetDevice(&dev); hipDeviceGetAttribute(&cus, hipDeviceAttributeMultiprocessorCount, dev);
    hipFuncSetAttribute((const void*)mk_fwd, hipFuncAttributeMaxDynamicSharedMemorySize, LDS_BYTES);
    hipOccupancyMaxActiveBlocksPerMultiprocessor(&per_cu, (const void*)mk_fwd, NTHREADS, LDS_BYTES);
    if (per_cu < 1 || cus < 1) { fprintf(stderr, "kernel_launch: occupancy query gave %d blocks/CU on %d CUs\n", per_cu, cus); grid = -1; return; }
    grid = cus * (per_cu > 1 ? 1 : per_cu);
  }
  if (grid < 0) return;
  Params p{};
  const float** pp = (const float**)&p;
  for (int i = 0; i < 22; ++i) pp[i] = (const float*)d_in[i];
  p.out = (float*)d_out; p.ws = (unsigned char*)d_ws;
  if (hipMemsetAsync((char*)d_ws + WS_BAR, 0, 16384, stream) != hipSuccess) { fprintf(stderr, "kernel_launch: memset of barrier words failed\n"); return; }
  void* args[] = {&p};
  hipError_t e = hipLaunchCooperativeKernel((void*)mk_fwd, dim3(grid), dim3(NTHREADS), args, LDS_BYTES, stream);
  if (e != hipSuccess) fprintf(stderr, "cooperative launch failed: %s (grid %d)\n", hipGetErrorString(e), grid);
}
```

```cpp
#include <hip/hip_runtime.h>
#include <hip/hip_cooperative_groups.h>
#include <cstdio>
#include <cstdint>


namespace cg = cooperative_groups;

#define LAS __attribute__((address_space(3)))
typedef unsigned short bf16_t;
typedef short bf16x8 __attribute__((ext_vector_type(8)));
typedef short s16x4 __attribute__((ext_vector_type(4)));
typedef float f32x4 __attribute__((ext_vector_type(4)));
typedef float f32x16 __attribute__((ext_vector_type(16)));
typedef unsigned u32x4 __attribute__((ext_vector_type(4)));
typedef unsigned u32x2 __attribute__((ext_vector_type(2)));
typedef float f32x2_t __attribute__((ext_vector_type(2)));
typedef __bf16 bf16x2_t __attribute__((ext_vector_type(2)));

constexpr int D = 1024, NBATCH = 32, SEQ = 2048, MP = NBATCH * SEQ, DB = 16, DSQ = 16, MS = DB * DSQ, MT = MP + MS, PAST = 4096;
constexpr int NIN = 2304, FF = 2816, NGU = 2 * FF;
constexpr int LROW = 4352, BROW = 768;
constexpr int MLAT = MP + DB * LROW, MBND = MP + DB * BROW;
constexpr float EPS = 1e-6f, LOG2E = 1.4426950408889634f;
constexpr float QSCALE_A = 0.10206207261596575f * LOG2E;
constexpr float QSCALE_B = 0.125f * LOG2E;
constexpr int NTHREADS = 512;
constexpr size_t OFF_Y = 0, OFF_CKVP = (size_t)MT * D, OFF_KRP = OFF_CKVP + (size_t)MP * 256, OFF_BKP = OFF_KRP + (size_t)MP * 32,
                 OFF_BVP = OFF_BKP + (size_t)NBATCH * 512 * 512, OFF_CKVS = OFF_BVP + (size_t)NBATCH * 512 * 512, OFF_KRS = OFF_CKVS + (size_t)MS * 256,
                 OFF_BKS = OFF_KRS + (size_t)MS * 32, OFF_BVS = OFF_BKS + (size_t)MS * 512, OUT_TOTAL = OFF_BVS + (size_t)MS * 512;
constexpr size_t al256(size_t x) { return (x + 255) & ~(size_t)255; }
constexpr size_t WS_SSQ = 0;
constexpr size_t WS_WIN = al256(WS_SSQ + 4 * (size_t)MT * 4);
constexpr size_t WS_WUQ = al256(WS_WIN + (size_t)NIN * 1024 * 2);
constexpr size_t WS_WKV = al256(WS_WUQ + (size_t)768 * 256 * 2);
constexpr size_t WS_WO = al256(WS_WKV + (size_t)1024 * 256 * 2);
constexpr size_t WS_WGU = al256(WS_WO + (size_t)1024 * 1024 * 2);
constexpr size_t WS_WD = al256(WS_WGU + (size_t)NGU * 1024 * 2);
constexpr size_t WS_X1B = al256(WS_WD + (size_t)1024 * FF * 2);
constexpr size_t WS_XN = al256(WS_X1B + (size_t)MT * 1024 * 2);
constexpr size_t WS_CQN = al256(WS_XN + (size_t)MT * 1024 * 2);
constexpr size_t WS_CKV = al256(WS_CQN + (size_t)MT * 256 * 2);
constexpr size_t WS_KR = al256(WS_CKV + (size_t)MLAT * 256 * 2);
constexpr size_t WS_QB = al256(WS_KR + (size_t)MLAT * 32 * 2);
constexpr size_t WS_KB = al256(WS_QB + (size_t)MT * 512 * 2);
constexpr size_t WS_VB = al256(WS_KB + (size_t)MBND * 512 * 2);
constexpr size_t WS_Q = al256(WS_VB + (size_t)MBND * 512 * 2);
constexpr size_t WS_KN = al256(WS_Q + (size_t)MT * 768 * 2);
constexpr size_t WS_V = al256(WS_KN + (size_t)MLAT * 512 * 2);
constexpr size_t WS_END = al256(WS_V + (size_t)MLAT * 512 * 2);
constexpr size_t WS_BAR = WS_END;
constexpr size_t WS_TOTAL = WS_END + 16384;
constexpr size_t WS_H = WS_XN;
static_assert(WS_H + (size_t)MT * FF * 2 <= WS_VB, "H overlay must end before anything live in P5/P6 (nothing is, but keep it inside dead buffers)");
static_assert(WS_TOTAL <= (size_t)1073741824, "workspace");

constexpr int LDS_GEMM = 131072, LDS_RED = LDS_GEMM, LDS_BYTES = 143360;
constexpr int KP_A = 208, KP_B = 144;
constexpr int AT_TILE = 0, AT_PRIV = 21504  , AT_QT = 51200  , AT_BIAS = 86016  , AT_WSF = 107008, AT_OSTG = 109056, AT_CMB = 141824;
static_assert(AT_CMB + 1024 <= LDS_BYTES, "attention LDS map");

struct Params {
  const float *xp, *xs, *c_ckv, *c_kr, *c_bk, *c_bv, *w_in, *g_attn, *g_q, *w_uq, *g_kv, *w_uk, *w_uv, *rel_bias, *g_out_a, *g_out_b, *w_out, *g_ffn,
      *w_gate, *w_up, *w_down, *g_final;
  float* out; unsigned char* ws;
};

typedef const __attribute__((address_space(4))) Params* ParamsC;
__device__ __forceinline__ unsigned f2bf(float f) { unsigned u = __builtin_bit_cast(unsigned, f); return (u + 0x7fffu + ((u >> 16) & 1u)) >> 16; }
__device__ __forceinline__ unsigned pk2(float lo, float hi) { f32x2_t v = {lo, hi}; bf16x2_t b = __builtin_convertvector(v, bf16x2_t); return __builtin_bit_cast(unsigned, b); }
__device__ __forceinline__ float bf2f(unsigned short b) { return __builtin_bit_cast(float, (unsigned)b << 16); }
__device__ __forceinline__ int maprow_lat(int row) { return row < MP ? row : MP + ((row - MP) >> 4) * LROW + PAST + ((row - MP) & 15); }
__device__ __forceinline__ int maprow_bnd(int row) { return row < MP ? row : MP + ((row - MP) >> 4) * BROW + 512 + ((row - MP) & 15); }
__device__ __forceinline__ int row_pos(int row) { return row < MP ? (row & (SEQ - 1)) : PAST + ((row - MP) & 15); }
__device__ __forceinline__ void rope_cs(int pos, int i, float& c, float& s) {
  const float inv = __builtin_amdgcn_exp2f(-(float)i * (13.287712379549449f / 16.0f));
  float rev = (float)pos * inv * 0.15915494309189535f; rev = rev - __builtin_floorf(rev);
  s = __builtin_amdgcn_sinf(rev); c = __builtin_amdgcn_cosf(rev);
}

namespace pg8 {
constexpr int BM = 256, BK = 64, HALF = 128, HTB = HALF * BK * 2, STAGE_BYTES = 8 * HTB, NXCD = 8, WGM = 8;
__host__ __device__ __forceinline__ int lds_byte(int r, int c) { const int st = (r >> 4) * 2 + (c >> 5), rr = r & 15, cc = c & 31, ob = rr * 64 + cc * 2; return st * 1024 + (ob ^ (((ob >> 9) & 1) << 5)); }
__host__ __device__ __forceinline__ void stage_rc(int b, int& R, int& C) { const int st = b / 1024, sb = b % 1024, swz = sb ^ (((sb >> 9) & 1) << 5); R = (st >> 1) * 16 + swz / 64; C = (st & 1) * 32 + (swz % 64) / 2; }
struct Unit { int pm, pn, koff; };
struct Gemm { const bf16_t* A; const bf16_t* Bt; int lda, ldb, K; };
struct StaticOrder {
  int nM, nN, nwg, G, c;
  __device__ void init(int M, int N, int G_, int c_) { nM = M / BM; nN = N / BM; nwg = nM * nN; G = G_; c = c_; }
  __device__ bool next(int i, Unit& u) const {
    const long L = (long)i * G + c; if (L >= nwg) return false;
    int wgid = (int)L; { const int q = nwg / NXCD, r = nwg % NXCD, xcd = wgid % NXCD, off = wgid / NXCD; wgid = (xcd < r ? xcd * (q + 1) : r * (q + 1) + (xcd - r) * q) + off; }
    const int nig = WGM * nN, gid = wgid / nig, fm = gid * WGM, gsz = (nM - fm) < WGM ? (nM - fm) : WGM;
    u.pm = fm + ((wgid % nig) % gsz); u.pn = (wgid % nig) / gsz; u.koff = 0; return true;
  }
};
struct SplitOrder {
  int pm, nN, nsub, kchunk, G, c;
  __device__ bool next(int i, Unit& u) const { const int s = i * G + c; if (s >= nsub) return false; u.pm = pm; u.pn = s % nN; u.koff = (s / nN) * kchunk; return true; }
};
template <class Epi, class Order>
__device__ __forceinline__ void gemm_phase(LAS unsigned char* lds, const Gemm g, const Order& S, Epi& E) {
  int tid_ = threadIdx.x; asm volatile("" : "+v"(tid_));
  const int tid = tid_, wid = __builtin_amdgcn_readfirstlane(tid >> 6), lane = tid & 63, wr = wid >> 2, wc = wid & 3, fr = lane & 15, fq = lane >> 4;
  int K_ = g.K; asm volatile("" : "+s"(K_));
  const int K = K_, nt = K / BK;
  int lda_ = g.lda, ldb_ = g.ldb; asm volatile("" : "+s"(lda_), "+s"(ldb_));
  unsigned voffA[2];
#pragma unroll
  for (int i = 0; i < 2; ++i) { int R, C; stage_rc(tid * 16 + i * 8192, R, C); voffA[i] = (unsigned)(R * lda_ + C) * 2u; }
  const size_t kstep = (size_t)(BK * 2), hstepA = (size_t)HALF * lda_ * 2, tstepA = 2 * hstepA, hstepB = (size_t)HALF * ldb_ * 2, tstepB = 2 * hstepB;
  const unsigned ldsw = (unsigned)wid * 1024u;
  const int aoff = lds_byte(wr * 64 + fr, fq * 8), boff = lds_byte(wc * 32 + fr, fq * 8);
#define PG8_SA(b, h) (((b) * 2 + (h)) * HTB)
#define PG8_SB(b, h) ((4 + (b) * 2 + (h)) * HTB)
#define PG8_STAGE_(bufoff, gbase, voff) do { _Pragma("unroll") for (int _i = 0; _i < 2; ++_i) \
    __builtin_amdgcn_global_load_lds((const unsigned*)((const char*)(gbase) + (voff)[_i]), (LAS unsigned*)(lds + (bufoff) + ldsw + _i * 8192), 16, 0, 0); } while (0)
#define PG8_STA(bufoff, gbase) PG8_STAGE_(bufoff, gbase, voffA)
#define PG8_STB(bufoff, gbase) PG8_STAGE_(bufoff, gbase, voffA)
#define PG8_LDA(dst, b, h) do { _Pragma("unroll") for (int m = 0; m < 4; ++m) _Pragma("unroll") for (int k = 0; k < 2; ++k) dst[m][k] = *(const LAS bf16x8*)(lds + PG8_SA(b, h) + aoff + m * 2048 + k * 1024); } while (0)
#define PG8_LDB(dst, b, h) do { _Pragma("unroll") for (int n = 0; n < 2; ++n) _Pragma("unroll") for (int k = 0; k < 2; ++k) dst[n][k] = *(const LAS bf16x8*)(lds + PG8_SB(b, h) + boff + n * 2048 + k * 1024); } while (0)
#define PG8_MMA(ai, bj, At, Bt) do { __builtin_amdgcn_s_setprio(1); _Pragma("unroll") for (int m = 0; m < 4; ++m) _Pragma("unroll") for (int n = 0; n < 2; ++n) _Pragma("unroll") for (int k = 0; k < 2; ++k) \
    acc[ai][bj][m][n] = __builtin_amdgcn_mfma_f32_16x16x32_bf16(Bt[n][k], At[m][k], acc[ai][bj][m][n], 0, 0, 0); __builtin_amdgcn_s_setprio(0); } while (0)
#define PG8_WAIT_V(n) asm volatile("s_waitcnt vmcnt(" #n ")" ::: "memory")
#define PG8_WAIT_L(n) asm volatile("s_waitcnt lgkmcnt(" #n ")" ::: "memory")
#define PG8_BAR __builtin_amdgcn_s_barrier()
#define PG8_SCHED __builtin_amdgcn_sched_barrier(0)
  Unit cur, nxt; int ui = 0;
  if (!S.next(0, cur)) return;
  f32x4 acc[2][2][4][2];
#pragma unroll
  for (int a = 0; a < 2; ++a)
#pragma unroll
    for (int b = 0; b < 2; ++b)
#pragma unroll
      for (int m = 0; m < 4; ++m)
#pragma unroll
        for (int n = 0; n < 2; ++n) acc[a][b][m][n] = (f32x4){0.f, 0.f, 0.f, 0.f};
  bf16x8 At[4][2], B0[2][2], B1[2][2];
  const char* cA = (const char*)g.A + (size_t)cur.pm * tstepA + (size_t)cur.koff * 2; const char* cB = (const char*)g.Bt + (size_t)cur.pn * tstepB + (size_t)cur.koff * 2;
  PG8_STB(PG8_SB(0, 0), cB); PG8_STB(PG8_SB(0, 1), cB + hstepB); PG8_STA(PG8_SA(0, 0), cA); PG8_STA(PG8_SA(0, 1), cA + hstepA);
  if (wr == 1) PG8_BAR;
  PG8_WAIT_V(2); PG8_BAR;
  PG8_STB(PG8_SB(1, 0), cB + kstep); PG8_STA(PG8_SA(1, 0), cA + kstep); PG8_STB(PG8_SB(1, 1), cB + hstepB + kstep);
  PG8_WAIT_V(6); PG8_BAR;
  for (;;) {
    const bool has_next = S.next(ui + 1, nxt);
    const char* nA = has_next ? (const char*)g.A + (size_t)nxt.pm * tstepA + (size_t)nxt.koff * 2 : cA; const char* nB = has_next ? (const char*)g.Bt + (size_t)nxt.pn * tstepB + (size_t)nxt.koff * 2 : cB;
    for (int t = 0; t < nt; t += 2) {
      const bool last = (t == nt - 2);
      const char* a1 = cA + (size_t)(t + 1) * kstep;
      const char* a2 = last ? nA : cA + (size_t)(t + 2) * kstep; const char* b2 = last ? nB : cB + (size_t)(t + 2) * kstep;
      const char* a3 = a2 + kstep; const char* b3 = b2 + kstep;
      if constexpr (Epi::HAS_PRE) { if (t == 0) E.pre_load(cur, tid); if (t == 2) E.pre_store(ui, tid); }
      if constexpr (Epi::HAS_MID) { if (t == E.tsplit) { asm volatile("" : "+s"(cur.pm)); E.mid(acc, cur, wr, wc, fr, fq); } }
      PG8_LDB(B0, 0, 0); PG8_LDB(B1, 0, 1); PG8_SCHED; PG8_LDA(At, 0, 0); PG8_STA(PG8_SA(1, 1), a1 + hstepA);
      PG8_WAIT_V(8); PG8_WAIT_L(0); PG8_BAR; PG8_MMA(0, 0, At, B0); PG8_MMA(0, 1, At, B1); PG8_BAR; PG8_SCHED;
      PG8_LDA(At, 0, 1); PG8_STB(PG8_SB(0, 0), b2); PG8_STB(PG8_SB(0, 1), b2 + hstepB); PG8_STA(PG8_SA(0, 0), a2);
      PG8_WAIT_V(8); PG8_WAIT_L(0); PG8_BAR; PG8_MMA(1, 0, At, B0); PG8_MMA(1, 1, At, B1); PG8_BAR; PG8_SCHED;
      PG8_LDB(B0, 1, 0); PG8_LDB(B1, 1, 1); PG8_SCHED; PG8_LDA(At, 1, 0); PG8_STA(PG8_SA(0, 1), a2 + hstepA);
      PG8_WAIT_V(8); PG8_WAIT_L(0); PG8_BAR; PG8_MMA(0, 0, At, B0); PG8_MMA(0, 1, At, B1); PG8_BAR; PG8_SCHED;
      PG8_LDA(At, 1, 1); PG8_STB(PG8_SB(1, 0), b3); PG8_STB(PG8_SB(1, 1), b3 + hstepB); PG8_STA(PG8_SA(1, 0), a3);
      PG8_WAIT_V(8); PG8_WAIT_L(0); PG8_BAR; PG8_MMA(1, 0, At, B0); PG8_MMA(1, 1, At, B1); PG8_BAR; PG8_SCHED;
    }
    if (wr == 0) PG8_BAR;
    asm volatile("" : "+s"(cur.pm), "+s"(cur.pn));
    E(acc, cur, wr, wc, fr, fq);
    if (!has_next) break;
#pragma unroll
    for (int a = 0; a < 2; ++a)
#pragma unroll
      for (int b = 0; b < 2; ++b)
#pragma unroll
        for (int m = 0; m < 4; ++m)
#pragma unroll
          for (int n = 0; n < 2; ++n) acc[a][b][m][n] = (f32x4){0.f, 0.f, 0.f, 0.f};
    cur = nxt; cA = nA; cB = nB; ++ui;
    if (wr == 1) PG8_BAR;
  }
  PG8_WAIT_V(0);
  PG8_BAR;
#undef PG8_SA
#undef PG8_SB
#undef PG8_STAGE_
#undef PG8_STA
#undef PG8_STB
#undef PG8_LDA
#undef PG8_LDB
#undef PG8_MMA
#undef PG8_WAIT_V
#undef PG8_WAIT_L
#undef PG8_BAR
#undef PG8_SCHED
}
}
using pg8::Unit;
typedef f32x4 Acc[2][2][4][2];
#define FOR_AM _Pragma("unroll") for (int ai = 0; ai < 2; ++ai) _Pragma("unroll") for (int m = 0; m < 4; ++m)
#define FOR_BN _Pragma("unroll") for (int bj = 0; bj < 2; ++bj) _Pragma("unroll") for (int n = 0; n < 2; ++n)
__device__ __forceinline__ void st_bf4(bf16_t* p, f32x4 v) { u32x2 w; w.x = pk2(v[0], v[1]); w.y = pk2(v[2], v[3]); *(u32x2*)p = w; }
__device__ __forceinline__ void st_bf8(bf16_t* p, f32x4 a, f32x4 b) { u32x4 w; w.x = pk2(a[0], a[1]); w.y = pk2(a[2], a[3]); w.z = pk2(b[0], b[1]); w.w = pk2(b[2], b[3]); *(u32x4*)p = w; }
__device__ __forceinline__ void st_bf4x2(bf16_t* pa, f32x4 a, bf16_t* pb, f32x4 b, int fq) {
  const unsigned A0 = pk2(a[0], a[1]), A1 = pk2(a[2], a[3]), B0 = pk2(b[0], b[1]), B1 = pk2(b[2], b[3]);
  const auto r0 = __builtin_amdgcn_permlane16_swap(A0, B0, false, false);
  const auto r1 = __builtin_amdgcn_permlane16_swap(A1, B1, false, false);
  u32x4 w; w.x = r0[0]; w.y = r1[0]; w.z = r0[1]; w.w = r1[1];
  *(u32x4*)((fq & 1) ? pb - 4 : pa) = w;
}
__device__ __forceinline__ void atomic_addf(float* p, float v) { __hip_atomic_fetch_add(p, v, __ATOMIC_RELAXED, __HIP_MEMORY_SCOPE_AGENT); }

struct EpiIn {
  static constexpr bool HAS_MID = false, HAS_PRE = false;
  float* out; bf16_t *CQN, *CKV, *KR, *QB, *KB, *VB; const float* g_kv; LAS float* red;
  __device__ __forceinline__ void operator()(const Acc& acc, const Unit& u, int wr, int wc, int fr, int fq) const {
    const int pn = u.pn, rbase = u.pm * 256 + wr * 64 + fr, cw = wc * 32 + 4 * fq;
    if (pn <= 1) {
      FOR_AM { float s = 0.f; FOR_BN { const f32x4 x = acc[ai][bj][m][n]; s += (x[0] * x[0] + x[1] * x[1]) + (x[2] * x[2] + x[3] * x[3]); }
        s += __shfl_xor(s, 16); s += __shfl_xor(s, 32);
        if (fq == 0) red[(ai * 128 + wr * 64 + m * 16 + fr) * 4 + wc] = s; }
      asm volatile("s_waitcnt lgkmcnt(0)" ::: "memory"); __builtin_amdgcn_s_barrier(); asm volatile("" ::: "memory");
      FOR_AM { const f32x4 t = *(const LAS f32x4*)(red + (ai * 128 + wr * 64 + m * 16 + fr) * 4);
        const float rstd = __builtin_amdgcn_rsqf(((t[0] + t[1]) + (t[2] + t[3])) * (1.0f / 256.0f) + EPS);
        const int row = rbase + ai * 128 + m * 16;
        if (pn == 0) {
#pragma unroll
          for (int bj = 0; bj < 2; ++bj) { bf16_t* q = CQN + (size_t)row * 256 + bj * 128 + cw; st_bf4x2(q, acc[ai][bj][m][0] * rstd, q + 16, acc[ai][bj][m][1] * rstd, fq); } }
        else { const int mr = maprow_lat(row); float* o = row < MP ? out + OFF_CKVP + (size_t)row * 256 : out + OFF_CKVS + (size_t)(row - MP) * 256;
#pragma unroll
          for (int bj = 0; bj < 2; ++bj) { const int col = bj * 128 + cw; const f32x4 v0 = acc[ai][bj][m][0] * rstd * *(const f32x4*)(g_kv + col), v1 = acc[ai][bj][m][1] * rstd * *(const f32x4*)(g_kv + col + 16);
            *(f32x4*)(o + col) = v0; *(f32x4*)(o + col + 16) = v1; st_bf4x2(CKV + (size_t)mr * 256 + col, v0, CKV + (size_t)mr * 256 + col + 16, v1, fq); } } }
      asm volatile("s_waitcnt lgkmcnt(0)" ::: "memory"); __builtin_amdgcn_s_barrier(); asm volatile("" ::: "memory");
    } else if (pn <= 3) {
      FOR_AM { const int row = rbase + ai * 128 + m * 16;
#pragma unroll
        for (int bj = 0; bj < 2; ++bj) { bf16_t* q = QB + (size_t)row * 512 + (pn - 2) * 256 + bj * 128 + cw; st_bf4x2(q, acc[ai][bj][m][0] * QSCALE_B, q + 16, acc[ai][bj][m][1] * QSCALE_B, fq); } }
    } else if (pn <= 7) {
      const bool isv = pn >= 6; bf16_t* dst = isv ? VB : KB; const int c0 = (pn & 1) * 256;
      FOR_AM { const int row = rbase + ai * 128 + m * 16; const int mr = maprow_bnd(row);
        float* o = nullptr;
        if (row >= MP) o = out + (isv ? OFF_BVS : OFF_BKS) + (size_t)(row - MP) * 512;
        else if ((row & (SEQ - 1)) >= SEQ - 512) o = out + (isv ? OFF_BVP : OFF_BKP) + ((size_t)(row >> 11) * 512 + ((row & (SEQ - 1)) - (SEQ - 512))) * 512;
#pragma unroll
        for (int bj = 0; bj < 2; ++bj) { const int col = c0 + bj * 128 + cw; st_bf4x2(dst + (size_t)mr * 512 + col, acc[ai][bj][m][0], dst + (size_t)mr * 512 + col + 16, acc[ai][bj][m][1], fq);
          if (o) { *(f32x4*)(o + col) = acc[ai][bj][m][0]; *(f32x4*)(o + col + 16) = acc[ai][bj][m][1]; } } }
    } else {
      if (wc == 0) {
        FOR_AM { const int row = rbase + ai * 128 + m * 16; const int pos = row_pos(row), mr = maprow_lat(row);
          float* o = row < MP ? out + OFF_KRP + (size_t)row * 32 : out + OFF_KRS + (size_t)(row - MP) * 32;
          const f32x4 x1 = acc[ai][0][m][0], x2 = acc[ai][0][m][1]; f32x4 y1, y2;
#pragma unroll
          for (int j = 0; j < 4; ++j) { float c, s; rope_cs(pos, 4 * fq + j, c, s); y1[j] = x1[j] * c - x2[j] * s; y2[j] = x1[j] * s + x2[j] * c; }
          *(f32x4*)(o + 4 * fq) = y1; *(f32x4*)(o + 16 + 4 * fq) = y2;
          st_bf4x2(KR + (size_t)mr * 32 + 4 * fq, y1, KR + (size_t)mr * 32 + 16 + 4 * fq, y2, fq); }
      }
    }
  }
};
struct EpiQ {
  static constexpr bool HAS_MID = false, HAS_PRE = false;
  bf16_t* Q;
  __device__ __forceinline__ void operator()(const Acc& acc, const Unit& u, int wr, int wc, int fr, int fq) const {
    const int pn = u.pn, rbase = u.pm * 256 + wr * 64 + fr;
    if (pn <= 1) {
      FOR_AM { const int row = rbase + ai * 128 + m * 16;
#pragma unroll
        for (int bj = 0; bj < 2; ++bj) { const int col = pn * 256 + bj * 128 + wc * 32 + 4 * fq; bf16_t* q = Q + (size_t)row * 768 + (col >> 6) * 96 + (col & 63);
          st_bf4x2(q, acc[ai][bj][m][0] * QSCALE_A, q + 16, acc[ai][bj][m][1] * QSCALE_A, fq); } }
    } else {
      FOR_AM { const int row = rbase + ai * 128 + m * 16; const int pos = row_pos(row);
        float cs[4], sn[4];
#pragma unroll
        for (int j = 0; j < 4; ++j) rope_cs(pos, 4 * fq + j, cs[j], sn[j]);
#pragma unroll
        for (int bj = 0; bj < 2; ++bj) { const int head = 4 * bj + wc; const f32x4 x1 = acc[ai][bj][m][0], x2 = acc[ai][bj][m][1]; f32x4 y1, y2;
#pragma unroll
          for (int j = 0; j < 4; ++j) { y1[j] = (x1[j] * cs[j] - x2[j] * sn[j]) * QSCALE_A; y2[j] = (x1[j] * sn[j] + x2[j] * cs[j]) * QSCALE_A; }
          bf16_t* q = Q + (size_t)row * 768 + head * 96 + 64 + 4 * fq; st_bf4x2(q, y1, q + 16, y2, fq); } __builtin_amdgcn_sched_barrier(0); }
    }
  }
};
struct EpiKV {
  static constexpr bool HAS_MID = false, HAS_PRE = false;
  bf16_t *KN, *V;
  __device__ __forceinline__ void operator()(const Acc& acc, const Unit& u, int wr, int wc, int fr, int fq) const {
    const int pn = u.pn, rbase = u.pm * 256 + wr * 64 + fr; bf16_t* dst = pn >= 2 ? V : KN; const int c0 = (pn & 1) * 256 + wc * 32 + 4 * fq;
    FOR_AM { const int row = rbase + ai * 128 + m * 16;
#pragma unroll
      for (int bj = 0; bj < 2; ++bj) { bf16_t* q = dst + (size_t)row * 512 + c0 + bj * 128; st_bf4x2(q, acc[ai][bj][m][0], q + 16, acc[ai][bj][m][1], fq); } }
  }
};
struct EpiO {
  static constexpr bool HAS_MID = true, HAS_PRE = true;
  int tsplit; const float *ssq_a, *ssq_b, *xp, *xs; bf16_t* X1B; float* ssq_x1; LAS float* pre; float p0, p1; int par;
  __device__ __forceinline__ void pre_load(const Unit& u, int tid) { if (tid < 256) { p0 = ssq_a[u.pm * 256 + tid]; p1 = ssq_b[u.pm * 256 + tid]; } }
  __device__ __forceinline__ void pre_store(int ui, int tid) { par = ui & 1; if (tid < 256) { pre[par * 512 + tid] = p0; pre[par * 512 + 256 + tid] = p1; } }
  __device__ __forceinline__ void mid(Acc& acc, const Unit& u, int wr, int wc, int fr, int fq) const {
    FOR_AM { const int rl = par * 512 + ai * 128 + wr * 64 + m * 16 + fr;
      const float ratio = __builtin_amdgcn_rsqf(pre[rl] * (1.0f / 512.0f) + EPS) * __builtin_sqrtf(pre[rl + 256] * (1.0f / 512.0f) + EPS);
      FOR_BN { acc[ai][bj][m][n] = acc[ai][bj][m][n] * ratio; }
      __builtin_amdgcn_sched_barrier(0); }
  }
  __device__ __forceinline__ void operator()(const Acc& acc, const Unit& u, int wr, int wc, int fr, int fq) const {
    const int rbase = u.pm * 256 + wr * 64 + fr, c0 = u.pn * 256 + wc * 32 + 4 * fq;
    f32x4 xb[2][4];
    { const int row = rbase; const float* xr = row < MP ? xp + (size_t)row * D : xs + (size_t)(row - MP) * D;
#pragma unroll
      for (int bj = 0; bj < 2; ++bj) { xb[0][2 * bj] = *(const f32x4*)(xr + c0 + bj * 128); xb[0][2 * bj + 1] = *(const f32x4*)(xr + c0 + bj * 128 + 16); } }
#pragma unroll
    for (int idx = 0; idx < 8; ++idx) { const int ai = idx >> 2, m = idx & 3; const int row = rbase + ai * 128 + m * 16;
      if (idx < 7) { const int rown = rbase + ((idx + 1) >> 2) * 128 + ((idx + 1) & 3) * 16; const float* xr = rown < MP ? xp + (size_t)rown * D : xs + (size_t)(rown - MP) * D;
#pragma unroll
        for (int bj = 0; bj < 2; ++bj) { xb[(idx + 1) & 1][2 * bj] = *(const f32x4*)(xr + c0 + bj * 128); xb[(idx + 1) & 1][2 * bj + 1] = *(const f32x4*)(xr + c0 + bj * 128 + 16); } }
      const float rb = u.koff < 0 ? 1.0f : __builtin_amdgcn_rsqf(pre[par * 512 + 256 + ai * 128 + wr * 64 + m * 16 + fr] * (1.0f / 512.0f) + EPS);
      float s = 0.f;
#pragma unroll
      for (int bj = 0; bj < 2; ++bj) { const int col = c0 + bj * 128; const f32x4 v0 = xb[idx & 1][2 * bj] + acc[ai][bj][m][0] * rb, v1 = xb[idx & 1][2 * bj + 1] + acc[ai][bj][m][1] * rb;
        st_bf4x2(X1B + (size_t)row * D + col, v0, X1B + (size_t)row * D + col + 16, v1, fq);
        s += ((v0[0] * v0[0] + v0[1] * v0[1]) + (v0[2] * v0[2] + v0[3] * v0[3])) + ((v1[0] * v1[0] + v1[1] * v1[1]) + (v1[2] * v1[2] + v1[3] * v1[3])); }
      s += __shfl_xor(s, 16); s += __shfl_xor(s, 32); if (fq == 0) atomic_addf(ssq_x1 + row, s); __builtin_amdgcn_sched_barrier(0); }
  }
};
struct EpiGU {
  static constexpr bool HAS_MID = false, HAS_PRE = true;
  const float* ssq_x1; bf16_t* H; LAS float* pre; float p0; int par;
  __device__ __forceinline__ void pre_load(const Unit& u, int tid) { if (tid < 256) p0 = ssq_x1[u.pm * 256 + tid]; }
  __device__ __forceinline__ void pre_store(int ui, int tid) { par = ui & 1; if (tid < 256) pre[par * 512 + tid] = p0; }
  __device__ __forceinline__ void operator()(const Acc& acc, const Unit& u, int wr, int wc, int fr, int fq) const {
    const int rbase = u.pm * 256 + wr * 64 + fr, c0 = u.pn * 128 + wc * 16 + 4 * fq;
    FOR_AM { const int row = rbase + ai * 128 + m * 16; const float rstd = __builtin_amdgcn_rsqf(pre[par * 512 + ai * 128 + wr * 64 + m * 16 + fr] * (1.0f / 1024.0f) + EPS);
      f32x4 hv[2];
#pragma unroll
      for (int bj = 0; bj < 2; ++bj) { const f32x4 g = acc[ai][bj][m][0] * rstd, up = acc[ai][bj][m][1] * rstd;
#pragma unroll
        for (int j = 0; j < 4; ++j) hv[bj][j] = g[j] * __builtin_amdgcn_rcpf(1.0f + __builtin_amdgcn_exp2f(-g[j] * LOG2E)) * up[j]; }
      st_bf4x2(H + (size_t)row * FF + c0, hv[0], H + (size_t)row * FF + c0 + 64, hv[1], fq); }
  }
};
__device__ __forceinline__ f32x4 ld_bf4(const bf16_t* p) { const u32x2 w = *(const u32x2*)p; return (f32x4){__builtin_bit_cast(float, w.x << 16), __builtin_bit_cast(float, w.x & 0xffff0000u), __builtin_bit_cast(float, w.y << 16), __builtin_bit_cast(float, w.y & 0xffff0000u)}; }
__device__ __forceinline__ void ld_bf4x2(const bf16_t* pa, const bf16_t* pb, int fq, f32x4& a, f32x4& b) {
  const u32x4 w = *(const u32x4*)((fq & 1) ? pb - 4 : pa);
  const auto r0 = __builtin_amdgcn_permlane16_swap(w.x, w.z, false, false);
  const auto r1 = __builtin_amdgcn_permlane16_swap(w.y, w.w, false, false);
  a = (f32x4){__builtin_bit_cast(float, r0[0] << 16), __builtin_bit_cast(float, r0[0] & 0xffff0000u), __builtin_bit_cast(float, r1[0] << 16), __builtin_bit_cast(float, r1[0] & 0xffff0000u)};
  b = (f32x4){__builtin_bit_cast(float, r0[1] << 16), __builtin_bit_cast(float, r0[1] & 0xffff0000u), __builtin_bit_cast(float, r1[1] << 16), __builtin_bit_cast(float, r1[1] & 0xffff0000u)};
}
struct EpiD {
  static constexpr bool HAS_MID = false, HAS_PRE = false;
  bf16_t* X; float* ssq_x2;
  __device__ __forceinline__ void operator()(const Acc& acc, const Unit& u, int wr, int wc, int fr, int fq) const {
    const int rbase = u.pm * 256 + wr * 64 + fr, c0 = u.pn * 256 + wc * 32 + 4 * fq + ((fq & 1) ? 12 : 0);
    u32x4 wb[2][2];
#pragma unroll
    for (int bj = 0; bj < 2; ++bj) wb[0][bj] = *(const u32x4*)(X + (size_t)rbase * D + c0 + bj * 128);
#pragma unroll
    for (int idx = 0; idx < 8; ++idx) { const int ai = idx >> 2, m = idx & 3; const int row = rbase + ai * 128 + m * 16;
      if (idx < 7) { const int rown = rbase + ((idx + 1) >> 2) * 128 + ((idx + 1) & 3) * 16;
#pragma unroll
        for (int bj = 0; bj < 2; ++bj) wb[(idx + 1) & 1][bj] = *(const u32x4*)(X + (size_t)rown * D + c0 + bj * 128); }
      float s = 0.f;
#pragma unroll
      for (int bj = 0; bj < 2; ++bj) { const u32x4 w = wb[idx & 1][bj];
        const auto r0 = __builtin_amdgcn_permlane16_swap(w.x, w.z, false, false); const auto r1 = __builtin_amdgcn_permlane16_swap(w.y, w.w, false, false);
        const f32x4 x0 = {__builtin_bit_cast(float, r0[0] << 16), __builtin_bit_cast(float, r0[0] & 0xffff0000u), __builtin_bit_cast(float, r1[0] << 16), __builtin_bit_cast(float, r1[0] & 0xffff0000u)};
        const f32x4 x1 = {__builtin_bit_cast(float, r0[1] << 16), __builtin_bit_cast(float, r0[1] & 0xffff0000u), __builtin_bit_cast(float, r1[1] << 16), __builtin_bit_cast(float, r1[1] & 0xffff0000u)};
        const f32x4 v0 = x0 + acc[ai][bj][m][0], v1 = x1 + acc[ai][bj][m][1];
        bf16_t* x = X + (size_t)row * D + u.pn * 256 + wc * 32 + 4 * fq + bj * 128;
        st_bf4x2(x, v0, x + 16, v1, fq);
        s += ((v0[0] * v0[0] + v0[1] * v0[1]) + (v0[2] * v0[2] + v0[3] * v0[3])) + ((v1[0] * v1[0] + v1[1] * v1[1]) + (v1[2] * v1[2] + v1[3] * v1[3])); }
      s += __shfl_xor(s, 16); s += __shfl_xor(s, 32); if (fq == 0) atomic_addf(ssq_x2 + row, s); __builtin_amdgcn_sched_barrier(0); }
  }
};
struct EpiPart {
  static constexpr bool HAS_MID = false, HAS_PRE = false;
  float* PART;
  __device__ __forceinline__ void operator()(const Acc& acc, const Unit& u, int wr, int wc, int fr, int fq) const {
    float* base = PART + (size_t)(u.koff >> 8) * 256 * D; const int r0 = wr * 64 + fr, c0 = u.pn * 256 + wc * 32 + 4 * fq;
    FOR_AM { FOR_BN { *(f32x4*)(base + (size_t)(r0 + ai * 128 + m * 16) * D + c0 + bj * 128 + n * 16) = acc[ai][bj][m][n]; } }
  }
};

__device__ __forceinline__ float wave_sum(float v) {
#pragma unroll
  for (int o = 1; o < 64; o <<= 1) v += __shfl_xor(v, o);
  return v;
}
template <class Map>
__device__ __forceinline__ void transpose_item(const float* W, int K, int N, bf16_t* WT, const float* g, LAS float* scr, int item, int lane, Map map) {
  const int nblk = N / 32, kb = item / nblk, nb = item % nblk, k0 = 64 * kb, n0 = 32 * nb;
  f32x4 wv[8];
#pragma unroll
  for (int i = 0; i < 8; ++i) { const int kk = 8 * i + (lane >> 3); wv[i] = *(const f32x4*)(W + (size_t)(k0 + kk) * N + n0 + 4 * (lane & 7)) * (g ? g[k0 + kk] : 1.0f); }
#pragma unroll
  for (int i = 0; i < 8; ++i) { const int kk = 8 * i + (lane >> 3); LAS float* d = scr + kk * 33 + 4 * (lane & 7); d[0] = wv[i][0]; d[1] = wv[i][1]; d[2] = wv[i][2]; d[3] = wv[i][3]; }
  asm volatile("s_waitcnt lgkmcnt(0)" ::: "memory");
  const int c = lane & 7;
#pragma unroll
  for (int j = 0; j < 4; ++j) { const int n = (lane >> 3) + 8 * j; const LAS float* s = scr + (8 * c) * 33 + n;
    u32x4 o; o.x = pk2(s[0 * 33], s[1 * 33]); o.y = pk2(s[2 * 33], s[3 * 33]); o.z = pk2(s[4 * 33], s[5 * 33]); o.w = pk2(s[6 * 33], s[7 * 33]);
    *(u32x4*)(WT + (size_t)map(n0 + n) * K + k0 + 8 * c) = o; }
  asm volatile("s_waitcnt lgkmcnt(0)" ::: "memory");
}
template <class Map>
__device__ __forceinline__ void convert_rows(const float* src, bf16_t* dst, int R, int cshift, int gt, int ngt, Map map) {
  const long n8 = ((long)R << cshift) >> 3;
  for (long i0 = gt; i0 < n8; i0 += 4L * ngt) {
    f32x4 v[4][2];
#pragma unroll
    for (int k = 0; k < 4; ++k) { const long i = i0 + (long)k * ngt; if (i < n8) { v[k][0] = *(const f32x4*)(src + i * 8); v[k][1] = *(const f32x4*)(src + i * 8 + 4); } }
#pragma unroll
    for (int k = 0; k < 4; ++k) { const long i = i0 + (long)k * ngt; if (i < n8) { const long e = i * 8; const int r = (int)(e >> cshift), c = (int)(e & ((1 << cshift) - 1));
      st_bf8(dst + ((size_t)map(r) << cshift) + c, v[k][0], v[k][1]); } }
  }
}
__device__ __forceinline__ void zero_rows(bf16_t* dst, int cshift, int r0, int nr, int nb, int bstride, int gt, int ngt) {
  const long per = ((long)nr << cshift) >> 3, n8 = per * nb;
  for (long i = gt; i < n8; i += ngt) { const int b = (int)(i / per); const long e = (i % per) * 8; *(u32x4*)(dst + (((size_t)b * bstride + r0) << cshift) + e) = (u32x4){0u, 0u, 0u, 0u}; }
}
__device__ __forceinline__ void prologue(ParamsC p, LAS unsigned char* lds, int G) {
  const int tid = threadIdx.x, lane = tid & 63, wave = tid >> 6; unsigned char* ws = p->ws;
  const int gw = blockIdx.x * 8 + wave, NGW = G * 8, gt = blockIdx.x * NTHREADS + tid, ngt = G * NTHREADS;
  LAS float* scr = (LAS float*)(lds + wave * 16384);
  bf16_t* WinT = (bf16_t*)(ws + WS_WIN); bf16_t* WuqT = (bf16_t*)(ws + WS_WUQ); bf16_t* WkvT = (bf16_t*)(ws + WS_WKV); bf16_t* WoT = (bf16_t*)(ws + WS_WO);
  bf16_t* WguT = (bf16_t*)(ws + WS_WGU); bf16_t* WdT = (bf16_t*)(ws + WS_WD);
  constexpr int I_IN = 16 * 65, I_UQ = 4 * 24, I_UK = 4 * 16, I_O = 16 * 32, I_G = 16 * 88, I_D = 44 * 32;
  constexpr int NITEMS = I_IN + I_UQ + 2 * I_UK + I_O + 2 * I_G + I_D;
  for (int it = gw; it < NITEMS; it += NGW) {
    int r = it;
    if (r < I_IN) { transpose_item(p->w_in, 1024, 2080, WinT, p->g_attn, scr, r, lane, [](int n) { return n < 512 ? n : (n < 544 ? 2048 + (n - 512) : 512 + (n - 544)); }); continue; } r -= I_IN;
    if (r < I_UQ) { transpose_item(p->w_uq, 256, 768, WuqT, p->g_q, scr, r, lane, [](int n) { const int h = n / 96, d = n % 96; return d < 64 ? h * 64 + d : 512 + h * 32 + (d - 64); }); continue; } r -= I_UQ;
    if (r < I_UK) { transpose_item(p->w_uk, 256, 512, WkvT, nullptr, scr, r, lane, [](int n) { return n; }); continue; } r -= I_UK;
    if (r < I_UK) { transpose_item(p->w_uv, 256, 512, WkvT, nullptr, scr, r, lane, [](int n) { return 512 + n; }); continue; } r -= I_UK;
    if (r < I_O) { const int kb = r / 32; transpose_item(p->w_out, 1024, 1024, WoT, kb < 8 ? p->g_out_a : p->g_out_b - 512, scr, r, lane, [](int n) { return n; }); continue; } r -= I_O;
    if (r < I_G) { transpose_item(p->w_gate, 1024, FF, WguT, p->g_ffn, scr, r, lane, [](int n) { return 32 * (n >> 4) + (n & 15); }); continue; } r -= I_G;
    if (r < I_G) { transpose_item(p->w_up, 1024, FF, WguT, p->g_ffn, scr, r, lane, [](int n) { return 32 * (n >> 4) + 16 + (n & 15); }); continue; } r -= I_G;
    transpose_item(p->w_down, FF, 1024, WdT, nullptr, scr, r, lane, [](int n) { return n; });
  }
  zero_rows(WinT, 10, 2080, NIN - 2080, 1, 0, gt, ngt);
  bf16_t* XN = (bf16_t*)(ws + WS_XN);
  for (int row0 = gw; row0 < MT; row0 += 4 * NGW) {
    f32x4 v[4][4]; float s[4] = {0.f, 0.f, 0.f, 0.f};
#pragma unroll
    for (int k = 0; k < 4; ++k) { const int row = row0 + k * NGW; if (row < MT) { const float* xr = row < MP ? p->xp + (size_t)row * D : p->xs + (size_t)(row - MP) * D;
#pragma unroll
      for (int j = 0; j < 2; ++j) { v[k][2 * j] = *(const f32x4*)(xr + 8 * lane + 512 * j); v[k][2 * j + 1] = *(const f32x4*)(xr + 8 * lane + 512 * j + 4); } } }
#pragma unroll
    for (int k = 0; k < 4; ++k) { const int row = row0 + k * NGW; if (row < MT) {
#pragma unroll
      for (int j = 0; j < 4; ++j) s[k] += (v[k][j][0] * v[k][j][0] + v[k][j][1] * v[k][j][1]) + (v[k][j][2] * v[k][j][2] + v[k][j][3] * v[k][j][3]);
      const float rstd = __builtin_amdgcn_rsqf(wave_sum(s[k]) * (1.0f / D) + EPS);
#pragma unroll
      for (int j = 0; j < 2; ++j) st_bf8(XN + (size_t)row * D + 8 * lane + 512 * j, v[k][2 * j] * rstd, v[k][2 * j + 1] * rstd); } }
  }
  bf16_t* CKV = (bf16_t*)(ws + WS_CKV); bf16_t* KR = (bf16_t*)(ws + WS_KR); bf16_t* KB = (bf16_t*)(ws + WS_KB); bf16_t* VB = (bf16_t*)(ws + WS_VB);
  convert_rows(p->c_ckv, CKV, DB * PAST, 8, gt, ngt, [](int r) { return MP + (r >> 12) * LROW + (r & 4095); });
  convert_rows(p->c_kr, KR, DB * PAST, 5, gt, ngt, [](int r) { return MP + (r >> 12) * LROW + (r & 4095); });
  convert_rows(p->c_bk, KB, DB * 512, 9, gt, ngt, [](int r) { return MP + (r >> 9) * BROW + (r & 511); });
  convert_rows(p->c_bv, VB, DB * 512, 9, gt, ngt, [](int r) { return MP + (r >> 9) * BROW + (r & 511); });
  zero_rows(CKV + (size_t)MP * 256, 8, PAST + DSQ, LROW - PAST - DSQ, DB, LROW, gt, ngt);
  zero_rows(KR + (size_t)MP * 32, 5, PAST + DSQ, LROW - PAST - DSQ, DB, LROW, gt, ngt);
  zero_rows(KB + (size_t)MP * 512, 9, 512 + DSQ, BROW - 512 - DSQ, DB, BROW, gt, ngt);
  zero_rows(VB + (size_t)MP * 512, 9, 512 + DSQ, BROW - 512 - DSQ, DB, BROW, gt, ngt);
  float* ssq = (float*)(ws + WS_SSQ);
  for (int i = gt; i < 4 * MT; i += ngt) ssq[i] = 0.f;
}

__device__ __forceinline__ f32x16 mfma32(bf16x8 a, bf16x8 b, f32x16 c) { return __builtin_amdgcn_mfma_f32_32x32x16_bf16(a, b, c, 0, 0, 0); }
__device__ __forceinline__ s16x4 vtr(const LAS unsigned char* p) { return __builtin_bit_cast(s16x4, __builtin_amdgcn_ds_read_tr16_b64_v4i16((LAS s16x4*)p)); }
template <int NS, bool BIAS, bool QL>
__device__ __forceinline__ void attn_qk(const LAS unsigned char* Kt, const bf16x8 (&qf)[NS], const LAS unsigned char* Qt, f32x16 (&st)[2], int nvalid, const LAS float* btab, int rb, bool lookup, int lane) {
  constexpr int KP = NS == 6 ? KP_A : KP_B;
  const int r = lane & 31, h = lane >> 5;
  bf16x8 qv[NS];
#pragma unroll
  for (int s = 0; s < NS; ++s) qv[s] = QL ? *(const LAS bf16x8*)(Qt + r * KP + (2 * s + h) * 16) : qf[s];
#pragma unroll
  for (int kh = 0; kh < 2; ++kh) {
    bf16x8 kf[NS];
#pragma unroll
    for (int s = 0; s < NS; ++s) kf[s] = *(const LAS bf16x8*)(Kt + (32 * kh + r) * KP + (2 * s + h) * 16);
    __builtin_amdgcn_sched_barrier(0);
    __builtin_amdgcn_s_setprio(1);
    { const f32x16 z = {0.f, 0.f, 0.f, 0.f, 0.f, 0.f, 0.f, 0.f, 0.f, 0.f, 0.f, 0.f, 0.f, 0.f, 0.f, 0.f}; st[kh] = mfma32(kf[0], qv[0], z); }
#pragma unroll
    for (int s = 1; s < NS; ++s) st[kh] = mfma32(kf[s], qv[s], st[kh]);
    __builtin_amdgcn_s_setprio(0);
    __builtin_amdgcn_sched_barrier(0);
  }
  if (BIAS) {
    if (lookup) { const LAS float* bp = btab + rb + 4 * h;
#pragma unroll
      for (int kh = 0; kh < 2; ++kh)
#pragma unroll
        for (int i = 0; i < 16; ++i) st[kh][i] += bp[32 * kh + (i & 3) + 8 * (i >> 2)];
    } else { const float bc = btab[0];
#pragma unroll
      for (int kh = 0; kh < 2; ++kh)
#pragma unroll
        for (int i = 0; i < 16; ++i) st[kh][i] += bc; }
  }
  if (nvalid < 64) {
#pragma unroll
    for (int kh = 0; kh < 2; ++kh)
#pragma unroll
      for (int i = 0; i < 16; ++i) { const int key = 32 * kh + (i & 3) + 8 * (i >> 2) + 4 * h; if (key >= nvalid) st[kh][i] = -1e30f; }
  }
}
__device__ __forceinline__ void attn_smpv(const LAS unsigned char* Vt, f32x16 (&st)[2], f32x16 (&o)[2], float& m_run, float& l_run, LAS float* wsf, int lane) {
  const int r = lane & 31, h = lane >> 5;
  float mx = st[0][0];
#pragma unroll
  for (int kh = 0; kh < 2; ++kh)
#pragma unroll
    for (int i = 0; i < 16; ++i) mx = __builtin_fmaxf(mx, st[kh][i]);
  mx = __builtin_fmaxf(mx, __shfl_xor(mx, 32));
  const float m_new = __builtin_fmaxf(m_run, mx), alpha = __builtin_amdgcn_exp2f(m_run - m_new);
  float rs = 0.f;
#pragma unroll
  for (int kh = 0; kh < 2; ++kh)
#pragma unroll
    for (int i = 0; i < 16; ++i) { const float pv = __builtin_amdgcn_exp2f(st[kh][i] - m_new); st[kh][i] = pv; rs += pv; }
  rs += __shfl_xor(rs, 32);
  l_run = l_run * alpha + rs; m_run = m_new;
  {
    if (h == 0) wsf[r] = alpha;
    typedef float f32x8 __attribute__((ext_vector_type(8)));
    const f32x4 a0 = *(const LAS f32x4*)(wsf + 4 * h), a1 = *(const LAS f32x4*)(wsf + 8 + 4 * h), a2 = *(const LAS f32x4*)(wsf + 16 + 4 * h), a3 = *(const LAS f32x4*)(wsf + 24 + 4 * h);
    const f32x8 lo = __builtin_shufflevector(a0, a1, 0, 1, 2, 3, 4, 5, 6, 7), hi = __builtin_shufflevector(a2, a3, 0, 1, 2, 3, 4, 5, 6, 7);
    const f32x16 av = __builtin_shufflevector(lo, hi, 0, 1, 2, 3, 4, 5, 6, 7, 8, 9, 10, 11, 12, 13, 14, 15);
    o[0] = o[0] * av; o[1] = o[1] * av;
  }
  const int blk = (lane >> 4) & 1, q = (lane & 15) >> 2, p = lane & 3;
  const int vb = (4 * h + q) * 128 + 8 * (p & 1), co0 = ((2 * blk + (p >> 1)) ^ (((q >> 1) & 1) << 2)) << 4;
#pragma unroll
  for (int kh = 0; kh < 2; ++kh)
#pragma unroll
    for (int s2 = 0; s2 < 2; ++s2) {
      u32x4 pw;
#pragma unroll
      for (int k = 0; k < 4; ++k) pw[k] = pk2(st[kh][8 * s2 + 2 * k], st[kh][8 * s2 + 2 * k + 1]);
      const bf16x8 pa = __builtin_bit_cast(bf16x8, pw);
#pragma unroll
      for (int c = 0; c < 2; ++c) {
        const LAS unsigned char* vp = Vt + (32 * kh + 16 * s2) * 128 + vb + (c ? (co0 ^ 64) : co0);
        const s16x4 lo = vtr(vp), hi = vtr(vp + 8 * 128);
        const bf16x8 vf = __builtin_shufflevector(lo, hi, 0, 1, 2, 3, 4, 5, 6, 7);
        __builtin_amdgcn_s_setprio(1); o[c] = mfma32(pa, vf, o[c]); __builtin_amdgcn_s_setprio(0);
      }
    }
}
__device__ __forceinline__ void scale_o(f32x16 (&o)[2], float f, LAS float* wsf, int lane) {
  const int r = lane & 31, h = lane >> 5;
  if (h == 0) wsf[r] = f;
#pragma unroll
  for (int g = 0; g < 4; ++g) { const f32x4 a4 = *(const LAS f32x4*)(wsf + 8 * g + 4 * h);
#pragma unroll
    for (int j = 0; j < 4; ++j) { o[0][4 * g + j] *= a4[j]; o[1][4 * g + j] *= a4[j]; } }
}
__device__ __forceinline__ void store_o(const f32x16 (&o)[2], LAS bf16_t* stg, bf16_t* att  , float* ssq  , int nq, int lane) {
  const int r = lane & 31, h = lane >> 5;
#pragma unroll
  for (int c = 0; c < 2; ++c)
#pragma unroll
    for (int i = 0; i < 16; ++i) stg[((i & 3) + 8 * (i >> 2) + 4 * h) * 64 + 32 * c + r] = (bf16_t)f2bf(o[c][i]);
  const int qr = lane >> 1, half = lane & 1; float s = 0.f; u32x4 v[4];
#pragma unroll
  for (int k = 0; k < 4; ++k) { v[k] = *(const LAS u32x4*)(stg + qr * 64 + half * 32 + 8 * k);
#pragma unroll
    for (int e = 0; e < 4; ++e) { const float a = __builtin_bit_cast(float, v[k][e] << 16), b = __builtin_bit_cast(float, v[k][e] & 0xffff0000u); s += a * a + b * b; } }
  s += __shfl_xor(s, 1);
  if (qr < nq) {
#pragma unroll
    for (int k = 0; k < 4; ++k) *(u32x4*)(att + (size_t)qr * D + half * 32 + 8 * k) = v[k];
    if (half == 0 && ssq) atomic_addf(ssq + qr, s);
  }
}
struct KVSrc { const bf16_t* K; const bf16_t* KRp; const bf16_t* V; };
template <int NS>
__device__ __forceinline__ u32x4 ld_kchunk(const KVSrc& s, long krow, int id) {
  if (NS == 6) { const int row = id / 12, ch = id - row * 12;
    return ch < 8 ? *(const u32x4*)(s.K + (krow + row) * 512 + ch * 8) : *(const u32x4*)(s.KRp + (krow + row) * 32 + (ch - 8) * 8); }
  else { const int row = id >> 3, ch = id & 7; return *(const u32x4*)(s.K + (krow + row) * 512 + ch * 8); }
}
template <int NS>
__device__ __forceinline__ void st_kchunk(LAS unsigned char* Kt, int id, u32x4 v) {
  constexpr int KP = NS == 6 ? KP_A : KP_B, CPR = NS == 6 ? 12 : 8;
  const int row = id / CPR, ch = id - row * CPR; *(LAS u32x4*)(Kt + row * KP + ch * 16) = v;
}
__device__ __forceinline__ void st_vchunk(LAS unsigned char* Vt, int id, u32x4 v) { const int row = id >> 3, ch = id & 7; *(LAS u32x4*)(Vt + row * 128 + ((ch ^ (((row >> 1) & 1) << 2)) << 4)) = v; }

__device__ __forceinline__ void glds16(const void* gsrc, unsigned lds_dst) {
  unsigned keep;
  asm volatile("s_mov_b32 %0, m0\n\ts_mov_b32 m0, %2\n\ts_nop 0\n\tglobal_load_lds_dwordx4 %1, off\n\ts_mov_b32 m0, %0" : "=&s"(keep) : "v"(gsrc), "s"(lds_dst) : "memory");
}
template <int NS>
__device__ __forceinline__ void dma_tile(LAS unsigned char* Kt, LAS unsigned char* Vt, const KVSrc& src, long krow, int wave, int lane) {
  constexpr int CPR = NS == 6 ? 13 : 9, ND = CPR;
#pragma unroll
  for (int k = 0; k < 2; ++k) { const int d = wave + 8 * k;
    if (d < ND) { const int c = d * 64 + lane, row = c / CPR, ch = c - row * CPR;
      const bf16_t* g = (NS == 6 && ch >= 8 && ch < 12) ? src.KRp + (krow + row) * 32 + (ch - 8) * 8 : src.K + (krow + row) * 512 + (ch < 8 ? ch : 0) * 8;
      glds16(g, (unsigned)__builtin_amdgcn_readfirstlane((int)(unsigned)(uintptr_t)(Kt + d * 1024))); } }
  { const int c = wave * 64 + lane, row = c >> 3, ch = (c & 7) ^ (((row >> 1) & 1) << 2);
    glds16(src.V + (krow + row) * 512 + ch * 8, (unsigned)__builtin_amdgcn_readfirstlane((int)(unsigned)(uintptr_t)(Vt + wave * 1024))); }
}
#define AT_VMWAIT(n) asm volatile("s_waitcnt vmcnt(" #n ")" ::: "memory")
template <int NS, bool BIAS>
__device__ __forceinline__ void attn_unit_shared(LAS unsigned char* lds, const bf16_t* Qw  , int qpitch, const KVSrc src, long krow0,
                                                 int t_lo, int t_hi, int w_lo, int w_hi, int qpos0  , bf16_t* att, float* ssq, int bhead = 0) {
  constexpr int SLOT = 21504, ND = NS == 6 ? 13 : 9;
  int tid_ = threadIdx.x; asm volatile("" : "+v"(tid_));
  const int tid = tid_, lane = tid & 63, wave = __builtin_amdgcn_readfirstlane(tid >> 6), r = lane & 31, h = lane >> 5;
  LAS float* wsf = (LAS float*)(lds + AT_WSF) + wave * 64; const LAS float* btab = (const LAS float*)(lds + AT_BIAS) + bhead * 640;
#pragma unroll
  for (int k = 0; k < 2; ++k) if (t_lo + k <= t_hi) dma_tile<NS>(lds + AT_TILE + k * SLOT, lds + AT_TILE + k * SLOT + 13312, src, krow0 + 64L * (t_lo + k), wave, lane);
  bf16x8 qf[NS];
#pragma unroll
  for (int s = 0; s < NS; ++s) qf[s] = *(const bf16x8*)(Qw + (size_t)r * qpitch + 16 * s + 8 * h);
#pragma unroll
  for (int s = 0; s < NS; ++s) asm volatile("" : "+v"(qf[s]));
  f32x16 o[2];
#pragma unroll
  for (int i = 0; i < 16; ++i) { o[0][i] = 0.f; o[1][i] = 0.f; }
  float m_run = -1e30f, l_run = 0.f;
  AT_VMWAIT(0);
  asm volatile("s_waitcnt lgkmcnt(0)" ::: "memory"); __builtin_amdgcn_s_barrier(); asm volatile("" ::: "memory");
  for (int t0 = t_lo; t0 <= t_hi; t0 += 2) {
#pragma unroll
    for (int k = 2; k < 4; ++k) if (t0 + k <= t_hi) { const int s3 = (t0 + k - t_lo) & 3; dma_tile<NS>(lds + AT_TILE + s3 * SLOT, lds + AT_TILE + s3 * SLOT + 13312, src, krow0 + 64L * (t0 + k), wave, lane); }
#pragma unroll
    for (int k = 0; k < 2; ++k) { const int t = t0 + k; const int sl = (t - t_lo) & 3;
      if (t <= t_hi && t >= w_lo && t <= w_hi) {
        const bool lookup = BIAS && (qpos0 - (64 * t + 63) < 256);
        f32x16 st[2]; attn_qk<NS, BIAS, false>(lds + AT_TILE + sl * SLOT, qf, nullptr, st, 64, btab, 639 - (qpos0 + r - 64 * t + 256), lookup, lane);
        attn_smpv(lds + AT_TILE + sl * SLOT + 13312, st, o, m_run, l_run, wsf, lane);
      } }
    AT_VMWAIT(0);
    asm volatile("s_waitcnt lgkmcnt(0)" ::: "memory"); __builtin_amdgcn_s_barrier(); asm volatile("" ::: "memory");
  }
  scale_o(o, 1.0f / l_run, wsf, lane);
  store_o(o, (LAS bf16_t*)(lds + AT_OSTG) + wave * 2048, att, ssq, 32, lane);
}
template <int NS, bool BIAS>
__device__ __forceinline__ void attn_unit_sample(LAS unsigned char* lds, const bf16_t* Qw, int qpitch, const KVSrc src, long krow0, int ntiles, int nvalid_last, int qpos0, bf16_t* att, float* ssq, int bhead = 0) {
  constexpr int NKC = NS == 6 ? 768 : 512;
  int tid_ = threadIdx.x; asm volatile("" : "+v"(tid_));
  const int tid = tid_, lane = tid & 63, wave = tid >> 6, r = lane & 31, h = lane >> 5;
  LAS float* wsf = (LAS float*)(lds + AT_WSF) + wave * 64; const LAS float* btab = (const LAS float*)(lds + AT_BIAS) + bhead * 640;
  LAS float* cm = (LAS float*)(lds + AT_CMB);
  f32x16 o[2];
#pragma unroll
  for (int i = 0; i < 16; ++i) { o[0][i] = 0.f; o[1][i] = 0.f; }
  float m_run = -1e30f, l_run = 0.f;
  LAS unsigned char* Kt = lds + AT_TILE + (wave & 3) * AT_PRIV; LAS unsigned char* Vt = Kt + 13312;
  bf16x8 qf[NS];
#pragma unroll
  for (int s = 0; s < NS; ++s) qf[s] = *(const bf16x8*)(Qw + (size_t)(r & 15) * qpitch + 16 * s + 8 * h);
  constexpr int NK4 = 4 * NKC / 512;
  u32x4 kc[NK4], vc[4];
#define SMP_LOAD(T0) do { _Pragma("unroll") for (int i = 0; i < NK4; ++i) { const int id = tid + 512 * i, tt = id / NKC, cid = id - tt * NKC; if ((T0) + tt < ntiles) kc[i] = ld_kchunk<NS>(src, krow0 + 64L * ((T0) + tt), cid); } \
    _Pragma("unroll") for (int i = 0; i < 4; ++i) { const int id = tid + 512 * i, tt = id >> 9, cid = id & 511; if ((T0) + tt < ntiles) vc[i] = *(const u32x4*)(src.V + (krow0 + 64L * ((T0) + tt) + (cid >> 3)) * 512 + (cid & 7) * 8); } } while (0)
#define SMP_STORE(T0) do { _Pragma("unroll") for (int i = 0; i < NK4; ++i) { const int id = tid + 512 * i, tt = id / NKC, cid = id - tt * NKC; if ((T0) + tt < ntiles) st_kchunk<NS>(lds + AT_TILE + tt * AT_PRIV, cid, kc[i]); } \
    _Pragma("unroll") for (int i = 0; i < 4; ++i) { const int id = tid + 512 * i, tt = id >> 9, cid = id & 511; if ((T0) + tt < ntiles) st_vchunk(lds + AT_TILE + tt * AT_PRIV + 13312, cid, vc[i]); } } while (0)
  SMP_LOAD(0); SMP_STORE(0);
  __syncthreads();
  for (int t0 = 0; t0 < ntiles; t0 += 4) {
    if (t0 + 4 < ntiles) SMP_LOAD(t0 + 4);
    const int t = t0 + wave;
    if (wave < 4 && t < ntiles) {
      const bool lookup = BIAS && (qpos0 - (64 * t + 63) < 256);
      f32x16 st[2]; attn_qk<NS, BIAS, false>(Kt, qf, nullptr, st, (t == ntiles - 1) ? nvalid_last : 64, btab, 639 - (qpos0 + (r & 15) - 64 * t + 256), lookup, lane);
      attn_smpv(Vt, st, o, m_run, l_run, wsf, lane);
    }
    __syncthreads();
    if (t0 + 4 < ntiles) { SMP_STORE(t0 + 4); }
    __syncthreads();
  }
#undef SMP_LOAD
#undef SMP_STORE
  if (wave < 4 && h == 0) cm[wave * 32 + r] = m_run;
  __syncthreads();
  if (wave < 4) {
    const float M = __builtin_fmaxf(__builtin_fmaxf(cm[r], cm[32 + r]), __builtin_fmaxf(cm[64 + r], cm[96 + r]));
    const float f = __builtin_amdgcn_exp2f(m_run - M);
    scale_o(o, f, wsf, lane);
    if (h == 0) cm[128 + wave * 32 + r] = l_run * f;
    LAS float* po = (LAS float*)(lds + AT_TILE + wave * AT_PRIV);
#pragma unroll
    for (int c = 0; c < 2; ++c)
#pragma unroll
      for (int i = 0; i < 16; ++i) po[(c * 16 + i) * 64 + lane] = o[c][i];
  }
  __syncthreads();
  if (wave == 0) {
    const float l = (cm[128 + r] + cm[160 + r]) + (cm[192 + r] + cm[224 + r]);
#pragma unroll
    for (int w = 1; w < 4; ++w) { const LAS float* po = (const LAS float*)(lds + AT_TILE + w * AT_PRIV);
#pragma unroll
      for (int c = 0; c < 2; ++c)
#pragma unroll
        for (int i = 0; i < 16; ++i) o[c][i] += po[(c * 16 + i) * 64 + lane]; }
    scale_o(o, 1.0f / l, wsf, lane);
    store_o(o, (LAS bf16_t*)(lds + AT_OSTG), att, ssq, 16, lane);
  }
  __syncthreads();
}
__device__ __forceinline__ void load_bias_all(LAS unsigned char* lds, const float* rel_bias) {
  LAS float* btab = (LAS float*)(lds + AT_BIAS);
  for (int i = threadIdx.x; i < 8 * 640; i += NTHREADS) { const int hd = i / 640, j = 639 - (i - hd * 640); btab[i] = rel_bias[hd * 513 + (j > 512 ? 512 : j)] * LOG2E; }
  __syncthreads();
}
__device__ __forceinline__ void attention_phase(ParamsC p, LAS unsigned char* lds, int G, bool dry, int apm = 15) {
  unsigned char* ws = p->ws; const int wave = threadIdx.x >> 6;
  const bf16_t* Q = (const bf16_t*)(ws + WS_Q); const bf16_t* KN = (const bf16_t*)(ws + WS_KN); const bf16_t* V = (const bf16_t*)(ws + WS_V); const bf16_t* KR = (const bf16_t*)(ws + WS_KR);
  const bf16_t* QB = (const bf16_t*)(ws + WS_QB); const bf16_t* KB = (const bf16_t*)(ws + WS_KB); const bf16_t* VB = (const bf16_t*)(ws + WS_VB);
  bf16_t* ATT = (bf16_t*)(ws + WS_XN); float* ssq_a = (float*)(ws + WS_SSQ); float* ssq_b = ssq_a + MT;
  load_bias_all(lds, p->rel_bias);
  for (int u = blockIdx.x; u < 256; u += G) {
    const int b = (u & 127) >> 3, head = u & 7; const int row0 = MP + b * DSQ;
#ifndef AP
#define AP 15
#endif
    if (u < 128) { if (apm & 1) {
      const KVSrc src{KN + head * 64, KR, V + head * 64};
      attn_unit_sample<6, false>(lds, Q + (size_t)row0 * 768 + head * 96, 768, src, (long)MP + (long)b * LROW, 65, 16, 0, ATT + (size_t)row0 * D + head * 64, dry ? nullptr : ssq_a + row0); }
    } else if (apm & 2) {
      const KVSrc src{KB + head * 64, nullptr, VB + head * 64};
      attn_unit_sample<4, true>(lds, QB + (size_t)row0 * 512 + head * 64, 512, src, (long)MP + (long)b * BROW, 9, 16, 512, ATT + (size_t)row0 * D + 512 + head * 64, dry ? nullptr : ssq_b + row0, head);
    }
  }
  if (G == 256) {
    const int vcu = (blockIdx.x & 7) * 32 + (blockIdx.x >> 3), grp = vcu >> 3, mem = vcu & 7; const int b = grp; const long brow = (long)b * SEQ;
    if (apm & 4) for (int i = 0; i < 8; ++i) { const int head = i, qb = (mem + i) & 7; const KVSrc src{KN + head * 64, KR, V + head * 64}; const long qrow = brow + 256 * qb + 32 * wave;
      attn_unit_shared<6, false>(lds, Q + (size_t)qrow * 768 + head * 96, 768, src, brow, 0, 4 * qb + 3, 0, 4 * qb + (wave >> 1), 0, ATT + (size_t)qrow * D + head * 64, dry ? nullptr : ssq_a + qrow); }
    if (apm & 8) for (int i = 0; i < 8; ++i) { const int head = i, cb = (mem + i) & 7;
      const KVSrc src{KB + head * 64, nullptr, VB + head * 64}; const long qrow = brow + 256 * cb + 32 * wave; const int cq = 4 * cb + (wave >> 1); const int tl = 4 * cb - 8 < 0 ? 0 : 4 * cb - 8;
      attn_unit_shared<4, true>(lds, QB + (size_t)qrow * 512 + head * 64, 512, src, brow, tl, 4 * cb + 3, cq - 8, cq, 256 * cb + 32 * wave, ATT + (size_t)qrow * D + 512 + head * 64, dry ? nullptr : ssq_b + qrow, head); }
  } else {
  for (int bh = blockIdx.x; bh < NBATCH * 8; bh += G) {
    const int b = bh >> 3, head = bh & 7; const long brow = (long)b * SEQ;
    if (apm & 4) { const KVSrc src{KN + head * 64, KR, V + head * 64};
      for (int qb = 0; qb < 8; ++qb) { const long qrow = brow + 256 * qb + 32 * wave;
        attn_unit_shared<6, false>(lds, Q + (size_t)qrow * 768 + head * 96, 768, src, brow, 0, 4 * qb + 3, 0, 4 * qb + (wave >> 1), 0, ATT + (size_t)qrow * D + head * 64, dry ? nullptr : ssq_a + qrow); } }
    if (apm & 8) { const KVSrc src{KB + head * 64, nullptr, VB + head * 64};
      for (int cb = 0; cb < 8; ++cb) { const long qrow = brow + 256 * cb + 32 * wave; const int cq = 4 * cb + (wave >> 1); const int tl = 4 * cb - 8 < 0 ? 0 : 4 * cb - 8;
        attn_unit_shared<4, true>(lds, QB + (size_t)qrow * 512 + head * 64, 512, src, brow, tl, 4 * cb + 3, cq - 8, cq, 256 * cb + 32 * wave, ATT + (size_t)qrow * D + 512 + head * 64, dry ? nullptr : ssq_b + qrow, head); } }
  }
  }
}


#define XB_TMO      128
#define XB_XCNT(j)  (256  + 64 * (j))
#define XB_XSUB(j)  (1280 + 64 * (j))
#define XB_XGEN(j)  (2304 + 64 * (j))
#define XB_TOP      3328
#define XB_TOPGEN   3392
#define XCD_BAR_WORDS 3456
#define XB_SPIN_CAP (1u << 18)
__device__ __forceinline__ unsigned xb_ld(unsigned* p)              { return __hip_atomic_load(p, __ATOMIC_RELAXED, __HIP_MEMORY_SCOPE_AGENT); }
__device__ __forceinline__ unsigned xb_add(unsigned* p, unsigned v) { return __hip_atomic_fetch_add(p, v, __ATOMIC_RELAXED, __HIP_MEMORY_SCOPE_AGENT); }
__device__ __forceinline__ unsigned xb_xcc_id() { return (unsigned)__builtin_amdgcn_s_getreg((3 << 11) | 20) & 0xFu; }
#define XB_SPIN(cond, bar) do { unsigned _sp = 0; while (cond) { __builtin_amdgcn_s_sleep(1); \
    if ((++_sp & 255u) == 0u) { if (xb_ld(&(bar)[XB_TMO])) break; if (_sp > XB_SPIN_CAP) { atomicAdd(&(bar)[XB_TMO], 1u); break; } } } } while (0)
__device__ __forceinline__ void xcd_barrier_complete(unsigned* bar, unsigned x, unsigned& nloc, unsigned& nx) {
  const unsigned G = gridDim.x * gridDim.y * gridDim.z;
  unsigned sum, cnt, mine, sp = 0u;
  for (;;) {
    sum = 0u; cnt = 0u; mine = 0u;
#pragma unroll
    for (unsigned j = 0; j < 16; ++j) { const unsigned c = xb_ld(&bar[XB_XCNT(j)]); sum += c; cnt += (c > 0u) ? 1u : 0u; mine = (j == x) ? c : mine; }
    if (sum == G) break;
    __builtin_amdgcn_s_sleep(1);
    if ((++sp & 255u) == 0u) { if (xb_ld(&bar[XB_TMO])) break; if (sp > XB_SPIN_CAP) { atomicAdd(&bar[XB_TMO], 1u); break; } }
  }
  nloc = mine > 0u ? mine : 1u; nx = cnt > 0u ? cnt : 1u;
}
__device__ __forceinline__ void xcd_barrier(unsigned* bar, volatile LAS unsigned* st) {
  asm volatile("s_waitcnt vmcnt(0)" ::: "memory");
  __syncthreads();
  if (threadIdx.x == 0) {
    const unsigned x = xb_xcc_id();
    __builtin_amdgcn_s_waitcnt(0);
    unsigned nloc = st[0], nx = st[1];
    if (nloc == 0u) { xcd_barrier_complete(bar, x, nloc, nx); st[0] = nloc; st[1] = nx; }
    const unsigned old = xb_add(&bar[XB_XSUB(x)], 1u);
    const unsigned gen = old / nloc;
    if (old + 1u == (gen + 1u) * nloc) {
      __builtin_amdgcn_fence(__ATOMIC_RELEASE, "agent");
      asm volatile("s_waitcnt vmcnt(0)" ::: "memory");
      const unsigned og = xb_add(&bar[XB_TOP], 1u);
      const unsigned tg = og / nx;
      if (og + 1u == (tg + 1u) * nx) xb_add(&bar[XB_TOPGEN], 1u);
      else XB_SPIN(xb_ld(&bar[XB_TOPGEN]) == tg, bar);
      __builtin_amdgcn_fence(__ATOMIC_ACQUIRE, "agent");
      xb_add(&bar[XB_XGEN(x)], 1u);
      asm volatile("s_waitcnt vmcnt(0)" ::: "memory");
    } else {
      XB_SPIN(xb_ld(&bar[XB_XGEN(x)]) == gen, bar);
      __builtin_amdgcn_fence(__ATOMIC_ACQUIRE, "agent");
      asm volatile("s_waitcnt vmcnt(0)" ::: "memory");
    }
  }
  __syncthreads();
}

__device__ __forceinline__ ParamsC get_params() {
  ParamsC pp = (ParamsC)__builtin_amdgcn_kernarg_segment_ptr(); asm volatile("" : "+s"(pp)); return pp;
}
__global__ void __launch_bounds__(NTHREADS) mk_fwd(Params p_unused) {
  extern __shared__ __attribute__((aligned(16))) unsigned char lds_raw[];
  LAS unsigned char* lds = (LAS unsigned char*)lds_raw;
  cg::grid_group grid = cg::this_grid();
  const int G = gridDim.x;
  volatile LAS unsigned* xst = (volatile LAS unsigned*)(lds + LDS_BYTES - 16);
  if (threadIdx.x < 2) xst[threadIdx.x] = 0u;
  if (threadIdx.x == 0) (void)xb_add(&((unsigned*)(get_params()->ws + WS_BAR))[XB_XCNT(xb_xcc_id())], 1u);
  __syncthreads();
#define FAST_SYNC() xcd_barrier((unsigned*)(get_params()->ws + WS_BAR), xst)
#define WSP(T, off) ((T*)(get_params()->ws + (off)))
#define ssq WSP(float, WS_SSQ)
#define X1B WSP(bf16_t, WS_X1B)
#define XN WSP(bf16_t, WS_XN)
#define CQN WSP(bf16_t, WS_CQN)
#define CKV WSP(bf16_t, WS_CKV)
#define KR WSP(bf16_t, WS_KR)
#define QB WSP(bf16_t, WS_QB)
#define KB WSP(bf16_t, WS_KB)
#define VB WSP(bf16_t, WS_VB)
#define Q WSP(bf16_t, WS_Q)
#define KN WSP(bf16_t, WS_KN)
#define V WSP(bf16_t, WS_V)
#define H WSP(bf16_t, WS_H)
  pg8::StaticOrder S;
#ifndef PH
#define PH 255
#endif
  if (PH & 1) prologue(get_params(), lds, G);
#ifdef DUP_P0
  grid.sync(); prologue(get_params(), lds, G);
#endif
  grid.sync();
  if (PH & 2) { pg8::Gemm g{XN, (const bf16_t*)(get_params()->ws + WS_WIN), 1024, 1024, 1024}; S.init(MT, NIN, G, blockIdx.x);
    ParamsC pp = get_params(); EpiIn E{pp->out, CQN, CKV, KR, QB, KB, VB, pp->g_kv, (LAS float*)(lds + LDS_RED)};
    pg8::gemm_phase(lds, g, S, E); }
  FAST_SYNC();
  if ((PH & 4) && !(PH & 256)) { pg8::Gemm g{CQN, (const bf16_t*)(get_params()->ws + WS_WUQ), 256, 256, 256}; S.init(MT, 768, G, blockIdx.x); EpiQ E{Q}; pg8::gemm_phase(lds, g, S, E); }
  if ((PH & 4) && !(PH & 512)) { pg8::Gemm g{CKV, (const bf16_t*)(get_params()->ws + WS_WKV), 256, 256, 256}; S.init(MLAT, 1024, G, blockIdx.x); EpiKV E{KN, V}; pg8::gemm_phase(lds, g, S, E); }
  FAST_SYNC();
  if (PH & 8) attention_phase(get_params(), lds, G, false);
#ifdef DUP_ATTN
  grid.sync(); attention_phase(get_params(), lds, G, true, DUP_ATTN);
#endif
  FAST_SYNC();
  if (PH & 16) { pg8::Gemm g{XN  , (const bf16_t*)(get_params()->ws + WS_WO), 1024, 1024, 1024}; S.init(MT, 1024, G, blockIdx.x);
    ParamsC pp = get_params(); EpiO E{8, ssq, ssq + MT, pp->xp, pp->xs, X1B, ssq + 2 * MT, (LAS float*)(lds + LDS_RED), 0.f, 0.f, 0}; pg8::gemm_phase(lds, g, S, E); }
  FAST_SYNC();
  if (PH & 32) { pg8::Gemm g{X1B, (const bf16_t*)(get_params()->ws + WS_WGU), 1024, 1024, 1024}; S.init(MT, NGU, G, blockIdx.x); EpiGU E{ssq + 2 * MT, H, (LAS float*)(lds + LDS_RED), 0.f, 0}; pg8::gemm_phase(lds, g, S, E);
#ifdef DUP_P5
    grid.sync(); pg8::gemm_phase(lds, g, S, E);
#endif
  }
  FAST_SYNC();
#define PART WSP(float, WS_Q)
  if (PH & 64) { pg8::Gemm g{H, (const bf16_t*)(get_params()->ws + WS_WD), FF, FF, FF}; S.init(MP, 1024, G, blockIdx.x); EpiD E{X1B, ssq + 3 * MT}; pg8::gemm_phase(lds, g, S, E);
    pg8::Gemm g2{H, (const bf16_t*)(get_params()->ws + WS_WD), FF, FF, 256}; pg8::SplitOrder S2{MP / 256, 4, 44, 256, G, (int)blockIdx.x}; EpiPart E2{PART}; pg8::gemm_phase(lds, g2, S2, E2); }
  FAST_SYNC();
  if (PH & 128) { ParamsC p = get_params(); int t7 = threadIdx.x; asm volatile("" : "+v"(t7)); const int lane = t7 & 63, gw = blockIdx.x * 8 + (t7 >> 6), NGW = G * 8; const float* s2 = ssq + 3 * MT;
    f32x4 gf[4];
#pragma unroll
    for (int j = 0; j < 2; ++j) { gf[2 * j] = *(const f32x4*)(p->g_final + 8 * lane + 512 * j); gf[2 * j + 1] = *(const f32x4*)(p->g_final + 8 * lane + 512 * j + 4); }
    for (int rr0 = gw; rr0 < MT; rr0 += 4 * NGW) {
      u32x4 raw[4][2]; int rows[4];
#pragma unroll
      for (int k = 0; k < 4; ++k) { const int rr = rr0 + k * NGW; rows[k] = rr < MS ? MP + rr : rr - MS;
        if (rr < MT) { const bf16_t* x = X1B + (size_t)rows[k] * D;
#pragma unroll
          for (int j = 0; j < 2; ++j) raw[k][j] = *(const u32x4*)(x + 8 * lane + 512 * j); } }
#pragma unroll
      for (int k = 0; k < 4; ++k) { const int rr = rr0 + k * NGW, row = rows[k]; if (rr < MT) {
        f32x4 v[4];
#pragma unroll
        for (int j = 0; j < 2; ++j) { const u32x4 w = raw[k][j];
          v[2 * j] = (f32x4){__builtin_bit_cast(float, w.x << 16), __builtin_bit_cast(float, w.x & 0xffff0000u), __builtin_bit_cast(float, w.y << 16), __builtin_bit_cast(float, w.y & 0xffff0000u)};
          v[2 * j + 1] = (f32x4){__builtin_bit_cast(float, w.z << 16), __builtin_bit_cast(float, w.z & 0xffff0000u), __builtin_bit_cast(float, w.w << 16), __builtin_bit_cast(float, w.w & 0xffff0000u)}; }
        float* y = p->out + OFF_Y + (size_t)row * D; float rstd;
        if (row >= MP) { float s = 0.f;
          for (int kc = 0; kc < 11; ++kc) { const float* pr = PART + ((size_t)kc * 256 + (row - MP)) * D;
#pragma unroll
            for (int j = 0; j < 2; ++j) { v[2 * j] = v[2 * j] + *(const f32x4*)(pr + 8 * lane + 512 * j); v[2 * j + 1] = v[2 * j + 1] + *(const f32x4*)(pr + 8 * lane + 512 * j + 4); } }
#pragma unroll
          for (int j = 0; j < 4; ++j) s += (v[j][0] * v[j][0] + v[j][1] * v[j][1]) + (v[j][2] * v[j][2] + v[j][3] * v[j][3]);
          rstd = __builtin_amdgcn_rsqf(wave_sum(s) * (1.0f / D) + EPS);
        } else rstd = __builtin_amdgcn_rsqf(s2[row] * (1.0f / D) + EPS);
#pragma unroll
        for (int j = 0; j < 2; ++j) { *(f32x4*)(y + 8 * lane + 512 * j) = v[2 * j] * rstd * gf[2 * j]; *(f32x4*)(y + 8 * lane + 512 * j + 4) = v[2 * j + 1] * rstd * gf[2 * j + 1]; } } } } }
}

#undef FAST_SYNC
#undef ssq
#undef X1B
#undef XN
#undef CQN
#undef CKV
#undef KR
#undef QB
#undef KB
#undef VB
#undef Q
#undef KN
#undef V
#undef H
#undef PART
extern "C" void kernel_launch(void* const* d_in, const int* in_sizes, int n_in, void* d_out, int out_size, void* d_ws, size_t ws_size, hipStream_t stream) {
  static int grid = 0;
  if (grid == 0) {
    if (n_in != 22 || (size_t)out_size != OUT_TOTAL || ws_size < WS_TOTAL) { fprintf(stderr, "kernel_launch: unexpected shapes (n_in %d out %d ws %zu, need ws %zu)\n", n_in, out_size, ws_size, (size_t)WS_END); grid = -1; return; }
    int dev = 0, cus = 0, per_cu = 0;
    hipGetDevice(&dev); hipDeviceGetAttribute(&cus, hipDeviceAttributeMultiprocessorCount, dev);
    hipFuncSetAttribute((const void*)mk_fwd, hipFuncAttributeMaxDynamicSharedMemorySize, LDS_BYTES);
    hipOccupancyMaxActiveBlocksPerMultiprocessor(&per_cu, (const void*)mk_fwd, NTHREADS, LDS_BYTES);
    if (per_cu < 1 || cus < 1) { fprintf(stderr, "kernel_launch: occupancy query gave %d blocks/CU on %d CUs\n", per_cu, cus); grid = -1; return; }
    grid = cus * (per_cu > 1 ? 1 : per_cu);
  }
  if (grid < 0) return;
  Params p{};
  const float** pp = (const float**)&p;
  for (int i = 0; i < 22; ++i) pp[i] = (const float*)d_in[i];
  p.out = (float*)d_out; p.ws = (unsigned char*)d_ws;
  if (hipMemsetAsync((char*)d_ws + WS_BAR, 0, 16384, stream) != hipSuccess) { fprintf(stderr, "kernel_launch: memset of barrier words failed\n"); return; }
  void* args[] = {&p};
  hipError_t e = hipLaunchCooperativeKernel((void*)mk_fwd, dim3(grid), dim3(NTHREADS), args, LDS_BYTES, stream);
  if (e != hipSuccess) fprintf(stderr, "cooperative launch failed: %s (grid %d)\n", hipGetErrorString(e), grid);
}
```

```cpp
#include <hip/hip_runtime.h>
#include <hip/hip_cooperative_groups.h>
#include <cstdio>
#include <cstdint>


namespace cg = cooperative_groups;

#define LAS __attribute__((address_space(3)))
typedef unsigned short bf16_t;
typedef short bf16x8 __attribute__((ext_vector_type(8)));
typedef short s16x4 __attribute__((ext_vector_type(4)));
typedef float f32x4 __attribute__((ext_vector_type(4)));
typedef float f32x16 __attribute__((ext_vector_type(16)));
typedef unsigned u32x4 __attribute__((ext_vector_type(4)));
typedef unsigned u32x2 __attribute__((ext_vector_type(2)));
typedef float f32x2_t __attribute__((ext_vector_type(2)));
typedef __bf16 bf16x2_t __attribute__((ext_vector_type(2)));

constexpr int D = 1024, NBATCH = 32, SEQ = 2048, MP = NBATCH * SEQ, DB = 16, DSQ = 16, MS = DB * DSQ, MT = MP + MS, PAST = 4096;
constexpr int NIN = 2304, FF = 2816, NGU = 2 * FF;
constexpr int LROW = 4352, BROW = 768;
constexpr int MLAT = MP + DB * LROW, MBND = MP + DB * BROW;
constexpr float EPS = 1e-6f, LOG2E = 1.4426950408889634f;
constexpr float QSCALE_A = 0.10206207261596575f * LOG2E;
constexpr float QSCALE_B = 0.125f * LOG2E;
constexpr int NTHREADS = 512;
constexpr size_t OFF_Y = 0, OFF_CKVP = (size_t)MT * D, OFF_KRP = OFF_CKVP + (size_t)MP * 256, OFF_BKP = OFF_KRP + (size_t)MP * 32,
                 OFF_BVP = OFF_BKP + (size_t)NBATCH * 512 * 512, OFF_CKVS = OFF_BVP + (size_t)NBATCH * 512 * 512, OFF_KRS = OFF_CKVS + (size_t)MS * 256,
                 OFF_BKS = OFF_KRS + (size_t)MS * 32, OFF_BVS = OFF_BKS + (size_t)MS * 512, OUT_TOTAL = OFF_BVS + (size_t)MS * 512;
constexpr size_t al256(size_t x) { return (x + 255) & ~(size_t)255; }
constexpr size_t WS_SSQ = 0;
constexpr size_t WS_WIN = al256(WS_SSQ + 4 * (size_t)MT * 4);
constexpr size_t WS_WUQ = al256(WS_WIN + (size_t)NIN * 1024 * 2);
constexpr size_t WS_WKV = al256(WS_WUQ + (size_t)768 * 256 * 2);
constexpr size_t WS_WO = al256(WS_WKV + (size_t)1024 * 256 * 2);
constexpr size_t WS_WGU = al256(WS_WO + (size_t)1024 * 1024 * 2);
constexpr size_t WS_WD = al256(WS_WGU + (size_t)NGU * 1024 * 2);
constexpr size_t WS_X1B = al256(WS_WD + (size_t)1024 * FF * 2);
constexpr size_t WS_XN = al256(WS_X1B + (size_t)MT * 1024 * 2);
constexpr size_t WS_CQN = al256(WS_XN + (size_t)MT * 1024 * 2);
constexpr size_t WS_CKV = al256(WS_CQN + (size_t)MT * 256 * 2);
constexpr size_t WS_KR = al256(WS_CKV + (size_t)MLAT * 256 * 2);
constexpr size_t WS_QB = al256(WS_KR + (size_t)MLAT * 32 * 2);
constexpr size_t WS_KB = al256(WS_QB + (size_t)MT * 512 * 2);
constexpr size_t WS_VB = al256(WS_KB + (size_t)MBND * 512 * 2);
constexpr size_t WS_Q = al256(WS_VB + (size_t)MBND * 512 * 2);
constexpr size_t WS_KN = al256(WS_Q + (size_t)MT * 768 * 2);
constexpr size_t WS_V = al256(WS_KN + (size_t)MLAT * 512 * 2);
constexpr size_t WS_END = al256(WS_V + (size_t)MLAT * 512 * 2);
constexpr size_t WS_BAR = WS_END;
constexpr size_t WS_TOTAL = WS_END + 16384;
constexpr size_t WS_H = WS_XN;
static_assert(WS_H + (size_t)MT * FF * 2 <= WS_VB, "H overlay must end before anything live in P5/P6 (nothing is, but keep it inside dead buffers)");
static_assert(WS_TOTAL <= (size_t)1073741824, "workspace");

constexpr int LDS_GEMM = 131072, LDS_RED = LDS_GEMM, LDS_BYTES = 143360;
constexpr int KP_A = 208, KP_B = 144;
constexpr int AT_TILE = 0, AT_PRIV = 21504  , AT_QT = 51200  , AT_BIAS = 86016  , AT_WSF = 107008, AT_OSTG = 109056, AT_CMB = 141824;
static_assert(AT_CMB + 1024 <= LDS_BYTES, "attention LDS map");

struct Params {
  const float *xp, *xs, *c_ckv, *c_kr, *c_bk, *c_bv, *w_in, *g_attn, *g_q, *w_uq, *g_kv, *w_uk, *w_uv, *rel_bias, *g_out_a, *g_out_b, *w_out, *g_ffn,
      *w_gate, *w_up, *w_down, *g_final;
  float* out; unsigned char* ws;
};

typedef const __attribute__((address_space(4))) Params* ParamsC;
__device__ __forceinline__ unsigned f2bf(float f) { unsigned u = __builtin_bit_cast(unsigned, f); return (u + 0x7fffu + ((u >> 16) & 1u)) >> 16; }
__device__ __forceinline__ unsigned pk2(float lo, float hi) { f32x2_t v = {lo, hi}; bf16x2_t b = __builtin_convertvector(v, bf16x2_t); return __builtin_bit_cast(unsigned, b); }
__device__ __forceinline__ float bf2f(unsigned short b) { return __builtin_bit_cast(float, (unsigned)b << 16); }
__device__ __forceinline__ int maprow_lat(int row) { return row < MP ? row : MP + ((row - MP) >> 4) * LROW + PAST + ((row - MP) & 15); }
__device__ __forceinline__ int maprow_bnd(int row) { return row < MP ? row : MP + ((row - MP) >> 4) * BROW + 512 + ((row - MP) & 15); }
__device__ __forceinline__ int row_pos(int row) { return row < MP ? (row & (SEQ - 1)) : PAST + ((row - MP) & 15); }
__device__ __forceinline__ void rope_cs(int pos, int i, float& c, float& s) {
  const float inv = __builtin_amdgcn_exp2f(-(float)i * (13.287712379549449f / 16.0f));
  float rev = (float)pos * inv * 0.15915494309189535f; rev = rev - __builtin_floorf(rev);
  s = __builtin_amdgcn_sinf(rev); c = __builtin_amdgcn_cosf(rev);
}

namespace pg8 {
constexpr int BM = 256, BK = 64, HALF = 128, HTB = HALF * BK * 2, STAGE_BYTES = 8 * HTB, NXCD = 8, WGM = 8;
__host__ __device__ __forceinline__ int lds_byte(int r, int c) { const int st = (r >> 4) * 2 + (c >> 5), rr = r & 15, cc = c & 31, ob = rr * 64 + cc * 2; return st * 1024 + (ob ^ (((ob >> 9) & 1) << 5)); }
__host__ __device__ __forceinline__ void stage_rc(int b, int& R, int& C) { const int st = b / 1024, sb = b % 1024, swz = sb ^ (((sb >> 9) & 1) << 5); R = (st >> 1) * 16 + swz / 64; C = (st & 1) * 32 + (swz % 64) / 2; }
struct Unit { int pm, pn, koff; };
struct Gemm { const bf16_t* A; const bf16_t* Bt; int lda, ldb, K; };
struct StaticOrder {
  int nM, nN, nwg, G, c;
  __device__ void init(int M, int N, int G_, int c_) { nM = M / BM; nN = N / BM; nwg = nM * nN; G = G_; c = c_; }
  __device__ bool next(int i, Unit& u) const {
    const long L = (long)i * G + c; if (L >= nwg) return false;
    int wgid = (int)L; { const int q = nwg / NXCD, r = nwg % NXCD, xcd = wgid % NXCD, off = wgid / NXCD; wgid = (xcd < r ? xcd * (q + 1) : r * (q + 1) + (xcd - r) * q) + off; }
    const int nig = WGM * nN, gid = wgid / nig, fm = gid * WGM, gsz = (nM - fm) < WGM ? (nM - fm) : WGM;
    u.pm = fm + ((wgid % nig) % gsz); u.pn = (wgid % nig) / gsz; u.koff = 0; return true;
  }
};
struct SplitOrder {
  int pm, nN, nsub, kchunk, G, c;
  __device__ bool next(int i, Unit& u) const { const int s = i * G + c; if (s >= nsub) return false; u.pm = pm; u.pn = s % nN; u.koff = (s / nN) * kchunk; return true; }
};
template <class Epi, class Order>
__device__ __forceinline__ void gemm_phase(LAS unsigned char* lds, const Gemm g, const Order& S, Epi& E) {
  int tid_ = threadIdx.x; asm volatile("" : "+v"(tid_));
  const int tid = tid_, wid = __builtin_amdgcn_readfirstlane(tid >> 6), lane = tid & 63, wr = wid >> 2, wc = wid & 3, fr = lane & 15, fq = lane >> 4;
  int K_ = g.K; asm volatile("" : "+s"(K_));
  const int K = K_, nt = K / BK;
  int lda_ = g.lda, ldb_ = g.ldb; asm volatile("" : "+s"(lda_), "+s"(ldb_));
  unsigned voffA[2];
#pragma unroll
  for (int i = 0; i < 2; ++i) { int R, C; stage_rc(tid * 16 + i * 8192, R, C); voffA[i] = (unsigned)(R * lda_ + C) * 2u; }
  const size_t kstep = (size_t)(BK * 2), hstepA = (size_t)HALF * lda_ * 2, tstepA = 2 * hstepA, hstepB = (size_t)HALF * ldb_ * 2, tstepB = 2 * hstepB;
  const unsigned ldsw = (unsigned)wid * 1024u;
  const int aoff = lds_byte(wr * 64 + fr, fq * 8), boff = lds_byte(wc * 32 + fr, fq * 8);
#define PG8_SA(b, h) (((b) * 2 + (h)) * HTB)
#define PG8_SB(b, h) ((4 + (b) * 2 + (h)) * HTB)
#define PG8_STAGE_(bufoff, gbase, voff) do { _Pragma("unroll") for (int _i = 0; _i < 2; ++_i) \
    __builtin_amdgcn_global_load_lds((const unsigned*)((const char*)(gbase) + (voff)[_i]), (LAS unsigned*)(lds + (bufoff) + ldsw + _i * 8192), 16, 0, 0); } while (0)
#define PG8_STA(bufoff, gbase) PG8_STAGE_(bufoff, gbase, voffA)
#define PG8_STB(bufoff, gbase) PG8_STAGE_(bufoff, gbase, voffA)
#define PG8_LDA(dst, b, h) do { _Pragma("unroll") for (int m = 0; m < 4; ++m) _Pragma("unroll") for (int k = 0; k < 2; ++k) dst[m][k] = *(const LAS bf16x8*)(lds + PG8_SA(b, h) + aoff + m * 2048 + k * 1024); } while (0)
#define PG8_LDB(dst, b, h) do { _Pragma("unroll") for (int n = 0; n < 2; ++n) _Pragma("unroll") for (int k = 0; k < 2; ++k) dst[n][k] = *(const LAS bf16x8*)(lds + PG8_SB(b, h) + boff + n * 2048 + k * 1024); } while (0)
#define PG8_MMA(ai, bj, At, Bt) do { __builtin_amdgcn_s_setprio(1); _Pragma("unroll") for (int m = 0; m < 4; ++m) _Pragma("unroll") for (int n = 0; n < 2; ++n) _Pragma("unroll") for (int k = 0; k < 2; ++k) \
    acc[ai][bj][m][n] = __builtin_amdgcn_mfma_f32_16x16x32_bf16(Bt[n][k], At[m][k], acc[ai][bj][m][n], 0, 0, 0); __builtin_amdgcn_s_setprio(0); } while (0)
#define PG8_WAIT_V(n) asm volatile("s_waitcnt vmcnt(" #n ")" ::: "memory")
#define PG8_WAIT_L(n) asm volatile("s_waitcnt lgkmcnt(" #n ")" ::: "memory")
#define PG8_BAR __builtin_amdgcn_s_barrier()
#define PG8_SCHED __builtin_amdgcn_sched_barrier(0)
  Unit cur, nxt; int ui = 0;
  if (!S.next(0, cur)) return;
  f32x4 acc[2][2][4][2];
#pragma unroll
  for (int a = 0; a < 2; ++a)
#pragma unroll
    for (int b = 0; b < 2; ++b)
#pragma unroll
      for (int m = 0; m < 4; ++m)
#pragma unroll
        for (int n = 0; n < 2; ++n) acc[a][b][m][n] = (f32x4){0.f, 0.f, 0.f, 0.f};
  bf16x8 At[4][2], B0[2][2], B1[2][2];
  const char* cA = (const char*)g.A + (size_t)cur.pm * tstepA + (size_t)cur.koff * 2; const char* cB = (const char*)g.Bt + (size_t)cur.pn * tstepB + (size_t)cur.koff * 2;
  PG8_STB(PG8_SB(0, 0), cB); PG8_STB(PG8_SB(0, 1), cB + hstepB); PG8_STA(PG8_SA(0, 0), cA); PG8_STA(PG8_SA(0, 1), cA + hstepA);
  if (wr == 1) PG8_BAR;
  PG8_WAIT_V(2); PG8_BAR;
  PG8_STB(PG8_SB(1, 0), cB + kstep); PG8_STA(PG8_SA(1, 0), cA + kstep); PG8_STB(PG8_SB(1, 1), cB + hstepB + kstep);
  PG8_WAIT_V(6); PG8_BAR;
  for (;;) {
    const bool has_next = S.next(ui + 1, nxt);
    const char* nA = has_next ? (const char*)g.A + (size_t)nxt.pm * tstepA + (size_t)nxt.koff * 2 : cA; const char* nB = has_next ? (const char*)g.Bt + (size_t)nxt.pn * tstepB + (size_t)nxt.koff * 2 : cB;
    for (int t = 0; t < nt; t += 2) {
      const bool last = (t == nt - 2);
      const char* a1 = cA + (size_t)(t + 1) * kstep;
      const char* a2 = last ? nA : cA + (size_t)(t + 2) * kstep; const char* b2 = last ? nB : cB + (size_t)(t + 2) * kstep;
      const char* a3 = a2 + kstep; const char* b3 = b2 + kstep;
      if constexpr (Epi::HAS_PRE) { if (t == 0) E.pre_load(cur, tid); if (t == 2) E.pre_store(ui, tid); }
      if constexpr (Epi::HAS_MID) { if (t == E.tsplit) { asm volatile("" : "+s"(cur.pm)); E.mid(acc, cur, wr, wc, fr, fq); } }
      PG8_LDB(B0, 0, 0); PG8_LDB(B1, 0, 1); PG8_SCHED; PG8_LDA(At, 0, 0); PG8_STA(PG8_SA(1, 1), a1 + hstepA);
      PG8_WAIT_V(8); PG8_WAIT_L(0); PG8_BAR; PG8_MMA(0, 0, At, B0); PG8_MMA(0, 1, At, B1); PG8_BAR; PG8_SCHED;
      PG8_LDA(At, 0, 1); PG8_STB(PG8_SB(0, 0), b2); PG8_STB(PG8_SB(0, 1), b2 + hstepB); PG8_STA(PG8_SA(0, 0), a2);
      PG8_WAIT_V(8); PG8_WAIT_L(0); PG8_BAR; PG8_MMA(1, 0, At, B0); PG8_MMA(1, 1, At, B1); PG8_BAR; PG8_SCHED;
      PG8_LDB(B0, 1, 0); PG8_LDB(B1, 1, 1); PG8_SCHED; PG8_LDA(At, 1, 0); PG8_STA(PG8_SA(0, 1), a2 + hstepA);
      PG8_WAIT_V(8); PG8_WAIT_L(0); PG8_BAR; PG8_MMA(0, 0, At, B0); PG8_MMA(0, 1, At, B1); PG8_BAR; PG8_SCHED;
      PG8_LDA(At, 1, 1); PG8_STB(PG8_SB(1, 0), b3); PG8_STB(PG8_SB(1, 1), b3 + hstepB); PG8_STA(PG8_SA(1, 0), a3);
      PG8_WAIT_V(8); PG8_WAIT_L(0); PG8_BAR; PG8_MMA(1, 0, At, B0); PG8_MMA(1, 1, At, B1); PG8_BAR; PG8_SCHED;
    }
    if (wr == 0) PG8_BAR;
    asm volatile("" : "+s"(cur.pm), "+s"(cur.pn));
    E(acc, cur, wr, wc, fr, fq);
    if (!has_next) break;
#pragma unroll
    for (int a = 0; a < 2; ++a)
#pragma unroll
      for (int b = 0; b < 2; ++b)
#pragma unroll
        for (int m = 0; m < 4; ++m)
#pragma unroll
          for (int n = 0; n < 2; ++n) acc[a][b][m][n] = (f32x4){0.f, 0.f, 0.f, 0.f};
    cur = nxt; cA = nA; cB = nB; ++ui;
    if (wr == 1) PG8_BAR;
  }
  PG8_WAIT_V(0);
  PG8_BAR;
#undef PG8_SA
#undef PG8_SB
#undef PG8_STAGE_
#undef PG8_STA
#undef PG8_STB
#undef PG8_LDA
#undef PG8_LDB
#undef PG8_MMA
#undef PG8_WAIT_V
#undef PG8_WAIT_L
#undef PG8_BAR
#undef PG8_SCHED
}
}
using pg8::Unit;
typedef f32x4 Acc[2][2][4][2];
#define FOR_AM _Pragma("unroll") for (int ai = 0; ai < 2; ++ai) _Pragma("unroll") for (int m = 0; m < 4; ++m)
#define FOR_BN _Pragma("unroll") for (int bj = 0; bj < 2; ++bj) _Pragma("unroll") for (int n = 0; n < 2; ++n)
__device__ __forceinline__ void st_bf4(bf16_t* p, f32x4 v) { u32x2 w; w.x = pk2(v[0], v[1]); w.y = pk2(v[2], v[3]); *(u32x2*)p = w; }
__device__ __forceinline__ void st_bf8(bf16_t* p, f32x4 a, f32x4 b) { u32x4 w; w.x = pk2(a[0], a[1]); w.y = pk2(a[2], a[3]); w.z = pk2(b[0], b[1]); w.w = pk2(b[2], b[3]); *(u32x4*)p = w; }
__device__ __forceinline__ void st_bf4x2(bf16_t* pa, f32x4 a, bf16_t* pb, f32x4 b, int fq) {
  const unsigned A0 = pk2(a[0], a[1]), A1 = pk2(a[2], a[3]), B0 = pk2(b[0], b[1]), B1 = pk2(b[2], b[3]);
  const auto r0 = __builtin_amdgcn_permlane16_swap(A0, B0, false, false);
  const auto r1 = __builtin_amdgcn_permlane16_swap(A1, B1, false, false);
  u32x4 w; w.x = r0[0]; w.y = r1[0]; w.z = r0[1]; w.w = r1[1];
  *(u32x4*)((fq & 1) ? pb - 4 : pa) = w;
}
__device__ __forceinline__ void atomic_addf(float* p, float v) { __hip_atomic_fetch_add(p, v, __ATOMIC_RELAXED, __HIP_MEMORY_SCOPE_AGENT); }

struct EpiIn {
  static constexpr bool HAS_MID = false, HAS_PRE = false;
  float* out; bf16_t *CQN, *CKV, *KR, *QB, *KB, *VB; const float* g_kv; LAS float* red;
  __device__ __forceinline__ void operator()(const Acc& acc, const Unit& u, int wr, int wc, int fr, int fq) const {
    const int pn = u.pn, rbase = u.pm * 256 + wr * 64 + fr, cw = wc * 32 + 4 * fq;
    if (pn <= 1) {
      FOR_AM { float s = 0.f; FOR_BN { const f32x4 x = acc[ai][bj][m][n]; s += (x[0] * x[0] + x[1] * x[1]) + (x[2] * x[2] + x[3] * x[3]); }
        s += __shfl_xor(s, 16); s += __shfl_xor(s, 32);
        if (fq == 0) red[(ai * 128 + wr * 64 + m * 16 + fr) * 4 + wc] = s; }
      asm volatile("s_waitcnt lgkmcnt(0)" ::: "memory"); __builtin_amdgcn_s_barrier(); asm volatile("" ::: "memory");
      FOR_AM { const f32x4 t = *(const LAS f32x4*)(red + (ai * 128 + wr * 64 + m * 16 + fr) * 4);
        const float rstd = __builtin_amdgcn_rsqf(((t[0] + t[1]) + (t[2] + t[3])) * (1.0f / 256.0f) + EPS);
        const int row = rbase + ai * 128 + m * 16;
        if (pn == 0) {
#pragma unroll
          for (int bj = 0; bj < 2; ++bj) { bf16_t* q = CQN + (size_t)row * 256 + bj * 128 + cw; st_bf4x2(q, acc[ai][bj][m][0] * rstd, q + 16, acc[ai][bj][m][1] * rstd, fq); } }
        else { const int mr = maprow_lat(row); float* o = row < MP ? out + OFF_CKVP + (size_t)row * 256 : out + OFF_CKVS + (size_t)(row - MP) * 256;
#pragma unroll
          for (int bj = 0; bj < 2; ++bj) { const int col = bj * 128 + cw; const f32x4 v0 = acc[ai][bj][m][0] * rstd * *(const f32x4*)(g_kv + col), v1 = acc[ai][bj][m][1] * rstd * *(const f32x4*)(g_kv + col + 16);
            *(f32x4*)(o + col) = v0; *(f32x4*)(o + col + 16) = v1; st_bf4x2(CKV + (size_t)mr * 256 + col, v0, CKV + (size_t)mr * 256 + col + 16, v1, fq); } } }
      asm volatile("s_waitcnt lgkmcnt(0)" ::: "memory"); __builtin_amdgcn_s_barrier(); asm volatile("" ::: "memory");
    } else if (pn <= 3) {
      FOR_AM { const int row = rbase + ai * 128 + m * 16;
#pragma unroll
        for (int bj = 0; bj < 2; ++bj) { bf16_t* q = QB + (size_t)row * 512 + (pn - 2) * 256 + bj * 128 + cw; st_bf4x2(q, acc[ai][bj][m][0] * QSCALE_B, q + 16, acc[ai][bj][m][1] * QSCALE_B, fq); } }
    } else if (pn <= 7) {
      const bool isv = pn >= 6; bf16_t* dst = isv ? VB : KB; const int c0 = (pn & 1) * 256;
      FOR_AM { const int row = rbase + ai * 128 + m * 16; const int mr = maprow_bnd(row);
        float* o = nullptr;
        if (row >= MP) o = out + (isv ? OFF_BVS : OFF_BKS) + (size_t)(row - MP) * 512;
        else if ((row & (SEQ - 1)) >= SEQ - 512) o = out + (isv ? OFF_BVP : OFF_BKP) + ((size_t)(row >> 11) * 512 + ((row & (SEQ - 1)) - (SEQ - 512))) * 512;
#pragma unroll
        for (int bj = 0; bj < 2; ++bj) { const int col = c0 + bj * 128 + cw; st_bf4x2(dst + (size_t)mr * 512 + col, acc[ai][bj][m][0], dst + (size_t)mr * 512 + col + 16, acc[ai][bj][m][1], fq);
          if (o) { *(f32x4*)(o + col) = acc[ai][bj][m][0]; *(f32x4*)(o + col + 16) = acc[ai][bj][m][1]; } } }
    } else {
      if (wc == 0) {
        FOR_AM { const int row = rbase + ai * 128 + m * 16; const int pos = row_pos(row), mr = maprow_lat(row);
          float* o = row < MP ? out + OFF_KRP + (size_t)row * 32 : out + OFF_KRS + (size_t)(row - MP) * 32;
          const f32x4 x1 = acc[ai][0][m][0], x2 = acc[ai][0][m][1]; f32x4 y1, y2;
#pragma unroll
          for (int j = 0; j < 4; ++j) { float c, s; rope_cs(pos, 4 * fq + j, c, s); y1[j] = x1[j] * c - x2[j] * s; y2[j] = x1[j] * s + x2[j] * c; }
          *(f32x4*)(o + 4 * fq) = y1; *(f32x4*)(o + 16 + 4 * fq) = y2;
          st_bf4x2(KR + (size_t)mr * 32 + 4 * fq, y1, KR + (size_t)mr * 32 + 16 + 4 * fq, y2, fq); }
      }
    }
  }
};
struct EpiQ {
  static constexpr bool HAS_MID = false, HAS_PRE = false;
  bf16_t* Q;
  __device__ __forceinline__ void operator()(const Acc& acc, const Unit& u, int wr, int wc, int fr, int fq) const {
    const int pn = u.pn, rbase = u.pm * 256 + wr * 64 + fr;
    if (pn <= 1) {
      FOR_AM { const int row = rbase + ai * 128 + m * 16;
#pragma unroll
        for (int bj = 0; bj < 2; ++bj) { const int col = pn * 256 + bj * 128 + wc * 32 + 4 * fq; bf16_t* q = Q + (size_t)row * 768 + (col >> 6) * 96 + (col & 63);
          st_bf4x2(q, acc[ai][bj][m][0] * QSCALE_A, q + 16, acc[ai][bj][m][1] * QSCALE_A, fq); } }
    } else {
      FOR_AM { const int row = rbase + ai * 128 + m * 16; const int pos = row_pos(row);
        float cs[4], sn[4];
#pragma unroll
        for (int j = 0; j < 4; ++j) rope_cs(pos, 4 * fq + j, cs[j], sn[j]);
#pragma unroll
        for (int bj = 0; bj < 2; ++bj) { const int head = 4 * bj + wc; const f32x4 x1 = acc[ai][bj][m][0], x2 = acc[ai][bj][m][1]; f32x4 y1, y2;
#pragma unroll
          for (int j = 0; j < 4; ++j) { y1[j] = (x1[j] * cs[j] - x2[j] * sn[j]) * QSCALE_A; y2[j] = (x1[j] * sn[j] + x2[j] * cs[j]) * QSCALE_A; }
          bf16_t* q = Q + (size_t)row * 768 + head * 96 + 64 + 4 * fq; st_bf4x2(q, y1, q + 16, y2, fq); } __builtin_amdgcn_sched_barrier(0); }
    }
  }
};
struct EpiKV {
  static constexpr bool HAS_MID = false, HAS_PRE = false;
  bf16_t *KN, *V;
  __device__ __forceinline__ void operator()(const Acc& acc, const Unit& u, int wr, int wc, int fr, int fq) const {
    const int pn = u.pn, rbase = u.pm * 256 + wr * 64 + fr; bf16_t* dst = pn >= 2 ? V : KN; const int c0 = (pn & 1) * 256 + wc * 32 + 4 * fq;
    FOR_AM { const int row = rbase + ai * 128 + m * 16;
#pragma unroll
      for (int bj = 0; bj < 2; ++bj) { bf16_t* q = dst + (size_t)row * 512 + c0 + bj * 128; st_bf4x2(q, acc[ai][bj][m][0], q + 16, acc[ai][bj][m][1], fq); } }
  }
};
struct EpiO {
  static constexpr bool HAS_MID = true, HAS_PRE = true;
  int tsplit; const float *ssq_a, *ssq_b, *xp, *xs; bf16_t* X1B; float* ssq_x1; LAS float* pre; float p0, p1; int par;
  __device__ __forceinline__ void pre_load(const Unit& u, int tid) { if (tid < 256) { p0 = ssq_a[u.pm * 256 + tid]; p1 = ssq_b[u.pm * 256 + tid]; } }
  __device__ __forceinline__ void pre_store(int ui, int tid) { par = ui & 1; if (tid < 256) { pre[par * 512 + tid] = p0; pre[par * 512 + 256 + tid] = p1; } }
  __device__ __forceinline__ void mid(Acc& acc, const Unit& u, int wr, int wc, int fr, int fq) const {
    FOR_AM { const int rl = par * 512 + ai * 128 + wr * 64 + m * 16 + fr;
      const float ratio = __builtin_amdgcn_rsqf(pre[rl] * (1.0f / 512.0f) + EPS) * __builtin_sqrtf(pre[rl + 256] * (1.0f / 512.0f) + EPS);
      FOR_BN { acc[ai][bj][m][n] = acc[ai][bj][m][n] * ratio; }
      __builtin_amdgcn_sched_barrier(0); }
  }
  __device__ __forceinline__ void operator()(const Acc& acc, const Unit& u, int wr, int wc, int fr, int fq) const {
    const int rbase = u.pm * 256 + wr * 64 + fr, c0 = u.pn * 256 + wc * 32 + 4 * fq;
    f32x4 xb[2][4];
    { const int row = rbase; const float* xr = row < MP ? xp + (size_t)row * D : xs + (size_t)(row - MP) * D;
#pragma unroll
      for (int bj = 0; bj < 2; ++bj) { xb[0][2 * bj] = *(const f32x4*)(xr + c0 + bj * 128); xb[0][2 * bj + 1] = *(const f32x4*)(xr + c0 + bj * 128 + 16); } }
#pragma unroll
    for (int idx = 0; idx < 8; ++idx) { const int ai = idx >> 2, m = idx & 3; const int row = rbase + ai * 128 + m * 16;
      if (idx < 7) { const int rown = rbase + ((idx + 1) >> 2) * 128 + ((idx + 1) & 3) * 16; const float* xr = rown < MP ? xp + (size_t)rown * D : xs + (size_t)(rown - MP) * D;
#pragma unroll
        for (int bj = 0; bj < 2; ++bj) { xb[(idx + 1) & 1][2 * bj] = *(const f32x4*)(xr + c0 + bj * 128); xb[(idx + 1) & 1][2 * bj + 1] = *(const f32x4*)(xr + c0 + bj * 128 + 16); } }
      const float rb = u.koff < 0 ? 1.0f : __builtin_amdgcn_rsqf(pre[par * 512 + 256 + ai * 128 + wr * 64 + m * 16 + fr] * (1.0f / 512.0f) + EPS);
      float s = 0.f;
#pragma unroll
      for (int bj = 0; bj < 2; ++bj) { const int col = c0 + bj * 128; const f32x4 v0 = xb[idx & 1][2 * bj] + acc[ai][bj][m][0] * rb, v1 = xb[idx & 1][2 * bj + 1] + acc[ai][bj][m][1] * rb;
        st_bf4x2(X1B + (size_t)row * D + col, v0, X1B + (size_t)row * D + col + 16, v1, fq);
        s += ((v0[0] * v0[0] + v0[1] * v0[1]) + (v0[2] * v0[2] + v0[3] * v0[3])) + ((v1[0] * v1[0] + v1[1] * v1[1]) + (v1[2] * v1[2] + v1[3] * v1[3])); }
      s += __shfl_xor(s, 16); s += __shfl_xor(s, 32); if (fq == 0) atomic_addf(ssq_x1 + row, s); __builtin_amdgcn_sched_barrier(0); }
  }
};
struct EpiGU {
  static constexpr bool HAS_MID = false, HAS_PRE = true;
  const float* ssq_x1; bf16_t* H; LAS float* pre; float p0; int par;
  __device__ __forceinline__ void pre_load(const Unit& u, int tid) { if (tid < 256) p0 = ssq_x1[u.pm * 256 + tid]; }
  __device__ __forceinline__ void pre_store(int ui, int tid) { par = ui & 1; if (tid < 256) pre[par * 512 + tid] = p0; }
  __device__ __forceinline__ void operator()(const Acc& acc, const Unit& u, int wr, int wc, int fr, int fq) const {
    const int rbase = u.pm * 256 + wr * 64 + fr, c0 = u.pn * 128 + wc * 16 + 4 * fq;
    FOR_AM { const int row = rbase + ai * 128 + m * 16; const float rstd = __builtin_amdgcn_rsqf(pre[par * 512 + ai * 128 + wr * 64 + m * 16 + fr] * (1.0f / 1024.0f) + EPS);
      f32x4 hv[2];
#pragma unroll
      for (int bj = 0; bj < 2; ++bj) { const f32x4 g = acc[ai][bj][m][0] * rstd, up = acc[ai][bj][m][1] * rstd;
#pragma unroll
        for (int j = 0; j < 4; ++j) hv[bj][j] = g[j] * __builtin_amdgcn_rcpf(1.0f + __builtin_amdgcn_exp2f(-g[j] * LOG2E)) * up[j]; }
      st_bf4x2(H + (size_t)row * FF + c0, hv[0], H + (size_t)row * FF + c0 + 64, hv[1], fq); }
  }
};
__device__ __forceinline__ f32x4 ld_bf4(const bf16_t* p) { const u32x2 w = *(const u32x2*)p; return (f32x4){__builtin_bit_cast(float, w.x << 16), __builtin_bit_cast(float, w.x & 0xffff0000u), __builtin_bit_cast(float, w.y << 16), __builtin_bit_cast(float, w.y & 0xffff0000u)}; }
__device__ __forceinline__ void ld_bf4x2(const bf16_t* pa, const bf16_t* pb, int fq, f32x4& a, f32x4& b) {
  const u32x4 w = *(const u32x4*)((fq & 1) ? pb - 4 : pa);
  const auto r0 = __builtin_amdgcn_permlane16_swap(w.x, w.z, false, false);
  const auto r1 = __builtin_amdgcn_permlane16_swap(w.y, w.w, false, false);
  a = (f32x4){__builtin_bit_cast(float, r0[0] << 16), __builtin_bit_cast(float, r0[0] & 0xffff0000u), __builtin_bit_cast(float, r1[0] << 16), __builtin_bit_cast(float, r1[0] & 0xffff0000u)};
  b = (f32x4){__builtin_bit_cast(float, r0[1] << 16), __builtin_bit_cast(float, r0[1] & 0xffff0000u), __builtin_bit_cast(float, r1[1] << 16), __builtin_bit_cast(float, r1[1] & 0xffff0000u)};
}
struct EpiD {
  static constexpr bool HAS_MID = false, HAS_PRE = false;
  bf16_t* X; float* ssq_x2;
  __device__ __forceinline__ void operator()(const Acc& acc, const Unit& u, int wr, int wc, int fr, int fq) const {
    const int rbase = u.pm * 256 + wr * 64 + fr, c0 = u.pn * 256 + wc * 32 + 4 * fq + ((fq & 1) ? 12 : 0);
    u32x4 wb[2][2];
#pragma unroll
    for (int bj = 0; bj < 2; ++bj) wb[0][bj] = *(const u32x4*)(X + (size_t)rbase * D + c0 + bj * 128);
#pragma unroll
    for (int idx = 0; idx < 8; ++idx) { const int ai = idx >> 2, m = idx & 3; const int row = rbase + ai * 128 + m * 16;
      if (idx < 7) { const int rown = rbase + ((idx + 1) >> 2) * 128 + ((idx + 1) & 3) * 16;
#pragma unroll
        for (int bj = 0; bj < 2; ++bj) wb[(idx + 1) & 1][bj] = *(const u32x4*)(X + (size_t)rown * D + c0 + bj * 128); }
      float s = 0.f;
#pragma unroll
      for (int bj = 0; bj < 2; ++bj) { const u32x4 w = wb[idx & 1][bj];
        const auto r0 = __builtin_amdgcn_permlane16_swap(w.x, w.z, false, false); const auto r1 = __builtin_amdgcn_permlane16_swap(w.y, w.w, false, false);
        const f32x4 x0 = {__builtin_bit_cast(float, r0[0] << 16), __builtin_bit_cast(float, r0[0] & 0xffff0000u), __builtin_bit_cast(float, r1[0] << 16), __builtin_bit_cast(float, r1[0] & 0xffff0000u)};
        const f32x4 x1 = {__builtin_bit_cast(float, r0[1] << 16), __builtin_bit_cast(float, r0[1] & 0xffff0000u), __builtin_bit_cast(float, r1[1] << 16), __builtin_bit_cast(float, r1[1] & 0xffff0000u)};
        const f32x4 v0 = x0 + acc[ai][bj][m][0], v1 = x1 + acc[ai][bj][m][1];
        bf16_t* x = X + (size_t)row * D + u.pn * 256 + wc * 32 + 4 * fq + bj * 128;
        st_bf4x2(x, v0, x + 16, v1, fq);
        s += ((v0[0] * v0[0] + v0[1] * v0[1]) + (v0[2] * v0[2] + v0[3] * v0[3])) + ((v1[0] * v1[0] + v1[1] * v1[1]) + (v1[2] * v1[2] + v1[3] * v1[3])); }
      s += __shfl_xor(s, 16); s += __shfl_xor(s, 32); if (fq == 0) atomic_addf(ssq_x2 + row, s); __builtin_amdgcn_sched_barrier(0); }
  }
};
struct EpiPart {
  static constexpr bool HAS_MID = false, HAS_PRE = false;
  float* PART;
  __device__ __forceinline__ void operator()(const Acc& acc, const Unit& u, int wr, int wc, int fr, int fq) const {
    float* base = PART + (size_t)(u.koff >> 8) * 256 * D; const int r0 = wr * 64 + fr, c0 = u.pn * 256 + wc * 32 + 4 * fq;
    FOR_AM { FOR_BN { *(f32x4*)(base + (size_t)(r0 + ai * 128 + m * 16) * D + c0 + bj * 128 + n * 16) = acc[ai][bj][m][n]; } }
  }
};

__device__ __forceinline__ float wave_sum(float v) {
#pragma unroll
  for (int o = 1; o < 64; o <<= 1) v += __shfl_xor(v, o);
  return v;
}
template <class Map>
__device__ __forceinline__ void transpose_item(const float* W, int K, int N, bf16_t* WT, const float* g, LAS float* scr, int item, int lane, Map map) {
  const int nblk = N / 32, kb = item / nblk, nb = item % nblk, k0 = 64 * kb, n0 = 32 * nb;
  f32x4 wv[8];
#pragma unroll
  for (int i = 0; i < 8; ++i) { const int kk = 8 * i + (lane >> 3); wv[i] = *(const f32x4*)(W + (size_t)(k0 + kk) * N + n0 + 4 * (lane & 7)) * (g ? g[k0 + kk] : 1.0f); }
#pragma unroll
  for (int i = 0; i < 8; ++i) { const int kk = 8 * i + (lane >> 3); LAS float* d = scr + kk * 33 + 4 * (lane & 7); d[0] = wv[i][0]; d[1] = wv[i][1]; d[2] = wv[i][2]; d[3] = wv[i][3]; }
  asm volatile("s_waitcnt lgkmcnt(0)" ::: "memory");
  const int c = lane & 7;
#pragma unroll
  for (int j = 0; j < 4; ++j) { const int n = (lane >> 3) + 8 * j; const LAS float* s = scr + (8 * c) * 33 + n;
    u32x4 o; o.x = pk2(s[0 * 33], s[1 * 33]); o.y = pk2(s[2 * 33], s[3 * 33]); o.z = pk2(s[4 * 33], s[5 * 33]); o.w = pk2(s[6 * 33], s[7 * 33]);
    *(u32x4*)(WT + (size_t)map(n0 + n) * K + k0 + 8 * c) = o; }
  asm volatile("s_waitcnt lgkmcnt(0)" ::: "memory");
}
template <class Map>
__device__ __forceinline__ void convert_rows(const float* src, bf16_t* dst, int R, int cshift, int gt, int ngt, Map map) {
  const long n8 = ((long)R << cshift) >> 3;
  for (long i0 = gt; i0 < n8; i0 += 4L * ngt) {
    f32x4 v[4][2];
#pragma unroll
    for (int k = 0; k < 4; ++k) { const long i = i0 + (long)k * ngt; if (i < n8) { v[k][0] = *(const f32x4*)(src + i * 8); v[k][1] = *(const f32x4*)(src + i * 8 + 4); } }
#pragma unroll
    for (int k = 0; k < 4; ++k) { const long i = i0 + (long)k * ngt; if (i < n8) { const long e = i * 8; const int r = (int)(e >> cshift), c = (int)(e & ((1 << cshift) - 1));
      st_bf8(dst + ((size_t)map(r) << cshift) + c, v[k][0], v[k][1]); } }
  }
}
__device__ __forceinline__ void zero_rows(bf16_t* dst, int cshift, int r0, int nr, int nb, int bstride, int gt, int ngt) {
  const long per = ((long)nr << cshift) >> 3, n8 = per * nb;
  for (long i = gt; i < n8; i += ngt) { const int b = (int)(i / per); const long e = (i % per) * 8; *(u32x4*)(dst + (((size_t)b * bstride + r0) << cshift) + e) = (u32x4){0u, 0u, 0u, 0u}; }
}
__device__ __forceinline__ void prologue(ParamsC p, LAS unsigned char* lds, int G) {
  const int tid = threadIdx.x, lane = tid & 63, wave = tid >> 6; unsigned char* ws = p->ws;
  const int gw = blockIdx.x * 8 + wave, NGW = G * 8, gt = blockIdx.x * NTHREADS + tid, ngt = G * NTHREADS;
  LAS float* scr = (LAS float*)(lds + wave * 16384);
  bf16_t* WinT = (bf16_t*)(ws + WS_WIN); bf16_t* WuqT = (bf16_t*)(ws + WS_WUQ); bf16_t* WkvT = (bf16_t*)(ws + WS_WKV); bf16_t* WoT = (bf16_t*)(ws + WS_WO);
  bf16_t* WguT = (bf16_t*)(ws + WS_WGU); bf16_t* WdT = (bf16_t*)(ws + WS_WD);
  constexpr int I_IN = 16 * 65, I_UQ = 4 * 24, I_UK = 4 * 16, I_O = 16 * 32, I_G = 16 * 88, I_D = 44 * 32;
  constexpr int NITEMS = I_IN + I_UQ + 2 * I_UK + I_O + 2 * I_G + I_D;
  for (int it = gw; it < NITEMS; it += NGW) {
    int r = it;
    if (r < I_IN) { transpose_item(p->w_in, 1024, 2080, WinT, p->g_attn, scr, r, lane, [](int n) { return n < 512 ? n : (n < 544 ? 2048 + (n - 512) : 512 + (n - 544)); }); continue; } r -= I_IN;
    if (r < I_UQ) { transpose_item(p->w_uq, 256, 768, WuqT, p->g_q, scr, r, lane, [](int n) { const int h = n / 96, d = n % 96; return d < 64 ? h * 64 + d : 512 + h * 32 + (d - 64); }); continue; } r -= I_UQ;
    if (r < I_UK) { transpose_item(p->w_uk, 256, 512, WkvT, nullptr, scr, r, lane, [](int n) { return n; }); continue; } r -= I_UK;
    if (r < I_UK) { transpose_item(p->w_uv, 256, 512, WkvT, nullptr, scr, r, lane, [](int n) { return 512 + n; }); continue; } r -= I_UK;
    if (r < I_O) { const int kb = r / 32; transpose_item(p->w_out, 1024, 1024, WoT, kb < 8 ? p->g_out_a : p->g_out_b - 512, scr, r, lane, [](int n) { return n; }); continue; } r -= I_O;
    if (r < I_G) { transpose_item(p->w_gate, 1024, FF, WguT, p->g_ffn, scr, r, lane, [](int n) { return 32 * (n >> 4) + (n & 15); }); continue; } r -= I_G;
    if (r < I_G) { transpose_item(p->w_up, 1024, FF, WguT, p->g_ffn, scr, r, lane, [](int n) { return 32 * (n >> 4) + 16 + (n & 15); }); continue; } r -= I_G;
    transpose_item(p->w_down, FF, 1024, WdT, nullptr, scr, r, lane, [](int n) { return n; });
  }
  zero_rows(WinT, 10, 2080, NIN - 2080, 1, 0, gt, ngt);
  bf16_t* XN = (bf16_t*)(ws + WS_XN);
  for (int row0 = gw; row0 < MT; row0 += 4 * NGW) {
    f32x4 v[4][4]; float s[4] = {0.f, 0.f, 0.f, 0.f};
#pragma unroll
    for (int k = 0; k < 4; ++k) { const int row = row0 + k * NGW; if (row < MT) { const float* xr = row < MP ? p->xp + (size_t)row * D : p->xs + (size_t)(row - MP) * D;
#pragma unroll
      for (int j = 0; j < 2; ++j) { v[k][2 * j] = *(const f32x4*)(xr + 8 * lane + 512 * j); v[k][2 * j + 1] = *(const f32x4*)(xr + 8 * lane + 512 * j + 4); } } }
#pragma unroll
    for (int k = 0; k < 4; ++k) { const int row = row0 + k * NGW; if (row < MT) {
#pragma unroll
      for (int j = 0; j < 4; ++j) s[k] += (v[k][j][0] * v[k][j][0] + v[k][j][1] * v[k][j][1]) + (v[k][j][2] * v[k][j][2] + v[k][j][3] * v[k][j][3]);
      const float rstd = __builtin_amdgcn_rsqf(wave_sum(s[k]) * (1.0f / D) + EPS);
#pragma unroll
      for (int j = 0; j < 2; ++j) st_bf8(XN + (size_t)row * D + 8 * lane + 512 * j, v[k][2 * j] * rstd, v[k][2 * j + 1] * rstd); } }
  }
  bf16_t* CKV = (bf16_t*)(ws + WS_CKV); bf16_t* KR = (bf16_t*)(ws + WS_KR); bf16_t* KB = (bf16_t*)(ws + WS_KB); bf16_t* VB = (bf16_t*)(ws + WS_VB);
  convert_rows(p->c_ckv, CKV, DB * PAST, 8, gt, ngt, [](int r) { return MP + (r >> 12) * LROW + (r & 4095); });
  convert_rows(p->c_kr, KR, DB * PAST, 5, gt, ngt, [](int r) { return MP + (r >> 12) * LROW + (r & 4095); });
  convert_rows(p->c_bk, KB, DB * 512, 9, gt, ngt, [](int r) { return MP + (r >> 9) * BROW + (r & 511); });
  convert_rows(p->c_bv, VB, DB * 512, 9, gt, ngt, [](int r) { return MP + (r >> 9) * BROW + (r & 511); });
  zero_rows(CKV + (size_t)MP * 256, 8, PAST + DSQ, LROW - PAST - DSQ, DB, LROW, gt, ngt);
  zero_rows(KR + (size_t)MP * 32, 5, PAST + DSQ, LROW - PAST - DSQ, DB, LROW, gt, ngt);
  zero_rows(KB + (size_t)MP * 512, 9, 512 + DSQ, BROW - 512 - DSQ, DB, BROW, gt, ngt);
  zero_rows(VB + (size_t)MP * 512, 9, 512 + DSQ, BROW - 512 - DSQ, DB, BROW, gt, ngt);
  float* ssq = (float*)(ws + WS_SSQ);
  for (int i = gt; i < 4 * MT; i += ngt) ssq[i] = 0.f;
}

__device__ __forceinline__ f32x16 mfma32(bf16x8 a, bf16x8 b, f32x16 c) { return __builtin_amdgcn_mfma_f32_32x32x16_bf16(a, b, c, 0, 0, 0); }
__device__ __forceinline__ s16x4 vtr(const LAS unsigned char* p) { return __builtin_bit_cast(s16x4, __builtin_amdgcn_ds_read_tr16_b64_v4i16((LAS s16x4*)p)); }
template <int NS, bool BIAS, bool QL>
__device__ __forceinline__ void attn_qk(const LAS unsigned char* Kt, const bf16x8 (&qf)[NS], const LAS unsigned char* Qt, f32x16 (&st)[2], int nvalid, const LAS float* btab, int rb, bool lookup, int lane) {
  constexpr int KP = NS == 6 ? KP_A : KP_B;
  const int r = lane & 31, h = lane >> 5;
  bf16x8 qv[NS];
#pragma unroll
  for (int s = 0; s < NS; ++s) qv[s] = QL ? *(const LAS bf16x8*)(Qt + r * KP + (2 * s + h) * 16) : qf[s];
#pragma unroll
  for (int kh = 0; kh < 2; ++kh) {
    bf16x8 kf[NS];
#pragma unroll
    for (int s = 0; s < NS; ++s) kf[s] = *(const LAS bf16x8*)(Kt + (32 * kh + r) * KP + (2 * s + h) * 16);
    __builtin_amdgcn_sched_barrier(0);
    __builtin_amdgcn_s_setprio(1);
    { const f32x16 z = {0.f, 0.f, 0.f, 0.f, 0.f, 0.f, 0.f, 0.f, 0.f, 0.f, 0.f, 0.f, 0.f, 0.f, 0.f, 0.f}; st[kh] = mfma32(kf[0], qv[0], z); }
#pragma unroll
    for (int s = 1; s < NS; ++s) st[kh] = mfma32(kf[s], qv[s], st[kh]);
    __builtin_amdgcn_s_setprio(0);
    __builtin_amdgcn_sched_barrier(0);
  }
  if (BIAS) {
    if (lookup) { const LAS float* bp = btab + rb + 4 * h;
#pragma unroll
      for (int kh = 0; kh < 2; ++kh)
#pragma unroll
        for (int i = 0; i < 16; ++i) st[kh][i] += bp[32 * kh + (i & 3) + 8 * (i >> 2)];
    } else { const float bc = btab[0];
#pragma unroll
      for (int kh = 0; kh < 2; ++kh)
#pragma unroll
        for (int i = 0; i < 16; ++i) st[kh][i] += bc; }
  }
  if (nvalid < 64) {
#pragma unroll
    for (int kh = 0; kh < 2; ++kh)
#pragma unroll
      for (int i = 0; i < 16; ++i) { const int key = 32 * kh + (i & 3) + 8 * (i >> 2) + 4 * h; if (key >= nvalid) st[kh][i] = -1e30f; }
  }
}
__device__ __forceinline__ void attn_smpv(const LAS unsigned char* Vt, f32x16 (&st)[2], f32x16 (&o)[2], float& m_run, float& l_run, LAS float* wsf, int lane) {
  const int r = lane & 31, h = lane >> 5;
  float mx = st[0][0];
#pragma unroll
  for (int kh = 0; kh < 2; ++kh)
#pragma unroll
    for (int i = 0; i < 16; ++i) mx = __builtin_fmaxf(mx, st[kh][i]);
  mx = __builtin_fmaxf(mx, __shfl_xor(mx, 32));
  const float m_new = __builtin_fmaxf(m_run, mx), alpha = __builtin_amdgcn_exp2f(m_run - m_new);
  float rs = 0.f;
#pragma unroll
  for (int kh = 0; kh < 2; ++kh)
#pragma unroll
    for (int i = 0; i < 16; ++i) { const float pv = __builtin_amdgcn_exp2f(st[kh][i] - m_new); st[kh][i] = pv; rs += pv; }
  rs += __shfl_xor(rs, 32);
  l_run = l_run * alpha + rs; m_run = m_new;
  {
    if (h == 0) wsf[r] = alpha;
    typedef float f32x8 __attribute__((ext_vector_type(8)));
    const f32x4 a0 = *(const LAS f32x4*)(wsf + 4 * h), a1 = *(const LAS f32x4*)(wsf + 8 + 4 * h), a2 = *(const LAS f32x4*)(wsf + 16 + 4 * h), a3 = *(const LAS f32x4*)(wsf + 24 + 4 * h);
    const f32x8 lo = __builtin_shufflevector(a0, a1, 0, 1, 2, 3, 4, 5, 6, 7), hi = __builtin_shufflevector(a2, a3, 0, 1, 2, 3, 4, 5, 6, 7);
    const f32x16 av = __builtin_shufflevector(lo, hi, 0, 1, 2, 3, 4, 5, 6, 7, 8, 9, 10, 11, 12, 13, 14, 15);
    o[0] = o[0] * av; o[1] = o[1] * av;
  }
  const int blk = (lane >> 4) & 1, q = (lane & 15) >> 2, p = lane & 3;
  const int vb = (4 * h + q) * 128 + 8 * (p & 1), co0 = ((2 * blk + (p >> 1)) ^ (((q >> 1) & 1) << 2)) << 4;
#pragma unroll
  for (int kh = 0; kh < 2; ++kh)
#pragma unroll
    for (int s2 = 0; s2 < 2; ++s2) {
      u32x4 pw;
#pragma unroll
      for (int k = 0; k < 4; ++k) pw[k] = pk2(st[kh][8 * s2 + 2 * k], st[kh][8 * s2 + 2 * k + 1]);
      const bf16x8 pa = __builtin_bit_cast(bf16x8, pw);
#pragma unroll
      for (int c = 0; c < 2; ++c) {
        const LAS unsigned char* vp = Vt + (32 * kh + 16 * s2) * 128 + vb + (c ? (co0 ^ 64) : co0);
        const s16x4 lo = vtr(vp), hi = vtr(vp + 8 * 128);
        const bf16x8 vf = __builtin_shufflevector(lo, hi, 0, 1, 2, 3, 4, 5, 6, 7);
        __builtin_amdgcn_s_setprio(1); o[c] = mfma32(pa, vf, o[c]); __builtin_amdgcn_s_setprio(0);
      }
    }
}
__device__ __forceinline__ void scale_o(f32x16 (&o)[2], float f, LAS float* wsf, int lane) {
  const int r = lane & 31, h = lane >> 5;
  if (h == 0) wsf[r] = f;
#pragma unroll
  for (int g = 0; g < 4; ++g) { const f32x4 a4 = *(const LAS f32x4*)(wsf + 8 * g + 4 * h);
#pragma unroll
    for (int j = 0; j < 4; ++j) { o[0][4 * g + j] *= a4[j]; o[1][4 * g + j] *= a4[j]; } }
}
__device__ __forceinline__ void store_o(const f32x16 (&o)[2], LAS bf16_t* stg, bf16_t* att  , float* ssq  , int nq, int lane) {
  const int r = lane & 31, h = lane >> 5;
#pragma unroll
  for (int c = 0; c < 2; ++c)
#pragma unroll
    for (int i = 0; i < 16; ++i) stg[((i & 3) + 8 * (i >> 2) + 4 * h) * 64 + 32 * c + r] = (bf16_t)f2bf(o[c][i]);
  const int qr = lane >> 1, half = lane & 1; float s = 0.f; u32x4 v[4];
#pragma unroll
  for (int k = 0; k < 4; ++k) { v[k] = *(const LAS u32x4*)(stg + qr * 64 + half * 32 + 8 * k);
#pragma unroll
    for (int e = 0; e < 4; ++e) { const float a = __builtin_bit_cast(float, v[k][e] << 16), b = __builtin_bit_cast(float, v[k][e] & 0xffff0000u); s += a * a + b * b; } }
  s += __shfl_xor(s, 1);
  if (qr < nq) {
#pragma unroll
    for (int k = 0; k < 4; ++k) *(u32x4*)(att + (size_t)qr * D + half * 32 + 8 * k) = v[k];
    if (half == 0 && ssq) atomic_addf(ssq + qr, s);
  }
}
struct KVSrc { const bf16_t* K; const bf16_t* KRp; const bf16_t* V; };
template <int NS>
__device__ __forceinline__ u32x4 ld_kchunk(const KVSrc& s, long krow, int id) {
  if (NS == 6) { const int row = id / 12, ch = id - row * 12;
    return ch < 8 ? *(const u32x4*)(s.K + (krow + row) * 512 + ch * 8) : *(const u32x4*)(s.KRp + (krow + row) * 32 + (ch - 8) * 8); }
  else { const int row = id >> 3, ch = id & 7; return *(const u32x4*)(s.K + (krow + row) * 512 + ch * 8); }
}
template <int NS>
__device__ __forceinline__ void st_kchunk(LAS unsigned char* Kt, int id, u32x4 v) {
  constexpr int KP = NS == 6 ? KP_A : KP_B, CPR = NS == 6 ? 12 : 8;
  const int row = id / CPR, ch = id - row * CPR; *(LAS u32x4*)(Kt + row * KP + ch * 16) = v;
}
__device__ __forceinline__ void st_vchunk(LAS unsigned char* Vt, int id, u32x4 v) { const int row = id >> 3, ch = id & 7; *(LAS u32x4*)(Vt + row * 128 + ((ch ^ (((row >> 1) & 1) << 2)) << 4)) = v; }

__device__ __forceinline__ void glds16(const void* gsrc, unsigned lds_dst) {
  unsigned keep;
  asm volatile("s_mov_b32 %0, m0\n\ts_mov_b32 m0, %2\n\ts_nop 0\n\tglobal_load_lds_dwordx4 %1, off\n\ts_mov_b32 m0, %0" : "=&s"(keep) : "v"(gsrc), "s"(lds_dst) : "memory");
}
template <int NS>
__device__ __forceinline__ void dma_tile(LAS unsigned char* Kt, LAS unsigned char* Vt, const KVSrc& src, long krow, int wave, int lane) {
  constexpr int CPR = NS == 6 ? 13 : 9, ND = CPR;
#pragma unroll
  for (int k = 0; k < 2; ++k) { const int d = wave + 8 * k;
    if (d < ND) { const int c = d * 64 + lane, row = c / CPR, ch = c - row * CPR;
      const bf16_t* g = (NS == 6 && ch >= 8 && ch < 12) ? src.KRp + (krow + row) * 32 + (ch - 8) * 8 : src.K + (krow + row) * 512 + (ch < 8 ? ch : 0) * 8;
      glds16(g, (unsigned)__builtin_amdgcn_readfirstlane((int)(unsigned)(uintptr_t)(Kt + d * 1024))); } }
  { const int c = wave * 64 + lane, row = c >> 3, ch = (c & 7) ^ (((row >> 1) & 1) << 2);
    glds16(src.V + (krow + row) * 512 + ch * 8, (unsigned)__builtin_amdgcn_readfirstlane((int)(unsigned)(uintptr_t)(Vt + wave * 1024))); }
}
#define AT_VMWAIT(n) asm volatile("s_waitcnt vmcnt(" #n ")" ::: "memory")
template <int NS, bool BIAS>
__device__ __forceinline__ void attn_unit_shared(LAS unsigned char* lds, const bf16_t* Qw  , int qpitch, const KVSrc src, long krow0,
                                                 int t_lo, int t_hi, int w_lo, int w_hi, int qpos0  , bf16_t* att, float* ssq, int bhead = 0) {
  constexpr int SLOT = 21504, ND = NS == 6 ? 13 : 9;
  int tid_ = threadIdx.x; asm volatile("" : "+v"(tid_));
  const int tid = tid_, lane = tid & 63, wave = __builtin_amdgcn_readfirstlane(tid >> 6), r = lane & 31, h = lane >> 5;
  LAS float* wsf = (LAS float*)(lds + AT_WSF) + wave * 64; const LAS float* btab = (const LAS float*)(lds + AT_BIAS) + bhead * 640;
#pragma unroll
  for (int k = 0; k < 2; ++k) if (t_lo + k <= t_hi) dma_tile<NS>(lds + AT_TILE + k * SLOT, lds + AT_TILE + k * SLOT + 13312, src, krow0 + 64L * (t_lo + k), wave, lane);
  bf16x8 qf[NS];
#pragma unroll
  for (int s = 0; s < NS; ++s) qf[s] = *(const bf16x8*)(Qw + (size_t)r * qpitch + 16 * s + 8 * h);
#pragma unroll
  for (int s = 0; s < NS; ++s) asm volatile("" : "+v"(qf[s]));
  f32x16 o[2];
#pragma unroll
  for (int i = 0; i < 16; ++i) { o[0][i] = 0.f; o[1][i] = 0.f; }
  float m_run = -1e30f, l_run = 0.f;
  AT_VMWAIT(0);
  asm volatile("s_waitcnt lgkmcnt(0)" ::: "memory"); __builtin_amdgcn_s_barrier(); asm volatile("" ::: "memory");
  for (int t0 = t_lo; t0 <= t_hi; t0 += 2) {
#pragma unroll
    for (int k = 2; k < 4; ++k) if (t0 + k <= t_hi) { const int s3 = (t0 + k - t_lo) & 3; dma_tile<NS>(lds + AT_TILE + s3 * SLOT, lds + AT_TILE + s3 * SLOT + 13312, src, krow0 + 64L * (t0 + k), wave, lane); }
#pragma unroll
    for (int k = 0; k < 2; ++k) { const int t = t0 + k; const int sl = (t - t_lo) & 3;
      if (t <= t_hi && t >= w_lo && t <= w_hi) {
        const bool lookup = BIAS && (qpos0 - (64 * t + 63) < 256);
        f32x16 st[2]; attn_qk<NS, BIAS, false>(lds + AT_TILE + sl * SLOT, qf, nullptr, st, 64, btab, 639 - (qpos0 + r - 64 * t + 256), lookup, lane);
        attn_smpv(lds + AT_TILE + sl * SLOT + 13312, st, o, m_run, l_run, wsf, lane);
      } }
    AT_VMWAIT(0);
    asm volatile("s_waitcnt lgkmcnt(0)" ::: "memory"); __builtin_amdgcn_s_barrier(); asm volatile("" ::: "memory");
  }
  scale_o(o, 1.0f / l_run, wsf, lane);
  store_o(o, (LAS bf16_t*)(lds + AT_OSTG) + wave * 2048, att, ssq, 32, lane);
}
template <int NS, bool BIAS>
__device__ __forceinline__ void attn_unit_sample(LAS unsigned char* lds, const bf16_t* Qw, int qpitch, const KVSrc src, long krow0, int ntiles, int nvalid_last, int qpos0, bf16_t* att, float* ssq, int bhead = 0) {
  constexpr int NKC = NS == 6 ? 768 : 512;
  int tid_ = threadIdx.x; asm volatile("" : "+v"(tid_));
  const int tid = tid_, lane = tid & 63, wave = tid >> 6, r = lane & 31, h = lane >> 5;
  LAS float* wsf = (LAS float*)(lds + AT_WSF) + wave * 64; const LAS float* btab = (const LAS float*)(lds + AT_BIAS) + bhead * 640;
  LAS float* cm = (LAS float*)(lds + AT_CMB);
  f32x16 o[2];
#pragma unroll
  for (int i = 0; i < 16; ++i) { o[0][i] = 0.f; o[1][i] = 0.f; }
  float m_run = -1e30f, l_run = 0.f;
  LAS unsigned char* Kt = lds + AT_TILE + (wave & 3) * AT_PRIV; LAS unsigned char* Vt = Kt + 13312;
  bf16x8 qf[NS];
#pragma unroll
  for (int s = 0; s < NS; ++s) qf[s] = *(const bf16x8*)(Qw + (size_t)(r & 15) * qpitch + 16 * s + 8 * h);
  constexpr int NK4 = 4 * NKC / 512;
  u32x4 kc[NK4], vc[4];
#define SMP_LOAD(T0) do { _Pragma("unroll") for (int i = 0; i < NK4; ++i) { const int id = tid + 512 * i, tt = id / NKC, cid = id - tt * NKC; if ((T0) + tt < ntiles) kc[i] = ld_kchunk<NS>(src, krow0 + 64L * ((T0) + tt), cid); } \
    _Pragma("unroll") for (int i = 0; i < 4; ++i) { const int id = tid + 512 * i, tt = id >> 9, cid = id & 511; if ((T0) + tt < ntiles) vc[i] = *(const u32x4*)(src.V + (krow0 + 64L * ((T0) + tt) + (cid >> 3)) * 512 + (cid & 7) * 8); } } while (0)
#define SMP_STORE(T0) do { _Pragma("unroll") for (int i = 0; i < NK4; ++i) { const int id = tid + 512 * i, tt = id / NKC, cid = id - tt * NKC; if ((T0) + tt < ntiles) st_kchunk<NS>(lds + AT_TILE + tt * AT_PRIV, cid, kc[i]); } \
    _Pragma("unroll") for (int i = 0; i < 4; ++i) { const int id = tid + 512 * i, tt = id >> 9, cid = id & 511; if ((T0) + tt < ntiles) st_vchunk(lds + AT_TILE + tt * AT_PRIV + 13312, cid, vc[i]); } } while (0)
  SMP_LOAD(0); SMP_STORE(0);
  __syncthreads();
  for (int t0 = 0; t0 < ntiles; t0 += 4) {
    if (t0 + 4 < ntiles) SMP_LOAD(t0 + 4);
    const int t = t0 + wave;
    if (wave < 4 && t < ntiles) {
      const bool lookup = BIAS && (qpos0 - (64 * t + 63) < 256);
      f32x16 st[2]; attn_qk<NS, BIAS, false>(Kt, qf, nullptr, st, (t == ntiles - 1) ? nvalid_last : 64, btab, 639 - (qpos0 + (r & 15) - 64 * t + 256), lookup, lane);
      attn_smpv(Vt, st, o, m_run, l_run, wsf, lane);
    }
    __syncthreads();
    if (t0 + 4 < ntiles) { SMP_STORE(t0 + 4); }
    __syncthreads();
  }
#undef SMP_LOAD
#undef SMP_STORE
  if (wave < 4 && h == 0) cm[wave * 32 + r] = m_run;
  __syncthreads();
  if (wave < 4) {
    const float M = __builtin_fmaxf(__builtin_fmaxf(cm[r], cm[32 + r]), __builtin_fmaxf(cm[64 + r], cm[96 + r]));
    const float f = __builtin_amdgcn_exp2f(m_run - M);
    scale_o(o, f, wsf, lane);
    if (h == 0) cm[128 + wave * 32 + r] = l_run * f;
    LAS float* po = (LAS float*)(lds + AT_TILE + wave * AT_PRIV);
#pragma unroll
    for (int c = 0; c < 2; ++c)
#pragma unroll
      for (int i = 0; i < 16; ++i) po[(c * 16 + i) * 64 + lane] = o[c][i];
  }
  __syncthreads();
  if (wave == 0) {
    const float l = (cm[128 + r] + cm[160 + r]) + (cm[192 + r] + cm[224 + r]);
#pragma unroll
    for (int w = 1; w < 4; ++w) { const LAS float* po = (const LAS float*)(lds + AT_TILE + w * AT_PRIV);
#pragma unroll
      for (int c = 0; c < 2; ++c)
#pragma unroll
        for (int i = 0; i < 16; ++i) o[c][i] += po[(c * 16 + i) * 64 + lane]; }
    scale_o(o, 1.0f / l, wsf, lane);
    store_o(o, (LAS bf16_t*)(lds + AT_OSTG), att, ssq, 16, lane);
  }
  __syncthreads();
}
__device__ __forceinline__ void load_bias_all(LAS unsigned char* lds, const float* rel_bias) {
  LAS float* btab = (LAS float*)(lds + AT_BIAS);
  for (int i = threadIdx.x; i < 8 * 640; i += NTHREADS) { const int hd = i / 640, j = 639 - (i - hd * 640); btab[i] = rel_bias[hd * 513 + (j > 512 ? 512 : j)] * LOG2E; }
  __syncthreads();
}
__device__ __forceinline__ void attention_phase(ParamsC p, LAS unsigned char* lds, int G, bool dry, int apm = 15) {
  unsigned char* ws = p->ws; const int wave = threadIdx.x >> 6;
  const bf16_t* Q = (const bf16_t*)(ws + WS_Q); const bf16_t* KN = (const bf16_t*)(ws + WS_KN); const bf16_t* V = (const bf16_t*)(ws + WS_V); const bf16_t* KR = (const bf16_t*)(ws + WS_KR);
  const bf16_t* QB = (const bf16_t*)(ws + WS_QB); const bf16_t* KB = (const bf16_t*)(ws + WS_KB); const bf16_t* VB = (const bf16_t*)(ws + WS_VB);
  bf16_t* ATT = (bf16_t*)(ws + WS_XN); float* ssq_a = (float*)(ws + WS_SSQ); float* ssq_b = ssq_a + MT;
  load_bias_all(lds, p->rel_bias);
  for (int u = blockIdx.x; u < 256; u += G) {
    const int b = (u & 127) >> 3, head = u & 7; const int row0 = MP + b * DSQ;
#ifndef AP
#define AP 15
#endif
    if (u < 128) { if (apm & 1) {
      const KVSrc src{KN + head * 64, KR, V + head * 64};
      attn_unit_sample<6, false>(lds, Q + (size_t)row0 * 768 + head * 96, 768, src, (long)MP + (long)b * LROW, 65, 16, 0, ATT + (size_t)row0 * D + head * 64, dry ? nullptr : ssq_a + row0); }
    } else if (apm & 2) {
      const KVSrc src{KB + head * 64, nullptr, VB + head * 64};
      attn_unit_sample<4, true>(lds, QB + (size_t)row0 * 512 + head * 64, 512, src, (long)MP + (long)b * BROW, 9, 16, 512, ATT + (size_t)row0 * D + 512 + head * 64, dry ? nullptr : ssq_b + row0, head);
    }
  }
  if (G == 256) {
    const int vcu = (blockIdx.x & 7) * 32 + (blockIdx.x >> 3), grp = vcu >> 3, mem = vcu & 7; const int b = grp; const long brow = (long)b * SEQ;
    if (apm & 4) for (int i = 0; i < 8; ++i) { const int head = i, qb = (mem + i) & 7; const KVSrc src{KN + head * 64, KR, V + head * 64}; const long qrow = brow + 256 * qb + 32 * wave;
      attn_unit_shared<6, false>(lds, Q + (size_t)qrow * 768 + head * 96, 768, src, brow, 0, 4 * qb + 3, 0, 4 * qb + (wave >> 1), 0, ATT + (size_t)qrow * D + head * 64, dry ? nullptr : ssq_a + qrow); }
    if (apm & 8) for (int i = 0; i < 8; ++i) { const int head = i, cb = (mem + i) & 7;
      const KVSrc src{KB + head * 64, nullptr, VB + head * 64}; const long qrow = brow + 256 * cb + 32 * wave; const int cq = 4 * cb + (wave >> 1); const int tl = 4 * cb - 8 < 0 ? 0 : 4 * cb - 8;
      attn_unit_shared<4, true>(lds, QB + (size_t)qrow * 512 + head * 64, 512, src, brow, tl, 4 * cb + 3, cq - 8, cq, 256 * cb + 32 * wave, ATT + (size_t)qrow * D + 512 + head * 64, dry ? nullptr : ssq_b + qrow, head); }
  } else {
  for (int bh = blockIdx.x; bh < NBATCH * 8; bh += G) {
    const int b = bh >> 3, head = bh & 7; const long brow = (long)b * SEQ;
    if (apm & 4) { const KVSrc src{KN + head * 64, KR, V + head * 64};
      for (int qb = 0; qb < 8; ++qb) { const long qrow = brow + 256 * qb + 32 * wave;
        attn_unit_shared<6, false>(lds, Q + (size_t)qrow * 768 + head * 96, 768, src, brow, 0, 4 * qb + 3, 0, 4 * qb + (wave >> 1), 0, ATT + (size_t)qrow * D + head * 64, dry ? nullptr : ssq_a + qrow); } }
    if (apm & 8) { const KVSrc src{KB + head * 64, nullptr, VB + head * 64};
      for (int cb = 0; cb < 8; ++cb) { const long qrow = brow + 256 * cb + 32 * wave; const int cq = 4 * cb + (wave >> 1); const int tl = 4 * cb - 8 < 0 ? 0 : 4 * cb - 8;
        attn_unit_shared<4, true>(lds, QB + (size_t)qrow * 512 + head * 64, 512, src, brow, tl, 4 * cb + 3, cq - 8, cq, 256 * cb + 32 * wave, ATT + (size_t)qrow * D + 512 + head * 64, dry ? nullptr : ssq_b + qrow, head); } }
  }
  }
}


#define XB_TMO      128
#define XB_XCNT(j)  (256  + 64 * (j))
#define XB_XSUB(j)  (1280 + 64 * (j))
#define XB_XGEN(j)  (2304 + 64 * (j))
#define XB_TOP      3328
#define XB_TOPGEN   3392
#define XCD_BAR_WORDS 3456
#define XB_SPIN_CAP (1u << 18)
__device__ __forceinline__ unsigned xb_ld(unsigned* p)              { return __hip_atomic_load(p, __ATOMIC_RELAXED, __HIP_MEMORY_SCOPE_AGENT); }
__device__ __forceinline__ unsigned xb_add(unsigned* p, unsigned v) { return __hip_atomic_fetch_add(p, v, __ATOMIC_RELAXED, __HIP_MEMORY_SCOPE_AGENT); }
__device__ __forceinline__ unsigned xb_xcc_id() { return (unsigned)__builtin_amdgcn_s_getreg((3 << 11) | 20) & 0xFu; }
#define XB_SPIN(cond, bar) do { unsigned _sp = 0; while (cond) { __builtin_amdgcn_s_sleep(1); \
    if ((++_sp & 255u) == 0u) { if (xb_ld(&(bar)[XB_TMO])) break; if (_sp > XB_SPIN_CAP) { atomicAdd(&(bar)[XB_TMO], 1u); break; } } } } while (0)
__device__ __forceinline__ void xcd_barrier_complete(unsigned* bar, unsigned x, unsigned& nloc, unsigned& nx) {
  const unsigned G = gridDim.x * gridDim.y * gridDim.z;
  unsigned sum, cnt, mine, sp = 0u;
  for (;;) {
    sum = 0u; cnt = 0u; mine = 0u;
#pragma unroll
    for (unsigned j = 0; j < 16; ++j) { const unsigned c = xb_ld(&bar[XB_XCNT(j)]); sum += c; cnt += (c > 0u) ? 1u : 0u; mine = (j == x) ? c : mine; }
    if (sum == G) break;
    __builtin_amdgcn_s_sleep(1);
    if ((++sp & 255u) == 0u) { if (xb_ld(&bar[XB_TMO])) break; if (sp > XB_SPIN_CAP) { atomicAdd(&bar[XB_TMO], 1u); break; } }
  }
  nloc = mine > 0u ? mine : 1u; nx = cnt > 0u ? cnt : 1u;
}
__device__ __forceinline__ void xcd_barrier(unsigned* bar, volatile LAS unsigned* st) {
  asm volatile("s_waitcnt vmcnt(0)" ::: "memory");
  __syncthreads();
  if (threadIdx.x == 0) {
    const unsigned x = xb_xcc_id();
    __builtin_amdgcn_s_waitcnt(0);
    unsigned nloc = st[0], nx = st[1];
    if (nloc == 0u) { xcd_barrier_complete(bar, x, nloc, nx); st[0] = nloc; st[1] = nx; }
    const unsigned old = xb_add(&bar[XB_XSUB(x)], 1u);
    const unsigned gen = old / nloc;
    if (old + 1u == (gen + 1u) * nloc) {
      __builtin_amdgcn_fence(__ATOMIC_RELEASE, "agent");
      asm volatile("s_waitcnt vmcnt(0)" ::: "memory");
      const unsigned og = xb_add(&bar[XB_TOP], 1u);
      const unsigned tg = og / nx;
      if (og + 1u == (tg + 1u) * nx) xb_add(&bar[XB_TOPGEN], 1u);
      else XB_SPIN(xb_ld(&bar[XB_TOPGEN]) == tg, bar);
      __builtin_amdgcn_fence(__ATOMIC_ACQUIRE, "agent");
      xb_add(&bar[XB_XGEN(x)], 1u);
      asm volatile("s_waitcnt vmcnt(0)" ::: "memory");
    } else {
      XB_SPIN(xb_ld(&bar[XB_XGEN(x)]) == gen, bar);
      __builtin_amdgcn_fence(__ATOMIC_ACQUIRE, "agent");
      asm volatile("s_waitcnt vmcnt(0)" ::: "memory");
    }
  }
  __syncthreads();
}

__device__ __forceinline__ ParamsC get_params() {
  ParamsC pp = (ParamsC)__builtin_amdgcn_kernarg_segment_ptr(); asm volatile("" : "+s"(pp)); return pp;
}
__global__ void __launch_bounds__(NTHREADS) mk_fwd(Params p_unused) {
  extern __shared__ __attribute__((aligned(16))) unsigned char lds_raw[];
  LAS unsigned char* lds = (LAS unsigned char*)lds_raw;
  cg::grid_group grid = cg::this_grid();
  const int G = gridDim.x;
  volatile LAS unsigned* xst = (volatile LAS unsigned*)(lds + LDS_BYTES - 16);
  if (threadIdx.x < 2) xst[threadIdx.x] = 0u;
  if (threadIdx.x == 0) (void)xb_add(&((unsigned*)(get_params()->ws + WS_BAR))[XB_XCNT(xb_xcc_id())], 1u);
  __syncthreads();
#define FAST_SYNC() xcd_barrier((unsigned*)(get_params()->ws + WS_BAR), xst)
#define WSP(T, off) ((T*)(get_params()->ws + (off)))
#define ssq WSP(float, WS_SSQ)
#define X1B WSP(bf16_t, WS_X1B)
#define XN WSP(bf16_t, WS_XN)
#define CQN WSP(bf16_t, WS_CQN)
#define CKV WSP(bf16_t, WS_CKV)
#define KR WSP(bf16_t, WS_KR)
#define QB WSP(bf16_t, WS_QB)
#define KB WSP(bf16_t, WS_KB)
#define VB WSP(bf16_t, WS_VB)
#define Q WSP(bf16_t, WS_Q)
#define KN WSP(bf16_t, WS_KN)
#define V WSP(bf16_t, WS_V)
#define H WSP(bf16_t, WS_H)
  pg8::StaticOrder S;
#ifndef PH
#define PH 255
#endif
  if (PH & 1) prologue(get_params(), lds, G);
#ifdef DUP_P0
  grid.sync(); prologue(get_params(), lds, G);
#endif
  grid.sync();
  if (PH & 2) { pg8::Gemm g{XN, (const bf16_t*)(get_params()->ws + WS_WIN), 1024, 1024, 1024}; S.init(MT, NIN, G, blockIdx.x);
    ParamsC pp = get_params(); EpiIn E{pp->out, CQN, CKV, KR, QB, KB, VB, pp->g_kv, (LAS float*)(lds + LDS_RED)};
    pg8::gemm_phase(lds, g, S, E); }
  FAST_SYNC();
  if ((PH & 4) && !(PH & 256)) { pg8::Gemm g{CQN, (const bf16_t*)(get_params()->ws + WS_WUQ), 256, 256, 256}; S.init(MT, 768, G, blockIdx.x); EpiQ E{Q}; pg8::gemm_phase(lds, g, S, E); }
  if ((PH & 4) && !(PH & 512)) { pg8::Gemm g{CKV, (const bf16_t*)(get_params()->ws + WS_WKV), 256, 256, 256}; S.init(MLAT, 1024, G, blockIdx.x); EpiKV E{KN, V}; pg8::gemm_phase(lds, g, S, E); }
  FAST_SYNC();
  if (PH & 8) attention_phase(get_params(), lds, G, false);
#ifdef DUP_ATTN
  grid.sync(); attention_phase(get_params(), lds, G, true, DUP_ATTN);
#endif
  FAST_SYNC();
  if (PH & 16) { pg8::Gemm g{XN  , (const bf16_t*)(get_params()->ws + WS_WO), 1024, 1024, 1024}; S.init(MT, 1024, G, blockIdx.x);
    ParamsC pp = get_params(); EpiO E{8, ssq, ssq + MT, pp->xp, pp->xs, X1B, ssq + 2 * MT, (LAS float*)(lds + LDS_RED), 0.f, 0.f, 0}; pg8::gemm_phase(lds, g, S, E); }
  FAST_SYNC();
  if (PH & 32) { pg8::Gemm g{X1B, (const bf16_t*)(get_params()->ws + WS_WGU), 1024, 1024, 1024}; S.init(MT, NGU, G, blockIdx.x); EpiGU E{ssq + 2 * MT, H, (LAS float*)(lds + LDS_RED), 0.f, 0}; pg8::gemm_phase(lds, g, S, E);
#ifdef DUP_P5
    grid.sync(); pg8::gemm_phase(lds, g, S, E);
#endif
  }
  FAST_SYNC();
#define PART WSP(float, WS_Q)
  if (PH & 64) { pg8::Gemm g{H, (const bf16_t*)(get_params()->ws + WS_WD), FF, FF, FF}; S.init(MP, 1024, G, blockIdx.x); EpiD E{X1B, ssq + 3 * MT}; pg8::gemm_phase(lds, g, S, E);
    pg8::Gemm g2{H, (const bf16_t*)(get_params()->ws + WS_WD), FF, FF, 256}; pg8::SplitOrder S2{MP / 256, 4, 44, 256, G, (int)blockIdx.x}; EpiPart E2{PART}; pg8::gemm_phase(lds, g2, S2, E2); }
  FAST_SYNC();
  if (PH & 128) { ParamsC p = get_params(); int t7 = threadIdx.x; asm volatile("" : "+v"(t7)); const int lane = t7 & 63, gw = blockIdx.x * 8 + (t7 >> 6), NGW = G * 8; const float* s2 = ssq + 3 * MT;
    f32x4 gf[4];
#pragma unroll
    for (int j = 0; j < 2; ++j) { gf[2 * j] = *(const f32x4*)(p->g_final + 8 * lane + 512 * j); gf[2 * j + 1] = *(const f32x4*)(p->g_final + 8 * lane + 512 * j + 4); }
    for (int rr0 = gw; rr0 < MT; rr0 += 4 * NGW) {
      u32x4 raw[4][2]; int rows[4];
#pragma unroll
      for (int k = 0; k < 4; ++k) { const int rr = rr0 + k * NGW; rows[k] = rr < MS ? MP + rr : rr - MS;
        if (rr < MT) { const bf16_t* x = X1B + (size_t)rows[k] * D;
#pragma unroll
          for (int j = 0; j < 2; ++j) raw[k][j] = *(const u32x4*)(x + 8 * lane + 512 * j); } }
#pragma unroll
      for (int k = 0; k < 4; ++k) { const int rr = rr0 + k * NGW, row = rows[k]; if (rr < MT) {
        f32x4 v[4];
#pragma unroll
        for (int j = 0; j < 2; ++j) { const u32x4 w = raw[k][j];
          v[2 * j] = (f32x4){__builtin_bit_cast(float, w.x << 16), __builtin_bit_cast(float, w.x & 0xffff0000u), __builtin_bit_cast(float, w.y << 16), __builtin_bit_cast(float, w.y & 0xffff0000u)};
          v[2 * j + 1] = (f32x4){__builtin_bit_cast(float, w.z << 16), __builtin_bit_cast(float, w.z & 0xffff0000u), __builtin_bit_cast(float, w.w << 16), __builtin_bit_cast(float, w.w & 0xffff0000u)}; }
        float* y = p->out + OFF_Y + (size_t)row * D; float rstd;
        if (row >= MP) { float s = 0.f;
#pragma unroll 4
          for (int kc = 0; kc < 11; ++kc) { const float* pr = PART + ((size_t)kc * 256 + (row - MP)) * D;
#pragma unroll
            for (int j = 0; j < 2; ++j) { v[2 * j] = v[2 * j] + *(const f32x4*)(pr + 8 * lane + 512 * j); v[2 * j + 1] = v[2 * j + 1] + *(const f32x4*)(pr + 8 * lane + 512 * j + 4); } }
#pragma unroll
          for (int j = 0; j < 4; ++j) s += (v[j][0] * v[j][0] + v[j][1] * v[j][1]) + (v[j][2] * v[j][2] + v[j][3] * v[j][3]);
          rstd = __builtin_amdgcn_rsqf(wave_sum(s) * (1.0f / D) + EPS);
        } else rstd = __builtin_amdgcn_rsqf(s2[row] * (1.0f / D) + EPS);
#pragma unroll
        for (int j = 0; j < 2; ++j) { *(f32x4*)(y + 8 * lane + 512 * j) = v[2 * j] * rstd * gf[2 * j]; *(f32x4*)(y + 8 * lane + 512 * j + 4) = v[2 * j + 1] * rstd * gf[2 * j + 1]; } } } } }
}

#undef FAST_SYNC
#undef ssq
#undef X1B
#undef XN
#undef CQN
#undef CKV
#undef KR
#undef QB
#undef KB
#undef VB
#undef Q
#undef KN
#undef V
#undef H
#undef PART
extern "C" void kernel_launch(void* const* d_in, const int* in_sizes, int n_in, void* d_out, int out_size, void* d_ws, size_t ws_size, hipStream_t stream) {
  static int grid = 0;
  if (grid == 0) {
    if (n_in != 22 || (size_t)out_size != OUT_TOTAL || ws_size < WS_TOTAL) { fprintf(stderr, "kernel_launch: unexpected shapes (n_in %d out %d ws %zu, need ws %zu)\n", n_in, out_size, ws_size, (size_t)WS_END); grid = -1; return; }
    int dev = 0, cus = 0, per_cu = 0;
    hipGetDevice(&dev); hipDeviceGetAttribute(&cus, hipDeviceAttributeMultiprocessorCount, dev);
    hipFuncSetAttribute((const void*)mk_fwd, hipFuncAttributeMaxDynamicSharedMemorySize, LDS_BYTES);
    hipOccupancyMaxActiveBlocksPerMultiprocessor(&per_cu, (const void*)mk_fwd, NTHREADS, LDS_BYTES);
    if (per_cu < 1 || cus < 1) { fprintf(stderr, "kernel_launch: occupancy query gave %d blocks/CU on %d CUs\n", per_cu, cus); grid = -1; return; }
    grid = cus * (per_cu > 1 ? 1 : per_cu);
  }
  if (grid < 0) return;
  Params p{};
  const float** pp = (const float**)&p;
  for (int i = 0; i < 22; ++i) pp[i] = (const float*)d_in[i];
  p.out = (float*)d_out; p.ws = (unsigned char*)d_ws;
  if (hipMemsetAsync((char*)d_ws + WS_BAR, 0, 16384, stream) != hipSuccess) { fprintf(stderr, "kernel_launch: memset of barrier words failed\n"); return; }
  void* args[] = {&p};
  hipError_t e = hipLaunchCooperativeKernel((void*)mk_fwd, dim3(grid), dim3(NTHREADS), args, LDS_BYTES, stream);
  if (e != hipSuccess) fprintf(stderr, "cooperative launch failed: %s (grid %d)\n", hipGetErrorString(e), grid);
}
```
